# Optimizing an MI355X kernel written in HIP

```python
import math
import jax
import jax.numpy as jnp
from jax import lax
import numpy as np


D_MODEL = 1024
BATCH = 8
SEQ = 4096
DEPTH = 1

D_MIX = D_MODEL
HEAD_DIM = 64
D_HYENA = D_MIX // 2
D_FOURIER = D_MIX - D_HYENA
N_HYENA_HEADS = D_HYENA // HEAD_DIM
N_FOURIER_GROUPS = D_FOURIER // HEAD_DIM
N_MIX_HEADS = N_HYENA_HEADS + N_FOURIER_GROUPS
D_IN_PROJ = 3 * D_HYENA + D_FOURIER
SHORT_CONV = 3
FILTER_EMB = 33
FILTER_BANDS = (FILTER_EMB - 1) // 2
FILTER_ORDER = 64
N_INNER_MLPS = 2
DECAY_FAST_PCT = 0.3
DECAY_SLOW_PCT = 1.5
DECAY_TARGET = 1e-2
N_GROUPS = 4
EXPERTS_PER_GROUP = 8
N_EXPERTS = N_GROUPS * EXPERTS_PER_GROUP
TOP_K = 2
D_EXPERT = D_MODEL // 2
MOE_BLOCK = 128
EPS = 1e-6

kernel_name = "hyena_fnet_hier_moe_block"


def rmsnorm(x, g):
    xf = x.astype(jnp.float32)
    y = xf * lax.rsqrt(jnp.mean(xf * xf, axis=-1, keepdims=True) + EPS)
    return (y * g.astype(jnp.float32)).astype(x.dtype)


def short_conv_centred(u, w, b):
    L = u.shape[1]
    half = SHORT_CONV // 2
    up = jnp.pad(u, ((0, 0), (half, half), (0, 0)))
    y = b
    for k in range(SHORT_CONV):
        y = y + up[:, k:k + L] * w[k]
    return y


def hyena_filters(L, f_w_in, f_b_in, f_w_mid, f_b_mid, f_freq, f_w_out):
    t = jnp.linspace(0.0, 1.0, L, dtype=jnp.float32)[:, None]
    w = (2.0 * math.pi / L) * jnp.arange(L, dtype=jnp.float32)[:, None]
    f = jnp.linspace(1e-4, FILTER_BANDS - 1, FILTER_BANDS, dtype=jnp.float32)[None, :]
    z = jnp.concatenate([t, jnp.cos(f * w), -jnp.sin(f * w)], axis=-1)
    h = jnp.sin(f_freq[0] * (z @ f_w_in + f_b_in))
    for i in range(N_INNER_MLPS):
        h = jnp.sin(f_freq[i + 1] * (h @ f_w_mid[i] + f_b_mid[i]))
    h = (h @ f_w_out).astype(jnp.float32).reshape(L, 2, D_HYENA)
    max_decay = math.log(DECAY_TARGET) / DECAY_FAST_PCT
    min_decay = math.log(DECAY_TARGET) / DECAY_SLOW_PCT
    deltas = jnp.abs(jnp.linspace(min_decay, max_decay, D_HYENA, dtype=jnp.float32))
    decay = jnp.exp(-t * deltas)
    h = h * decay[:, None, :]
    return h[:, 0], h[:, 1]


def bidirectional_long_conv(u, h_fwd, h_bwd):
    L = u.shape[1]
    k = jnp.concatenate([h_fwd, jnp.zeros_like(h_fwd[:1]), h_bwd[:0:-1]], axis=0)
    k = k / jnp.sum(jnp.abs(k), axis=0, keepdims=True)
    k_f = jnp.fft.rfft(k, n=2 * L, axis=0)
    u_f = jnp.fft.rfft(u, n=2 * L, axis=1)
    return jnp.fft.irfft(u_f * k_f[None], n=2 * L, axis=1)[:, :L]


def hyena_mixer(u, conv_w, conv_b, f_w_in, f_b_in, f_w_mid, f_b_mid, f_freq, f_w_out, f_bias):
    uc = short_conv_centred(u, conv_w, conv_b).astype(jnp.float32)
    x0, x1, v = jnp.split(uc, 3, axis=-1)
    h_fwd, h_bwd = hyena_filters(u.shape[1], f_w_in, f_b_in, f_w_mid, f_b_mid, f_freq, f_w_out)
    z = x1 * v
    z = bidirectional_long_conv(z, h_fwd, h_bwd) + z * f_bias.astype(jnp.float32)
    return x0 * z


def fourier_mixer(u):
    B, L, _ = u.shape
    ug = u.astype(jnp.float32).reshape(B, L, N_FOURIER_GROUPS, HEAD_DIM)
    y = jnp.fft.fftn(ug, axes=(1, 3), norm='ortho').real
    return y.reshape(B, L, D_FOURIER)


def head_rmsnorm(y, g):
    B, L, _ = y.shape
    yh = y.reshape(B, L, N_MIX_HEADS, HEAD_DIM)
    yh = yh * lax.rsqrt(jnp.mean(yh * yh, axis=-1, keepdims=True) + EPS)
    return yh.reshape(B, L, D_MIX) * g.astype(jnp.float32)


def mixer_sublayer(x, norm_g, w_in, conv_w, conv_b, f_w_in, f_b_in, f_w_mid, f_b_mid, f_freq, f_w_out,
                   f_bias, mix_g, w_out):
    h = rmsnorm(x, norm_g)
    proj = h @ w_in
    y_hyena = hyena_mixer(proj[..., :3 * D_HYENA], conv_w, conv_b, f_w_in, f_b_in, f_w_mid, f_b_mid,
                          f_freq, f_w_out, f_bias)
    y_fourier = fourier_mixer(proj[..., 3 * D_HYENA:])
    y = head_rmsnorm(jnp.concatenate([y_hyena, y_fourier], axis=-1), mix_g).astype(x.dtype)
    return x + y @ w_out


def hierarchical_moe(h, w_group, b_group, w_router, b_router, w_gate, w_up, w_down):
    B, L, D = h.shape
    T = B * L
    tok = h.reshape(T, D)
    g_logits = (tok @ w_group).astype(jnp.float32) + b_group.astype(jnp.float32)
    g_sel = jnp.argmax(g_logits, axis=-1)
    p_group = jnp.take_along_axis(jax.nn.softmax(g_logits, axis=-1), g_sel[:, None], axis=-1)[:, 0]
    e_logits = jnp.einsum('td,gde->tge', tok, w_router).astype(jnp.float32) + b_router.astype(jnp.float32)
    e_logits = jnp.take_along_axis(e_logits, g_sel[:, None, None], axis=1)[:, 0]
    top_l, top_i = lax.top_k(e_logits, TOP_K)
    weight = p_group[:, None] * jax.nn.softmax(top_l, axis=-1)
    expert = (g_sel[:, None] * EXPERTS_PER_GROUP + top_i).astype(jnp.int32)

    P = T * TOP_K
    flat_e = expert.reshape(P)
    flat_t = jnp.repeat(jnp.arange(T, dtype=jnp.int32), TOP_K)
    flat_w = weight.reshape(P)
    order = jnp.argsort(flat_e)
    se = flat_e[order]
    counts = jnp.bincount(flat_e, length=N_EXPERTS).astype(jnp.int32)
    starts = jnp.cumsum(counts) - counts
    padded = ((counts + MOE_BLOCK - 1) // MOE_BLOCK) * MOE_BLOCK
    pad_ends = jnp.cumsum(padded)
    pad_starts = pad_ends - padded
    dest = pad_starts[se] + (jnp.arange(P, dtype=jnp.int32) - starts[se])
    n_blocks = -(-P // MOE_BLOCK) + N_EXPERTS
    n_rows = n_blocks * MOE_BLOCK
    row_tok = jnp.zeros((n_rows,), jnp.int32).at[dest].set(flat_t[order])
    row_w = jnp.zeros((n_rows,), jnp.float32).at[dest].set(flat_w[order])
    block_start = jnp.arange(n_blocks, dtype=jnp.int32) * MOE_BLOCK
    block_e = jnp.minimum(jnp.searchsorted(pad_ends, block_start, side='right'), N_EXPERTS - 1)

    def expert_block(args):
        e, rows_tok, rows_w = args
        xb = tok[rows_tok]
        a = xb @ w_gate[e]
        u = xb @ w_up[e]
        y = (jax.nn.silu(a) * u) @ w_down[e]
        return (y * rows_w[:, None].astype(y.dtype)).astype(tok.dtype)

    ys = lax.map(expert_block, (block_e, row_tok.reshape(n_blocks, MOE_BLOCK), row_w.reshape(n_blocks, MOE_BLOCK)))
    out = jnp.zeros((T, D), tok.dtype).at[row_tok].add(ys.reshape(n_rows, D))
    return out.reshape(B, L, D)


def setup_inputs(seed: int = 0) -> dict:
    key = jax.random.key(seed)
    ks = jax.random.split(key, 24)
    f32 = jnp.float32
    n = lambda k, shape, s: (jax.random.normal(k, shape, f32) * s)
    return {
        'x': n(ks[0], (BATCH, SEQ, D_MODEL), 1.0),
        'norm1_g': 1.0 + n(ks[1], (DEPTH, D_MODEL), 0.02),
        'w_in': n(ks[2], (DEPTH, D_MODEL, D_IN_PROJ), D_MODEL ** -0.5),
        'conv_w': n(ks[3], (DEPTH, SHORT_CONV, 3 * D_HYENA), SHORT_CONV ** -0.5),
        'conv_b': n(ks[4], (DEPTH, 3 * D_HYENA), 0.02),
        'f_w_in': n(ks[5], (DEPTH, FILTER_EMB, FILTER_ORDER), FILTER_EMB ** -0.5),
        'f_b_in': n(ks[6], (DEPTH, FILTER_ORDER), 0.1),
        'f_w_mid': n(ks[7], (DEPTH, N_INNER_MLPS, FILTER_ORDER, FILTER_ORDER), FILTER_ORDER ** -0.5),
        'f_b_mid': n(ks[8], (DEPTH, N_INNER_MLPS, FILTER_ORDER), 0.1),
        'f_freq': 1.0 + n(ks[9], (DEPTH, N_INNER_MLPS + 1, FILTER_ORDER), 0.1),
        'f_w_out': n(ks[10], (DEPTH, FILTER_ORDER, 2 * D_HYENA), FILTER_ORDER ** -0.5),
        'f_bias': n(ks[11], (DEPTH, D_HYENA), 1.0),
        'mix_g': 1.0 + n(ks[12], (DEPTH, D_MIX), 0.02),
        'w_out': n(ks[13], (DEPTH, D_MIX, D_MODEL), D_MIX ** -0.5),
        'norm2_g': 1.0 + n(ks[14], (DEPTH, D_MODEL), 0.02),
        'w_group': n(ks[15], (DEPTH, D_MODEL, N_GROUPS), D_MODEL ** -0.5),
        'b_group': n(ks[16], (DEPTH, N_GROUPS), 0.01),
        'w_router': n(ks[17], (DEPTH, N_GROUPS, D_MODEL, EXPERTS_PER_GROUP), D_MODEL ** -0.5),
        'b_router': n(ks[18], (DEPTH, N_GROUPS, EXPERTS_PER_GROUP), 0.01),
        'w_gate': n(ks[19], (DEPTH, N_EXPERTS, D_MODEL, D_EXPERT), D_MODEL ** -0.5),
        'w_up': n(ks[20], (DEPTH, N_EXPERTS, D_MODEL, D_EXPERT), D_MODEL ** -0.5),
        'w_down': n(ks[21], (DEPTH, N_EXPERTS, D_EXPERT, D_MODEL), D_EXPERT ** -0.5),
        'final_g': 1.0 + n(ks[22], (D_MODEL,), 0.02),
    }


def reference(x, norm1_g, w_in, conv_w, conv_b, f_w_in, f_b_in, f_w_mid, f_b_mid, f_freq, f_w_out, f_bias,
              mix_g, w_out, norm2_g, w_group, b_group, w_router, b_router, w_gate, w_up, w_down, final_g):
    for i in range(DEPTH):
        x = mixer_sublayer(x, norm1_g[i], w_in[i], conv_w[i], conv_b[i], f_w_in[i], f_b_in[i], f_w_mid[i],
                           f_b_mid[i], f_freq[i], f_w_out[i], f_bias[i], mix_g[i], w_out[i])
        x = x + hierarchical_moe(rmsnorm(x, norm2_g[i]), w_group[i], b_group[i], w_router[i], b_router[i],
                                 w_gate[i], w_up[i], w_down[i])
    return rmsnorm(x, final_g)
```

```cpp
#include <hip/hip_runtime.h>
#include <cstdio>
#include <cstdint>

#define MK_N_LAUNCHES 10
#define MK_CHECK 0

constexpr int D_MODEL = 1024, BATCH = 8, SEQ = 4096, T_TOK = BATCH * SEQ;
constexpr int D_HYENA = 512, D_FOURIER = 512, D_IN_PROJ = 2048, N_EXP = 32, D_EXPERT = 512;
constexpr int NPT_ROWS = 2560;
constexpr float EPS = 1e-6f;
constexpr int MAX_ROWS = 65536 + 32 * 256;
constexpr int MAX_TILES = MAX_ROWS / 256;
constexpr int NWAVES = 8, NTHREADS = 512;

constexpr size_t MiB = 1u << 20;
constexpr size_t WS_CTL = 0, CTL_ZERO_BYTES = 64 * 1024;
constexpr size_t WS_CNT = 64 * 1024;
constexpr size_t WS_TILE_E = 128 * 1024;
constexpr size_t WS_CHK = 192 * 1024;
constexpr size_t WS_EXPID = 1 * MiB;
constexpr size_t WS_EXPW = 1 * MiB + 256 * 1024;
constexpr size_t WS_LIST = 2 * MiB;
constexpr size_t WS_ROWW = 2 * MiB + 512 * 1024;
constexpr size_t WS_TW4096 = 3 * MiB;
constexpr size_t WS_TW8192 = 3 * MiB + 32 * 1024;
constexpr size_t WS_H3 = 4 * MiB;
constexpr size_t WS_WIN_T = 8 * MiB;
constexpr size_t WS_WOUT_T = 13 * MiB;
constexpr size_t WS_WGU_T = 16 * MiB;
constexpr size_t WS_WD_T = 80 * MiB;
constexpr size_t WS_KF = 112 * MiB;
constexpr size_t WS_HN = 144 * MiB;
constexpr size_t WS_PT = 208 * MiB;
constexpr size_t WS_YT = 368 * MiB;
constexpr size_t WS_YN = 440 * MiB;
constexpr size_t WS_END = 504 * MiB;

constexpr int LDS_BYTES = 147456;
constexpr int BARST_OFF = LDS_BYTES - 64;
constexpr int FFT_BUF_BYTES = 4352 * 8;
constexpr int L_BUFA = 0, L_BUFB = FFT_BUF_BYTES, L_TW = 2 * FFT_BUF_BYTES, L_SCR = L_TW + 32768, L_RED = L_SCR + 32768;
static_assert(L_RED + 1024 <= BARST_OFF, "LDS map");

#define GAS __attribute__((address_space(1)))
#define LAS __attribute__((address_space(3)))
typedef unsigned short bf16;
typedef float f32x4 __attribute__((ext_vector_type(4)));
typedef float f32x2 __attribute__((ext_vector_type(2)));
typedef unsigned u32x4 __attribute__((ext_vector_type(4)));
typedef unsigned u32x2 __attribute__((ext_vector_type(2)));
#define LDS_WAIT() asm volatile("s_waitcnt lgkmcnt(0)" ::: "memory")
__device__ __forceinline__ unsigned f2bf(float f) { unsigned u = __builtin_bit_cast(unsigned, f); return (u + 0x7fffu + ((u >> 16) & 1u)) >> 16; }
__device__ __forceinline__ unsigned pk2(float lo, float hi) { return f2bf(lo) | (f2bf(hi) << 16); }
__device__ __forceinline__ float bflo(unsigned w) { return __builtin_bit_cast(float, w << 16); }
__device__ __forceinline__ float bfhi(unsigned w) { return __builtin_bit_cast(float, w & 0xffff0000u); }
__device__ __forceinline__ float bf1(bf16 h) { return __builtin_bit_cast(float, (unsigned)h << 16); }
__device__ __forceinline__ float wave_sum(float v) {
#pragma unroll
    for (int o = 1; o < 64; o <<= 1) v += __shfl_xor(v, o);
    return v;
}

namespace pg8 {
#define PG8_LAS __attribute__((address_space(3)))
typedef unsigned short bf16_t;
typedef short bf16x8 __attribute__((ext_vector_type(8)));
typedef float f32x4 __attribute__((ext_vector_type(4)));
typedef unsigned u32x4 __attribute__((ext_vector_type(4)));
typedef unsigned u32x2 __attribute__((ext_vector_type(2)));
constexpr int BM = 256, BK = 64, HALF = 128, HTB = HALF * BK * 2  , STAGE_BYTES = 8 * HTB, NXCD = 8, WGM = 8;

__host__ __device__ __forceinline__ int lds_byte(int r, int c) { const int st = (r >> 4) * 2 + (c >> 5), rr = r & 15, cc = c & 31, ob = rr * 64 + cc * 2; return st * 1024 + (ob ^ (((ob >> 9) & 1) << 5)); }
__host__ __device__ __forceinline__ void stage_rc(int b, int& R, int& C) { const int st = b / 1024, sb = b % 1024, swz = sb ^ (((sb >> 9) & 1) << 5); R = (st >> 1) * 16 + swz / 64; C = (st & 1) * 32 + (swz % 64) / 2; }
__host__ __device__ __forceinline__ int perm32(int rho) { const int n = rho >> 4, i = rho & 15; return 8 * (i >> 2) + 4 * n + (i & 3); }

struct Unit { int pm, pn; const char* a; const char* b; };

struct StaticOrder {
    int nM, nN, nwg, G, c; const char* A; const char* Bt; size_t tstep;
    __device__ void init(const void* A_, const void* Bt_, int M, int N, int K, int G_, int c_) { A = (const char*)A_; Bt = (const char*)Bt_; nM = M / BM; nN = N / BM; nwg = nM * nN; G = G_; c = c_; tstep = (size_t)BM * K * 2; }
    __device__ bool next(int i, Unit& u) const {
        const long L = (long)i * G + c; if (L >= nwg) return false;
        int wgid = (int)L; { const int q = nwg / NXCD, r = nwg % NXCD, xcd = wgid % NXCD, off = wgid / NXCD; wgid = (xcd < r ? xcd * (q + 1) : r * (q + 1) + (xcd - r) * q) + off; }
        const int nig = WGM * nN, gid = wgid / nig, fm = gid * WGM, gsz = (nM - fm) < WGM ? (nM - fm) : WGM;
        u.pm = fm + ((wgid % nig) % gsz); u.pn = (wgid % nig) / gsz; u.a = A + (size_t)u.pm * tstep; u.b = Bt + (size_t)u.pn * tstep; return true;
    }
};
struct MoeOrder {
    int nwg, G, c; const char* A; const char* Bt; const int* tile_e; size_t a_tstep, b_tstep;
    __device__ void init(const void* A_, const void* Bt_, const int* tile_e_, int ntiles, int K, int G_, int c_) { A = (const char*)A_; Bt = (const char*)Bt_; tile_e = tile_e_; nwg = ntiles * 4; G = G_; c = c_; a_tstep = (size_t)BM * K * 2; b_tstep = (size_t)BM * K * 2; }
    __device__ bool next(int i, Unit& u) const {
        const long L = (long)i * G + c; if (L >= nwg) return false;
        int wgid = (int)L; { const int q = nwg / NXCD, r = nwg % NXCD, xcd = wgid % NXCD, off = wgid / NXCD; wgid = (xcd < r ? xcd * (q + 1) : r * (q + 1) + (xcd - r) * q) + off; }
        u.pm = wgid >> 2; u.pn = wgid & 3; const int e = __builtin_amdgcn_readfirstlane(tile_e[u.pm]);
        u.a = A + (size_t)u.pm * a_tstep; u.b = Bt + (size_t)(e * 4 + u.pn) * b_tstep; return true;
    }
};

__device__ __forceinline__ unsigned cvt_pk_bf16(float lo, float hi) { unsigned r; asm volatile("v_cvt_pk_bf16_f32 %0, %1, %2" : "=v"(r) : "v"(lo), "v"(hi)); return r; }

struct EpiStoreBf16 {
    static constexpr bool PERM = true;
    bf16_t* O; int ldc;
    __device__ __forceinline__ void operator()(const f32x4 (&acc)[2][2][4][2], const Unit& u, int wr, int wc, int fr, int fq) const {
        const int row0 = u.pm * BM + wr * 64 + fr; const int col0 = u.pn * BM + wc * 32 + 8 * fq;
#pragma unroll
        for (int ai = 0; ai < 2; ++ai)
#pragma unroll
            for (int m = 0; m < 4; ++m) { bf16_t* rowp = O + (size_t)(row0 + ai * HALF + m * 16) * ldc + col0;
#pragma unroll
                for (int bj = 0; bj < 2; ++bj) { const f32x4 v0 = acc[ai][bj][m][0], v1 = acc[ai][bj][m][1];
                    u32x4 w; w.x = cvt_pk_bf16(v0[0], v0[1]); w.y = cvt_pk_bf16(v0[2], v0[3]); w.z = cvt_pk_bf16(v1[0], v1[1]); w.w = cvt_pk_bf16(v1[2], v1[3]);
                    *(u32x4*)(rowp + bj * HALF) = w; } }
    }
};
struct EpiResF32 {
    static constexpr bool PERM = false;
    const float* base; float* out; int ldc;
    __device__ __forceinline__ void operator()(const f32x4 (&acc)[2][2][4][2], const Unit& u, int wr, int wc, int fr, int fq) const {
        const int row0 = u.pm * BM + wr * 64 + fr; const int col0 = u.pn * BM + wc * 32 + 4 * fq;
#pragma unroll
        for (int ai = 0; ai < 2; ++ai)
#pragma unroll
            for (int m = 0; m < 4; ++m) { const size_t off = (size_t)(row0 + ai * HALF + m * 16) * ldc + col0;
#pragma unroll
                for (int bj = 0; bj < 2; ++bj)
#pragma unroll
                    for (int n = 0; n < 2; ++n) { const f32x4 bs = *(const f32x4*)(base + off + bj * HALF + n * 16); *(f32x4*)(out + off + bj * HALF + n * 16) = bs + acc[ai][bj][m][n]; } }
    }
};
struct EpiSwiGLU {
    static constexpr bool PERM = false;
    bf16_t* H;
    __device__ __forceinline__ void operator()(const f32x4 (&acc)[2][2][4][2], const Unit& u, int wr, int wc, int fr, int fq) const {
        const int row0 = u.pm * BM + wr * 64 + fr;
#pragma unroll
        for (int ai = 0; ai < 2; ++ai)
#pragma unroll
            for (int m = 0; m < 4; ++m) { bf16_t* rowp = H + (size_t)(row0 + ai * HALF + m * 16) * 512 + u.pn * 128 + wc * 32 + 4 * fq;
#pragma unroll
                for (int n = 0; n < 2; ++n) { const f32x4 g = acc[ai][0][m][n], up = acc[ai][1][m][n]; f32x4 h;
#pragma unroll
                    for (int q = 0; q < 4; ++q) h[q] = g[q] * __builtin_amdgcn_rcpf(1.0f + __expf(-g[q])) * up[q];
                    u32x2 w; w.x = cvt_pk_bf16(h[0], h[1]); w.y = cvt_pk_bf16(h[2], h[3]); *(u32x2*)(rowp + n * 16) = w; } }
    }
};
struct EpiMoeDown {
    static constexpr bool PERM = true;
    bf16_t* YP; const int* list; const float* roww;
    __device__ __forceinline__ void operator()(const f32x4 (&acc)[2][2][4][2], const Unit& u, int wr, int wc, int fr, int fq) const {
        const int row0 = u.pm * BM + wr * 64 + fr; const int col0 = u.pn * BM + wc * 32 + 8 * fq;
#pragma unroll
        for (int ai = 0; ai < 2; ++ai)
#pragma unroll
            for (int m = 0; m < 4; ++m) { const int row = row0 + ai * HALF + m * 16; const int pair = list[row]; const float w = roww[row];
                if (pair >= 0) { bf16_t* rowp = YP + (size_t)pair * 1024 + col0;
#pragma unroll
                    for (int bj = 0; bj < 2; ++bj) { const f32x4 v0 = acc[ai][bj][m][0] * w, v1 = acc[ai][bj][m][1] * w;
                        u32x4 o; o.x = cvt_pk_bf16(v0[0], v0[1]); o.y = cvt_pk_bf16(v0[2], v0[3]); o.z = cvt_pk_bf16(v1[0], v1[1]); o.w = cvt_pk_bf16(v1[2], v1[3]);
                        *(u32x4*)(rowp + bj * HALF) = o; } } }
    }
};

template <class Epi, class Sched, bool ALIGN_EPI = true>
__device__ __forceinline__ void gemm_phase(PG8_LAS unsigned char* lds, const int K, const Sched& S, const Epi& E) {
    const int tid = threadIdx.x, wid = __builtin_amdgcn_readfirstlane(tid >> 6), lane = tid & 63, wr = wid >> 2, wc = wid & 3, fr = lane & 15, fq = lane >> 4;
    const int nt = K / BK;
    unsigned voffA[2], voffB[2];
#pragma unroll
    for (int i = 0; i < 2; ++i) { int R, C; stage_rc(tid * 16 + i * 8192, R, C); const int Rb = Epi::PERM ? ((R & ~31) + perm32(R & 31)) : R;
        voffA[i] = (unsigned)(R * K + C) * 2u; voffB[i] = (unsigned)(Rb * K + C) * 2u; }
    const size_t kstep = (size_t)(BK * 2);
    const size_t hstep = (size_t)HALF * K * 2;
    const unsigned ldsw = (unsigned)wid * 1024u;
    const int aoff = lds_byte(wr * 64 + fr, fq * 8), boff = lds_byte(wc * 32 + fr, fq * 8);
#define PG8_SA(b, h) (((b) * 2 + (h)) * HTB)
#define PG8_SB(b, h) ((4 + (b) * 2 + (h)) * HTB)
#define PG8_STAGE(bufoff, gbase, voff) do { _Pragma("unroll") for (int _i = 0; _i < 2; ++_i) \
        __builtin_amdgcn_global_load_lds((const unsigned*)((const char*)(gbase) + (voff)[_i]), (PG8_LAS unsigned*)(lds + (bufoff) + ldsw + _i * 8192), 16, 0, 0); } while (0)
#define PG8_LDA(dst, b, h) do { _Pragma("unroll") for (int m = 0; m < 4; ++m) _Pragma("unroll") for (int k = 0; k < 2; ++k) dst[m][k] = *(const PG8_LAS bf16x8*)(lds + PG8_SA(b, h) + aoff + m * 2048 + k * 1024); } while (0)
#define PG8_LDB(dst, b, h) do { _Pragma("unroll") for (int n = 0; n < 2; ++n) _Pragma("unroll") for (int k = 0; k < 2; ++k) dst[n][k] = *(const PG8_LAS bf16x8*)(lds + PG8_SB(b, h) + boff + n * 2048 + k * 1024); } while (0)
#define PG8_MMA(ai, bj, At, Bt) do { __builtin_amdgcn_s_setprio(1); _Pragma("unroll") for (int m = 0; m < 4; ++m) _Pragma("unroll") for (int n = 0; n < 2; ++n) _Pragma("unroll") for (int k = 0; k < 2; ++k) \
        acc[ai][bj][m][n] = __builtin_amdgcn_mfma_f32_16x16x32_bf16(Bt[n][k], At[m][k], acc[ai][bj][m][n], 0, 0, 0); __builtin_amdgcn_s_setprio(0); } while (0)
#define PG8_WAIT_V(n) asm volatile("s_waitcnt vmcnt(" #n ")" ::: "memory")
#define PG8_WAIT_L(n) asm volatile("s_waitcnt lgkmcnt(" #n ")" ::: "memory")
#define PG8_BAR __builtin_amdgcn_s_barrier()
#define PG8_SCHED __builtin_amdgcn_sched_barrier(0)
    Unit cur, nxt; int ui = 0;
    if (!S.next(0, cur)) return;
    f32x4 acc[2][2][4][2];
#pragma unroll
    for (int a = 0; a < 2; ++a)
#pragma unroll
        for (int b = 0; b < 2; ++b)
#pragma unroll
            for (int m = 0; m < 4; ++m)
#pragma unroll
                for (int n = 0; n < 2; ++n) acc[a][b][m][n] = (f32x4){0.f, 0.f, 0.f, 0.f};
    bf16x8 At[4][2], B0[2][2], B1[2][2];
    const char* cA = cur.a; const char* cB = cur.b;
    PG8_STAGE(PG8_SB(0, 0), cB, voffB); PG8_STAGE(PG8_SB(0, 1), cB + hstep, voffB); PG8_STAGE(PG8_SA(0, 0), cA, voffA); PG8_STAGE(PG8_SA(0, 1), cA + hstep, voffA);
    if (wr == 1) PG8_BAR;
    PG8_WAIT_V(2); PG8_BAR;
    PG8_STAGE(PG8_SB(1, 0), cB + kstep, voffB); PG8_STAGE(PG8_SA(1, 0), cA + kstep, voffA); PG8_STAGE(PG8_SB(1, 1), cB + hstep + kstep, voffB);
    PG8_WAIT_V(6); PG8_BAR;
    for (;;) {
        const bool has_next = S.next(ui + 1, nxt);
        const char* nA = has_next ? nxt.a : cA; const char* nB = has_next ? nxt.b : cB;
        for (int t = 0; t < nt; t += 2) {
            const bool last = (t == nt - 2);
            const char* a1 = cA + (size_t)(t + 1) * kstep;
            const char* a2 = last ? nA : cA + (size_t)(t + 2) * kstep; const char* b2 = last ? nB : cB + (size_t)(t + 2) * kstep;
            const char* a3 = a2 + kstep; const char* b3 = b2 + kstep;
            PG8_LDB(B0, 0, 0); PG8_LDB(B1, 0, 1); PG8_SCHED; PG8_LDA(At, 0, 0); PG8_STAGE(PG8_SA(1, 1), a1 + hstep, voffA);
            PG8_WAIT_V(8); PG8_WAIT_L(0); PG8_BAR; PG8_MMA(0, 0, At, B0); PG8_MMA(0, 1, At, B1); PG8_BAR; PG8_SCHED;
            PG8_LDA(At, 0, 1); PG8_STAGE(PG8_SB(0, 0), b2, voffB); PG8_STAGE(PG8_SB(0, 1), b2 + hstep, voffB); PG8_STAGE(PG8_SA(0, 0), a2, voffA);
            PG8_WAIT_V(8); PG8_WAIT_L(0); PG8_BAR; PG8_MMA(1, 0, At, B0); PG8_MMA(1, 1, At, B1); PG8_BAR; PG8_SCHED;
            PG8_LDB(B0, 1, 0); PG8_LDB(B1, 1, 1); PG8_SCHED; PG8_LDA(At, 1, 0); PG8_STAGE(PG8_SA(0, 1), a2 + hstep, voffA);
            PG8_WAIT_V(8); PG8_WAIT_L(0); PG8_BAR; PG8_MMA(0, 0, At, B0); PG8_MMA(0, 1, At, B1); PG8_BAR; PG8_SCHED;
            PG8_LDA(At, 1, 1); PG8_STAGE(PG8_SB(1, 0), b3, voffB); PG8_STAGE(PG8_SB(1, 1), b3 + hstep, voffB); PG8_STAGE(PG8_SA(1, 0), a3, voffA);
            PG8_WAIT_V(8); PG8_WAIT_L(0); PG8_BAR; PG8_MMA(1, 0, At, B0); PG8_MMA(1, 1, At, B1); PG8_BAR; PG8_SCHED;
        }
        if constexpr (ALIGN_EPI) { if (wr == 0) PG8_BAR; }
        E(acc, cur, wr, wc, fr, fq);
        if (!has_next) break;
#pragma unroll
        for (int a = 0; a < 2; ++a)
#pragma unroll
            for (int b = 0; b < 2; ++b)
#pragma unroll
                for (int m = 0; m < 4; ++m)
#pragma unroll
                    for (int n = 0; n < 2; ++n) acc[a][b][m][n] = (f32x4){0.f, 0.f, 0.f, 0.f};
        cur = nxt; cA = nA; cB = nB; ++ui;
        if constexpr (ALIGN_EPI) { if (wr == 1) PG8_BAR; }
    }
    PG8_WAIT_V(0);
    if constexpr (!ALIGN_EPI) { if (wr == 0) PG8_BAR; }
    PG8_BAR;
#undef PG8_SA
#undef PG8_SB
#undef PG8_STAGE
#undef PG8_LDA
#undef PG8_LDB
#undef PG8_MMA
#undef PG8_WAIT_V
#undef PG8_WAIT_L
#undef PG8_BAR
#undef PG8_SCHED
}
}

#define FDEV __device__ __forceinline__
#define LDSPTR LAS
#define CF_DEFINED
typedef float cf __attribute__((ext_vector_type(2)));
#ifndef FFT_ENGINE_H
#define FFT_ENGINE_H
#ifndef CF_DEFINED
struct cf { float x, y; };
#endif
FDEV cf mkc(float a, float b) { cf r; r.x = a; r.y = b; return r; }
FDEV cf cadd(cf a, cf b) { return mkc(a.x + b.x, a.y + b.y); }
FDEV cf csub(cf a, cf b) { return mkc(a.x - b.x, a.y - b.y); }
FDEV cf cmul(cf a, cf b) { return mkc(a.x * b.x - a.y * b.y, a.x * b.y + a.y * b.x); }
FDEV cf cmulc(cf a, cf b) { return mkc(a.x * b.x + a.y * b.y, a.y * b.x - a.x * b.y); }
FDEV cf mul_mi(cf a) { return mkc(a.y, -a.x); }
FDEV cf mul_pi(cf a) { return mkc(-a.y, a.x); }
constexpr int FFT_N = 4096, FFT_LDS_ELEMS = 16 * 272;
FDEV int fpos(int p) { return 272 * (p >> 8) + 17 * ((p >> 4) & 15) + (p & 15); }

template <bool INV> FDEV void dft16(cf (&v)[16]) {
    const float C1 = 0.92387953251128674f, S1 = 0.38268343236508977f, C2 = 0.70710678118654752f;
#pragma unroll
    for (int n0 = 0; n0 < 4; ++n0) {
        cf x0 = v[n0], x1 = v[4 + n0], x2 = v[8 + n0], x3 = v[12 + n0];
        cf A = cadd(x0, x2), B = csub(x0, x2), C = cadd(x1, x3), D = csub(x1, x3);
        cf Dm = INV ? mul_pi(D) : mul_mi(D);
        v[n0] = cadd(A, C); v[4 + n0] = cadd(B, Dm); v[8 + n0] = csub(A, C); v[12 + n0] = csub(B, Dm);
    }
#define W16(m) (mkc( (m)==0?1.f:(m)==1?C1:(m)==2?C2:(m)==3?S1:(m)==4?0.f:(m)==6?-C2:(m)==9?-C1:0.f, \
                    (INV?1.f:-1.f) * ((m)==0?0.f:(m)==1?S1:(m)==2?C2:(m)==3?C1:(m)==4?1.f:(m)==6?C2:(m)==9?-S1:0.f) ))
    v[4 + 1] = cmul(v[4 + 1], W16(1)); v[4 + 2] = cmul(v[4 + 2], W16(2)); v[4 + 3] = cmul(v[4 + 3], W16(3));
    v[8 + 1] = cmul(v[8 + 1], W16(2)); v[8 + 2] = cmul(v[8 + 2], W16(4)); v[8 + 3] = cmul(v[8 + 3], W16(6));
    v[12 + 1] = cmul(v[12 + 1], W16(3)); v[12 + 2] = cmul(v[12 + 2], W16(6)); v[12 + 3] = cmul(v[12 + 3], W16(9));
#undef W16
    cf o[16];
#pragma unroll
    for (int k1 = 0; k1 < 4; ++k1) {
        cf x0 = v[4 * k1], x1 = v[4 * k1 + 1], x2 = v[4 * k1 + 2], x3 = v[4 * k1 + 3];
        cf A = cadd(x0, x2), B = csub(x0, x2), C = cadd(x1, x3), D = csub(x1, x3);
        cf Dm = INV ? mul_pi(D) : mul_mi(D);
        o[k1] = cadd(A, C); o[k1 + 4] = cadd(B, Dm); o[k1 + 8] = csub(A, C); o[k1 + 12] = csub(B, Dm);
    }
#pragma unroll
    for (int i = 0; i < 16; ++i) v[i] = o[i];
}

template <int GEO> FDEV int geo_idx(int r, int e) {
    if (GEO == 1) return 272 * e + 17 * (r >> 4) + (r & 15);
    if (GEO == 2) return 272 * (r >> 4) + 17 * e + (r & 15);
    return 272 * (r >> 4) + 17 * (r & 15) + e;
}
template <int GEO> FDEV void fft_pass_fwd(LDSPTR cf* buf, const LDSPTR cf* tw, int r) {
    cf v[16];
#pragma unroll
    for (int e = 0; e < 16; ++e) v[e] = buf[geo_idx<GEO>(r, e)];
    dft16<false>(v);
    if (GEO == 1) {
#pragma unroll
        for (int s = 1; s < 16; ++s) v[s] = cmul(v[s], tw[(r * s) & 4095]);
    } else if (GEO == 2) {
        const int t = r & 15;
#pragma unroll
        for (int s = 1; s < 16; ++s) v[s] = cmul(v[s], tw[(16 * t * s) & 4095]);
    }
#pragma unroll
    for (int e = 0; e < 16; ++e) buf[geo_idx<GEO>(r, e)] = v[e];
}
template <int GEO> FDEV void fft_pass_inv(LDSPTR cf* buf, const LDSPTR cf* tw, int r) {
    cf v[16];
#pragma unroll
    for (int e = 0; e < 16; ++e) v[e] = buf[geo_idx<GEO>(r, e)];
    if (GEO == 1) {
#pragma unroll
        for (int s = 1; s < 16; ++s) v[s] = cmulc(v[s], tw[(r * s) & 4095]);
    } else if (GEO == 2) {
        const int t = r & 15;
#pragma unroll
        for (int s = 1; s < 16; ++s) v[s] = cmulc(v[s], tw[(16 * t * s) & 4095]);
    }
    dft16<true>(v);
#pragma unroll
    for (int e = 0; e < 16; ++e) buf[geo_idx<GEO>(r, e)] = v[e];
}
FDEV int freq_pos(int k) { return 256 * (k & 15) + 16 * ((k >> 4) & 15) + (k >> 8); }
#endif

#define XB_TMO      128
#define XB_XCNT(j)  (256  + 64 * (j))
#define XB_XSUB(j)  (1280 + 64 * (j))
#define XB_XGEN(j)  (2304 + 64 * (j))
#define XB_TOP      3328
#define XB_TOPGEN   3392
#define XCD_BAR_WORDS 3456
#define XB_SPIN_CAP (1u << 18)
__device__ __forceinline__ unsigned xb_ld(unsigned* p)              { return __hip_atomic_load(p, __ATOMIC_RELAXED, __HIP_MEMORY_SCOPE_AGENT); }
__device__ __forceinline__ unsigned xb_add(unsigned* p, unsigned v) { return __hip_atomic_fetch_add(p, v, __ATOMIC_RELAXED, __HIP_MEMORY_SCOPE_AGENT); }
__device__ __forceinline__ unsigned xb_xcc_id() { return (unsigned)__builtin_amdgcn_s_getreg((3 << 11) | 20) & 0xFu; }
#define XB_SPIN(cond, bar) do { unsigned _sp = 0; while (cond) { __builtin_amdgcn_s_sleep(1); \
    if ((++_sp & 255u) == 0u) { if (xb_ld(&(bar)[XB_TMO])) break; if (_sp > XB_SPIN_CAP) { atomicAdd(&(bar)[XB_TMO], 1u); break; } } } } while (0)
struct XcdBarrier { unsigned* bar; unsigned x; volatile LAS unsigned* st; };
__device__ __forceinline__ XcdBarrier xcd_barrier_post(unsigned* bar, volatile LAS unsigned* st) {
    XcdBarrier b; b.bar = bar; b.x = xb_xcc_id(); b.st = st;
    if (threadIdx.x == 0) (void)xb_add(&bar[XB_XCNT(b.x)], 1u);
    return b;
}
__device__ __forceinline__ void xcd_barrier_complete(unsigned* bar, unsigned x, unsigned& nloc, unsigned& nx) {
    const unsigned G = gridDim.x * gridDim.y * gridDim.z;
    unsigned sum, cnt, mine, sp = 0u;
    for (;;) {
        sum = 0u; cnt = 0u; mine = 0u;
#pragma unroll
        for (unsigned j = 0; j < 16; ++j) { const unsigned c = xb_ld(&bar[XB_XCNT(j)]); sum += c; cnt += (c > 0u) ? 1u : 0u; mine = (j == x) ? c : mine; }
        if (sum == G) break;
        __builtin_amdgcn_s_sleep(1);
        if ((++sp & 255u) == 0u) { if (xb_ld(&bar[XB_TMO])) break; if (sp > XB_SPIN_CAP) { atomicAdd(&bar[XB_TMO], 1u); break; } }
    }
    nloc = mine > 0u ? mine : 1u; nx = cnt > 0u ? cnt : 1u;
}
__device__ __forceinline__ void xcd_barrier(const XcdBarrier& b) {
    asm volatile("s_waitcnt vmcnt(0)" ::: "memory");
    __syncthreads();
    if (threadIdx.x == 0) {
        unsigned* bar = b.bar;
        __builtin_amdgcn_s_waitcnt(0);
        unsigned nloc = b.st[0], nx = b.st[1];
        if (nloc == 0u) { xcd_barrier_complete(bar, b.x, nloc, nx); b.st[0] = nloc; b.st[1] = nx; }
        const unsigned old = xb_add(&bar[XB_XSUB(b.x)], 1u);
        const unsigned gen = old / nloc;
        if (old + 1u == (gen + 1u) * nloc) {
            __builtin_amdgcn_fence(__ATOMIC_RELEASE, "agent");
            asm volatile("s_waitcnt vmcnt(0)" ::: "memory");
            const unsigned og = xb_add(&bar[XB_TOP], 1u);
            const unsigned tg = og / nx;
            if (og + 1u == (tg + 1u) * nx) xb_add(&bar[XB_TOPGEN], 1u);
            else XB_SPIN(xb_ld(&bar[XB_TOPGEN]) == tg, bar);
            __builtin_amdgcn_fence(__ATOMIC_ACQUIRE, "agent");
            xb_add(&bar[XB_XGEN(b.x)], 1u);
            asm volatile("s_waitcnt vmcnt(0)" ::: "memory");
        } else {
            XB_SPIN(xb_ld(&bar[XB_XGEN(b.x)]) == gen, bar);
            __builtin_amdgcn_fence(__ATOMIC_ACQUIRE, "agent");
            asm volatile("s_waitcnt vmcnt(0)" ::: "memory");
        }
    }
    __syncthreads();
}

struct Frame {
    LAS unsigned char* lds;
    unsigned char* ws;
    int tid, lane, wave, vcu, G, bid;
    const float *x, *norm1_g, *w_in, *conv_w, *conv_b, *f_w_in, *f_b_in, *f_w_mid, *f_b_mid, *f_freq, *f_w_out, *f_bias, *mix_g, *w_out, *norm2_g,
                *w_group, *b_group, *w_router, *b_router, *w_gate, *w_up, *w_down, *final_g;
    float* out;
};
#define WSP(T, off) ((T*)(F.ws + (off)))

__device__ __forceinline__ void transpose_item(const float* W, int ldw, bf16* WT, int ldo, LAS float* scr, int lane) {
#pragma unroll 8
    for (int i = 0; i < 32; ++i) { const int kk = 2 * i + (lane >> 5); scr[kk * 33 + (lane & 31)] = W[(size_t)kk * ldw + (lane & 31)]; }
    LDS_WAIT(); asm volatile("" ::: "memory");
    const int c = lane & 7;
#pragma unroll
    for (int j = 0; j < 4; ++j) { const int n = (lane >> 3) + 8 * j; const LAS float* s = scr + (8 * c) * 33 + n;
        u32x4 o; o.x = pk2(s[0 * 33], s[1 * 33]); o.y = pk2(s[2 * 33], s[3 * 33]); o.z = pk2(s[4 * 33], s[5 * 33]); o.w = pk2(s[6 * 33], s[7 * 33]);
        *(GAS u32x4*)(WT + (size_t)n * ldo + 8 * c) = o; }
    LDS_WAIT(); asm volatile("" ::: "memory");
}
__device__ __forceinline__ void rms_row_to_bf16(const float* xrow, const float* g, bf16* orow, int lane) {
    const GAS f32x4* xr = (const GAS f32x4*)xrow + lane; const GAS f32x4* gr = (const GAS f32x4*)g + lane;
    f32x4 v[4]; float s = 0.f;
#pragma unroll
    for (int j = 0; j < 4; ++j) { v[j] = xr[64 * j]; s += (v[j].x * v[j].x + v[j].y * v[j].y) + (v[j].z * v[j].z + v[j].w * v[j].w); }
    const float rinv = 1.0f / sqrtf(wave_sum(s) * (1.f / 1024.f) + EPS);
    GAS u32x2* o8 = (GAS u32x2*)orow + lane;
#pragma unroll
    for (int j = 0; j < 4; ++j) { const f32x4 gg = gr[64 * j]; u32x2 w; w.x = pk2(v[j].x * rinv * gg.x, v[j].y * rinv * gg.y); w.y = pk2(v[j].z * rinv * gg.z, v[j].w * rinv * gg.w); o8[64 * j] = w; }
}
__device__ __forceinline__ void phase_prologue(Frame& F) {
    const int gw = F.vcu * NWAVES + F.wave, NGW = F.G * NWAVES;
    {
        LAS float* scr = (LAS float*)(F.lds + F.wave * 16384);
        constexpr int I_IN = 16 * 48, I_OUT = 16 * 32, I_G = 32 * 16 * 16, I_D = 32 * 8 * 32;
        constexpr int NITEMS = I_IN + I_OUT + 2 * I_G + I_D;
        bf16* WIN_T = WSP(bf16, WS_WIN_T); bf16* WOUT_T = WSP(bf16, WS_WOUT_T); bf16* WGU_T = WSP(bf16, WS_WGU_T); bf16* WD_T = WSP(bf16, WS_WD_T);
        for (int it = gw; it < NITEMS; it += NGW) {
            int r = it;
            if (r < I_IN) { const int kb = r / 48, nb = r % 48; transpose_item(F.w_in + (size_t)(64 * kb) * D_IN_PROJ + 32 * nb, D_IN_PROJ, WIN_T + (size_t)(32 * nb) * 1024 + 64 * kb, 1024, scr, F.lane); continue; } r -= I_IN;
            if (r < I_OUT) { const int kb = r / 32, nb = r % 32; transpose_item(F.w_out + (size_t)(64 * kb) * 1024 + 32 * nb, 1024, WOUT_T + (size_t)(32 * nb) * 1024 + 64 * kb, 1024, scr, F.lane); continue; } r -= I_OUT;
            if (r < 2 * I_G) { const int up = r / I_G; r %= I_G; const int e = r / 256, kb = (r % 256) / 16, nb = r % 16; const int n0 = 32 * nb;
                const float* W = (up ? F.w_up : F.w_gate) + (size_t)e * 1024 * 512 + (size_t)(64 * kb) * 512 + n0;
                const int orow = 256 * (n0 >> 7) + (n0 & 127) + (up ? 128 : 0);
                transpose_item(W, 512, WGU_T + ((size_t)e * 1024 + orow) * 1024 + 64 * kb, 1024, scr, F.lane); continue; } r -= 2 * I_G;
            { const int e = r / 256, kb = (r % 256) / 32, nb = r % 32;
              transpose_item(F.w_down + (size_t)e * 512 * 1024 + (size_t)(64 * kb) * 1024 + 32 * nb, 1024, WD_T + ((size_t)e * 1024 + 32 * nb) * 512 + 64 * kb, 512, scr, F.lane); }
        }
    }
    __syncthreads();
    {
        LAS float* wl = (LAS float*)F.lds;
        LAS float* ct = (LAS float*)(F.lds + 64 * 65 * 4);
        bf16* WIN_T = WSP(bf16, WS_WIN_T);
        for (int it = F.bid; it < 128; it += F.G) {
            const int g = it >> 4, kb = it & 15;
            for (int i = F.tid; i < 4096; i += NTHREADS) { const int kk = i >> 6, c = i & 63; wl[kk * 65 + c] = F.w_in[(size_t)(64 * kb + kk) * D_IN_PROJ + 1536 + 64 * g + c]; }
            if (F.tid < 64) { ct[F.tid] = cospif((float)F.tid * (1.0f / 32.0f)); ct[64 + F.tid] = sinpif((float)F.tid * (1.0f / 32.0f)); }
            __syncthreads();
            const int kk = F.tid & 63, nb = F.tid >> 6;
#pragma unroll 1
            for (int i = 0; i < 16; ++i) { const int np = nb + 8 * i; const int cp = np & 63; float s = 0.f;
                if (np < 64) { for (int c = 0; c < 64; ++c) s += wl[kk * 65 + c] * ct[(c * cp) & 63]; }
                else         { for (int c = 0; c < 64; ++c) s -= wl[kk * 65 + c] * ct[64 + ((c * cp) & 63)]; }
                WIN_T[(size_t)(1536 + 128 * g + np) * 1024 + 64 * kb + kk] = (bf16)f2bf(s); }
            __syncthreads();
        }
    }
    { bf16* HN = WSP(bf16, WS_HN); for (int m = gw; m < T_TOK; m += NGW) rms_row_to_bf16(F.x + (size_t)m * 1024, F.norm1_g, HN + (size_t)m * 1024, F.lane); }
    { const int gt = F.bid * NTHREADS + F.tid;
      if (gt < 4096) { f32x2 w; w.x = cospif((float)gt * (1.0f / 2048.0f)); w.y = -sinpif((float)gt * (1.0f / 2048.0f)); WSP(f32x2, WS_TW4096)[gt] = w; }
      else if (gt < 8192) { const int n = gt - 4096; f32x2 w; w.x = cospif((float)n * (1.0f / 4096.0f)); w.y = -sinpif((float)n * (1.0f / 4096.0f)); WSP(f32x2, WS_TW8192)[n] = w; } }
    {
        LAS float* a0 = (LAS float*)F.lds;
        LAS float* a1 = a0 + 16 * 33;
        LAS float* a2 = a1 + 16 * 64;
        float* H3 = WSP(float, WS_H3);
        for (int pb = F.bid; pb < 256; pb += F.G) {
            __syncthreads();
            for (int i = F.tid; i < 16 * 33; i += NTHREADS) { const int p = i / 33, j = i % 33, l = 16 * pb + p; float v;
                if (j == 0) v = (float)l / 4095.0f;
                else { const int q = (j - 1) & 15; const float fq = 1e-4f + (float)q * ((15.0f - 1e-4f) / 15.0f); const float ang = fq * ((2.0f * 3.14159265358979323846f / 4096.0f) * (float)l); v = (j <= 16) ? cosf(ang) : -sinf(ang); }
                a0[i] = v; }
            __syncthreads();
            for (int o = F.tid; o < 1024; o += NTHREADS) { const int p = o >> 6, j = o & 63; float s = F.f_b_in[j];
                for (int i = 0; i < 33; ++i) s += a0[p * 33 + i] * F.f_w_in[i * 64 + j];
                a1[o] = sinf(F.f_freq[j] * s); }
            __syncthreads();
            for (int o = F.tid; o < 1024; o += NTHREADS) { const int p = o >> 6, j = o & 63; float s = F.f_b_mid[j];
                for (int i = 0; i < 64; ++i) s += a1[p * 64 + i] * F.f_w_mid[i * 64 + j];
                a2[o] = sinf(F.f_freq[64 + j] * s); }
            __syncthreads();
            for (int o = F.tid; o < 1024; o += NTHREADS) { const int p = o >> 6, j = o & 63; float s = F.f_b_mid[64 + j];
                for (int i = 0; i < 64; ++i) s += a2[p * 64 + i] * F.f_w_mid[4096 + i * 64 + j];
                H3[(size_t)(16 * pb + p) * 64 + j] = sinf(F.f_freq[128 + j] * s); }
        }
        __syncthreads();
    }
}

__device__ __forceinline__ void load_tw_lds(Frame& F) {
    LAS f32x2* tw = (LAS f32x2*)(F.lds + L_TW); const f32x2* g = WSP(f32x2, WS_TW4096);
    for (int i = F.tid; i < 4096; i += NTHREADS) tw[i] = g[i];
    __syncthreads();
}
__device__ __forceinline__ void fft_fwd3(Frame& F) {
    LAS cf* buf = (LAS cf*)(F.lds + ((F.tid >> 8) ? L_BUFB : L_BUFA)); const LAS cf* tw = (const LAS cf*)(F.lds + L_TW); const int r = F.tid & 255;
    fft_pass_fwd<1>(buf, tw, r); __syncthreads(); fft_pass_fwd<2>(buf, tw, r); __syncthreads(); fft_pass_fwd<3>(buf, tw, r); __syncthreads();
}
__device__ __forceinline__ void fft_inv3(Frame& F) {
    LAS cf* buf = (LAS cf*)(F.lds + ((F.tid >> 8) ? L_BUFB : L_BUFA)); const LAS cf* tw = (const LAS cf*)(F.lds + L_TW); const int r = F.tid & 255;
    fft_pass_inv<3>(buf, tw, r); __syncthreads(); fft_pass_inv<2>(buf, tw, r); __syncthreads(); fft_pass_inv<1>(buf, tw, r); __syncthreads();
}
__device__ __forceinline__ void filter_item(Frame& F, int c) {
    LAS cf* bufA = (LAS cf*)(F.lds + L_BUFA); LAS cf* bufB = (LAS cf*)(F.lds + L_BUFB);
    LAS float* kfb = (LAS float*)(F.lds + L_SCR);
    LAS float* red = (LAS float*)(F.lds + L_RED);
    const float* H3 = WSP(float, WS_H3);
    if (F.tid < 128) { const int i = F.tid & 63, dir = F.tid >> 6; red[F.tid] = F.f_w_out[(size_t)i * 1024 + dir * 512 + c]; }
    __syncthreads();
    const float mind = -3.0701134573253946f, maxd = -15.350567286626973f;
    const float delta = fabsf(mind + (float)c * ((maxd - mind) / 511.0f));
    float asum = 0.f;
    for (int l = F.tid; l < 4096; l += NTHREADS) {
        const f32x4* hr = (const f32x4*)(H3 + (size_t)l * 64); float sf = 0.f, sb = 0.f;
#pragma unroll
        for (int q = 0; q < 16; ++q) { const f32x4 h = hr[q];
            sf += h.x * red[4 * q] + h.y * red[4 * q + 1] + h.z * red[4 * q + 2] + h.w * red[4 * q + 3];
            sb += h.x * red[64 + 4 * q] + h.y * red[64 + 4 * q + 1] + h.z * red[64 + 4 * q + 2] + h.w * red[64 + 4 * q + 3]; }
        const float dec = expf(-((float)l / 4095.0f) * delta); sf *= dec; sb *= dec;
        kfb[l] = sf; kfb[4096 + l] = sb; asum += fabsf(sf) + (l >= 1 ? fabsf(sb) : 0.f);
    }
    asum = wave_sum(asum);
    if (F.lane == 0) red[128 + F.wave] = asum;
    __syncthreads();
    if (F.tid == 0) { float s = 0.f; for (int i = 0; i < 8; ++i) s += red[128 + i]; red[136] = s; }
    __syncthreads();
    const float sc = 1.0f / (red[136] * 8192.0f);
    const f32x2* tw2 = WSP(f32x2, WS_TW8192);
    for (int n = F.tid; n < 4096; n += NTHREADS) {
        const float kf = kfb[n], kbm = (n >= 1) ? kfb[4096 + 4096 - n] : 0.f;
        const float a = (kf + kbm) * sc, d = (kf - kbm) * sc; const f32x2 w = tw2[n];
        bufA[fpos(n)] = mkc(a, 0.f); bufB[fpos(n)] = mkc(d * w.x, d * w.y);
    }
    __syncthreads();
    fft_fwd3(F);
    f32x2* KF = WSP(f32x2, WS_KF) + (size_t)c * 8192;
    for (int p = F.tid; p < 4096; p += NTHREADS) { const cf a = bufA[fpos(p)], b = bufB[fpos(p)]; KF[p] = (f32x2){a.x, a.y}; KF[4096 + p] = (f32x2){b.x, b.y}; }
    __syncthreads();
}
__device__ __forceinline__ void conv8(const bf16* row, int l0, float w0, float w1, float w2, float b, float (&o)[8]) {
    const u32x4 v = *(const u32x4*)(row + l0);
    float u[10];
    u[0] = (l0 > 0) ? bf1(row[l0 - 1]) : 0.f; u[9] = (l0 + 8 < 4096) ? bf1(row[l0 + 8]) : 0.f;
    u[1] = bflo(v.x); u[2] = bfhi(v.x); u[3] = bflo(v.y); u[4] = bfhi(v.y); u[5] = bflo(v.z); u[6] = bfhi(v.z); u[7] = bflo(v.w); u[8] = bfhi(v.w);
#pragma unroll
    for (int i = 0; i < 8; ++i) o[i] = b + w0 * u[i] + w1 * u[i + 1] + w2 * u[i + 2];
}
__device__ __forceinline__ void hyena_item(Frame& F, int c, int bp) {
    LAS cf* bufA = (LAS cf*)(F.lds + L_BUFA); LAS cf* bufB = (LAS cf*)(F.lds + L_BUFB);
    const bf16* PT = WSP(bf16, WS_PT);
    const f32x2* tw2 = WSP(f32x2, WS_TW8192);
    const int l0 = 8 * F.tid;
    float z0[8], z1[8];
    {
        const float* cw = F.conv_w; const float* cb = F.conv_b;
        const float a0 = cw[512 + c], a1 = cw[1536 + 512 + c], a2 = cw[3072 + 512 + c], ab = cb[512 + c];
        const float v0 = cw[1024 + c], v1 = cw[1536 + 1024 + c], v2 = cw[3072 + 1024 + c], vb = cb[1024 + c];
        float t1[8], t2[8];
        const bf16* x1r = PT + (size_t)(512 + c) * T_TOK + (size_t)(2 * bp) * SEQ; const bf16* vr = PT + (size_t)(1024 + c) * T_TOK + (size_t)(2 * bp) * SEQ;
        conv8(x1r, l0, a0, a1, a2, ab, t1); conv8(vr, l0, v0, v1, v2, vb, t2);
#pragma unroll
        for (int i = 0; i < 8; ++i) z0[i] = t1[i] * t2[i];
        conv8(x1r + SEQ, l0, a0, a1, a2, ab, t1); conv8(vr + SEQ, l0, v0, v1, v2, vb, t2);
#pragma unroll
        for (int i = 0; i < 8; ++i) z1[i] = t1[i] * t2[i];
    }
#pragma unroll
    for (int i = 0; i < 8; ++i) { const int l = l0 + i; const f32x2 w = tw2[l]; const cf z = mkc(z0[i], z1[i]);
        bufA[fpos(l)] = z; bufB[fpos(l)] = cmul(z, mkc(w.x, w.y)); }
    __syncthreads();
    fft_fwd3(F);
    { const f32x2* KF = WSP(f32x2, WS_KF) + (size_t)c * 8192;
      for (int p = F.tid; p < 4096; p += NTHREADS) { const f32x2 ke = KF[p], ko = KF[4096 + p]; const int q = fpos(p);
          bufA[q] = cmul(bufA[q], mkc(ke.x, ke.y)); bufB[q] = cmul(bufB[q], mkc(ko.x, ko.y)); } }
    __syncthreads();
    fft_inv3(F);
    {
        const float* cw = F.conv_w; const float* cb = F.conv_b;
        const float w0 = cw[c], w1 = cw[1536 + c], w2 = cw[3072 + c], wb = cb[c]; const float bias = F.f_bias[c];
        const bf16* x0r = PT + (size_t)c * T_TOK + (size_t)(2 * bp) * SEQ;
        bf16* YT = WSP(bf16, WS_YT) + (size_t)c * T_TOK + (size_t)(2 * bp) * SEQ;
        float x0a[8], x0b[8], ya[8], yb[8];
        conv8(x0r, l0, w0, w1, w2, wb, x0a); conv8(x0r + SEQ, l0, w0, w1, w2, wb, x0b);
#pragma unroll
        for (int i = 0; i < 8; ++i) { const int l = l0 + i; const f32x2 w = tw2[l]; const cf e = bufA[fpos(l)], o = bufB[fpos(l)]; const cf y = cadd(e, cmulc(o, mkc(w.x, w.y)));
            ya[i] = x0a[i] * (y.x + bias * z0[i]); yb[i] = x0b[i] * (y.y + bias * z1[i]); }
        u32x4 oa, ob; oa.x = pk2(ya[0], ya[1]); oa.y = pk2(ya[2], ya[3]); oa.z = pk2(ya[4], ya[5]); oa.w = pk2(ya[6], ya[7]);
        ob.x = pk2(yb[0], yb[1]); ob.y = pk2(yb[2], yb[3]); ob.z = pk2(yb[4], yb[5]); ob.w = pk2(yb[6], yb[7]);
        *(u32x4*)(YT + l0) = oa; *(u32x4*)(YT + SEQ + l0) = ob;
    }
    __syncthreads();
}
__device__ __forceinline__ void fourier_item(Frame& F, int q) {
    const int f = F.tid >> 8, r = F.tid & 255; const int s = 2 * q + f, b = s >> 9, gc = s & 511, g = gc >> 6, cp = gc & 63;
    LAS cf* buf = (LAS cf*)(F.lds + (f ? L_BUFB : L_BUFA));
    const bf16* PT = WSP(bf16, WS_PT);
    const bf16* r1 = PT + (size_t)(1536 + 128 * g + cp) * T_TOK + (size_t)b * SEQ; const bf16* r2 = r1 + (size_t)64 * T_TOK;
    const int l0 = 16 * r;
#pragma unroll
    for (int h = 0; h < 2; ++h) { const u32x4 a = *(const u32x4*)(r1 + l0 + 8 * h), d = *(const u32x4*)(r2 + l0 + 8 * h); const int l = l0 + 8 * h;
        buf[fpos(l + 0)] = mkc(bflo(a.x), bflo(d.x)); buf[fpos(l + 1)] = mkc(bfhi(a.x), bfhi(d.x)); buf[fpos(l + 2)] = mkc(bflo(a.y), bflo(d.y)); buf[fpos(l + 3)] = mkc(bfhi(a.y), bfhi(d.y));
        buf[fpos(l + 4)] = mkc(bflo(a.z), bflo(d.z)); buf[fpos(l + 5)] = mkc(bfhi(a.z), bfhi(d.z)); buf[fpos(l + 6)] = mkc(bflo(a.w), bflo(d.w)); buf[fpos(l + 7)] = mkc(bfhi(a.w), bfhi(d.w)); }
    __syncthreads();
    fft_fwd3(F);
    bf16* YT = WSP(bf16, WS_YT) + (size_t)(512 + gc) * T_TOK + (size_t)b * SEQ;
    float y[16];
#pragma unroll
    for (int i = 0; i < 16; ++i) y[i] = buf[fpos(freq_pos(l0 + i))].x * (1.0f / 512.0f);
    u32x4 o0, o1; o0.x = pk2(y[0], y[1]); o0.y = pk2(y[2], y[3]); o0.z = pk2(y[4], y[5]); o0.w = pk2(y[6], y[7]);
    o1.x = pk2(y[8], y[9]); o1.y = pk2(y[10], y[11]); o1.z = pk2(y[12], y[13]); o1.w = pk2(y[14], y[15]);
    *(u32x4*)(YT + l0) = o0; *(u32x4*)(YT + l0 + 8) = o1;
    __syncthreads();
}

__device__ __forceinline__ void phase_headnorm(Frame& F) {
    LAS float* tl = (LAS float*)F.lds;
    LAS float* rs = tl + 64 * 257;
    const bf16* YT = WSP(bf16, WS_YT); bf16* YN = WSP(bf16, WS_YN);
    for (int it = F.bid; it < 16 * 128; it += F.G) {
        const int h = it & 15, tt = it >> 4, tok0 = tt * 256;
#pragma unroll
        for (int i = 0; i < 4; ++i) { const int idx = F.tid + 512 * i, row = idx >> 5, ch = idx & 31;
            const u32x4 v = *(const u32x4*)(YT + (size_t)(64 * h + row) * T_TOK + tok0 + 8 * ch); LAS float* d = tl + row * 257 + 8 * ch;
            d[0] = bflo(v.x); d[1] = bfhi(v.x); d[2] = bflo(v.y); d[3] = bfhi(v.y); d[4] = bflo(v.z); d[5] = bfhi(v.z); d[6] = bflo(v.w); d[7] = bfhi(v.w); }
        __syncthreads();
        if (F.tid < 256) { float s = 0.f;
#pragma unroll 8
            for (int c = 0; c < 64; ++c) { const float v = tl[c * 257 + F.tid]; s += v * v; }
            rs[F.tid] = 1.0f / sqrtf(s * (1.0f / 64.0f) + EPS); }
        __syncthreads();
#pragma unroll
        for (int i = 0; i < 4; ++i) { const int idx = F.tid + 512 * i, tok = idx >> 3, q = idx & 7; const float r = rs[tok]; const float* g = F.mix_g + 64 * h + 8 * q;
            float v[8];
#pragma unroll
            for (int j = 0; j < 8; ++j) v[j] = tl[(8 * q + j) * 257 + tok] * r * g[j];
            u32x4 o; o.x = pk2(v[0], v[1]); o.y = pk2(v[2], v[3]); o.z = pk2(v[4], v[5]); o.w = pk2(v[6], v[7]);
            *(u32x4*)(YN + (size_t)(tok0 + tok) * 1024 + 64 * h + 8 * q) = o; }
        __syncthreads();
    }
}

__device__ __forceinline__ void phase_route(Frame& F, const float* X1) {
    LAS int* lcnt = (LAS int*)F.lds;
    bf16* H2 = WSP(bf16, WS_HN); int* EXPID = WSP(int, WS_EXPID); float* EXPW = WSP(float, WS_EXPW); int* CNT = WSP(int, WS_CNT);
    for (int blk = F.bid; blk < 256; blk += F.G) {
        __syncthreads();
        if (F.tid < 32) lcnt[F.tid] = 0;
        __syncthreads();
        for (int i = 0; i < 16; ++i) {
            const int t = blk * 128 + F.wave * 16 + i;
            const GAS f32x4* xr = (const GAS f32x4*)(X1 + (size_t)t * 1024) + F.lane; const GAS f32x4* gr = (const GAS f32x4*)F.norm2_g + F.lane;
            f32x4 v[4]; float s = 0.f;
#pragma unroll
            for (int j = 0; j < 4; ++j) { v[j] = xr[64 * j]; s += (v[j].x * v[j].x + v[j].y * v[j].y) + (v[j].z * v[j].z + v[j].w * v[j].w); }
            const float rinv = 1.0f / sqrtf(wave_sum(s) * (1.f / 1024.f) + EPS);
            GAS u32x2* o8 = (GAS u32x2*)(H2 + (size_t)t * 1024) + F.lane;
            float gl0 = 0.f, gl1 = 0.f, gl2 = 0.f, gl3 = 0.f;
#pragma unroll
            for (int j = 0; j < 4; ++j) { const f32x4 gg = gr[64 * j]; v[j].x *= rinv * gg.x; v[j].y *= rinv * gg.y; v[j].z *= rinv * gg.z; v[j].w *= rinv * gg.w;
                u32x2 w; w.x = pk2(v[j].x, v[j].y); w.y = pk2(v[j].z, v[j].w); o8[64 * j] = w;
                const f32x4* wg = (const f32x4*)F.w_group + (256 * j + 4 * F.lane);
                const f32x4 w0 = wg[0], w1 = wg[1], w2 = wg[2], w3 = wg[3];
                gl0 += v[j].x * w0.x + v[j].y * w1.x + v[j].z * w2.x + v[j].w * w3.x;
                gl1 += v[j].x * w0.y + v[j].y * w1.y + v[j].z * w2.y + v[j].w * w3.y;
                gl2 += v[j].x * w0.z + v[j].y * w1.z + v[j].z * w2.z + v[j].w * w3.z;
                gl3 += v[j].x * w0.w + v[j].y * w1.w + v[j].z * w2.w + v[j].w * w3.w; }
            gl0 = wave_sum(gl0) + F.b_group[0]; gl1 = wave_sum(gl1) + F.b_group[1]; gl2 = wave_sum(gl2) + F.b_group[2]; gl3 = wave_sum(gl3) + F.b_group[3];
            int gs = 0; float gm = gl0; if (gl1 > gm) { gm = gl1; gs = 1; } if (gl2 > gm) { gm = gl2; gs = 2; } if (gl3 > gm) { gm = gl3; gs = 3; }
            const float pg = 1.0f / (expf(gl0 - gm) + expf(gl1 - gm) + expf(gl2 - gm) + expf(gl3 - gm));
            float el[8];
#pragma unroll
            for (int e = 0; e < 8; ++e) el[e] = 0.f;
            const f32x4* wr = (const f32x4*)(F.w_router + (size_t)gs * 1024 * 8);
#pragma unroll
            for (int j = 0; j < 4; ++j) {
#pragma unroll
                for (int q = 0; q < 4; ++q) { const int k = 256 * j + 4 * F.lane + q; const f32x4 wa = wr[2 * k], wb = wr[2 * k + 1]; const float hv = v[j][q];
                    el[0] += hv * wa.x; el[1] += hv * wa.y; el[2] += hv * wa.z; el[3] += hv * wa.w; el[4] += hv * wb.x; el[5] += hv * wb.y; el[6] += hv * wb.z; el[7] += hv * wb.w; } }
#pragma unroll
            for (int e = 0; e < 8; ++e) el[e] = wave_sum(el[e]) + F.b_router[gs * 8 + e];
            int i1 = 0; float m1 = el[0];
#pragma unroll
            for (int e = 1; e < 8; ++e) if (el[e] > m1) { m1 = el[e]; i1 = e; }
            int i2 = -1; float m2 = -3.0e38f;
#pragma unroll
            for (int e = 0; e < 8; ++e) if (e != i1 && el[e] > m2) { m2 = el[e]; i2 = e; }
            const float e2 = expf(m2 - m1); const float wa1 = pg / (1.0f + e2), wa2 = pg * e2 / (1.0f + e2);
            if (F.lane == 0) { EXPID[2 * t] = gs * 8 + i1; EXPID[2 * t + 1] = gs * 8 + i2; EXPW[2 * t] = wa1; EXPW[2 * t + 1] = wa2;
                atomicAdd((int*)&lcnt[gs * 8 + i1], 1); atomicAdd((int*)&lcnt[gs * 8 + i2], 1); }
        }
        __syncthreads();
        if (F.tid < 32) CNT[blk * 32 + F.tid] = lcnt[F.tid];
    }
    __syncthreads();
}

__device__ __forceinline__ void phase_lists(Frame& F) {
    LAS int* tot = (LAS int*)F.lds;
    LAS int* base = tot + 32;
    LAS int* seg = base + 32;
    LAS int* pe = seg + 40;
    LAS int* prow = pe + 256;
    const int* CNT = WSP(int, WS_CNT); const int* EXPID = WSP(int, WS_EXPID); const float* EXPW = WSP(float, WS_EXPW);
    int* LIST = WSP(int, WS_LIST); float* ROWW = WSP(float, WS_ROWW); int* TILE_E = WSP(int, WS_TILE_E);
    const bf16* H2 = WSP(bf16, WS_HN); bf16* XG = WSP(bf16, WS_PT);
    for (int blk = F.bid; blk < 256; blk += F.G) {
        __syncthreads();
        if (F.tid < 32) { int t = 0, b = 0; for (int j = 0; j < 256; ++j) { const int c = CNT[j * 32 + F.tid]; t += c; b += (j < blk) ? c : 0; } tot[F.tid] = t; base[F.tid] = b; }
        if (F.tid >= 64 && F.tid < 64 + 256) pe[F.tid - 64] = EXPID[blk * 256 + (F.tid - 64)];
        __syncthreads();
        if (F.tid == 0) { int s = 0; for (int e = 0; e < 32; ++e) { seg[e] = s; s += (tot[e] + 255) & ~255; } seg[32] = s; }
        __syncthreads();
        if (F.tid < 32) { int n = seg[F.tid] + base[F.tid]; for (int p = 0; p < 256; ++p) if (pe[p] == F.tid) prow[p] = n++; }
        __syncthreads();
        if (F.tid < 256) { const int row = prow[F.tid], pair = blk * 256 + F.tid; LIST[row] = pair; ROWW[row] = EXPW[pair]; }
        if (blk < 32) { const int e = blk; for (int r = seg[e] + tot[e] + F.tid; r < seg[e + 1]; r += NTHREADS) { LIST[r] = -1; ROWW[r] = 0.f; } }
        if (blk == 0) { if (F.tid < 32) { for (int r = seg[F.tid] >> 8; r < (seg[F.tid + 1] >> 8); ++r) TILE_E[r] = F.tid; } if (F.tid == 32) TILE_E[MAX_TILES] = seg[32] >> 8; }
        for (int p = F.wave; p < 256; p += NWAVES) { const int row = prow[p], t = blk * 128 + (p >> 1);
            const u32x4* s = (const u32x4*)(H2 + (size_t)t * 1024) + F.lane; u32x4* d = (u32x4*)(XG + (size_t)row * 1024) + F.lane;
            const u32x4 a = s[0], b = s[64]; d[0] = a; d[64] = b; }
    }
    __syncthreads();
}

__device__ __forceinline__ void phase_final(Frame& F, float* X1) {
    const int gw = F.vcu * NWAVES + F.wave, NGW = F.G * NWAVES; const bf16* YP = WSP(bf16, WS_PT);
    for (int t = gw; t < T_TOK; t += NGW) {
        GAS f32x4* xr = (GAS f32x4*)(X1 + (size_t)t * 1024) + F.lane; const GAS f32x4* gr = (const GAS f32x4*)F.final_g + F.lane;
        const GAS u32x2* y0 = (const GAS u32x2*)(YP + (size_t)(2 * t) * 1024) + F.lane; const GAS u32x2* y1 = (const GAS u32x2*)(YP + (size_t)(2 * t + 1) * 1024) + F.lane;
        f32x4 v[4]; float s = 0.f;
#pragma unroll
        for (int j = 0; j < 4; ++j) { v[j] = xr[64 * j]; const u32x2 a = y0[64 * j], b = y1[64 * j];
            v[j].x += bflo(a.x) + bflo(b.x); v[j].y += bfhi(a.x) + bfhi(b.x); v[j].z += bflo(a.y) + bflo(b.y); v[j].w += bfhi(a.y) + bfhi(b.y);
            s += (v[j].x * v[j].x + v[j].y * v[j].y) + (v[j].z * v[j].z + v[j].w * v[j].w); }
        const float rinv = 1.0f / sqrtf(wave_sum(s) * (1.f / 1024.f) + EPS);
#pragma unroll
        for (int j = 0; j < 4; ++j) { const f32x4 gg = gr[64 * j]; f32x4 o; o.x = v[j].x * rinv * gg.x; o.y = v[j].y * rinv * gg.y; o.z = v[j].z * rinv * gg.z; o.w = v[j].w * rinv * gg.w; xr[64 * j] = o; }
    }
}

constexpr int N_PHASES = 10;
struct Args { const float* in[23]; float* out; unsigned char* ws; int ph_lo, ph_hi; };
static_assert(sizeof(Args) == 23 * 8 + 8 + 8 + 8, "Args has no padding");

__global__ void __launch_bounds__(NTHREADS, 2) mk_fwd(Args args) {
    extern __shared__ __attribute__((aligned(16))) unsigned char lds_raw[];
    Frame F;
    F.lds = (LAS unsigned char*)lds_raw; F.ws = args.ws;
    F.tid = threadIdx.x; F.lane = F.tid & 63; F.wave = __builtin_amdgcn_readfirstlane(F.tid >> 6);
    F.G = gridDim.x; F.bid = blockIdx.x; F.vcu = (F.G % 8 == 0) ? (F.bid % 8) * (F.G / 8) + F.bid / 8 : F.bid;
    F.x = args.in[0]; F.norm1_g = args.in[1]; F.w_in = args.in[2]; F.conv_w = args.in[3]; F.conv_b = args.in[4]; F.f_w_in = args.in[5]; F.f_b_in = args.in[6];
    F.f_w_mid = args.in[7]; F.f_b_mid = args.in[8]; F.f_freq = args.in[9]; F.f_w_out = args.in[10]; F.f_bias = args.in[11]; F.mix_g = args.in[12]; F.w_out = args.in[13];
    F.norm2_g = args.in[14]; F.w_group = args.in[15]; F.b_group = args.in[16]; F.w_router = args.in[17]; F.b_router = args.in[18]; F.w_gate = args.in[19]; F.w_up = args.in[20];
    F.w_down = args.in[21]; F.final_g = args.in[22]; F.out = args.out;
    volatile LAS unsigned* bst = (volatile LAS unsigned*)(F.lds + BARST_OFF);
    if (F.tid < 16) bst[F.tid] = 0u;
    __syncthreads();
    const int lo = args.ph_lo, hi = args.ph_hi;
    const bool need_bar = (hi - lo) > 1;
    XcdBarrier bar; bar.bar = (unsigned*)(F.ws + WS_CTL); bar.x = 0; bar.st = bst;
    if (need_bar) bar = xcd_barrier_post((unsigned*)(F.ws + WS_CTL), bst);
#define IN(k) (lo <= (k) && (k) < hi)
#define SEAM(k) do { if (IN(k) && IN((k) + 1)) xcd_barrier(bar); } while (0)
    float* X1 = F.out;

    if (IN(0)) { phase_prologue(F); } SEAM(0);

    if (IN(1)) {
        pg8::StaticOrder S; S.init(F.ws + WS_WIN_T, F.ws + WS_HN, NPT_ROWS, T_TOK, 1024, F.G, F.bid);
        pg8::EpiStoreBf16 E{WSP(bf16, WS_PT), T_TOK};
        pg8::gemm_phase<pg8::EpiStoreBf16, pg8::StaticOrder>(F.lds, 1024, S, E);
        load_tw_lds(F);
        for (int c = F.bid; c < 512; c += F.G) filter_item(F, c);
    } SEAM(1);

    if (IN(2)) {
        load_tw_lds(F);
        for (int it = F.bid; it < 2048; it += F.G) hyena_item(F, it >> 2, it & 3);
        for (int it = F.bid; it < 2048; it += F.G) fourier_item(F, it);
    } SEAM(2);

    if (IN(3)) { phase_headnorm(F); } SEAM(3);

    if (IN(4)) {
        pg8::StaticOrder S; S.init(F.ws + WS_YN, F.ws + WS_WOUT_T, T_TOK, 1024, 1024, F.G, F.bid);
        pg8::EpiResF32 E{F.x, X1, 1024};
        pg8::gemm_phase<pg8::EpiResF32, pg8::StaticOrder>(F.lds, 1024, S, E);
    } SEAM(4);

    if (IN(5)) { phase_route(F, X1); } SEAM(5);

    if (IN(6)) { phase_lists(F); } SEAM(6);

    if (IN(7)) {
        const int* TILE_E = WSP(int, WS_TILE_E); const int ntiles = __builtin_amdgcn_readfirstlane(TILE_E[MAX_TILES]);
        pg8::MoeOrder S; S.init(F.ws + WS_PT, F.ws + WS_WGU_T, TILE_E, ntiles, 1024, F.G, F.bid);
        pg8::EpiSwiGLU E{WSP(bf16, WS_YT)};
        pg8::gemm_phase<pg8::EpiSwiGLU, pg8::MoeOrder>(F.lds, 1024, S, E);
    } SEAM(7);

    if (IN(8)) {
        const int* TILE_E = WSP(int, WS_TILE_E); const int ntiles = __builtin_amdgcn_readfirstlane(TILE_E[MAX_TILES]);
        pg8::MoeOrder S; S.init(F.ws + WS_YT, F.ws + WS_WD_T, TILE_E, ntiles, 512, F.G, F.bid);
        pg8::EpiMoeDown E{WSP(bf16, WS_PT), WSP(int, WS_LIST), WSP(float, WS_ROWW)};
        pg8::gemm_phase<pg8::EpiMoeDown, pg8::MoeOrder>(F.lds, 512, S, E);
    } SEAM(8);

    if (IN(9)) { phase_final(F, X1); }
#undef IN
#undef SEAM
}


extern "C" void kernel_launch(void* const* d_in, const int* in_sizes, int n_in, void* d_out, int out_size, void* d_ws, size_t ws_size, hipStream_t stream) {
    static int grid = 0;
    if (grid == 0) {
        if (n_in != 23 || in_sizes[0] != T_TOK * D_MODEL || out_size != T_TOK * D_MODEL || ws_size < WS_END) { fprintf(stderr, "kernel_launch: unexpected shapes (n_in %d, in0 %d, out %d, ws %zu)\n", n_in, n_in > 0 ? in_sizes[0] : -1, out_size, ws_size); grid = -1; return; }
        int dev = 0, cus = 0;
        if (hipGetDevice(&dev) != hipSuccess || hipDeviceGetAttribute(&cus, hipDeviceAttributeMultiprocessorCount, dev) != hipSuccess) { grid = -1; return; }
        if (hipFuncSetAttribute((const void*)mk_fwd, hipFuncAttributeMaxDynamicSharedMemorySize, LDS_BYTES) != hipSuccess) { fprintf(stderr, "kernel_launch: hipFuncSetAttribute failed\n"); grid = -1; return; }
        int per_cu = 0;
        if (hipOccupancyMaxActiveBlocksPerMultiprocessor(&per_cu, (const void*)mk_fwd, NTHREADS, LDS_BYTES) != hipSuccess || per_cu < 1) fprintf(stderr, "kernel_launch: occupancy query reports %d\n", per_cu);
        (void)hipGetLastError();
        grid = cus;
    }
    if (grid < 0) return;
    (void)hipMemsetAsync((char*)d_ws + WS_CTL, 0, CTL_ZERO_BYTES, stream);
    Args a{};
    for (int i = 0; i < 23; ++i) a.in[i] = (const float*)d_in[i];
    a.out = (float*)d_out; a.ws = (unsigned char*)d_ws;
#if MK_N_LAUNCHES == 1
    a.ph_lo = 0; a.ph_hi = N_PHASES;
    hipLaunchKernelGGL(mk_fwd, dim3(grid), dim3(NTHREADS), LDS_BYTES, stream, a);
#else
    for (int p = 0; p < N_PHASES; ++p) {
        a.ph_lo = p; a.ph_hi = p + 1;
        hipLaunchKernelGGL(mk_fwd, dim3(grid), dim3(NTHREADS), LDS_BYTES, stream, a);
#if MK_CHECK
        launch_checks(p, a, grid, stream);
#endif
    }
#if MK_CHECK
    launch_encode(a, grid, stream);
#endif
#endif
}
```

```cpp
#include <hip/hip_runtime.h>
#include <cstdio>
#include <cstdint>

#define MK_N_LAUNCHES 1
#define MK_DUP -1
#define MK_CHECK 0

#ifndef MK_DUP
#define MK_DUP -1
#endif
constexpr int D_MODEL = 1024, BATCH = 8, SEQ = 4096, T_TOK = BATCH * SEQ;
constexpr int D_HYENA = 512, D_FOURIER = 512, D_IN_PROJ = 2048, N_EXP = 32, D_EXPERT = 512;
constexpr int NPT_ROWS = 2048;
constexpr float EPS = 1e-6f;
constexpr int MAX_ROWS = 65536 + 32 * 256;
constexpr int MAX_TILES = MAX_ROWS / 256;
constexpr int NWAVES = 8, NTHREADS = 512;

constexpr size_t MiB = 1u << 20;
constexpr size_t WS_CTL = 0, CTL_ZERO_BYTES = 64 * 1024;
constexpr size_t WS_TOT = 48 * 1024;
constexpr size_t WS_CHK = 192 * 1024;
constexpr size_t WS_TW4096 = 3 * MiB;
constexpr size_t WS_TW8192 = 3 * MiB + 32 * 1024;
constexpr size_t WS_H3 = 4 * MiB;
constexpr size_t WS_WIN_T = 8 * MiB;
constexpr size_t WS_WOUT_T = 13 * MiB;
constexpr size_t WS_WGU_T = 16 * MiB;
constexpr size_t WS_WD_T = 80 * MiB;
constexpr size_t WS_KF = 112 * MiB;
constexpr size_t WS_HN = 144 * MiB;
constexpr size_t WS_PT = 208 * MiB;
constexpr size_t WS_X1Q = 208 * MiB;
constexpr size_t WS_YP = 144 * MiB;
constexpr size_t WS_X1 = 272 * MiB;
constexpr int ECAP = 32768;
constexpr size_t WS_LIST = 336 * MiB;
constexpr size_t WS_ROWW = 340 * MiB;
constexpr size_t WS_ROWR = 344 * MiB;
constexpr size_t WS_YT = 368 * MiB;
constexpr size_t WS_YN = 440 * MiB;
constexpr size_t WS_KT = WS_YN;
constexpr size_t WS_SP = WS_YT + (size_t)512 * T_TOK * 2;
constexpr size_t WS_END = 504 * MiB;

constexpr int LDS_BYTES = 163840;
constexpr int BARST_OFF = LDS_BYTES - 64;
constexpr int FFT_BUF_BYTES = 4352 * 8;
constexpr int L_BUFA = 0, L_BUFB = FFT_BUF_BYTES, L_TW = 2 * FFT_BUF_BYTES, L_SCR = L_TW + 32768, L_RED = L_SCR + 32768, L_TW256 = L_RED + 1024;
static_assert(L_TW256 + 2048 <= BARST_OFF, "LDS map");
constexpr int M_TW = 98304, M_TW256 = M_TW + 32768;
constexpr int L_TILES = 132 * 1024;

#define GAS __attribute__((address_space(1)))
#define LAS __attribute__((address_space(3)))
typedef unsigned short bf16;
typedef float f32x4 __attribute__((ext_vector_type(4)));
typedef float f32x2 __attribute__((ext_vector_type(2)));
typedef unsigned u32x4 __attribute__((ext_vector_type(4)));
typedef unsigned u32x2 __attribute__((ext_vector_type(2)));
#ifndef MK_WT
#define MK_WT 1
#endif
__device__ __forceinline__ void st16_plain(void* p, u32x4 v) { *(u32x4*)p = v; }
__device__ __forceinline__ void st16_wt(void* p, u32x4 v) {
#if MK_WT
    asm volatile("global_store_dwordx4 %0, %1, off sc1\n\ts_nop 1" :: "v"(p), "v"(v) : "memory");
#else
    *(u32x4*)p = v;
#endif
}
constexpr float W_SCALE = 16.0f, H_SCALE = 8.0f;
__device__ __forceinline__ unsigned pk4_fp8s(float a, float b, float c, float d, float sc) {
    a = __builtin_amdgcn_fmed3f(a * sc, -448.f, 448.f); b = __builtin_amdgcn_fmed3f(b * sc, -448.f, 448.f); c = __builtin_amdgcn_fmed3f(c * sc, -448.f, 448.f); d = __builtin_amdgcn_fmed3f(d * sc, -448.f, 448.f);
    int t = __builtin_amdgcn_cvt_pk_fp8_f32(a, b, 0, false); t = __builtin_amdgcn_cvt_pk_fp8_f32(c, d, t, true); return (unsigned)t;
}
#define LDS_WAIT() asm volatile("s_waitcnt lgkmcnt(0)" ::: "memory")
__device__ __forceinline__ unsigned f2bf(float f) { unsigned u = __builtin_bit_cast(unsigned, f); return (u + 0x7fffu + ((u >> 16) & 1u)) >> 16; }
__device__ __forceinline__ unsigned pk2(float lo, float hi) { return f2bf(lo) | (f2bf(hi) << 16); }
__device__ __forceinline__ unsigned pk2h(float lo, float hi) { typedef float f32x2_t __attribute__((ext_vector_type(2))); typedef __bf16 bf16x2_t __attribute__((ext_vector_type(2))); const f32x2_t v = {lo, hi}; const bf16x2_t b = __builtin_convertvector(v, bf16x2_t); return __builtin_bit_cast(unsigned, b); }
__device__ __forceinline__ float bflo(unsigned w) { return __builtin_bit_cast(float, w << 16); }
__device__ __forceinline__ float bfhi(unsigned w) { return __builtin_bit_cast(float, w & 0xffff0000u); }
__device__ __forceinline__ float bf1(bf16 h) { return __builtin_bit_cast(float, (unsigned)h << 16); }
__device__ __forceinline__ float wave_sum(float v) {
#pragma unroll
    for (int o = 1; o < 64; o <<= 1) v += __shfl_xor(v, o);
    return v;
}

namespace pg8 {
#define PG8_LAS __attribute__((address_space(3)))
typedef unsigned short bf16_t;
typedef short bf16x8 __attribute__((ext_vector_type(8)));
typedef float f32x4 __attribute__((ext_vector_type(4)));
typedef unsigned u32x4 __attribute__((ext_vector_type(4)));
typedef unsigned u32x2 __attribute__((ext_vector_type(2)));
constexpr int BM = 256, BK = 64, HALF = 128, HTB = HALF * BK * 2  , STAGE_BYTES = 8 * HTB, NXCD = 8, WGM = 8;

__host__ __device__ __forceinline__ int lds_byte(int r, int c) { const int st = (r >> 4) * 2 + (c >> 5), rr = r & 15, cc = c & 31, ob = rr * 64 + cc * 2; return st * 1024 + (ob ^ (((ob >> 9) & 1) << 5)); }
__host__ __device__ __forceinline__ void stage_rc(int b, int& R, int& C) { const int st = b / 1024, sb = b % 1024, swz = sb ^ (((sb >> 9) & 1) << 5); R = (st >> 1) * 16 + swz / 64; C = (st & 1) * 32 + (swz % 64) / 2; }
__host__ __device__ __forceinline__ int perm32(int rho) { const int n = rho >> 4, i = rho & 15; return 8 * (i >> 2) + 4 * n + (i & 3); }

struct Unit { int pm, pn; const char* a; const char* b; int lrow, nv; };

struct StaticOrder {
    static constexpr bool GATHER = false;
    int nM, nN, nwg, G, c, reps = 1; const char* A; const char* Bt; size_t tstep;
    __device__ void init(const void* A_, const void* Bt_, int M, int N, int K, int G_, int c_) { A = (const char*)A_; Bt = (const char*)Bt_; nM = M / BM; nN = N / BM; nwg = nM * nN; G = G_; c = c_; tstep = (size_t)BM * K * 2; }
    __device__ bool next(int i, Unit& u) const {
        long L = (long)i * G + c; if (L >= (long)nwg * reps) return false; if (L >= nwg) L -= nwg;
        int wgid = (int)L; { const int q = nwg / NXCD, r = nwg % NXCD, xcd = wgid % NXCD, off = wgid / NXCD; wgid = (xcd < r ? xcd * (q + 1) : r * (q + 1) + (xcd - r) * q) + off; }
        const int nig = WGM * nN, gid = wgid / nig, fm = gid * WGM, gsz = (nM - fm) < WGM ? (nM - fm) : WGM;
        u.pm = fm + ((wgid % nig) % gsz); u.pn = (wgid % nig) / gsz; u.a = A + (size_t)u.pm * tstep; u.b = Bt + (size_t)u.pn * tstep; u.lrow = 0; u.nv = BM; return true;
    }
};
struct MoeOrder {
    static constexpr bool GATHER = false;
    int nwg, G, c; const char* A; const char* Bt; const PG8_LAS int* tl; const PG8_LAS int* tnv; size_t a_tstep, b_tstep;
    __device__ void init(const void* A_, const void* Bt_, const PG8_LAS int* tl_, const PG8_LAS int* tnv_, int ntiles, int K, int G_, int c_, int ES = 2) { A = (const char*)A_; Bt = (const char*)Bt_; tl = tl_; tnv = tnv_; nwg = ntiles * 4; G = G_; c = c_; a_tstep = (size_t)BM * K * ES; b_tstep = (size_t)BM * K * ES; }
    __device__ bool next(int i, Unit& u) const {
        const long L = (long)i * G + c; if (L >= nwg) return false;
        int wgid = (int)L; { const int q = nwg / NXCD, r = nwg % NXCD, xcd = wgid % NXCD, off = wgid / NXCD; wgid = (xcd < r ? xcd * (q + 1) : r * (q + 1) + (xcd - r) * q) + off; }
        u.pm = wgid >> 2; u.pn = wgid & 3; u.lrow = __builtin_amdgcn_readfirstlane(tl[u.pm]); u.nv = __builtin_amdgcn_readfirstlane(tnv[u.pm]); const int e = u.lrow >> 15;
        u.a = A + (size_t)u.pm * a_tstep; u.b = Bt + (size_t)(e * 4 + u.pn) * b_tstep; return true;
    }
};

struct MoeGatherOrder {
    static constexpr bool GATHER = true;
    int nwg, G, c, es; const char* A; const char* Bt; const PG8_LAS int* tl; const PG8_LAS int* tnv; const int* list; size_t b_tstep;
    __device__ void init(const void* A_, const void* Bt_, const PG8_LAS int* tl_, const PG8_LAS int* tnv_, const int* list_, int ntiles, int K, int G_, int c_, int ES = 2) { A = (const char*)A_; Bt = (const char*)Bt_; tl = tl_; tnv = tnv_; list = list_; nwg = ntiles * 4; G = G_; c = c_; es = ES; b_tstep = (size_t)BM * K * ES; }
    __device__ bool next(int i, Unit& u) const {
        const long L = (long)i * G + c; if (L >= nwg) return false;
        int wgid = (int)L; { const int q = nwg / NXCD, r = nwg % NXCD, xcd = wgid % NXCD, off = wgid / NXCD; wgid = (xcd < r ? xcd * (q + 1) : r * (q + 1) + (xcd - r) * q) + off; }
        u.pm = wgid >> 2; u.pn = wgid & 3; u.lrow = __builtin_amdgcn_readfirstlane(tl[u.pm]); u.nv = __builtin_amdgcn_readfirstlane(tnv[u.pm]); const int e = u.lrow >> 15;
        u.a = A; u.b = Bt + (size_t)(e * 4 + u.pn) * b_tstep; return true;
    }
    __device__ __forceinline__ void offsets(const Unit& u, int K, const int (&R)[2], const int (&C)[2], unsigned (&o)[2][2]) const {
#pragma unroll
        for (int h = 0; h < 2; ++h)
#pragma unroll
            for (int i = 0; i < 2; ++i) { const int lr = h * HALF + R[i]; const int pr = list[u.lrow + (lr < u.nv ? lr : 0)]; const int tok = (lr < u.nv ? pr : 0) >> 1; o[h][i] = (unsigned)(tok * K) * (unsigned)es + (unsigned)C[i] * 2u; }
    }
};

__device__ __forceinline__ unsigned cvt_pk_bf16(float lo, float hi) { unsigned r; asm volatile("v_cvt_pk_bf16_f32 %0, %1, %2" : "=v"(r) : "v"(lo), "v"(hi)); return r; }

struct EpiStoreBf16 {
    static constexpr bool PERM = true;
    bf16_t* O; int ldc;
    __device__ __forceinline__ void operator()(const f32x4 (&acc)[2][2][4][2], const Unit& u, int wr, int wc, int fr, int fq) const {
        const int row0 = u.pm * BM + wr * 64 + fr; const int col0 = u.pn * BM + wc * 32 + 8 * fq;
#pragma unroll
        for (int ai = 0; ai < 2; ++ai)
#pragma unroll
            for (int m = 0; m < 4; ++m) { bf16_t* rowp = O + (size_t)(row0 + ai * HALF + m * 16) * ldc + col0;
#pragma unroll
                for (int bj = 0; bj < 2; ++bj) { const f32x4 v0 = acc[ai][bj][m][0], v1 = acc[ai][bj][m][1];
                    u32x4 w; w.x = cvt_pk_bf16(v0[0], v0[1]); w.y = cvt_pk_bf16(v0[2], v0[3]); w.z = cvt_pk_bf16(v1[0], v1[1]); w.w = cvt_pk_bf16(v1[2], v1[3]);
                    *(u32x4*)(rowp + bj * HALF) = w; } }
    }
};
struct EpiStorePT {
    static constexpr bool PERM = true;
    bf16_t* O; int nrows;
    __device__ __forceinline__ void operator()(const f32x4 (&acc)[2][2][4][2], const Unit& u, int wr, int wc, int fr, int fq) const {
        const int row0 = u.pm * BM + wr * 64 + fr; const int col0 = wc * 32 + 8 * fq; bf16_t* base = O + (size_t)u.pn * nrows * 256;
#pragma unroll
        for (int ai = 0; ai < 2; ++ai)
#pragma unroll
            for (int m = 0; m < 4; ++m) { bf16_t* rowp = base + (size_t)(row0 + ai * HALF + m * 16) * 256 + col0;
#pragma unroll
                for (int bj = 0; bj < 2; ++bj) { const f32x4 v0 = acc[ai][bj][m][0], v1 = acc[ai][bj][m][1];
                    u32x4 w; w.x = cvt_pk_bf16(v0[0], v0[1]); w.y = cvt_pk_bf16(v0[2], v0[3]); w.z = cvt_pk_bf16(v1[0], v1[1]); w.w = cvt_pk_bf16(v1[2], v1[3]);
                    st16_plain(rowp + bj * HALF, w); } }
    }
};
struct EpiResF32 {
    static constexpr bool PERM = false;
    const float* base; float* out; int ldc;
    __device__ __forceinline__ void operator()(const f32x4 (&acc)[2][2][4][2], const Unit& u, int wr, int wc, int fr, int fq) const {
        const int row0 = u.pm * BM + wr * 64 + fr; const int col0 = u.pn * BM + wc * 32 + 4 * fq;
#pragma unroll
        for (int ai = 0; ai < 2; ++ai)
#pragma unroll
            for (int m = 0; m < 4; ++m) { const size_t off = (size_t)(row0 + ai * HALF + m * 16) * ldc + col0;
#pragma unroll
                for (int bj = 0; bj < 2; ++bj)
#pragma unroll
                    for (int n = 0; n < 2; ++n) { const f32x4 bs = *(const f32x4*)(base + off + bj * HALF + n * 16); *(f32x4*)(out + off + bj * HALF + n * 16) = bs + acc[ai][bj][m][n]; } }
    }
};
struct EpiResBf16 {
    static constexpr bool PERM = true;
    const float* __restrict__ base; bf16_t* __restrict__ out; int ldc;
    __device__ __forceinline__ void operator()(const f32x4 (&acc)[2][2][4][2], const Unit& u, int wr, int wc, int fr, int fq) const {
        const int row0 = u.pm * BM + wr * 64 + fr; const int col0 = u.pn * BM + wc * 32 + 8 * fq;
#pragma unroll
        for (int ai = 0; ai < 2; ++ai) {
            f32x4 r0[4][2], r1[4][2];
#pragma unroll
            for (int m = 0; m < 4; ++m) { const size_t off = (size_t)(row0 + ai * HALF + m * 16) * ldc + col0;
#pragma unroll
                for (int bj = 0; bj < 2; ++bj) { r0[m][bj] = *(const f32x4*)(base + off + bj * HALF); r1[m][bj] = *(const f32x4*)(base + off + bj * HALF + 4); } }
#pragma unroll
            for (int m = 0; m < 4; ++m) { const size_t off = (size_t)(row0 + ai * HALF + m * 16) * ldc + col0;
#pragma unroll
                for (int bj = 0; bj < 2; ++bj) { const f32x4 v0 = acc[ai][bj][m][0] + r0[m][bj], v1 = acc[ai][bj][m][1] + r1[m][bj];
                    u32x4 w; w.x = cvt_pk_bf16(v0[0], v0[1]); w.y = cvt_pk_bf16(v0[2], v0[3]); w.z = cvt_pk_bf16(v1[0], v1[1]); w.w = cvt_pk_bf16(v1[2], v1[3]);
                    st16_plain(out + off + bj * HALF, w); } }
        }
    }
};
struct EpiSwiGLU {
    static constexpr bool PERM = false;
    unsigned char* __restrict__ H; const float* __restrict__ rowr;
    __device__ __forceinline__ void operator()(const f32x4 (&acc)[2][2][4][2], const Unit& u, int wr, int wc, int fr, int fq) const {
        const int row0 = u.pm * BM + wr * 64 + fr;
#pragma unroll
        for (int ai = 0; ai < 2; ++ai)
#pragma unroll
            for (int m = 0; m < 4; ++m) { const int lr = wr * 64 + fr + ai * HALF + m * 16; const int row = row0 + ai * HALF + m * 16; const float rr = ((lr < u.nv) ? rowr[u.lrow + lr] : 0.f) * (1.0f / W_SCALE); unsigned char* rowp = H + (size_t)row * 512 + u.pn * 128 + wc * 32 + 4 * fq;
#pragma unroll
                for (int n = 0; n < 2; ++n) { const f32x4 g = acc[ai][0][m][n] * rr, up = acc[ai][1][m][n] * rr; f32x4 h;
#pragma unroll
                    for (int q = 0; q < 4; ++q) h[q] = g[q] * __builtin_amdgcn_rcpf(1.0f + __expf(-g[q])) * up[q];
                    *(unsigned*)(rowp + n * 16) = pk4_fp8s(h[0], h[1], h[2], h[3], H_SCALE); } }
    }
};
constexpr float YP_SCALE = 32.0f;
__device__ __forceinline__ unsigned pk4_fp8(float a, float b, float c, float d) {
    a = __builtin_amdgcn_fmed3f(a * YP_SCALE, -448.f, 448.f); b = __builtin_amdgcn_fmed3f(b * YP_SCALE, -448.f, 448.f); c = __builtin_amdgcn_fmed3f(c * YP_SCALE, -448.f, 448.f); d = __builtin_amdgcn_fmed3f(d * YP_SCALE, -448.f, 448.f);
    int t = __builtin_amdgcn_cvt_pk_fp8_f32(a, b, 0, false); t = __builtin_amdgcn_cvt_pk_fp8_f32(c, d, t, true); return (unsigned)t;
}
struct EpiMoeDown {
    static constexpr bool PERM = true;
    unsigned char* __restrict__ YP; const int* __restrict__ list; const float* __restrict__ roww;
    __device__ __forceinline__ void operator()(const f32x4 (&acc)[2][2][4][2], const Unit& u, int wr, int wc, int fr, int fq) const {
        const int col0 = u.pn * BM + wc * 32 + 8 * fq;
        int prv[2][4]; float wv[2][4];
#pragma unroll
        for (int ai = 0; ai < 2; ++ai)
#pragma unroll
            for (int m = 0; m < 4; ++m) { const int lr = wr * 64 + fr + ai * HALF + m * 16; const int li = u.lrow + (lr < u.nv ? lr : 0); prv[ai][m] = list[li]; wv[ai][m] = roww[li]; }
#pragma unroll
        for (int ai = 0; ai < 2; ++ai)
#pragma unroll
            for (int m = 0; m < 4; ++m) { const int lr = wr * 64 + fr + ai * HALF + m * 16; const bool ok = lr < u.nv; const int pair = ok ? prv[ai][m] : 0; const float w = ok ? wv[ai][m] : 0.f;
                if (ok) { unsigned char* rowp = YP + (size_t)pair * 1024 + col0;
#pragma unroll
                    for (int bj = 0; bj < 2; ++bj) { const f32x4 v0 = acc[ai][bj][m][0] * (w * (1.0f / (W_SCALE * H_SCALE))), v1 = acc[ai][bj][m][1] * (w * (1.0f / (W_SCALE * H_SCALE)));
                        u32x2 o; o.x = pk4_fp8(v0[0], v0[1], v0[2], v0[3]); o.y = pk4_fp8(v1[0], v1[1], v1[2], v1[3]);
                        *(u32x2*)(rowp + bj * HALF) = o; } } }
    }
};

typedef int v8i_t __attribute__((ext_vector_type(8)));
template <class Epi, class Sched, bool ALIGN_EPI = true, bool FP8 = false>
__device__ __forceinline__ void gemm_phase(PG8_LAS unsigned char* lds, const int K, const Sched& S, const Epi& E) {
    const int tid = threadIdx.x, wid = __builtin_amdgcn_readfirstlane(tid >> 6), lane = tid & 63, wr = wid >> 2, wc = wid & 3, fr = lane & 15, fq = lane >> 4;
    constexpr int ES = FP8 ? 1 : 2;
    const int nt = K * ES / (BK * 2);
    unsigned voffA[2], voffB[2]; int sR[2], sC[2];
#pragma unroll
    for (int i = 0; i < 2; ++i) { int R, C; stage_rc(tid * 16 + i * 8192, R, C); const int Rb = Epi::PERM ? ((R & ~31) + perm32(R & 31)) : R; sR[i] = R; sC[i] = C;
        voffA[i] = (unsigned)(R * K) * (unsigned)ES + (unsigned)C * 2u; voffB[i] = (unsigned)(Rb * K) * (unsigned)ES + (unsigned)C * 2u; }
    int sc127 = 0x7f7f7f7f; asm volatile("" : "+v"(sc127));
    constexpr bool GA = Sched::GATHER;
    unsigned oc[2][2], on[2][2];
    const size_t kstep = (size_t)(BK * 2);
    const size_t hstep = (size_t)HALF * K * ES;
    const unsigned ldsw = (unsigned)wid * 1024u;
    const int aoff = lds_byte(wr * 64 + fr, fq * 8), boff = lds_byte(wc * 32 + fr, fq * 8);
#define PG8_SA(b, h) (((b) * 2 + (h)) * HTB)
#define PG8_SB(b, h) ((4 + (b) * 2 + (h)) * HTB)
#define PG8_STAGE(bufoff, gbase, voff) do { _Pragma("unroll") for (int _i = 0; _i < 2; ++_i) \
        __builtin_amdgcn_global_load_lds((const unsigned*)((const char*)(gbase) + (voff)[_i]), (PG8_LAS unsigned*)(lds + (bufoff) + ldsw + _i * 8192), 16, 0, 0); } while (0)
#define PG8_LDA(dst, b, h) do { _Pragma("unroll") for (int m = 0; m < 4; ++m) _Pragma("unroll") for (int k = 0; k < 2; ++k) dst[m][k] = *(const PG8_LAS bf16x8*)(lds + PG8_SA(b, h) + aoff + m * 2048 + k * 1024); } while (0)
#define PG8_LDB(dst, b, h) do { _Pragma("unroll") for (int n = 0; n < 2; ++n) _Pragma("unroll") for (int k = 0; k < 2; ++k) dst[n][k] = *(const PG8_LAS bf16x8*)(lds + PG8_SB(b, h) + boff + n * 2048 + k * 1024); } while (0)
#define PG8_CAT(x0, x1) (v8i_t){ (int)__builtin_bit_cast(u32x4, x0).x, (int)__builtin_bit_cast(u32x4, x0).y, (int)__builtin_bit_cast(u32x4, x0).z, (int)__builtin_bit_cast(u32x4, x0).w, (int)__builtin_bit_cast(u32x4, x1).x, (int)__builtin_bit_cast(u32x4, x1).y, (int)__builtin_bit_cast(u32x4, x1).z, (int)__builtin_bit_cast(u32x4, x1).w }
#define PG8_MMA(ai, bj, At, Bt) do { __builtin_amdgcn_s_setprio(1); _Pragma("unroll") for (int m = 0; m < 4; ++m) _Pragma("unroll") for (int n = 0; n < 2; ++n) { \
        if constexpr (FP8) { const v8i_t b8_ = PG8_CAT(Bt[n][0], Bt[n][1]), a8_ = PG8_CAT(At[m][0], At[m][1]); \
            asm volatile("s_nop 1\n\tv_mfma_scale_f32_16x16x128_f8f6f4 %0, %1, %2, %0, %3, %3 op_sel_hi:[0,0,0]" : "+v"(acc[ai][bj][m][n]) : "v"(b8_), "v"(a8_), "v"(sc127)); } \
        else { _Pragma("unroll") for (int k = 0; k < 2; ++k) acc[ai][bj][m][n] = __builtin_amdgcn_mfma_f32_16x16x32_bf16(Bt[n][k], At[m][k], acc[ai][bj][m][n], 0, 0, 0); } } __builtin_amdgcn_s_setprio(0); } while (0)
#define PG8_WAIT_V(n) asm volatile("s_waitcnt vmcnt(" #n ")" ::: "memory")
#define PG8_WAIT_L(n) asm volatile("s_waitcnt lgkmcnt(" #n ")" ::: "memory")
#define PG8_BAR __builtin_amdgcn_s_barrier()
#define PG8_SCHED __builtin_amdgcn_sched_barrier(0)
    Unit cur, nxt; int ui = 0;
    if (!S.next(0, cur)) return;
    f32x4 acc[2][2][4][2];
#pragma unroll
    for (int a = 0; a < 2; ++a)
#pragma unroll
        for (int b = 0; b < 2; ++b)
#pragma unroll
            for (int m = 0; m < 4; ++m)
#pragma unroll
                for (int n = 0; n < 2; ++n) acc[a][b][m][n] = (f32x4){0.f, 0.f, 0.f, 0.f};
    bf16x8 At[4][2], B0[2][2], B1[2][2];
    const char* cA = cur.a; const char* cB = cur.b;
    const size_t hA = GA ? (size_t)0 : hstep;
    if constexpr (GA) { S.offsets(cur, K, sR, sC, oc); }
#define PG8_OA(h, sel) (GA ? (sel)[h] : voffA)
    PG8_STAGE(PG8_SB(0, 0), cB, voffB); PG8_STAGE(PG8_SB(0, 1), cB + hstep, voffB); PG8_STAGE(PG8_SA(0, 0), cA, PG8_OA(0, oc)); PG8_STAGE(PG8_SA(0, 1), cA + hA, PG8_OA(1, oc));
    if (wr == 1) PG8_BAR;
    PG8_WAIT_V(2); PG8_BAR;
    PG8_STAGE(PG8_SB(1, 0), cB + kstep, voffB); PG8_STAGE(PG8_SA(1, 0), cA + kstep, PG8_OA(0, oc)); PG8_STAGE(PG8_SB(1, 1), cB + hstep + kstep, voffB);
    PG8_WAIT_V(6); PG8_BAR;
    for (;;) {
        const bool has_next = S.next(ui + 1, nxt);
        const char* nA = has_next ? nxt.a : cA; const char* nB = has_next ? nxt.b : cB;
        if constexpr (GA) { if (has_next) S.offsets(nxt, K, sR, sC, on); else {
#pragma unroll
            for (int h = 0; h < 2; ++h)
#pragma unroll
                for (int i = 0; i < 2; ++i) on[h][i] = oc[h][i]; } }
#pragma unroll 1
        for (int t = 0; t < nt; t += 2) {
            const bool last = (t == nt - 2);
            const char* a1 = cA + (size_t)(t + 1) * kstep;
            const char* a2 = last ? nA : cA + (size_t)(t + 2) * kstep; const char* b2 = last ? nB : cB + (size_t)(t + 2) * kstep;
            const char* a3 = a2 + kstep; const char* b3 = b2 + kstep;
            unsigned o2[2][2];
            if constexpr (GA) {
#pragma unroll
                for (int h = 0; h < 2; ++h)
#pragma unroll
                    for (int i = 0; i < 2; ++i) o2[h][i] = last ? on[h][i] : oc[h][i]; }
            PG8_LDB(B0, 0, 0); PG8_LDB(B1, 0, 1); PG8_SCHED; PG8_LDA(At, 0, 0); PG8_STAGE(PG8_SA(1, 1), a1 + hA, PG8_OA(1, oc));
            PG8_WAIT_V(8); PG8_WAIT_L(0); PG8_BAR; PG8_MMA(0, 0, At, B0); PG8_MMA(0, 1, At, B1); PG8_BAR; PG8_SCHED;
            PG8_LDA(At, 0, 1); PG8_STAGE(PG8_SB(0, 0), b2, voffB); PG8_STAGE(PG8_SB(0, 1), b2 + hstep, voffB); PG8_STAGE(PG8_SA(0, 0), a2, PG8_OA(0, o2));
            PG8_WAIT_V(8); PG8_WAIT_L(0); PG8_BAR; PG8_MMA(1, 0, At, B0); PG8_MMA(1, 1, At, B1); PG8_BAR; PG8_SCHED;
            PG8_LDB(B0, 1, 0); PG8_LDB(B1, 1, 1); PG8_SCHED; PG8_LDA(At, 1, 0); PG8_STAGE(PG8_SA(0, 1), a2 + hA, PG8_OA(1, o2));
            PG8_WAIT_V(8); PG8_WAIT_L(0); PG8_BAR; PG8_MMA(0, 0, At, B0); PG8_MMA(0, 1, At, B1); PG8_BAR; PG8_SCHED;
            PG8_LDA(At, 1, 1); PG8_STAGE(PG8_SB(1, 0), b3, voffB); PG8_STAGE(PG8_SB(1, 1), b3 + hstep, voffB); PG8_STAGE(PG8_SA(1, 0), a3, PG8_OA(0, o2));
            PG8_WAIT_V(8); PG8_WAIT_L(0); PG8_BAR; PG8_MMA(1, 0, At, B0); PG8_MMA(1, 1, At, B1); PG8_BAR; PG8_SCHED;
        }
        if constexpr (ALIGN_EPI) { if (wr == 0) PG8_BAR; }
        if constexpr (FP8) asm volatile("s_nop 7\n\ts_nop 7" : "+v"(acc[1][1][0][0]), "+v"(acc[1][1][0][1]), "+v"(acc[1][1][1][0]), "+v"(acc[1][1][1][1]), "+v"(acc[1][1][2][0]), "+v"(acc[1][1][2][1]), "+v"(acc[1][1][3][0]), "+v"(acc[1][1][3][1]) :: "memory");
        E(acc, cur, wr, wc, fr, fq);
        if (!has_next) break;
#pragma unroll
        for (int a = 0; a < 2; ++a)
#pragma unroll
            for (int b = 0; b < 2; ++b)
#pragma unroll
                for (int m = 0; m < 4; ++m)
#pragma unroll
                    for (int n = 0; n < 2; ++n) acc[a][b][m][n] = (f32x4){0.f, 0.f, 0.f, 0.f};
        cur = nxt; cA = nA; cB = nB; ++ui;
        if constexpr (GA) {
#pragma unroll
            for (int h = 0; h < 2; ++h)
#pragma unroll
                for (int i = 0; i < 2; ++i) oc[h][i] = on[h][i]; }
        if constexpr (ALIGN_EPI) { if (wr == 1) PG8_BAR; }
    }
    PG8_WAIT_V(0);
    if constexpr (!ALIGN_EPI) { if (wr == 0) PG8_BAR; }
    PG8_BAR;
#undef PG8_SA
#undef PG8_OA
#undef PG8_CAT
#undef PG8_SB
#undef PG8_STAGE
#undef PG8_LDA
#undef PG8_LDB
#undef PG8_MMA
#undef PG8_WAIT_V
#undef PG8_WAIT_L
#undef PG8_BAR
#undef PG8_SCHED
}
}

#define FDEV __device__ __forceinline__
#define LDSPTR LAS
#define CF_DEFINED
typedef float cf __attribute__((ext_vector_type(2)));
#ifndef FFT_ENGINE_H
#define FFT_ENGINE_H
#ifndef CF_DEFINED
struct cf { float x, y; };
#endif
FDEV cf mkc(float a, float b) { cf r; r.x = a; r.y = b; return r; }
FDEV cf cadd(cf a, cf b) { return mkc(a.x + b.x, a.y + b.y); }
FDEV cf csub(cf a, cf b) { return mkc(a.x - b.x, a.y - b.y); }
FDEV cf cmul(cf a, cf b) { return mkc(a.x * b.x - a.y * b.y, a.x * b.y + a.y * b.x); }
FDEV cf cmulc(cf a, cf b) { return mkc(a.x * b.x + a.y * b.y, a.y * b.x - a.x * b.y); }
FDEV cf mul_mi(cf a) { return mkc(a.y, -a.x); }
FDEV cf mul_pi(cf a) { return mkc(-a.y, a.x); }
constexpr int FFT_N = 4096, FFT_LDS_ELEMS = 16 * 272;
FDEV int fpos(int p) { return 272 * (p >> 8) + 17 * ((p >> 4) & 15) + (p & 15); }

template <bool INV> FDEV void dft16(cf (&v)[16]) {
    const float C1 = 0.92387953251128674f, S1 = 0.38268343236508977f, C2 = 0.70710678118654752f;
#pragma unroll
    for (int n0 = 0; n0 < 4; ++n0) {
        cf x0 = v[n0], x1 = v[4 + n0], x2 = v[8 + n0], x3 = v[12 + n0];
        cf A = cadd(x0, x2), B = csub(x0, x2), C = cadd(x1, x3), D = csub(x1, x3);
        cf Dm = INV ? mul_pi(D) : mul_mi(D);
        v[n0] = cadd(A, C); v[4 + n0] = cadd(B, Dm); v[8 + n0] = csub(A, C); v[12 + n0] = csub(B, Dm);
    }
#define W16(m) (mkc( (m)==0?1.f:(m)==1?C1:(m)==2?C2:(m)==3?S1:(m)==4?0.f:(m)==6?-C2:(m)==9?-C1:0.f, \
                    (INV?1.f:-1.f) * ((m)==0?0.f:(m)==1?S1:(m)==2?C2:(m)==3?C1:(m)==4?1.f:(m)==6?C2:(m)==9?-S1:0.f) ))
    v[4 + 1] = cmul(v[4 + 1], W16(1)); v[4 + 2] = cmul(v[4 + 2], W16(2)); v[4 + 3] = cmul(v[4 + 3], W16(3));
    v[8 + 1] = cmul(v[8 + 1], W16(2)); v[8 + 2] = cmul(v[8 + 2], W16(4)); v[8 + 3] = cmul(v[8 + 3], W16(6));
    v[12 + 1] = cmul(v[12 + 1], W16(3)); v[12 + 2] = cmul(v[12 + 2], W16(6)); v[12 + 3] = cmul(v[12 + 3], W16(9));
#undef W16
    cf o[16];
#pragma unroll
    for (int k1 = 0; k1 < 4; ++k1) {
        cf x0 = v[4 * k1], x1 = v[4 * k1 + 1], x2 = v[4 * k1 + 2], x3 = v[4 * k1 + 3];
        cf A = cadd(x0, x2), B = csub(x0, x2), C = cadd(x1, x3), D = csub(x1, x3);
        cf Dm = INV ? mul_pi(D) : mul_mi(D);
        o[k1] = cadd(A, C); o[k1 + 4] = cadd(B, Dm); o[k1 + 8] = csub(A, C); o[k1 + 12] = csub(B, Dm);
    }
#pragma unroll
    for (int i = 0; i < 16; ++i) v[i] = o[i];
}

template <int GEO> FDEV int geo_idx(int r, int e) {
    if (GEO == 1) return 272 * e + 17 * (r >> 4) + (r & 15);
    if (GEO == 2) return 272 * (r >> 4) + 17 * e + (r & 15);
    return 272 * (r >> 4) + 17 * (r & 15) + e;
}
template <int GEO> FDEV void fft_pass_fwd(LDSPTR cf* buf, const LDSPTR cf* tw, const LDSPTR cf* tw256, int r) {
    cf v[16];
#pragma unroll
    for (int e = 0; e < 16; ++e) v[e] = buf[geo_idx<GEO>(r, e)];
    dft16<false>(v);
    if (GEO == 1) {
#pragma unroll
        for (int s = 1; s < 16; ++s) v[s] = cmul(v[s], tw[(r * s) & 4095]);
    } else if (GEO == 2) {
        const int t = r & 15;
#pragma unroll
        for (int s = 1; s < 16; ++s) v[s] = cmul(v[s], tw256[t * s]);
    }
#pragma unroll
    for (int e = 0; e < 16; ++e) buf[geo_idx<GEO>(r, e)] = v[e];
}
template <int GEO> FDEV void fft_pass_inv(LDSPTR cf* buf, const LDSPTR cf* tw, const LDSPTR cf* tw256, int r) {
    cf v[16];
#pragma unroll
    for (int e = 0; e < 16; ++e) v[e] = buf[geo_idx<GEO>(r, e)];
    if (GEO == 1) {
#pragma unroll
        for (int s = 1; s < 16; ++s) v[s] = cmulc(v[s], tw[(r * s) & 4095]);
    } else if (GEO == 2) {
        const int t = r & 15;
#pragma unroll
        for (int s = 1; s < 16; ++s) v[s] = cmulc(v[s], tw256[t * s]);
    }
    dft16<true>(v);
#pragma unroll
    for (int e = 0; e < 16; ++e) buf[geo_idx<GEO>(r, e)] = v[e];
}
FDEV int freq_pos(int k) { return 256 * (k & 15) + 16 * ((k >> 4) & 15) + (k >> 8); }
#endif

#define XB_TMO      128
#define XB_XCNT(j)  (256  + 64 * (j))
#define XB_XSUB(j)  (1280 + 64 * (j))
#define XB_XGEN(j)  (2304 + 64 * (j))
#define XB_TOP      3328
#define XB_TOPGEN   3392
#define XCD_BAR_WORDS 3456
#define XB_SPIN_CAP (1u << 18)
__device__ __forceinline__ unsigned xb_ld(unsigned* p)              { return __hip_atomic_load(p, __ATOMIC_RELAXED, __HIP_MEMORY_SCOPE_AGENT); }
__device__ __forceinline__ unsigned xb_add(unsigned* p, unsigned v) { return __hip_atomic_fetch_add(p, v, __ATOMIC_RELAXED, __HIP_MEMORY_SCOPE_AGENT); }
__device__ __forceinline__ unsigned xb_xcc_id() { return (unsigned)__builtin_amdgcn_s_getreg((3 << 11) | 20) & 0xFu; }
#define XB_SPIN(cond, bar) do { unsigned _sp = 0; while (cond) { __builtin_amdgcn_s_sleep(1); \
    if ((++_sp & 255u) == 0u) { if (xb_ld(&(bar)[XB_TMO])) break; if (_sp > XB_SPIN_CAP) { atomicAdd(&(bar)[XB_TMO], 1u); break; } } } } while (0)
struct XcdBarrier { unsigned* bar; unsigned x; volatile LAS unsigned* st; };
__device__ __forceinline__ XcdBarrier xcd_barrier_post(unsigned* bar, volatile LAS unsigned* st) {
    XcdBarrier b; b.bar = bar; b.x = xb_xcc_id(); b.st = st;
    if (threadIdx.x == 0) (void)xb_add(&bar[XB_XCNT(b.x)], 1u);
    return b;
}
__device__ __forceinline__ void xcd_barrier_complete(unsigned* bar, unsigned x, unsigned& nloc, unsigned& nx) {
    const unsigned G = gridDim.x * gridDim.y * gridDim.z;
    unsigned sum, cnt, mine, sp = 0u;
    for (;;) {
        sum = 0u; cnt = 0u; mine = 0u;
#pragma unroll
        for (unsigned j = 0; j < 16; ++j) { const unsigned c = xb_ld(&bar[XB_XCNT(j)]); sum += c; cnt += (c > 0u) ? 1u : 0u; mine = (j == x) ? c : mine; }
        if (sum == G) break;
        __builtin_amdgcn_s_sleep(1);
        if ((++sp & 255u) == 0u) { if (xb_ld(&bar[XB_TMO])) break; if (sp > XB_SPIN_CAP) { atomicAdd(&bar[XB_TMO], 1u); break; } }
    }
    nloc = mine > 0u ? mine : 1u; nx = cnt > 0u ? cnt : 1u;
}
__device__ __forceinline__ void xcd_barrier(const XcdBarrier& b) {
    asm volatile("s_waitcnt vmcnt(0)" ::: "memory");
    __syncthreads();
    if (threadIdx.x == 0) {
        unsigned* bar = b.bar;
        __builtin_amdgcn_s_waitcnt(0);
        unsigned nloc = b.st[0], nx = b.st[1];
        if (nloc == 0u) { xcd_barrier_complete(bar, b.x, nloc, nx); b.st[0] = nloc; b.st[1] = nx; }
        const unsigned old = xb_add(&bar[XB_XSUB(b.x)], 1u);
        const unsigned gen = old / nloc;
        if (old + 1u == (gen + 1u) * nloc) {
            __builtin_amdgcn_fence(__ATOMIC_RELEASE, "agent");
            asm volatile("s_waitcnt vmcnt(0)" ::: "memory");
            const unsigned og = xb_add(&bar[XB_TOP], 1u);
            const unsigned tg = og / nx;
            if (og + 1u == (tg + 1u) * nx) xb_add(&bar[XB_TOPGEN], 1u);
            else XB_SPIN(xb_ld(&bar[XB_TOPGEN]) == tg, bar);
            __builtin_amdgcn_fence(__ATOMIC_ACQUIRE, "agent");
            xb_add(&bar[XB_XGEN(b.x)], 1u);
            asm volatile("s_waitcnt vmcnt(0)" ::: "memory");
        } else {
            XB_SPIN(xb_ld(&bar[XB_XGEN(b.x)]) == gen, bar);
            __builtin_amdgcn_fence(__ATOMIC_ACQUIRE, "agent");
            asm volatile("s_waitcnt vmcnt(0)" ::: "memory");
        }
    }
    __syncthreads();
}

struct Frame {
    LAS unsigned char* lds;
    unsigned char* ws;
    int tid, lane, wave, vcu, G, bid;
    const float *x, *norm1_g, *w_in, *conv_w, *conv_b, *f_w_in, *f_b_in, *f_w_mid, *f_b_mid, *f_freq, *f_w_out, *f_bias, *mix_g, *w_out, *norm2_g,
                *w_group, *b_group, *w_router, *b_router, *w_gate, *w_up, *w_down, *final_g;
    float* out;
};
#define WSP(T, off) ((T*)(F.ws + (off)))

__device__ __forceinline__ void transpose_item(const float* W, int ldw, bf16* WT, int ldo, LAS float* scr, int lane, const float* gk = nullptr) {
    asm volatile("" : "+s"(ldw));
    const float* Wl = W + (size_t)(lane >> 5) * ldw + (lane & 31);
    float t[32];
#pragma unroll
    for (int i = 0; i < 32; ++i) t[i] = Wl[(size_t)(2 * i) * ldw];
    if (gk) { const float* gl = gk + (lane >> 5);
#pragma unroll
        for (int i = 0; i < 32; ++i) t[i] *= gl[2 * i]; }
#pragma unroll
    for (int i = 0; i < 32; ++i) { const int kk = 2 * i + (lane >> 5); scr[kk * 33 + (lane & 31)] = t[i]; }
    LDS_WAIT(); asm volatile("" ::: "memory");
    const int c = lane & 7;
#pragma unroll
    for (int j = 0; j < 4; ++j) { const int n = (lane >> 3) + 8 * j; const LAS float* s = scr + (8 * c) * 33 + n;
        u32x4 o; o.x = pk2(s[0 * 33], s[1 * 33]); o.y = pk2(s[2 * 33], s[3 * 33]); o.z = pk2(s[4 * 33], s[5 * 33]); o.w = pk2(s[6 * 33], s[7 * 33]);
        st16_wt(WT + (size_t)n * ldo + 8 * c, o); }
    LDS_WAIT(); asm volatile("" ::: "memory");
}
__device__ __forceinline__ void transpose_item_fp8(const float* W, int ldw, unsigned char* WT, int ldo, LAS float* scr, int lane, const float* gk, float scale) {
    asm volatile("" : "+s"(ldw));
    const float* Wl = W + (size_t)(lane >> 5) * ldw + (lane & 31);
    float t[32];
#pragma unroll
    for (int i = 0; i < 32; ++i) t[i] = Wl[(size_t)(2 * i) * ldw];
    if (gk) { const float* gl = gk + (lane >> 5);
#pragma unroll
        for (int i = 0; i < 32; ++i) t[i] *= gl[2 * i]; }
#pragma unroll
    for (int i = 0; i < 32; ++i) { const int kk = 2 * i + (lane >> 5); scr[kk * 33 + (lane & 31)] = t[i]; }
    LDS_WAIT(); asm volatile("" ::: "memory");
    const int n = lane >> 1, hf = lane & 1; const LAS float* s = scr + (32 * hf) * 33 + n;
    u32x4 o0, o1;
    o0.x = pk4_fp8s(s[0 * 33], s[1 * 33], s[2 * 33], s[3 * 33], scale); o0.y = pk4_fp8s(s[4 * 33], s[5 * 33], s[6 * 33], s[7 * 33], scale);
    o0.z = pk4_fp8s(s[8 * 33], s[9 * 33], s[10 * 33], s[11 * 33], scale); o0.w = pk4_fp8s(s[12 * 33], s[13 * 33], s[14 * 33], s[15 * 33], scale);
    o1.x = pk4_fp8s(s[16 * 33], s[17 * 33], s[18 * 33], s[19 * 33], scale); o1.y = pk4_fp8s(s[20 * 33], s[21 * 33], s[22 * 33], s[23 * 33], scale);
    o1.z = pk4_fp8s(s[24 * 33], s[25 * 33], s[26 * 33], s[27 * 33], scale); o1.w = pk4_fp8s(s[28 * 33], s[29 * 33], s[30 * 33], s[31 * 33], scale);
    unsigned char* d = WT + (size_t)n * ldo + 32 * hf;
    st16_wt(d, o0); st16_wt(d + 16, o1);
    LDS_WAIT(); asm volatile("" ::: "memory");
}
__device__ __forceinline__ void rms_row_to_bf16(const float* xrow, const float* g, bf16* orow, int lane) {
    const GAS f32x4* xr = (const GAS f32x4*)xrow + lane; const GAS f32x4* gr = (const GAS f32x4*)g + lane;
    f32x4 v[4]; float s = 0.f;
#pragma unroll
    for (int j = 0; j < 4; ++j) { v[j] = xr[64 * j]; s += (v[j].x * v[j].x + v[j].y * v[j].y) + (v[j].z * v[j].z + v[j].w * v[j].w); }
    const float rinv = 1.0f / sqrtf(wave_sum(s) * (1.f / 1024.f) + EPS);
    GAS u32x2* o8 = (GAS u32x2*)orow + lane;
#pragma unroll
    for (int j = 0; j < 4; ++j) { const f32x4 gg = gr[64 * j]; u32x2 w; w.x = pk2(v[j].x * rinv * gg.x, v[j].y * rinv * gg.y); w.y = pk2(v[j].z * rinv * gg.z, v[j].w * rinv * gg.w); o8[64 * j] = w; }
}
__device__ __forceinline__ void wave_lds_sync() { asm volatile("s_waitcnt lgkmcnt(0)" ::: "memory"); }
template <int NIN, int astride> __device__ __forceinline__ void mlp_layer(const float* W  , const float* bvec, const float* fvec, const LAS float* ain, LAS float* aout, int lane) {
    float w[64];
    unsigned ul = (unsigned)lane; asm volatile("" : "+v"(ul));
#pragma unroll
    for (int i = 0; i < 64; ++i) w[i] = (i < NIN) ? W[(unsigned)(i * 64) + ul] : 0.f;
    const float b = bvec[lane], fr = fvec[lane];
#pragma unroll 1
    for (int p = 0; p < 16; ++p) {
        const LAS float* ap = ain + p * astride; float s = b;
        if (NIN == 33) {
#pragma unroll
            for (int i = 0; i < 33; ++i) s += ap[i] * w[i];
        } else {
#pragma unroll
            for (int i4 = 0; i4 < 16; ++i4) { const f32x4 hv = *(const LAS f32x4*)(ap + 4 * i4); s += (hv.x * w[4 * i4] + hv.y * w[4 * i4 + 1]) + (hv.z * w[4 * i4 + 2] + hv.w * w[4 * i4 + 3]); }
        }
        aout[p * 64 + lane] = sinf(fr * s);
    }
    asm volatile("s_waitcnt lgkmcnt(0)" ::: "memory");
}
__device__ __forceinline__ void filter_mlp_wave(Frame& F, int pb, int half, unsigned lds_off) {
    const int lane = F.lane;
    asm volatile("" : "+v"(lds_off));
    LAS float* a0 = (LAS float*)(F.lds + lds_off); LAS float* a1 = a0 + 16 * 36; LAS float* a2 = a1 + 1024;
    for (int i = lane; i < 16 * 33; i += 64) { const int p = i / 33, j = i % 33, l = 16 * pb + p; float v;
        if (j == 0) v = (float)l / 4095.0f;
        else { const int q = (j - 1) & 15; const float fq = 1e-4f + (float)q * ((15.0f - 1e-4f) / 15.0f); const float ang = fq * ((2.0f * 3.14159265358979323846f / 4096.0f) * (float)l); v = (j <= 16) ? cosf(ang) : -sinf(ang); }
        a0[p * 36 + j] = v; }
    asm volatile("s_waitcnt lgkmcnt(0)" ::: "memory");
    mlp_layer<33, 36>(F.f_w_in, F.f_b_in, F.f_freq, a0, a1, lane);
    mlp_layer<64, 64>(F.f_w_mid, F.f_b_mid, F.f_freq + 64, a1, a2, lane);
    mlp_layer<64, 64>(F.f_w_mid + 4096, F.f_b_mid + 64, F.f_freq + 128, a2, a1, lane);
    float* KT = WSP(float, WS_KT);
#pragma unroll 1
    for (int m = half; m < 16; m += 4) { const int j = 64 * m + lane;
        float w[64]; unsigned uj = (unsigned)j; asm volatile("" : "+v"(uj));
#pragma unroll
        for (int i = 0; i < 64; ++i) w[i] = F.f_w_out[(unsigned)(i * 1024) + uj];
        const float mind = -3.0701134573253946f, maxd = -15.350567286626973f;
        const float delta = fabsf(mind + (float)(j & 511) * ((maxd - mind) / 511.0f));
        f32x4* o4 = (f32x4*)(KT + (size_t)j * 4096 + 16 * pb);
#pragma unroll 1
        for (int pg = 0; pg < 4; ++pg) {
            float acc[4];
#pragma unroll
            for (int q = 0; q < 4; ++q) { const LAS float* ap = a1 + (4 * pg + q) * 64; float sacc = 0.f;
#pragma unroll
                for (int i4 = 0; i4 < 16; ++i4) { const f32x4 hv = *(const LAS f32x4*)(ap + 4 * i4); sacc += (hv.x * w[4 * i4] + hv.y * w[4 * i4 + 1]) + (hv.z * w[4 * i4 + 2] + hv.w * w[4 * i4 + 3]); }
                acc[q] = sacc * __expf(-((float)(16 * pb + 4 * pg + q) / 4095.0f) * delta); }
            o4[pg] = (f32x4){acc[0], acc[1], acc[2], acc[3]};
        }
    }
}
constexpr int WD_HERE = 4096;
__device__ __forceinline__ void phase_prologue(Frame& F) {
    { const int gt = F.bid * NTHREADS + F.tid;
      if (gt < 4096) { f32x2 w; w.x = cospif((float)gt * (1.0f / 2048.0f)); w.y = -sinpif((float)gt * (1.0f / 2048.0f)); WSP(f32x2, WS_TW4096)[gt] = w; }
      else if (gt < 8192) { const int n = gt - 4096; f32x2 w; w.x = cospif((float)n * (1.0f / 4096.0f)); w.y = -sinpif((float)n * (1.0f / 4096.0f)); WSP(f32x2, WS_TW8192)[n] = w; } }
    LAS unsigned* ticket = (LAS unsigned*)(F.lds + 158 * 1024);
    for (int rr_ = 0; rr_ < ((MK_DUP == 15) ? 2 : 1); ++rr_) {
    __syncthreads();
    if (F.tid == 0) ticket[0] = 0u;
    __syncthreads();
    if (F.wave >= 4 && rr_ == 0) { for (int pb = F.bid; pb < 256; pb += F.G) filter_mlp_wave(F, pb, F.wave - 4, (unsigned)((72 + 12 * (F.wave - 4)) * 1024)); }
    {
        LAS float* scr = (LAS float*)(F.lds + F.wave * 8704);
        constexpr int I_IN = 16 * 64, I_OUT = 16 * 32, I_G = 32 * 16 * 16, I_D = 32 * 8 * 32, I_RMS = T_TOK / 4;
        constexpr int NITEMS = I_IN + I_OUT + 2 * I_G + I_RMS + WD_HERE;
        bf16* WIN_T = WSP(bf16, WS_WIN_T); bf16* WOUT_T = WSP(bf16, WS_WOUT_T); unsigned char* WGU8 = WSP(unsigned char, WS_WGU_T); unsigned char* WD8 = WSP(unsigned char, WS_WD_T); bf16* HN = WSP(bf16, WS_HN);
        f32x4 gg[4];
#pragma unroll
        for (int j = 0; j < 4; ++j) gg[j] = ((const GAS f32x4*)F.norm1_g)[64 * j + F.lane];
        for (;;) {
            unsigned tk = 0; if (F.lane == 0) tk = __hip_atomic_fetch_add((unsigned*)ticket, 1u, __ATOMIC_RELAXED, __HIP_MEMORY_SCOPE_WORKGROUP);
            tk = __builtin_amdgcn_readfirstlane(tk);
            const long itl = (long)tk * F.G + F.vcu; if (itl >= NITEMS) break;
            int r = (int)itl;
            if (r < I_RMS) {
                const int m0 = 4 * r; f32x4 v[4][4];
#pragma unroll
                for (int q = 0; q < 4; ++q) { const GAS f32x4* xr = (const GAS f32x4*)(F.x + (size_t)(m0 + q) * 1024) + F.lane;
#pragma unroll
                    for (int j = 0; j < 4; ++j) v[q][j] = xr[64 * j]; }
#pragma unroll
                for (int q = 0; q < 4; ++q) { float s = 0.f;
#pragma unroll
                    for (int j = 0; j < 4; ++j) s += (v[q][j].x * v[q][j].x + v[q][j].y * v[q][j].y) + (v[q][j].z * v[q][j].z + v[q][j].w * v[q][j].w);
                    const float rinv = 1.0f / sqrtf(wave_sum(s) * (1.f / 1024.f) + EPS);
                    GAS u32x2* o8 = (GAS u32x2*)(HN + (size_t)(m0 + q) * 1024) + F.lane;
#pragma unroll
                    for (int j = 0; j < 4; ++j) { u32x2 w; w.x = pk2(v[q][j].x * rinv * gg[j].x, v[q][j].y * rinv * gg[j].y); w.y = pk2(v[q][j].z * rinv * gg[j].z, v[q][j].w * rinv * gg[j].w); o8[64 * j] = w; } }
                continue; } r -= I_RMS;
            if (r < I_IN) { const int kb = r / 64, nb = r % 64; transpose_item(F.w_in + (size_t)(64 * kb) * D_IN_PROJ + 32 * nb, D_IN_PROJ, WIN_T + (size_t)(32 * nb) * 1024 + 64 * kb, 1024, scr, F.lane); continue; } r -= I_IN;
            if (r < I_OUT) { const int kb = r / 32, nb = r % 32; transpose_item(F.w_out + (size_t)(64 * kb) * 1024 + 32 * nb, 1024, WOUT_T + (size_t)(32 * nb) * 1024 + 64 * kb, 1024, scr, F.lane); continue; } r -= I_OUT;
            if (r < 2 * I_G) { const int up = r / I_G; r %= I_G; const int e = r / 256, kb = (r % 256) / 16, nb = r % 16; const int n0 = 32 * nb;
                const float* W = (up ? F.w_up : F.w_gate) + (size_t)e * 1024 * 512 + (size_t)(64 * kb) * 512 + n0;
                const int orow = 256 * (n0 >> 7) + (n0 & 127) + (up ? 128 : 0);
                transpose_item_fp8(W, 512, WGU8 + ((size_t)e * 1024 + orow) * 1024 + 64 * kb, 1024, scr, F.lane, F.norm2_g + 64 * kb, W_SCALE); continue; } r -= 2 * I_G;
            { const int e = r / 256, kb = (r % 256) / 32, nb = r % 32;
              transpose_item_fp8(F.w_down + (size_t)e * 512 * 1024 + (size_t)(64 * kb) * 1024 + 32 * nb, 1024, WD8 + ((size_t)e * 1024 + 32 * nb) * 512 + 64 * kb, 512, scr, F.lane, nullptr, W_SCALE); }
        }
        (void)I_D;
    }
    }
    __syncthreads();
}
__device__ __forceinline__ void wdown_items(Frame& F, int first, int stride) {
    LAS float* scr = (LAS float*)(F.lds + F.wave * 8704); unsigned char* WD8 = WSP(unsigned char, WS_WD_T);
    for (int r = WD_HERE + first; r < 32 * 8 * 32; r += stride) { const int e = r / 256, kb = (r % 256) / 32, nb = r % 32;
        transpose_item_fp8(F.w_down + (size_t)e * 512 * 1024 + (size_t)(64 * kb) * 1024 + 32 * nb, 1024, WD8 + ((size_t)e * 1024 + 32 * nb) * 512 + 64 * kb, 512, scr, F.lane, nullptr, W_SCALE); }
}

__device__ __forceinline__ void load_tw_lds(Frame& F, int tw_off, int tw256_off) {
    __syncthreads();
    LAS f32x2* tw = (LAS f32x2*)(F.lds + tw_off); const f32x2* g = WSP(f32x2, WS_TW4096);
    f32x2 tv[8];
#pragma unroll
    for (int i = 0; i < 8; ++i) tv[i] = g[F.tid + NTHREADS * i];
    const f32x2 t2 = g[16 * (F.tid & 255)];
#pragma unroll
    for (int i = 0; i < 8; ++i) tw[F.tid + NTHREADS * i] = tv[i];
    if (F.tid < 256) ((LAS f32x2*)(F.lds + tw256_off))[F.tid] = t2;
    __syncthreads();
}
__device__ __forceinline__ void fft_fwd3(Frame& F) {
    LAS cf* buf = (LAS cf*)(F.lds + ((F.tid >> 8) ? L_BUFB : L_BUFA)); const LAS cf* tw = (const LAS cf*)(F.lds + L_TW); const LAS cf* t256 = (const LAS cf*)(F.lds + L_TW256); const int r = F.tid & 255;
    fft_pass_fwd<1>(buf, tw, t256, r); __syncthreads(); fft_pass_fwd<2>(buf, tw, t256, r); __syncthreads(); fft_pass_fwd<3>(buf, tw, t256, r); __syncthreads();
}
__device__ __forceinline__ void fft_inv3(Frame& F) {
    LAS cf* buf = (LAS cf*)(F.lds + ((F.tid >> 8) ? L_BUFB : L_BUFA)); const LAS cf* tw = (const LAS cf*)(F.lds + L_TW); const LAS cf* t256 = (const LAS cf*)(F.lds + L_TW256); const int r = F.tid & 255;
    fft_pass_inv<3>(buf, tw, t256, r); __syncthreads(); fft_pass_inv<2>(buf, tw, t256, r); __syncthreads(); fft_pass_inv<1>(buf, tw, t256, r); __syncthreads();
}
__device__ __forceinline__ void filter_item(Frame& F, int c) {
    LAS cf* bufA = (LAS cf*)(F.lds + L_BUFA); LAS cf* bufB = (LAS cf*)(F.lds + L_BUFB);
    LAS float* kfb = (LAS float*)(F.lds + L_SCR);
    LAS float* red = (LAS float*)(F.lds + L_RED);
    const float* KT = WSP(float, WS_KT); const f32x2* tw2 = WSP(f32x2, WS_TW8192);
    float sfv[8], sbv[8]; f32x2 wv[8];
#pragma unroll
    for (int i = 0; i < 8; ++i) { const int l = F.tid + NTHREADS * i; sfv[i] = KT[(size_t)c * 4096 + l]; sbv[i] = KT[(size_t)(512 + c) * 4096 + l]; wv[i] = tw2[l]; }
    float asum = 0.f;
#pragma unroll
    for (int i = 0; i < 8; ++i) { const int l = F.tid + NTHREADS * i; kfb[l] = sfv[i]; kfb[4096 + l] = sbv[i]; asum += fabsf(sfv[i]) + (l >= 1 ? fabsf(sbv[i]) : 0.f); }
    asum = wave_sum(asum);
    if (F.lane == 0) red[128 + F.wave] = asum;
    __syncthreads();
    float tot = 0.f;
#pragma unroll
    for (int i = 0; i < 8; ++i) tot += red[128 + i];
    const float sc = 1.0f / (tot * 8192.0f);
#pragma unroll
    for (int i = 0; i < 8; ++i) { const int n = F.tid + NTHREADS * i;
        const float kf = sfv[i], kbm = (n >= 1) ? kfb[4096 + 4096 - n] : 0.f;
        const float a = (kf + kbm) * sc, d = (kf - kbm) * sc;
        bufA[fpos(n)] = mkc(a, 0.f); bufB[fpos(n)] = mkc(d * wv[i].x, d * wv[i].y); }
    __syncthreads();
    fft_fwd3(F);
    f32x2* KF = WSP(f32x2, WS_KF) + (size_t)c * 8192;
    for (int p = F.tid; p < 4096; p += NTHREADS) { const cf a = bufA[fpos(p)], b = bufB[fpos(p)]; KF[p] = (f32x2){a.x, a.y}; KF[4096 + p] = (f32x2){b.x, b.y}; }
    __syncthreads();
}
__device__ __forceinline__ const bf16* pt_at(const bf16* PT, int row, int tok) { return PT + ((size_t)(tok >> 8) * NPT_ROWS + row) * 256 + (tok & 255); }
struct Row8 { u32x4 w; float lft, rgt; };
__device__ __forceinline__ Row8 row8_load(const bf16* PT, int row, int tb, int l0) {
    Row8 r; r.w = *(const u32x4*)pt_at(PT, row, tb + l0);
    const bf16 a = *pt_at(PT, row, tb + (l0 > 0 ? l0 - 1 : 0)), b = *pt_at(PT, row, tb + (l0 + 8 < 4096 ? l0 + 8 : 4095));
    r.lft = (l0 > 0) ? bf1(a) : 0.f; r.rgt = (l0 + 8 < 4096) ? bf1(b) : 0.f; return r;
}
__device__ __forceinline__ void conv8(const Row8& r, float w0, float w1, float w2, float b, float (&o)[8]) {
    float u[10];
    u[0] = r.lft; u[9] = r.rgt; const u32x4 v = r.w;
    u[1] = bflo(v.x); u[2] = bfhi(v.x); u[3] = bflo(v.y); u[4] = bfhi(v.y); u[5] = bflo(v.z); u[6] = bfhi(v.z); u[7] = bflo(v.w); u[8] = bfhi(v.w);
#pragma unroll
    for (int i = 0; i < 8; ++i) o[i] = b + w0 * u[i] + w1 * u[i + 1] + w2 * u[i + 2];
}
struct HyRaw { Row8 a0, v0, a1, v1; };
__device__ __forceinline__ void hy_load(Frame& F, int it, HyRaw& r) {
    const int c = it >> 2, bp = it & 3, l0 = 8 * F.tid; const bf16* PT = WSP(bf16, WS_PT);
    const int tb = 2 * bp * SEQ;
    r.a0 = row8_load(PT, 512 + c, tb, l0); r.v0 = row8_load(PT, 1024 + c, tb, l0); r.a1 = row8_load(PT, 512 + c, tb + SEQ, l0); r.v1 = row8_load(PT, 1024 + c, tb + SEQ, l0);
}
__device__ __forceinline__ void hyena_items(Frame& F) {
    LAS cf* bufA = (LAS cf*)(F.lds + L_BUFA); LAS cf* bufB = (LAS cf*)(F.lds + L_BUFB); const LAS cf* tw2 = (const LAS cf*)(F.lds + L_SCR);
    const bf16* PT = WSP(bf16, WS_PT); const float* cw = F.conv_w; const float* cb = F.conv_b;
    const int l0 = 8 * F.tid;
    HyRaw nx; int it = F.bid;
    if (it < 2048) hy_load(F, it, nx);
    for (; it < 2048; it += F.G) {
        const int c = it >> 2, bp = it & 3;
        float z0[8], z1[8];
        {
            const float a0 = cw[512 + c], a1 = cw[1536 + 512 + c], a2 = cw[3072 + 512 + c], ab = cb[512 + c];
            const float v0 = cw[1024 + c], v1 = cw[1536 + 1024 + c], v2 = cw[3072 + 1024 + c], vb = cb[1024 + c];
            float t1[8], t2[8];
            conv8(nx.a0, a0, a1, a2, ab, t1); conv8(nx.v0, v0, v1, v2, vb, t2);
#pragma unroll
            for (int i = 0; i < 8; ++i) z0[i] = t1[i] * t2[i];
            conv8(nx.a1, a0, a1, a2, ab, t1); conv8(nx.v1, v0, v1, v2, vb, t2);
#pragma unroll
            for (int i = 0; i < 8; ++i) z1[i] = t1[i] * t2[i];
        }
#pragma unroll
        for (int i = 0; i < 8; ++i) { const int l = l0 + i; const cf z = mkc(z0[i], z1[i]); bufA[fpos(l)] = z; bufB[fpos(l)] = cmul(z, tw2[l]); }
        f32x2 ke[8], ko[8];
        { const f32x2* KF = WSP(f32x2, WS_KF) + (size_t)c * 8192;
#pragma unroll
          for (int i = 0; i < 8; ++i) { ke[i] = KF[F.tid + 512 * i]; ko[i] = KF[4096 + F.tid + 512 * i]; } }
        __syncthreads();
        fft_fwd3(F);
#pragma unroll
        for (int i = 0; i < 8; ++i) { const int q = fpos(F.tid + 512 * i); bufA[q] = cmul(bufA[q], ke[i]); bufB[q] = cmul(bufB[q], ko[i]); }
        Row8 xa, xb;
        { const int tb = 2 * bp * SEQ; xa = row8_load(PT, c, tb, l0); xb = row8_load(PT, c, tb + SEQ, l0); }
        if (it + F.G < 2048) hy_load(F, it + F.G, nx);
        __syncthreads();
        fft_inv3(F);
        {
            const float w0 = cw[c], w1 = cw[1536 + c], w2 = cw[3072 + c], wb = cb[c]; const float bias = F.f_bias[c];
            bf16* YT = WSP(bf16, WS_YT) + (size_t)c * T_TOK + (size_t)(2 * bp) * SEQ;
            float x0a[8], x0b[8], ya[8], yb[8];
            conv8(xa, w0, w1, w2, wb, x0a); conv8(xb, w0, w1, w2, wb, x0b);
#pragma unroll
            for (int i = 0; i < 8; ++i) { const int l = l0 + i; const cf e = bufA[fpos(l)], o = bufB[fpos(l)]; const cf y = cadd(e, cmulc(o, tw2[l]));
                ya[i] = x0a[i] * (y.x + bias * z0[i]); yb[i] = x0b[i] * (y.y + bias * z1[i]); }
            u32x4 oa, ob; oa.x = pk2(ya[0], ya[1]); oa.y = pk2(ya[2], ya[3]); oa.z = pk2(ya[4], ya[5]); oa.w = pk2(ya[6], ya[7]);
            ob.x = pk2(yb[0], yb[1]); ob.y = pk2(yb[2], yb[3]); ob.z = pk2(yb[4], yb[5]); ob.w = pk2(yb[6], yb[7]);
            *(u32x4*)(YT + l0) = oa; *(u32x4*)(YT + SEQ + l0) = ob;
        }
        __syncthreads();
    }
}
struct FoRaw { u32x4 a0, d0, a1, d1; };
__device__ __forceinline__ void fo_load(Frame& F, int q, FoRaw& r) {
    const int f = F.tid >> 8, s = 2 * q + f, b = s >> 9, gc = s & 511, g = gc >> 6, cp = gc & 63, l0 = 16 * (F.tid & 255);
    const bf16* PT = WSP(bf16, WS_PT); const int r1 = 1536 + 128 * g + cp, r2 = r1 + 64, tk = b * SEQ + l0;
    r.a0 = *(const u32x4*)pt_at(PT, r1, tk); r.d0 = *(const u32x4*)pt_at(PT, r2, tk); r.a1 = *(const u32x4*)pt_at(PT, r1, tk + 8); r.d1 = *(const u32x4*)pt_at(PT, r2, tk + 8);
}
__device__ __forceinline__ void fo_put(LAS cf* buf, int l, u32x4 a, u32x4 d) {
    buf[fpos(l + 0)] = mkc(bflo(a.x), bflo(d.x)); buf[fpos(l + 1)] = mkc(bfhi(a.x), bfhi(d.x)); buf[fpos(l + 2)] = mkc(bflo(a.y), bflo(d.y)); buf[fpos(l + 3)] = mkc(bfhi(a.y), bfhi(d.y));
    buf[fpos(l + 4)] = mkc(bflo(a.z), bflo(d.z)); buf[fpos(l + 5)] = mkc(bfhi(a.z), bfhi(d.z)); buf[fpos(l + 6)] = mkc(bflo(a.w), bflo(d.w)); buf[fpos(l + 7)] = mkc(bfhi(a.w), bfhi(d.w));
}
__device__ __forceinline__ void fourier_items(Frame& F) {
    const int f = F.tid >> 8, r = F.tid & 255, l0 = 16 * r;
    LAS cf* buf = (LAS cf*)(F.lds + (f ? L_BUFB : L_BUFA));
    FoRaw nx; int q = F.bid;
    if (q < 2048) fo_load(F, q, nx);
    for (; q < 2048; q += F.G) {
        const int s = 2 * q + f, b = s >> 9, gc = s & 511;
        fo_put(buf, l0, nx.a0, nx.d0); fo_put(buf, l0 + 8, nx.a1, nx.d1);
        if (q + F.G < 2048) fo_load(F, q + F.G, nx);
        __syncthreads();
        fft_fwd3(F);
        bf16* YT = WSP(bf16, WS_YT) + (size_t)(512 + gc) * T_TOK + (size_t)b * SEQ;
        float y[16];
#pragma unroll
        for (int i = 0; i < 16; ++i) y[i] = buf[fpos(freq_pos(l0 + i))].x * (1.0f / 512.0f);
        u32x4 o0, o1; o0.x = pk2(y[0], y[1]); o0.y = pk2(y[2], y[3]); o0.z = pk2(y[4], y[5]); o0.w = pk2(y[6], y[7]);
        o1.x = pk2(y[8], y[9]); o1.y = pk2(y[10], y[11]); o1.z = pk2(y[12], y[13]); o1.w = pk2(y[14], y[15]);
        *(u32x4*)(YT + l0) = o0; *(u32x4*)(YT + l0 + 8) = o1;
        __syncthreads();
    }
}

#define MF_LO 1
constexpr int MF_NS = 288;
constexpr int MF_PS = 24;
constexpr int MF_PLANE = 6144;
typedef short bf16x8v __attribute__((ext_vector_type(8)));
typedef short s16x4v __attribute__((ext_vector_type(4)));
typedef float f32x16 __attribute__((ext_vector_type(16)));
struct DftFrag { bf16x8v hi[2], lo[2]; };
__device__ __forceinline__ void make_dft_frag(DftFrag& f, int lane, bool inv, const LAS cf* tw  ) {
    const int i = lane & 31, h = lane >> 5, ii = i & 15;
#pragma unroll
    for (int st = 0; st < 2; ++st)
#pragma unroll
        for (int j = 0; j < 8; ++j) { const int e = 8 * h + j; const int m = (ii * e) & 15; const cf w = tw[256 * m]; const float c = w.x, s = -w.y;
            const float di = inv ? s : -s;
            const float val = (st == 0) ? ((i < 16) ? c : di) : ((i < 16) ? -di : c);
            const unsigned hb = f2bf(val); const float rem = val - __builtin_bit_cast(float, hb << 16);
            f.hi[st][j] = (short)hb; f.lo[st][j] = (short)f2bf(rem); }
}
__device__ __forceinline__ unsigned cvtpk_v(float lo, float hi) { typedef float f32x2_t __attribute__((ext_vector_type(2))); typedef __bf16 bf16x2_t __attribute__((ext_vector_type(2))); const f32x2_t v = {lo, hi}; const bf16x2_t b = __builtin_convertvector(v, bf16x2_t); return __builtin_bit_cast(unsigned, b); }
__device__ __forceinline__ s16x4v lds_tr16(const LAS bf16* p) { typedef short v4i16_t __attribute__((ext_vector_type(4))); return __builtin_bit_cast(s16x4v, __builtin_amdgcn_ds_read_tr16_b64_v4i16((LAS v4i16_t*)p)); }
template <int PASS, bool INV, int EPI>
__device__ __forceinline__ void mfft_block(const LAS bf16* inR, const LAS bf16* inI, LAS bf16* outR, LAS bf16* outI, const DftFrag& M, const LAS cf* tw, const LAS cf* tw256, int cb, int lane, const cf* kf, float rs) {
    asm volatile("" : "+v"(lane));
    const int n = lane & 31, h = lane >> 5;
    bf16x8v bR, bI;
    if (PASS == 1) {
        const int g = lane >> 4, q = (lane & 15) >> 2, p = lane & 3;
        const int off = (8 * (g >> 1) + q) * MF_NS + 32 * cb + 16 * (g & 1) + 4 * p;
        const LAS bf16* pr = inR + off; const LAS bf16* pi = inI + off;
        const s16x4v r0 = lds_tr16(pr), r1 = lds_tr16(pr + 4 * MF_NS), i0 = lds_tr16(pi), i1 = lds_tr16(pi + 4 * MF_NS);
        asm volatile("" :: "v"(pr), "v"(pi) : "memory");
        bR = (bf16x8v){r0[0], r0[1], r0[2], r0[3], r1[0], r1[1], r1[2], r1[3]}; bI = (bf16x8v){i0[0], i0[1], i0[2], i0[3], i1[0], i1[1], i1[2], i1[3]};
    } else {
        const int off = (32 * cb + n) * MF_PS + 8 * h;
        bR = *(const LAS bf16x8v*)(inR + off); bI = *(const LAS bf16x8v*)(inI + off);
    }
    f32x16 acc = {0.f, 0.f, 0.f, 0.f, 0.f, 0.f, 0.f, 0.f, 0.f, 0.f, 0.f, 0.f, 0.f, 0.f, 0.f, 0.f};
    acc = __builtin_amdgcn_mfma_f32_32x32x16_bf16(M.hi[0], bR, acc, 0, 0, 0);
    acc = __builtin_amdgcn_mfma_f32_32x32x16_bf16(M.hi[1], bI, acc, 0, 0, 0);
#if MF_LO
    acc = __builtin_amdgcn_mfma_f32_32x32x16_bf16(M.lo[0], bR, acc, 0, 0, 0);
    acc = __builtin_amdgcn_mfma_f32_32x32x16_bf16(M.lo[1], bI, acc, 0, 0, 0);
#endif
    const int c = 32 * cb + n;
    int base, qs;
    if (PASS == 1) { base = MF_PS * (c & 15) + (c >> 4) + 64 * MF_PS * h; qs = 16 * MF_PS; }
    else if (PASS == 2) { base = 16 * MF_PS * (c >> 4) + (c & 15) + 4 * MF_PS * h; qs = MF_PS; }
    else { base = (c >> 4) + 16 * (c & 15) + 4 * MF_NS * h; qs = MF_NS; }
    float yr[8], yi[8];
#pragma unroll
    for (int q = 0; q < 8; ++q) { float a = acc[q], b = acc[8 + q];
        if (PASS == 1) { const int s = (q & 3) + 8 * (q >> 2) + 4 * h; const cf w = tw[(c * s) & 4095]; const float wy = INV ? -w.y : w.y; const float t = a * w.x - b * wy; b = a * wy + b * w.x; a = t; }
        else if (PASS == 2) { const int s = (q & 3) + 8 * (q >> 2) + 4 * h; const cf w = tw256[(c & 15) * s]; const float wy = INV ? -w.y : w.y; const float t = a * w.x - b * wy; b = a * wy + b * w.x; a = t; }
        else if (EPI == 1) { const cf w = kf[q]; const float t = a * w.x - b * w.y; b = -(a * w.y + b * w.x); a = t; }
        else if (EPI == 2) { a *= rs; }
        else if (EPI == 3) { a *= rs; b *= rs; }
        yr[q] = a; yi[q] = b; }
#pragma unroll
    for (int q = 0; q < 8; q += 2) { const int o0 = base + qs * ((q & 3) + 8 * (q >> 2)), o1 = o0 + qs;
        const unsigned pr = cvtpk_v(yr[q], yr[q + 1]); outR[o0] = (bf16)(pr & 0xffffu); outR[o1] = (bf16)(pr >> 16);
        if (!(PASS == 3 && EPI == 2)) { const unsigned pi = cvtpk_v(yi[q], yi[q + 1]); outI[o0] = (bf16)(pi & 0xffffu); outI[o1] = (bf16)(pi >> 16); } }
}

__device__ __forceinline__ int mf_nat(int x) { return MF_NS * (x >> 8) + (x & 255); }
__device__ __forceinline__ void fo2_load(Frame& F, int q, FoRaw& r) {
    const int f = F.tid >> 8, pp = 2 * q + f, b = pp >> 8, c = 2 * (pp & 255), l0 = 16 * (F.tid & 255);
    const bf16* PT = WSP(bf16, WS_PT); const int r1 = 1536 + c, r2 = r1 + 1, tk = b * SEQ + l0;
    r.a0 = *(const u32x4*)pt_at(PT, r1, tk); r.d0 = *(const u32x4*)pt_at(PT, r2, tk); r.a1 = *(const u32x4*)pt_at(PT, r1, tk + 8); r.d1 = *(const u32x4*)pt_at(PT, r2, tk + 8);
}
__device__ __forceinline__ void fourier_items_mfma(Frame& F) {
    const int f = F.tid >> 8, r = F.tid & 255, l0 = 16 * r, n0 = mf_nat(l0);
    LAS bf16* S0R = (LAS bf16*)(F.lds + f * 49152); LAS bf16* S0I = S0R + MF_PLANE; LAS bf16* S1R = S0R + 2 * MF_PLANE; LAS bf16* S1I = S0R + 3 * MF_PLANE;
    const LAS cf* tw = (const LAS cf*)(F.lds + M_TW); const LAS cf* t256 = (const LAS cf*)(F.lds + M_TW256);
    DftFrag Mf; make_dft_frag(Mf, F.lane, false, tw);
    const int cb0 = 2 * (F.wave & 3);
    bf16* SP = WSP(bf16, WS_SP);
    FoRaw nx; int q = F.bid;
    if (q < 1024) fo2_load(F, q, nx);
    for (; q < 1024; q += F.G) {
        const int pp = 2 * q + f, b = pp >> 8, c = 2 * (pp & 255);
        *(LAS u32x4*)(S0R + n0) = nx.a0; *(LAS u32x4*)(S0R + n0 + 8) = nx.a1; *(LAS u32x4*)(S0I + n0) = nx.d0; *(LAS u32x4*)(S0I + n0 + 8) = nx.d1;
        if (q + F.G < 1024) fo2_load(F, q + F.G, nx);
        __syncthreads();
        mfft_block<1, false, 0>(S0R, S0I, S1R, S1I, Mf, tw, t256, cb0, F.lane, nullptr, 1.f); mfft_block<1, false, 0>(S0R, S0I, S1R, S1I, Mf, tw, t256, cb0 + 1, F.lane, nullptr, 1.f);
        __syncthreads();
        mfft_block<2, false, 0>(S1R, S1I, S0R, S0I, Mf, tw, t256, cb0, F.lane, nullptr, 1.f); mfft_block<2, false, 0>(S1R, S1I, S0R, S0I, Mf, tw, t256, cb0 + 1, F.lane, nullptr, 1.f);
        __syncthreads();
        mfft_block<3, false, 0>(S0R, S0I, S1R, S1I, Mf, tw, t256, cb0, F.lane, nullptr, 1.f); mfft_block<3, false, 0>(S0R, S0I, S1R, S1I, Mf, tw, t256, cb0 + 1, F.lane, nullptr, 1.f);
        __syncthreads();
        {
            const int k0 = 8 * r, m0 = mf_nat(k0);
            const u32x4 zr = *(const LAS u32x4*)(S1R + m0), zi = *(const LAS u32x4*)(S1I + m0);
            float Zr[8], Zi[8], Mr[8], Mi[8];
            Zr[0] = bflo(zr.x); Zr[1] = bfhi(zr.x); Zr[2] = bflo(zr.y); Zr[3] = bfhi(zr.y); Zr[4] = bflo(zr.z); Zr[5] = bfhi(zr.z); Zr[6] = bflo(zr.w); Zr[7] = bfhi(zr.w);
            Zi[0] = bflo(zi.x); Zi[1] = bfhi(zi.x); Zi[2] = bflo(zi.y); Zi[3] = bfhi(zi.y); Zi[4] = bflo(zi.z); Zi[5] = bfhi(zi.z); Zi[6] = bflo(zi.w); Zi[7] = bfhi(zi.w);
#pragma unroll
            for (int i = 0; i < 8; ++i) { const int km = mf_nat((4096 - k0 - i) & 4095); Mr[i] = bf1(S1R[km]); Mi[i] = bf1(S1I[km]); }
            float Ac[8], Bc[8], Ad[8], Bd[8];
#pragma unroll
            for (int i = 0; i < 8; ++i) { Ac[i] = 0.5f * (Zr[i] + Mr[i]); Bc[i] = 0.5f * (Mi[i] - Zi[i]); Ad[i] = 0.5f * (Zi[i] + Mi[i]); Bd[i] = 0.5f * (Zr[i] - Mr[i]); }
            if (k0 == 0) { const int kn = mf_nat(2048); Bc[0] = bf1(S1R[kn]); Bd[0] = bf1(S1I[kn]); }
            bf16* s0 = SP + ((size_t)(c * 8 + b) * 2) * 2048 + k0; bf16* s1 = SP + ((size_t)((c + 1) * 8 + b) * 2) * 2048 + k0;
            u32x4 o; o.x = pk2(Ac[0], Ac[1]); o.y = pk2(Ac[2], Ac[3]); o.z = pk2(Ac[4], Ac[5]); o.w = pk2(Ac[6], Ac[7]); st16_wt(s0, o);
            o.x = pk2(Bc[0], Bc[1]); o.y = pk2(Bc[2], Bc[3]); o.z = pk2(Bc[4], Bc[5]); o.w = pk2(Bc[6], Bc[7]); st16_wt(s0 + 2048, o);
            o.x = pk2(Ad[0], Ad[1]); o.y = pk2(Ad[2], Ad[3]); o.z = pk2(Ad[4], Ad[5]); o.w = pk2(Ad[6], Ad[7]); st16_wt(s1, o);
            o.x = pk2(Bd[0], Bd[1]); o.y = pk2(Bd[2], Bd[3]); o.z = pk2(Bd[4], Bd[5]); o.w = pk2(Bd[6], Bd[7]); st16_wt(s1 + 2048, o);
        }
        __syncthreads();
    }
    __syncthreads();
}
__device__ __forceinline__ void hyena_items_mfma(Frame& F) {
    const int f = F.tid >> 8;
    LAS bf16* A0R = (LAS bf16*)F.lds; LAS bf16* A0I = A0R + MF_PLANE; LAS bf16* B0R = (LAS bf16*)(F.lds + 49152); LAS bf16* B0I = B0R + MF_PLANE;
    LAS bf16* S0R = (LAS bf16*)(F.lds + f * 49152); LAS bf16* S0I = S0R + MF_PLANE; LAS bf16* S1R = S0R + 2 * MF_PLANE; LAS bf16* S1I = S0R + 3 * MF_PLANE;
    const LAS cf* tw = (const LAS cf*)(F.lds + M_TW); const LAS cf* t256 = (const LAS cf*)(F.lds + M_TW256);
    const cf w81 = mkc(0.99999970586288221916f, -0.00076699031874270453f);
    DftFrag Mf; make_dft_frag(Mf, F.lane, false, tw);
    const bf16* PT = WSP(bf16, WS_PT); const float* cw = F.conv_w; const float* cb = F.conv_b;
    const int l0 = 8 * F.tid, n0 = mf_nat(l0), cb0 = 2 * (F.wave & 3), ln = F.lane & 31, lh = F.lane >> 5;
    HyRaw nx; int it = F.bid;
    if (it < 2048) hy_load(F, it, nx);
    for (; it < 2048; it += F.G) {
        const int c = it >> 2, bp = it & 3;
        float z0[8], z1[8];
        {
            const float a0 = cw[512 + c], a1 = cw[1536 + 512 + c], a2 = cw[3072 + 512 + c], ab = cb[512 + c];
            const float v0 = cw[1024 + c], v1 = cw[1536 + 1024 + c], v2 = cw[3072 + 1024 + c], vb = cb[1024 + c];
            float t1[8], t2[8];
            conv8(nx.a0, a0, a1, a2, ab, t1); conv8(nx.v0, v0, v1, v2, vb, t2);
#pragma unroll
            for (int i = 0; i < 8; ++i) z0[i] = t1[i] * t2[i];
            conv8(nx.a1, a0, a1, a2, ab, t1); conv8(nx.v1, v0, v1, v2, vb, t2);
#pragma unroll
            for (int i = 0; i < 8; ++i) z1[i] = t1[i] * t2[i];
        }
        {
            float br[8], bi[8];
#pragma unroll
            for (int i = 0; i < 8; ++i) { cf w = tw[(l0 >> 1) + (i >> 1)]; if (i & 1) w = cmul(w, w81); br[i] = z0[i] * w.x - z1[i] * w.y; bi[i] = z0[i] * w.y + z1[i] * w.x; }
            u32x4 v; v.x = pk2h(z0[0], z0[1]); v.y = pk2h(z0[2], z0[3]); v.z = pk2h(z0[4], z0[5]); v.w = pk2h(z0[6], z0[7]); *(LAS u32x4*)(A0R + n0) = v;
            v.x = pk2h(z1[0], z1[1]); v.y = pk2h(z1[2], z1[3]); v.z = pk2h(z1[4], z1[5]); v.w = pk2h(z1[6], z1[7]); *(LAS u32x4*)(A0I + n0) = v;
            v.x = pk2h(br[0], br[1]); v.y = pk2h(br[2], br[3]); v.z = pk2h(br[4], br[5]); v.w = pk2h(br[6], br[7]); *(LAS u32x4*)(B0R + n0) = v;
            v.x = pk2h(bi[0], bi[1]); v.y = pk2h(bi[2], bi[3]); v.z = pk2h(bi[4], bi[5]); v.w = pk2h(bi[6], bi[7]); *(LAS u32x4*)(B0I + n0) = v;
        }
        __syncthreads();
        mfft_block<1, false, 0>(S0R, S0I, S1R, S1I, Mf, tw, t256, cb0, F.lane, nullptr, 1.f); mfft_block<1, false, 0>(S0R, S0I, S1R, S1I, Mf, tw, t256, cb0 + 1, F.lane, nullptr, 1.f);
        cf kf[2][8];
        { const f32x4* KF = (const f32x4*)(WSP(f32x2, WS_KF) + (size_t)c * 8192 + (size_t)f * 4096);
#pragma unroll
          for (int j = 0; j < 2; ++j) { const int cc = 32 * (cb0 + j) + ln; const f32x4* kp = KF + (cc * 16 + 4 * lh) / 2;
              const f32x4 k0 = kp[0], k1 = kp[1], k2 = kp[4], k3 = kp[5];
              kf[j][0] = mkc(k0.x, k0.y); kf[j][1] = mkc(k0.z, k0.w); kf[j][2] = mkc(k1.x, k1.y); kf[j][3] = mkc(k1.z, k1.w);
              kf[j][4] = mkc(k2.x, k2.y); kf[j][5] = mkc(k2.z, k2.w); kf[j][6] = mkc(k3.x, k3.y); kf[j][7] = mkc(k3.z, k3.w); } }
        __syncthreads();
        mfft_block<2, false, 0>(S1R, S1I, S0R, S0I, Mf, tw, t256, cb0, F.lane, nullptr, 1.f); mfft_block<2, false, 0>(S1R, S1I, S0R, S0I, Mf, tw, t256, cb0 + 1, F.lane, nullptr, 1.f);
        __syncthreads();
        mfft_block<3, false, 1>(S0R, S0I, S1R, S1I, Mf, tw, t256, cb0, F.lane, kf[0], 1.f); mfft_block<3, false, 1>(S0R, S0I, S1R, S1I, Mf, tw, t256, cb0 + 1, F.lane, kf[1], 1.f);
        __syncthreads();
        mfft_block<1, false, 0>(S1R, S1I, S0R, S0I, Mf, tw, t256, cb0, F.lane, nullptr, 1.f); mfft_block<1, false, 0>(S1R, S1I, S0R, S0I, Mf, tw, t256, cb0 + 1, F.lane, nullptr, 1.f);
        __syncthreads();
        mfft_block<2, false, 0>(S0R, S0I, S1R, S1I, Mf, tw, t256, cb0, F.lane, nullptr, 1.f); mfft_block<2, false, 0>(S0R, S0I, S1R, S1I, Mf, tw, t256, cb0 + 1, F.lane, nullptr, 1.f);
        Row8 xa, xb;
        { const int tb = 2 * bp * SEQ; xa = row8_load(PT, c, tb, l0); xb = row8_load(PT, c, tb + SEQ, l0); }
        if (it + F.G < 2048) hy_load(F, it + F.G, nx);
        __syncthreads();
        mfft_block<3, false, 0>(S1R, S1I, S0R, S0I, Mf, tw, t256, cb0, F.lane, nullptr, 1.f); mfft_block<3, false, 0>(S1R, S1I, S0R, S0I, Mf, tw, t256, cb0 + 1, F.lane, nullptr, 1.f);
        __syncthreads();
        {
            const float w0 = cw[c], w1 = cw[1536 + c], w2 = cw[3072 + c], wb = cb[c]; const float bias = F.f_bias[c];
            bf16* YT = WSP(bf16, WS_YT) + (size_t)c * T_TOK + (size_t)(2 * bp) * SEQ;
            float x0a[8], x0b[8], ya[8], yb[8], er[8], ei[8], orr[8], oi[8];
            conv8(xa, w0, w1, w2, wb, x0a); conv8(xb, w0, w1, w2, wb, x0b);
            { const u32x4 a = *(const LAS u32x4*)(A0R + n0), b = *(const LAS u32x4*)(A0I + n0), d = *(const LAS u32x4*)(B0R + n0), g = *(const LAS u32x4*)(B0I + n0);
              er[0] = bflo(a.x); er[1] = bfhi(a.x); er[2] = bflo(a.y); er[3] = bfhi(a.y); er[4] = bflo(a.z); er[5] = bfhi(a.z); er[6] = bflo(a.w); er[7] = bfhi(a.w);
              ei[0] = bflo(b.x); ei[1] = bfhi(b.x); ei[2] = bflo(b.y); ei[3] = bfhi(b.y); ei[4] = bflo(b.z); ei[5] = bfhi(b.z); ei[6] = bflo(b.w); ei[7] = bfhi(b.w);
              orr[0] = bflo(d.x); orr[1] = bfhi(d.x); orr[2] = bflo(d.y); orr[3] = bfhi(d.y); orr[4] = bflo(d.z); orr[5] = bfhi(d.z); orr[6] = bflo(d.w); orr[7] = bfhi(d.w);
              oi[0] = bflo(g.x); oi[1] = bfhi(g.x); oi[2] = bflo(g.y); oi[3] = bfhi(g.y); oi[4] = bflo(g.z); oi[5] = bfhi(g.z); oi[6] = bflo(g.w); oi[7] = bfhi(g.w); }
#pragma unroll
            for (int i = 0; i < 8; ++i) { cf w = tw[(l0 >> 1) + (i >> 1)]; if (i & 1) w = cmul(w, w81);
                const float eim = -ei[i], oim = -oi[i];
                const float yr = er[i] + (orr[i] * w.x + oim * w.y), yi = eim + (oim * w.x - orr[i] * w.y);
                ya[i] = x0a[i] * (yr + bias * z0[i]); yb[i] = x0b[i] * (yi + bias * z1[i]); }
            u32x4 oa, ob; oa.x = pk2h(ya[0], ya[1]); oa.y = pk2h(ya[2], ya[3]); oa.z = pk2h(ya[4], ya[5]); oa.w = pk2h(ya[6], ya[7]);
            ob.x = pk2h(yb[0], yb[1]); ob.y = pk2h(yb[2], yb[3]); ob.z = pk2h(yb[4], yb[5]); ob.w = pk2h(yb[6], yb[7]);
            st16_wt(YT + l0, oa); st16_wt(YT + SEQ + l0, ob);
        }
        __syncthreads();
    }
}

__device__ __forceinline__ void phase_headnorm(Frame& F) {
    LAS float* tl = (LAS float*)F.lds;
    LAS float* rs = tl + 64 * 257;
    const bf16* YT = WSP(bf16, WS_YT); bf16* YN = WSP(bf16, WS_YN);
    u32x4 nxv[4];
    if (F.bid < 8 * 128) { const int h = F.bid & 7, tok0 = (F.bid >> 3) * 256;
#pragma unroll
        for (int i = 0; i < 4; ++i) { const int idx = F.tid + 512 * i, row = idx >> 5, ch = idx & 31; nxv[i] = *(const u32x4*)(YT + (size_t)(64 * h + row) * T_TOK + tok0 + 8 * ch); } }
    for (int it = F.bid; it < 8 * 128; it += F.G) {
        const int h = it & 7, tt = it >> 3, tok0 = tt * 256;
#pragma unroll
        for (int i = 0; i < 4; ++i) { const int idx = F.tid + 512 * i, row = idx >> 5, ch = idx & 31;
            const u32x4 v = nxv[i]; LAS float* d = tl + row * 257 + 8 * ch;
            d[0] = bflo(v.x); d[1] = bfhi(v.x); d[2] = bflo(v.y); d[3] = bfhi(v.y); d[4] = bflo(v.z); d[5] = bfhi(v.z); d[6] = bflo(v.w); d[7] = bfhi(v.w); }
        if (it + F.G < 8 * 128) { const int it2 = it + F.G, h2 = it2 & 7, tk2 = (it2 >> 3) * 256;
#pragma unroll
            for (int i = 0; i < 4; ++i) { const int idx = F.tid + 512 * i, row = idx >> 5, ch = idx & 31; nxv[i] = *(const u32x4*)(YT + (size_t)(64 * h2 + row) * T_TOK + tk2 + 8 * ch); } }
        __syncthreads();
        if (F.tid < 256) { float s = 0.f;
#pragma unroll 8
            for (int c = 0; c < 64; ++c) { const float v = tl[c * 257 + F.tid]; s += v * v; }
            rs[F.tid] = 1.0f / sqrtf(s * (1.0f / 64.0f) + EPS); }
        __syncthreads();
#pragma unroll
        for (int i = 0; i < 4; ++i) { const int idx = F.tid + 512 * i, tok = idx >> 3, q = idx & 7; const float r = rs[tok]; const float* g = F.mix_g + 64 * h + 8 * q;
            float v[8];
#pragma unroll
            for (int j = 0; j < 8; ++j) v[j] = tl[(8 * q + j) * 257 + tok] * r * g[j];
            u32x4 o; o.x = pk2(v[0], v[1]); o.y = pk2(v[2], v[3]); o.z = pk2(v[4], v[5]); o.w = pk2(v[6], v[7]);
            st16_wt(YN + (size_t)(tok0 + tok) * 1024 + 64 * h + 8 * q, o); }
        __syncthreads();
    }
}

constexpr int MX_NS = 288, MX_XA = 0, MX_XB = 64 * MX_NS * 2, MX_MT = 2 * MX_XB, MX_MTLO = MX_MT + 32768, MX_NYQ = MX_MTLO + 32768, MX_SLOT = 144;
__device__ __forceinline__ void mix_load(Frame& F, int tile, u32x4 (&v)[8]) {
    const int b = tile >> 6, g = (tile >> 3) & 7, kt = tile & 7; const bf16* SP = WSP(bf16, WS_SP);
#pragma unroll
    for (int u = 0; u < 8; ++u) { const int idx = F.tid + NTHREADS * u, row = idx >> 5, ch = idx & 31, ab = row >> 6, c = row & 63;
        v[u] = *(const u32x4*)(SP + ((size_t)((64 * g + c) * 8 + b) * 2 + ab) * 2048 + 256 * kt + 8 * ch); }
}
__device__ __forceinline__ void fourier_mix(Frame& F) {
    LAS bf16* XA = (LAS bf16*)(F.lds + MX_XA); LAS bf16* XB = (LAS bf16*)(F.lds + MX_XB);
    LAS u32x4* MT = (LAS u32x4*)(F.lds + MX_MT); LAS u32x4* MTL = (LAS u32x4*)(F.lds + MX_MTLO); LAS float* nyq = (LAS float*)(F.lds + MX_NYQ);
    LAS unsigned char* STG = F.lds;
    const bf16* SP = WSP(bf16, WS_SP); bf16* YN = WSP(bf16, WS_YN);
    LAS float* cst = nyq + 64;
    __syncthreads();
    if (F.tid < 64) { cst[F.tid] = cospif((float)F.tid * (1.0f / 32.0f)); cst[64 + F.tid] = sinpif((float)F.tid * (1.0f / 32.0f)); }
    __syncthreads();
    for (int idx = F.tid; idx < 32 * 64; idx += NTHREADS) { const int lane = idx & 63, fs = idx >> 6, rb = fs >> 3, s = fs & 7, i = lane & 31, h = lane >> 5;
        unsigned hw[4], lw[4];
#pragma unroll
        for (int jj = 0; jj < 4; ++jj) { unsigned hh[2], ll[2];
#pragma unroll
            for (int u = 0; u < 2; ++u) { const int j = 2 * jj + u, kap = 16 * s + 8 * h + j, c = kap & 63, isB = kap >> 6, cpp = 32 * rb + i, cp = cpp & 63, mir = cpp >> 6;
                const int m = (c * cp) & 63; const float cv = cst[m], sv = cst[64 + m];
                const float val = (isB ? (mir ? sv : -sv) : cv) * (1.0f / 512.0f);
                hh[u] = f2bf(val); ll[u] = f2bf(val - __builtin_bit_cast(float, hh[u] << 16)); }
            hw[jj] = hh[0] | (hh[1] << 16); lw[jj] = ll[0] | (ll[1] << 16); }
        MT[idx] = (u32x4){hw[0], hw[1], hw[2], hw[3]}; MTL[idx] = (u32x4){lw[0], lw[1], lw[2], lw[3]}; }
    u32x4 nxv[8];
    if (F.bid < 512) mix_load(F, F.bid, nxv);
    for (int tile = F.bid; tile < 512; tile += F.G) {
        const int b = tile >> 6, g = (tile >> 3) & 7, kt = tile & 7;
        __syncthreads();
#pragma unroll
        for (int u = 0; u < 8; ++u) { const int idx = F.tid + NTHREADS * u, row = idx >> 5, ch = idx & 31, ab = row >> 6, c = row & 63;
            u32x4 v = nxv[u];
            if (kt == 0 && ab == 1 && ch == 0) { nyq[c] = bflo(v.x); v.x &= 0xffff0000u; }
            *(LAS u32x4*)((ab ? XB : XA) + c * MX_NS + 8 * ch) = v; }
        if (tile + F.G < 512) mix_load(F, tile + F.G, nxv);
        __syncthreads();
        f32x16 acc[4];
#pragma unroll
        for (int rb = 0; rb < 4; ++rb) acc[rb] = (f32x16){0.f, 0.f, 0.f, 0.f, 0.f, 0.f, 0.f, 0.f, 0.f, 0.f, 0.f, 0.f, 0.f, 0.f, 0.f, 0.f};
        { int lane = F.lane; asm volatile("" : "+v"(lane));
          const int gq = lane >> 4, q = (lane & 15) >> 2, p = lane & 3;
#pragma unroll
          for (int s = 0; s < 8; ++s) {
              const LAS bf16* pr = ((s < 4) ? XA : XB) + (16 * (s & 3) + 8 * (gq >> 1) + q) * MX_NS + 32 * F.wave + 16 * (gq & 1) + 4 * p;
              const s16x4v r0 = lds_tr16(pr), r1 = lds_tr16(pr + 4 * MX_NS);
              asm volatile("" :: "v"(pr) : "memory");
              const bf16x8v bfr = (bf16x8v){r0[0], r0[1], r0[2], r0[3], r1[0], r1[1], r1[2], r1[3]};
#pragma unroll
              for (int rb = 0; rb < 4; ++rb) { const bf16x8v mh = __builtin_bit_cast(bf16x8v, MT[(rb * 8 + s) * 64 + lane]), ml = __builtin_bit_cast(bf16x8v, MTL[(rb * 8 + s) * 64 + lane]);
                  acc[rb] = __builtin_amdgcn_mfma_f32_32x32x16_bf16(mh, bfr, acc[rb], 0, 0, 0); acc[rb] = __builtin_amdgcn_mfma_f32_32x32x16_bf16(ml, bfr, acc[rb], 0, 0, 0); } } }
        float sk = 0.f, sm = 0.f;
#pragma unroll
        for (int r = 0; r < 16; ++r) { sk += acc[0][r] * acc[0][r] + acc[1][r] * acc[1][r]; sm += acc[2][r] * acc[2][r] + acc[3][r] * acc[3][r]; }
        sk += __shfl_xor(sk, 32); sm += __shfl_xor(sm, 32);
        const float rk = 1.0f / sqrtf(sk * (1.0f / 64.0f) + EPS), rm = 1.0f / sqrtf(sm * (1.0f / 64.0f) + EPS);
        __syncthreads();
        { const int n = F.lane & 31, hi = F.lane >> 5; const float* mg = F.mix_g + 512 + 64 * g;
#pragma unroll
          for (int rb = 0; rb < 4; ++rb) { const int slot = 32 * F.wave + n + ((rb >> 1) ? 256 : 0); const float rr = (rb >> 1) ? rm : rk;
#pragma unroll
              for (int rg = 0; rg < 4; ++rg) { const int cp = 32 * (rb & 1) + 8 * rg + 4 * hi; const f32x4 gg = *(const f32x4*)(mg + cp);
                  u32x2 w; w.x = pk2(acc[rb][4 * rg] * rr * gg.x, acc[rb][4 * rg + 1] * rr * gg.y); w.y = pk2(acc[rb][4 * rg + 2] * rr * gg.z, acc[rb][4 * rg + 3] * rr * gg.w);
                  *(LAS u32x2*)(STG + slot * MX_SLOT + 2 * cp) = w; } } }
        __syncthreads();
#pragma unroll
        for (int u = 0; u < 8; ++u) { const int idx = F.tid + NTHREADS * u, slot = idx >> 3, ch = idx & 7; const int kk = 256 * kt + (slot & 255);
            const int tok = b * SEQ + ((slot < 256) ? kk : (4096 - kk));
            if (!(slot >= 256 && kk == 0)) st16_wt(YN + (size_t)tok * 1024 + 512 + 64 * g + 8 * ch, *(const LAS u32x4*)(STG + slot * MX_SLOT + 16 * ch)); }
        if (kt == 0 && F.wave == 0) {
            const int cp = F.lane; float y = 0.f;
            for (int c = 0; c < 64; ++c) y += nyq[c] * cst[(c * cp) & 63];
            y *= (1.0f / 512.0f);
            const float r2 = 1.0f / sqrtf(wave_sum(y * y) * (1.0f / 64.0f) + EPS);
            YN[(size_t)(b * SEQ + 2048) * 1024 + 512 + 64 * g + cp] = (bf16)f2bf(y * r2 * F.mix_g[512 + 64 * g + cp]);
        }
    }
    __syncthreads();
}

__device__ __forceinline__ float wave_reduce8(const float (&a)[8], int lane) {
    const bool h5 = (lane & 32) != 0, h4 = (lane & 16) != 0, h3 = (lane & 8) != 0;
    float b[4], c[2], d;
#pragma unroll
    for (int i = 0; i < 4; ++i) { const float snd = h5 ? a[i] : a[4 + i], keep = h5 ? a[4 + i] : a[i]; b[i] = keep + __shfl_xor(snd, 32); }
#pragma unroll
    for (int i = 0; i < 2; ++i) { const float snd = h4 ? b[i] : b[2 + i], keep = h4 ? b[2 + i] : b[i]; c[i] = keep + __shfl_xor(snd, 16); }
    { const float snd = h3 ? c[0] : c[1], keep = h3 ? c[1] : c[0]; d = keep + __shfl_xor(snd, 8); }
    d += __shfl_xor(d, 4); d += __shfl_xor(d, 2); d += __shfl_xor(d, 1);
    return d;
}
__device__ __forceinline__ float rdlane(float v, int l) { return __builtin_bit_cast(float, __builtin_amdgcn_readlane(__builtin_bit_cast(int, v), l)); }
__device__ __forceinline__ void phase_route(Frame& F, const bf16* X1) {
    LAS f32x4* wrl = (LAS f32x4*)F.lds;
    LAS f32x4* wgl = (LAS f32x4*)(F.lds + 131072);
    LAS int* lcnt = (LAS int*)(F.lds + 147456);
    LAS int* lbase = lcnt + 32;
    LAS int* pe = lcnt + 64;
    LAS float* pw = (LAS float*)(pe + 256);
    LAS float* prr = pw + 256;
    LAS int* prow = (LAS int*)(prr + 256);
    LAS float* lbr = (LAS float*)(prow + 256);
    int* TOT = WSP(int, WS_TOT); int* LIST = WSP(int, WS_LIST); float* ROWW = WSP(float, WS_ROWW); float* ROWR = WSP(float, WS_ROWR);
    __syncthreads();
    { const f32x4* w4 = (const f32x4*)F.w_router;
      f32x4 wv0[8], wv1[8];
#pragma unroll
      for (int u = 0; u < 8; ++u) { const int i = F.tid + NTHREADS * u; wv0[u] = w4[2 * i]; wv1[u] = w4[2 * i + 1]; }
#pragma unroll
      for (int u = 0; u < 8; ++u) { const int i = F.tid + NTHREADS * u; const int g = i >> 10, k = i & 1023; const int slot = (4 * (k >> 8) + (k & 3)) * 64 + ((k >> 2) & 63);
          wrl[(g * 2 + 0) * 1024 + slot] = wv0[u]; wrl[(g * 2 + 1) * 1024 + slot] = wv1[u]; }
      const f32x4* wg = (const f32x4*)F.w_group;
      for (int k = F.tid; k < 1024; k += NTHREADS) wgl[(4 * (k >> 8) + (k & 3)) * 64 + ((k >> 2) & 63)] = wg[k];
      if (F.tid < 32) lbr[F.tid] = F.b_router[F.tid]; }
    f32x4 g4[4];
    { const GAS f32x4* gr = (const GAS f32x4*)F.norm2_g + F.lane;
#pragma unroll
      for (int j = 0; j < 4; ++j) g4[j] = gr[64 * j]; }
    const float bg0 = F.b_group[0], bg1 = F.b_group[1], bg2 = F.b_group[2], bg3 = F.b_group[3];
    for (int blk = F.bid; blk < 256; blk += F.G) {
        __syncthreads();
        if (F.tid < 32) lcnt[F.tid] = 0;
        __syncthreads();
        const int t0 = blk * 128 + F.wave * 16;
        u32x2 vn[2][4];
#pragma unroll
        for (int u = 0; u < 2; ++u) { const GAS u32x2* xr = (const GAS u32x2*)(X1 + (size_t)(t0 + u) * 1024) + F.lane;
#pragma unroll
          for (int j = 0; j < 4; ++j) vn[u][j] = xr[64 * j]; }
#pragma unroll 1
        for (int i0 = 0; i0 < 16; i0 += 2) {
#pragma unroll
          for (int u = 0; u < 2; ++u) {
            const int i = i0 + u; const int t = t0 + i;
            f32x4 v[4];
#pragma unroll
            for (int j = 0; j < 4; ++j) { v[j].x = bflo(vn[u][j].x); v[j].y = bfhi(vn[u][j].x); v[j].z = bflo(vn[u][j].y); v[j].w = bfhi(vn[u][j].y); }
            { GAS unsigned* xq = (GAS unsigned*)(WSP(unsigned char, WS_X1Q) + (size_t)t * 1024) + F.lane;
#pragma unroll
              for (int j = 0; j < 4; ++j) xq[64 * j] = pk4_fp8s(v[j].x, v[j].y, v[j].z, v[j].w, 1.0f); }
            if (i + 2 < 16) { const GAS u32x2* xr = (const GAS u32x2*)(X1 + (size_t)(t + 2) * 1024) + F.lane;
#pragma unroll
                for (int j = 0; j < 4; ++j) vn[u][j] = xr[64 * j]; }
            float a[8];
#pragma unroll
            for (int e = 0; e < 8; ++e) a[e] = 0.f;
#pragma unroll
            for (int j = 0; j < 4; ++j) { a[0] += (v[j].x * v[j].x + v[j].y * v[j].y) + (v[j].z * v[j].z + v[j].w * v[j].w); v[j] = v[j] * g4[j];
#pragma unroll
                for (int q = 0; q < 4; ++q) { const float hv = v[j][q]; const f32x4 w = wgl[(4 * j + q) * 64 + F.lane]; a[1] += hv * w.x; a[2] += hv * w.y; a[3] += hv * w.z; a[4] += hv * w.w; } }
            const float d = wave_reduce8(a, F.lane);
            const float rinv = 1.0f / sqrtf(rdlane(d, 0) * (1.f / 1024.f) + EPS);
            const float gl0 = rdlane(d, 8) * rinv + bg0, gl1 = rdlane(d, 16) * rinv + bg1, gl2 = rdlane(d, 24) * rinv + bg2, gl3 = rdlane(d, 32) * rinv + bg3;
            int gs = 0; float gm = gl0; if (gl1 > gm) { gm = gl1; gs = 1; } if (gl2 > gm) { gm = gl2; gs = 2; } if (gl3 > gm) { gm = gl3; gs = 3; }
            const float pg = 1.0f / (expf(gl0 - gm) + expf(gl1 - gm) + expf(gl2 - gm) + expf(gl3 - gm));
            float el[8];
#pragma unroll
            for (int e = 0; e < 8; ++e) el[e] = 0.f;
            const LAS f32x4* wb = wrl + gs * 2048 + F.lane;
#pragma unroll
            for (int j = 0; j < 4; ++j) {
#pragma unroll
                for (int q = 0; q < 4; ++q) { const f32x4 wa = wb[(4 * j + q) * 64], wc = wb[1024 + (4 * j + q) * 64]; const float hv = v[j][q];
                    el[0] += hv * wa.x; el[1] += hv * wa.y; el[2] += hv * wa.z; el[3] += hv * wa.w; el[4] += hv * wc.x; el[5] += hv * wc.y; el[6] += hv * wc.z; el[7] += hv * wc.w; } }
            const float d2 = wave_reduce8(el, F.lane);
            float er[8];
#pragma unroll
            for (int e = 0; e < 8; ++e) er[e] = rdlane(d2, 8 * e) * rinv + lbr[gs * 8 + e];
            int i1 = 0; float m1 = er[0];
#pragma unroll
            for (int e = 1; e < 8; ++e) if (er[e] > m1) { m1 = er[e]; i1 = e; }
            int i2 = -1; float m2 = -3.0e38f;
#pragma unroll
            for (int e = 0; e < 8; ++e) if (e != i1 && er[e] > m2) { m2 = er[e]; i2 = e; }
            const float e2 = expf(m2 - m1); const float wa1 = pg / (1.0f + e2), wa2 = pg * e2 / (1.0f + e2);
            if (F.lane == 0) { const int lp = 2 * (F.wave * 16 + i); pe[lp] = gs * 8 + i1; pe[lp + 1] = gs * 8 + i2; pw[lp] = wa1; pw[lp + 1] = wa2; prr[lp] = rinv; prr[lp + 1] = rinv;
                atomicAdd((int*)&lcnt[gs * 8 + i1], 1); atomicAdd((int*)&lcnt[gs * 8 + i2], 1); }
          }
        }
        __syncthreads();
        if (F.tid < 32) lbase[F.tid] = atomicAdd(&TOT[F.tid], lcnt[F.tid]);
        __syncthreads();
        if (F.tid < 32) { int n = lbase[F.tid]; for (int p = 0; p < 256; ++p) if (pe[p] == F.tid) prow[p] = n++; }
        __syncthreads();
        if (F.tid < 256) { const int row = pe[F.tid] * ECAP + prow[F.tid]; LIST[row] = blk * 256 + F.tid; ROWW[row] = pw[F.tid]; ROWR[row] = prr[F.tid]; }
    }
    __syncthreads();
}

__device__ __forceinline__ int build_tiles(Frame& F) {
    LAS int* tl = (LAS int*)(F.lds + L_TILES); LAS int* tnv = tl + MAX_TILES; LAS int* misc = tnv + MAX_TILES;
    const int* TOT = WSP(int, WS_TOT);
    __syncthreads();
    if (F.tid < 32) misc[33 + F.tid] = TOT[F.tid];
    __syncthreads();
    if (F.tid == 0) { int s = 0; for (int e = 0; e < 32; ++e) { misc[e] = s; s += (misc[33 + e] + 255) >> 8; } misc[32] = s; }
    __syncthreads();
    if (F.tid < 32) { const int e = F.tid, tot = misc[33 + e]; for (int j = 0, t = misc[e]; t < misc[e + 1]; ++j, ++t) { tl[t] = e * ECAP + 256 * j; tnv[t] = (tot - 256 * j) < 256 ? (tot - 256 * j) : 256; } }
    __syncthreads();
    return misc[32];
}

__device__ __forceinline__ void phase_final(Frame& F, const bf16* X1, float* OUT) {
    typedef float f2v __attribute__((ext_vector_type(2)));
    const int gw = F.vcu * NWAVES + F.wave, NGW = F.G * NWAVES; const unsigned char* YP = WSP(unsigned char, WS_YP);
    f32x4 gg[4];
#pragma unroll
    for (int j = 0; j < 4; ++j) gg[j] = ((const GAS f32x4*)F.final_g)[64 * j + F.lane];
    for (int t0 = 4 * gw; t0 < T_TOK; t0 += 4 * NGW) {
        u32x2 xw[4][4]; unsigned ya[4][4], yb[4][4];
#pragma unroll
        for (int r = 0; r < 4; ++r) { const int t = t0 + r;
            const GAS u32x2* xr = (const GAS u32x2*)(X1 + (size_t)t * 1024) + F.lane;
            const GAS unsigned* y0 = (const GAS unsigned*)(YP + (size_t)(2 * t) * 1024) + F.lane; const GAS unsigned* y1 = (const GAS unsigned*)(YP + (size_t)(2 * t + 1) * 1024) + F.lane;
#pragma unroll
            for (int j = 0; j < 4; ++j) { xw[r][j] = xr[64 * j]; ya[r][j] = y0[64 * j]; yb[r][j] = y1[64 * j]; } }
#pragma unroll
        for (int r = 0; r < 4; ++r) { const int t = t0 + r; GAS f32x4* orow = (GAS f32x4*)(OUT + (size_t)t * 1024) + F.lane;
            f32x4 v[4]; float s = 0.f;
#pragma unroll
            for (int j = 0; j < 4; ++j) { const u32x2 x = xw[r][j];
                const f2v a0 = __builtin_amdgcn_cvt_pk_f32_fp8((int)ya[r][j], false), a1 = __builtin_amdgcn_cvt_pk_f32_fp8((int)ya[r][j], true);
                const f2v b0 = __builtin_amdgcn_cvt_pk_f32_fp8((int)yb[r][j], false), b1 = __builtin_amdgcn_cvt_pk_f32_fp8((int)yb[r][j], true);
                const float is = 1.0f / pg8::YP_SCALE;
                v[j].x = bflo(x.x) + (a0[0] + b0[0]) * is; v[j].y = bfhi(x.x) + (a0[1] + b0[1]) * is; v[j].z = bflo(x.y) + (a1[0] + b1[0]) * is; v[j].w = bfhi(x.y) + (a1[1] + b1[1]) * is;
                s += (v[j].x * v[j].x + v[j].y * v[j].y) + (v[j].z * v[j].z + v[j].w * v[j].w); }
            const float rinv = 1.0f / sqrtf(wave_sum(s) * (1.f / 1024.f) + EPS);
#pragma unroll
            for (int j = 0; j < 4; ++j) { f32x4 o; o.x = v[j].x * rinv * gg[j].x; o.y = v[j].y * rinv * gg[j].y; o.z = v[j].z * rinv * gg[j].z; o.w = v[j].w * rinv * gg[j].w; orow[64 * j] = o; } }
    }
}

constexpr int N_PHASES = 10;
struct Args { const float* in[23]; float* out; unsigned char* ws; int ph_lo, ph_hi; };
static_assert(sizeof(Args) == 23 * 8 + 8 + 8 + 8, "Args has no padding");

__global__ void __launch_bounds__(NTHREADS, 2) mk_fwd(Args args) {
    extern __shared__ __attribute__((aligned(16))) unsigned char lds_raw[];
    Frame F;
    F.lds = (LAS unsigned char*)lds_raw; F.ws = args.ws;
    F.tid = threadIdx.x; F.lane = F.tid & 63; F.wave = __builtin_amdgcn_readfirstlane(F.tid >> 6);
    F.G = gridDim.x; F.bid = blockIdx.x; F.vcu = (F.G % 8 == 0) ? (F.bid % 8) * (F.G / 8) + F.bid / 8 : F.bid;
    F.x = args.in[0]; F.norm1_g = args.in[1]; F.w_in = args.in[2]; F.conv_w = args.in[3]; F.conv_b = args.in[4]; F.f_w_in = args.in[5]; F.f_b_in = args.in[6];
    F.f_w_mid = args.in[7]; F.f_b_mid = args.in[8]; F.f_freq = args.in[9]; F.f_w_out = args.in[10]; F.f_bias = args.in[11]; F.mix_g = args.in[12]; F.w_out = args.in[13];
    F.norm2_g = args.in[14]; F.w_group = args.in[15]; F.b_group = args.in[16]; F.w_router = args.in[17]; F.b_router = args.in[18]; F.w_gate = args.in[19]; F.w_up = args.in[20];
    F.w_down = args.in[21]; F.final_g = args.in[22]; F.out = args.out;
    volatile LAS unsigned* bst = (volatile LAS unsigned*)(F.lds + BARST_OFF);
    if (F.tid < 16) bst[F.tid] = 0u;
    __syncthreads();
    const int lo = args.ph_lo, hi = args.ph_hi;
    const bool need_bar = (hi - lo) > 1;
    XcdBarrier bar; bar.bar = (unsigned*)(F.ws + WS_CTL); bar.x = 0; bar.st = bst;
    if (need_bar) bar = xcd_barrier_post((unsigned*)(F.ws + WS_CTL), bst);
#define IN(k) (lo <= (k) && (k) < hi)
#ifndef MK_DUP
#define MK_DUP -1
#endif
#define REPS(k) (((k) == MK_DUP) ? 2 : 1)
#define SEAM(k) do { if (IN(k) && IN((k) + 1)) xcd_barrier(bar); } while (0)
    bf16* X1 = WSP(bf16, WS_X1);

    if (IN(0)) for (int rep_ = 0; rep_ < REPS(0); ++rep_) { if (rep_) xcd_barrier(bar); phase_prologue(F); } SEAM(0);

    if (IN(1)) {
        pg8::StaticOrder S; S.init(F.ws + WS_WIN_T, F.ws + WS_HN, NPT_ROWS, T_TOK, 1024, F.G, F.bid); S.reps = (MK_DUP == 11) ? 2 : REPS(1);
        pg8::EpiStorePT E{WSP(bf16, WS_PT), NPT_ROWS};
        pg8::gemm_phase<pg8::EpiStorePT, pg8::StaticOrder>(F.lds, 1024, S, E);
        load_tw_lds(F, L_TW, L_TW256);
        for (int c = F.bid; c < 512 * ((MK_DUP == 12) ? 2 : REPS(1)); c += F.G) filter_item(F, c & 511);
    } SEAM(1);

    if (IN(2)) for (int rep_ = 0; rep_ < REPS(2); ++rep_) { if (rep_) xcd_barrier(bar);
        load_tw_lds(F, M_TW, M_TW256);
        hyena_items_mfma(F);
        fourier_items_mfma(F);
    } SEAM(2);

    if (IN(3)) for (int rep_ = 0; rep_ < REPS(3); ++rep_) { if (rep_) xcd_barrier(bar); phase_headnorm(F); if (MK_DUP == 13) phase_headnorm(F); for (int rr_ = 0; rr_ < ((MK_DUP == 14) ? 2 : 1); ++rr_) fourier_mix(F); } SEAM(3);

    if (IN(4)) for (int rep_ = 0; rep_ < REPS(4); ++rep_) { if (rep_) xcd_barrier(bar);
        pg8::StaticOrder S; S.init(F.ws + WS_YN, F.ws + WS_WOUT_T, T_TOK, 1024, 1024, F.G, F.bid);
        pg8::EpiResBf16 E{F.x, X1, 1024};
        pg8::gemm_phase<pg8::EpiResBf16, pg8::StaticOrder>(F.lds, 1024, S, E);
    } SEAM(4);

    if (IN(5)) { phase_route(F, X1); } if (IN(5) && IN(7)) xcd_barrier(bar);


    if (IN(7)) for (int rep_ = 0; rep_ < REPS(7); ++rep_) { if (rep_) xcd_barrier(bar);
        const int ntiles = __builtin_amdgcn_readfirstlane(build_tiles(F)); const LAS int* tl = (const LAS int*)(F.lds + L_TILES);
        pg8::MoeGatherOrder S; S.init(F.ws + WS_X1Q, F.ws + WS_WGU_T, tl, tl + MAX_TILES, WSP(int, WS_LIST), ntiles, 1024, F.G, F.bid, 1);
        pg8::EpiSwiGLU E{WSP(unsigned char, WS_YT), WSP(float, WS_ROWR)};
        pg8::gemm_phase<pg8::EpiSwiGLU, pg8::MoeGatherOrder, true, true>(F.lds, 1024, S, E);
        if (rep_ == 0) {
            const int nwg = ntiles * 4, R = (nwg + F.G - 1) / F.G, nheavy = nwg - (R - 1) * F.G; const bool all = (nheavy >= F.G) || (nheavy <= 0);
            const int nl = all ? F.G : F.G - nheavy, li = all ? F.bid : F.bid - nheavy;
            if (li >= 0) wdown_items(F, li * NWAVES + F.wave, nl * NWAVES);
        }
    } SEAM(7);

    if (IN(8)) for (int rep_ = 0; rep_ < REPS(8); ++rep_) { if (rep_) xcd_barrier(bar);
        const int ntiles = __builtin_amdgcn_readfirstlane(build_tiles(F)); const LAS int* tl = (const LAS int*)(F.lds + L_TILES);
        pg8::MoeOrder S; S.init(F.ws + WS_YT, F.ws + WS_WD_T, tl, tl + MAX_TILES, ntiles, 512, F.G, F.bid, 1);
        pg8::EpiMoeDown E{WSP(unsigned char, WS_YP), WSP(int, WS_LIST), WSP(float, WS_ROWW)};
        pg8::gemm_phase<pg8::EpiMoeDown, pg8::MoeOrder, true, true>(F.lds, 512, S, E);
    } SEAM(8);

    if (IN(9)) { if (REPS(9) == 2) { phase_final(F, X1, WSP(float, WS_YT)); xcd_barrier(bar); } phase_final(F, X1, F.out); }
#undef IN
#undef SEAM
}


extern "C" void kernel_launch(void* const* d_in, const int* in_sizes, int n_in, void* d_out, int out_size, void* d_ws, size_t ws_size, hipStream_t stream) {
    static int grid = 0;
    if (grid == 0) {
        if (n_in != 23 || in_sizes[0] != T_TOK * D_MODEL || out_size != T_TOK * D_MODEL || ws_size < WS_END) { fprintf(stderr, "kernel_launch: unexpected shapes (n_in %d, in0 %d, out %d, ws %zu)\n", n_in, n_in > 0 ? in_sizes[0] : -1, out_size, ws_size); grid = -1; return; }
        int dev = 0, cus = 0;
        if (hipGetDevice(&dev) != hipSuccess || hipDeviceGetAttribute(&cus, hipDeviceAttributeMultiprocessorCount, dev) != hipSuccess) { grid = -1; return; }
        if (hipFuncSetAttribute((const void*)mk_fwd, hipFuncAttributeMaxDynamicSharedMemorySize, LDS_BYTES) != hipSuccess) { fprintf(stderr, "kernel_launch: hipFuncSetAttribute failed\n"); grid = -1; return; }
        int per_cu = 0;
        if (hipOccupancyMaxActiveBlocksPerMultiprocessor(&per_cu, (const void*)mk_fwd, NTHREADS, LDS_BYTES) != hipSuccess || per_cu < 1) fprintf(stderr, "kernel_launch: occupancy query reports %d\n", per_cu);
        (void)hipGetLastError();
        grid = cus;
    }
    if (grid < 0) return;
    (void)hipMemsetAsync((char*)d_ws + WS_CTL, 0, CTL_ZERO_BYTES, stream);
    Args a{};
    for (int i = 0; i < 23; ++i) a.in[i] = (const float*)d_in[i];
    a.out = (float*)d_out; a.ws = (unsigned char*)d_ws;
#if MK_N_LAUNCHES == 1
    a.ph_lo = 0; a.ph_hi = N_PHASES;
    hipLaunchKernelGGL(mk_fwd, dim3(grid), dim3(NTHREADS), LDS_BYTES, stream, a);
#else
    for (int p = 0; p < N_PHASES; ++p) {
        a.ph_lo = p; a.ph_hi = p + 1;
        hipLaunchKernelGGL(mk_fwd, dim3(grid), dim3(NTHREADS), LDS_BYTES, stream, a);
#ifdef MK_DUPLAUNCH
        if (p == MK_DUPLAUNCH) hipLaunchKernelGGL(mk_fwd, dim3(grid), dim3(NTHREADS), LDS_BYTES, stream, a);
#endif
#if MK_CHECK
        launch_checks(p, a, grid, stream);
#endif
    }
#if MK_CHECK
    launch_encode(a, grid, stream);
#endif
#endif
}
```

```cpp
#include <hip/hip_runtime.h>
#include <cstdio>
#include <cstdint>

#define MK_N_LAUNCHES 1
#define MK_DUP -1
#define MK_CHECK 0

#ifndef MK_DUP
#define MK_DUP -1
#endif
constexpr int D_MODEL = 1024, BATCH = 8, SEQ = 4096, T_TOK = BATCH * SEQ;
constexpr int D_HYENA = 512, D_FOURIER = 512, D_IN_PROJ = 2048, N_EXP = 32, D_EXPERT = 512;
constexpr int NPT_ROWS = 2048;
constexpr float EPS = 1e-6f;
constexpr int MAX_ROWS = 65536 + 32 * 256;
constexpr int MAX_TILES = MAX_ROWS / 256;
constexpr int NWAVES = 8, NTHREADS = 512;

constexpr size_t MiB = 1u << 20;
constexpr size_t WS_CTL = 0, CTL_ZERO_BYTES = 64 * 1024;
constexpr size_t WS_TOT = 48 * 1024;
constexpr size_t WS_CHK = 192 * 1024;
constexpr size_t WS_TW4096 = 3 * MiB;
constexpr size_t WS_TW8192 = 3 * MiB + 32 * 1024;
constexpr size_t WS_H3 = 4 * MiB;
constexpr size_t WS_WIN_T = 8 * MiB;
constexpr size_t WS_WOUT_T = 13 * MiB;
constexpr size_t WS_WGU_T = 16 * MiB;
constexpr size_t WS_WD_T = 80 * MiB;
constexpr size_t WS_KF = 112 * MiB;
constexpr size_t WS_HN = 144 * MiB;
constexpr size_t WS_PT = 208 * MiB;
constexpr size_t WS_X1Q = 208 * MiB;
constexpr size_t WS_YP = 144 * MiB;
constexpr size_t WS_X1 = 272 * MiB;
constexpr int ECAP = 32768;
constexpr size_t WS_LIST = 336 * MiB;
constexpr size_t WS_ROWW = 340 * MiB;
constexpr size_t WS_ROWR = 344 * MiB;
constexpr size_t WS_YT = 368 * MiB;
constexpr size_t WS_YN = 440 * MiB;
constexpr size_t WS_KT = WS_YN;
constexpr size_t WS_SP = WS_YT + (size_t)512 * T_TOK * 2;
constexpr size_t WS_END = 504 * MiB;

constexpr int LDS_BYTES = 163840;
constexpr int BARST_OFF = LDS_BYTES - 64;
constexpr int FFT_BUF_BYTES = 4352 * 8;
constexpr int L_BUFA = 0, L_BUFB = FFT_BUF_BYTES, L_TW = 2 * FFT_BUF_BYTES, L_SCR = L_TW + 32768, L_RED = L_SCR + 32768, L_TW256 = L_RED + 1024;
static_assert(L_TW256 + 2048 <= BARST_OFF, "LDS map");
constexpr int M_TW = 98304, M_TW256 = M_TW + 32768;
constexpr int L_TILES = 132 * 1024;

#define GAS __attribute__((address_space(1)))
#define LAS __attribute__((address_space(3)))
typedef unsigned short bf16;
typedef float f32x4 __attribute__((ext_vector_type(4)));
typedef float f32x2 __attribute__((ext_vector_type(2)));
typedef unsigned u32x4 __attribute__((ext_vector_type(4)));
typedef unsigned u32x2 __attribute__((ext_vector_type(2)));
#ifndef MK_WT
#define MK_WT 1
#endif
__device__ __forceinline__ void st16_plain(void* p, u32x4 v) { *(u32x4*)p = v; }
__device__ __forceinline__ void st16_wt(void* p, u32x4 v) {
#if MK_WT
    asm volatile("global_store_dwordx4 %0, %1, off sc1\n\ts_nop 1" :: "v"(p), "v"(v) : "memory");
#else
    *(u32x4*)p = v;
#endif
}
constexpr float W_SCALE = 16.0f, H_SCALE = 8.0f;
__device__ __forceinline__ unsigned pk4_fp8s(float a, float b, float c, float d, float sc) {
    a = __builtin_amdgcn_fmed3f(a * sc, -448.f, 448.f); b = __builtin_amdgcn_fmed3f(b * sc, -448.f, 448.f); c = __builtin_amdgcn_fmed3f(c * sc, -448.f, 448.f); d = __builtin_amdgcn_fmed3f(d * sc, -448.f, 448.f);
    int t = __builtin_amdgcn_cvt_pk_fp8_f32(a, b, 0, false); t = __builtin_amdgcn_cvt_pk_fp8_f32(c, d, t, true); return (unsigned)t;
}
#define LDS_WAIT() asm volatile("s_waitcnt lgkmcnt(0)" ::: "memory")
__device__ __forceinline__ unsigned f2bf(float f) { unsigned u = __builtin_bit_cast(unsigned, f); return (u + 0x7fffu + ((u >> 16) & 1u)) >> 16; }
__device__ __forceinline__ unsigned pk2(float lo, float hi) { return f2bf(lo) | (f2bf(hi) << 16); }
__device__ __forceinline__ unsigned pk2h(float lo, float hi) { typedef float f32x2_t __attribute__((ext_vector_type(2))); typedef __bf16 bf16x2_t __attribute__((ext_vector_type(2))); const f32x2_t v = {lo, hi}; const bf16x2_t b = __builtin_convertvector(v, bf16x2_t); return __builtin_bit_cast(unsigned, b); }
__device__ __forceinline__ float bflo(unsigned w) { return __builtin_bit_cast(float, w << 16); }
__device__ __forceinline__ float bfhi(unsigned w) { return __builtin_bit_cast(float, w & 0xffff0000u); }
__device__ __forceinline__ float bf1(bf16 h) { return __builtin_bit_cast(float, (unsigned)h << 16); }
__device__ __forceinline__ float wave_sum(float v) {
#pragma unroll
    for (int o = 1; o < 64; o <<= 1) v += __shfl_xor(v, o);
    return v;
}

namespace pg8 {
#define PG8_LAS __attribute__((address_space(3)))
typedef unsigned short bf16_t;
typedef short bf16x8 __attribute__((ext_vector_type(8)));
typedef float f32x4 __attribute__((ext_vector_type(4)));
typedef unsigned u32x4 __attribute__((ext_vector_type(4)));
typedef unsigned u32x2 __attribute__((ext_vector_type(2)));
constexpr int BM = 256, BK = 64, HALF = 128, HTB = HALF * BK * 2  , STAGE_BYTES = 8 * HTB, NXCD = 8, WGM = 8;

__host__ __device__ __forceinline__ int lds_byte(int r, int c) { const int st = (r >> 4) * 2 + (c >> 5), rr = r & 15, cc = c & 31, ob = rr * 64 + cc * 2; return st * 1024 + (ob ^ (((ob >> 9) & 1) << 5)); }
__host__ __device__ __forceinline__ void stage_rc(int b, int& R, int& C) { const int st = b / 1024, sb = b % 1024, swz = sb ^ (((sb >> 9) & 1) << 5); R = (st >> 1) * 16 + swz / 64; C = (st & 1) * 32 + (swz % 64) / 2; }
__host__ __device__ __forceinline__ int perm32(int rho) { const int n = rho >> 4, i = rho & 15; return 8 * (i >> 2) + 4 * n + (i & 3); }

struct Unit { int pm, pn; const char* a; const char* b; int lrow, nv; };

struct StaticOrder {
    static constexpr bool GATHER = false;
    int nM, nN, nwg, G, c, reps = 1; const char* A; const char* Bt; size_t tstep;
    __device__ void init(const void* A_, const void* Bt_, int M, int N, int K, int G_, int c_) { A = (const char*)A_; Bt = (const char*)Bt_; nM = M / BM; nN = N / BM; nwg = nM * nN; G = G_; c = c_; tstep = (size_t)BM * K * 2; }
    __device__ bool next(int i, Unit& u) const {
        long L = (long)i * G + c; if (L >= (long)nwg * reps) return false; if (L >= nwg) L -= nwg;
        int wgid = (int)L; { const int q = nwg / NXCD, r = nwg % NXCD, xcd = wgid % NXCD, off = wgid / NXCD; wgid = (xcd < r ? xcd * (q + 1) : r * (q + 1) + (xcd - r) * q) + off; }
        const int nig = WGM * nN, gid = wgid / nig, fm = gid * WGM, gsz = (nM - fm) < WGM ? (nM - fm) : WGM;
        u.pm = fm + ((wgid % nig) % gsz); u.pn = (wgid % nig) / gsz; u.a = A + (size_t)u.pm * tstep; u.b = Bt + (size_t)u.pn * tstep; u.lrow = 0; u.nv = BM; return true;
    }
};
struct MoeOrder {
    static constexpr bool GATHER = false;
    int nwg, G, c; const char* A; const char* Bt; const PG8_LAS int* tl; const PG8_LAS int* tnv; size_t a_tstep, b_tstep;
    __device__ void init(const void* A_, const void* Bt_, const PG8_LAS int* tl_, const PG8_LAS int* tnv_, int ntiles, int K, int G_, int c_, int ES = 2) { A = (const char*)A_; Bt = (const char*)Bt_; tl = tl_; tnv = tnv_; nwg = ntiles * 4; G = G_; c = c_; a_tstep = (size_t)BM * K * ES; b_tstep = (size_t)BM * K * ES; }
    __device__ bool next(int i, Unit& u) const {
        const long L = (long)i * G + c; if (L >= nwg) return false;
        int wgid = (int)L; { const int q = nwg / NXCD, r = nwg % NXCD, xcd = wgid % NXCD, off = wgid / NXCD; wgid = (xcd < r ? xcd * (q + 1) : r * (q + 1) + (xcd - r) * q) + off; }
        u.pm = wgid >> 2; u.pn = wgid & 3; u.lrow = __builtin_amdgcn_readfirstlane(tl[u.pm]); u.nv = __builtin_amdgcn_readfirstlane(tnv[u.pm]); const int e = u.lrow >> 15;
        u.a = A + (size_t)u.pm * a_tstep; u.b = Bt + (size_t)(e * 4 + u.pn) * b_tstep; return true;
    }
};

struct MoeGatherOrder {
    static constexpr bool GATHER = true;
    int nwg, G, c, es; const char* A; const char* Bt; const PG8_LAS int* tl; const PG8_LAS int* tnv; const int* list; size_t b_tstep;
    __device__ void init(const void* A_, const void* Bt_, const PG8_LAS int* tl_, const PG8_LAS int* tnv_, const int* list_, int ntiles, int K, int G_, int c_, int ES = 2) { A = (const char*)A_; Bt = (const char*)Bt_; tl = tl_; tnv = tnv_; list = list_; nwg = ntiles * 4; G = G_; c = c_; es = ES; b_tstep = (size_t)BM * K * ES; }
    __device__ bool next(int i, Unit& u) const {
        const long L = (long)i * G + c; if (L >= nwg) return false;
        int wgid = (int)L; { const int q = nwg / NXCD, r = nwg % NXCD, xcd = wgid % NXCD, off = wgid / NXCD; wgid = (xcd < r ? xcd * (q + 1) : r * (q + 1) + (xcd - r) * q) + off; }
        u.pm = wgid >> 2; u.pn = wgid & 3; u.lrow = __builtin_amdgcn_readfirstlane(tl[u.pm]); u.nv = __builtin_amdgcn_readfirstlane(tnv[u.pm]); const int e = u.lrow >> 15;
        u.a = A; u.b = Bt + (size_t)(e * 4 + u.pn) * b_tstep; return true;
    }
    __device__ __forceinline__ void offsets(const Unit& u, int K, const int (&R)[2], const int (&C)[2], unsigned (&o)[2][2]) const {
#pragma unroll
        for (int h = 0; h < 2; ++h)
#pragma unroll
            for (int i = 0; i < 2; ++i) { const int lr = h * HALF + R[i]; const int pr = list[u.lrow + (lr < u.nv ? lr : 0)]; const int tok = (lr < u.nv ? pr : 0) >> 1; o[h][i] = (unsigned)(tok * K) * (unsigned)es + (unsigned)C[i] * 2u; }
    }
};

__device__ __forceinline__ unsigned cvt_pk_bf16(float lo, float hi) { unsigned r; asm volatile("v_cvt_pk_bf16_f32 %0, %1, %2" : "=v"(r) : "v"(lo), "v"(hi)); return r; }

struct EpiStoreBf16 {
    static constexpr bool PERM = true;
    bf16_t* O; int ldc;
    __device__ __forceinline__ void operator()(const f32x4 (&acc)[2][2][4][2], const Unit& u, int wr, int wc, int fr, int fq) const {
        const int row0 = u.pm * BM + wr * 64 + fr; const int col0 = u.pn * BM + wc * 32 + 8 * fq;
#pragma unroll
        for (int ai = 0; ai < 2; ++ai)
#pragma unroll
            for (int m = 0; m < 4; ++m) { bf16_t* rowp = O + (size_t)(row0 + ai * HALF + m * 16) * ldc + col0;
#pragma unroll
                for (int bj = 0; bj < 2; ++bj) { const f32x4 v0 = acc[ai][bj][m][0], v1 = acc[ai][bj][m][1];
                    u32x4 w; w.x = cvt_pk_bf16(v0[0], v0[1]); w.y = cvt_pk_bf16(v0[2], v0[3]); w.z = cvt_pk_bf16(v1[0], v1[1]); w.w = cvt_pk_bf16(v1[2], v1[3]);
                    *(u32x4*)(rowp + bj * HALF) = w; } }
    }
};
struct EpiStorePT {
    static constexpr bool PERM = true;
    bf16_t* O; int nrows;
    __device__ __forceinline__ void operator()(const f32x4 (&acc)[2][2][4][2], const Unit& u, int wr, int wc, int fr, int fq) const {
        const int row0 = u.pm * BM + wr * 64 + fr; const int col0 = wc * 32 + 8 * fq; bf16_t* base = O + (size_t)u.pn * nrows * 256;
#pragma unroll
        for (int ai = 0; ai < 2; ++ai)
#pragma unroll
            for (int m = 0; m < 4; ++m) { bf16_t* rowp = base + (size_t)(row0 + ai * HALF + m * 16) * 256 + col0;
#pragma unroll
                for (int bj = 0; bj < 2; ++bj) { const f32x4 v0 = acc[ai][bj][m][0], v1 = acc[ai][bj][m][1];
                    u32x4 w; w.x = cvt_pk_bf16(v0[0], v0[1]); w.y = cvt_pk_bf16(v0[2], v0[3]); w.z = cvt_pk_bf16(v1[0], v1[1]); w.w = cvt_pk_bf16(v1[2], v1[3]);
                    st16_plain(rowp + bj * HALF, w); } }
    }
};
struct EpiResF32 {
    static constexpr bool PERM = false;
    const float* base; float* out; int ldc;
    __device__ __forceinline__ void operator()(const f32x4 (&acc)[2][2][4][2], const Unit& u, int wr, int wc, int fr, int fq) const {
        const int row0 = u.pm * BM + wr * 64 + fr; const int col0 = u.pn * BM + wc * 32 + 4 * fq;
#pragma unroll
        for (int ai = 0; ai < 2; ++ai)
#pragma unroll
            for (int m = 0; m < 4; ++m) { const size_t off = (size_t)(row0 + ai * HALF + m * 16) * ldc + col0;
#pragma unroll
                for (int bj = 0; bj < 2; ++bj)
#pragma unroll
                    for (int n = 0; n < 2; ++n) { const f32x4 bs = *(const f32x4*)(base + off + bj * HALF + n * 16); *(f32x4*)(out + off + bj * HALF + n * 16) = bs + acc[ai][bj][m][n]; } }
    }
};
struct EpiResBf16 {
    static constexpr bool PERM = true;
    const float* __restrict__ base; bf16_t* __restrict__ out; int ldc;
    __device__ __forceinline__ void operator()(const f32x4 (&acc)[2][2][4][2], const Unit& u, int wr, int wc, int fr, int fq) const {
        const int row0 = u.pm * BM + wr * 64 + fr; const int col0 = u.pn * BM + wc * 32 + 8 * fq;
#pragma unroll
        for (int ai = 0; ai < 2; ++ai) {
            f32x4 r0[4][2], r1[4][2];
#pragma unroll
            for (int m = 0; m < 4; ++m) { const size_t off = (size_t)(row0 + ai * HALF + m * 16) * ldc + col0;
#pragma unroll
                for (int bj = 0; bj < 2; ++bj) { r0[m][bj] = *(const f32x4*)(base + off + bj * HALF); r1[m][bj] = *(const f32x4*)(base + off + bj * HALF + 4); } }
#pragma unroll
            for (int m = 0; m < 4; ++m) { const size_t off = (size_t)(row0 + ai * HALF + m * 16) * ldc + col0;
#pragma unroll
                for (int bj = 0; bj < 2; ++bj) { const f32x4 v0 = acc[ai][bj][m][0] + r0[m][bj], v1 = acc[ai][bj][m][1] + r1[m][bj];
                    u32x4 w; w.x = cvt_pk_bf16(v0[0], v0[1]); w.y = cvt_pk_bf16(v0[2], v0[3]); w.z = cvt_pk_bf16(v1[0], v1[1]); w.w = cvt_pk_bf16(v1[2], v1[3]);
                    st16_plain(out + off + bj * HALF, w); } }
        }
    }
};
struct EpiSwiGLU {
    static constexpr bool PERM = false;
    unsigned char* __restrict__ H; const float* __restrict__ rowr;
    __device__ __forceinline__ void operator()(const f32x4 (&acc)[2][2][4][2], const Unit& u, int wr, int wc, int fr, int fq) const {
        const int row0 = u.pm * BM + wr * 64 + fr;
#pragma unroll
        for (int ai = 0; ai < 2; ++ai)
#pragma unroll
            for (int m = 0; m < 4; ++m) { const int lr = wr * 64 + fr + ai * HALF + m * 16; const int row = row0 + ai * HALF + m * 16; const float rr = ((lr < u.nv) ? rowr[u.lrow + lr] : 0.f) * (1.0f / W_SCALE); unsigned char* rowp = H + (size_t)row * 512 + u.pn * 128 + wc * 32 + 4 * fq;
#pragma unroll
                for (int n = 0; n < 2; ++n) { const f32x4 g = acc[ai][0][m][n] * rr, up = acc[ai][1][m][n] * rr; f32x4 h;
#pragma unroll
                    for (int q = 0; q < 4; ++q) h[q] = g[q] * __builtin_amdgcn_rcpf(1.0f + __expf(-g[q])) * up[q];
                    *(unsigned*)(rowp + n * 16) = pk4_fp8s(h[0], h[1], h[2], h[3], H_SCALE); } }
    }
};
constexpr float YP_SCALE = 32.0f;
__device__ __forceinline__ unsigned pk4_fp8(float a, float b, float c, float d) {
    a = __builtin_amdgcn_fmed3f(a * YP_SCALE, -448.f, 448.f); b = __builtin_amdgcn_fmed3f(b * YP_SCALE, -448.f, 448.f); c = __builtin_amdgcn_fmed3f(c * YP_SCALE, -448.f, 448.f); d = __builtin_amdgcn_fmed3f(d * YP_SCALE, -448.f, 448.f);
    int t = __builtin_amdgcn_cvt_pk_fp8_f32(a, b, 0, false); t = __builtin_amdgcn_cvt_pk_fp8_f32(c, d, t, true); return (unsigned)t;
}
struct EpiMoeDown {
    static constexpr bool PERM = true;
    unsigned char* __restrict__ YP; const int* __restrict__ list; const float* __restrict__ roww;
    __device__ __forceinline__ void operator()(const f32x4 (&acc)[2][2][4][2], const Unit& u, int wr, int wc, int fr, int fq) const {
        const int col0 = u.pn * BM + wc * 32 + 8 * fq;
        int prv[2][4]; float wv[2][4];
#pragma unroll
        for (int ai = 0; ai < 2; ++ai)
#pragma unroll
            for (int m = 0; m < 4; ++m) { const int lr = wr * 64 + fr + ai * HALF + m * 16; const int li = u.lrow + (lr < u.nv ? lr : 0); prv[ai][m] = list[li]; wv[ai][m] = roww[li]; }
#pragma unroll
        for (int ai = 0; ai < 2; ++ai)
#pragma unroll
            for (int m = 0; m < 4; ++m) { const int lr = wr * 64 + fr + ai * HALF + m * 16; const bool ok = lr < u.nv; const int pair = ok ? prv[ai][m] : 0; const float w = ok ? wv[ai][m] : 0.f;
                if (ok) { unsigned char* rowp = YP + (size_t)pair * 1024 + col0;
#pragma unroll
                    for (int bj = 0; bj < 2; ++bj) { const f32x4 v0 = acc[ai][bj][m][0] * (w * (1.0f / (W_SCALE * H_SCALE))), v1 = acc[ai][bj][m][1] * (w * (1.0f / (W_SCALE * H_SCALE)));
                        u32x2 o; o.x = pk4_fp8(v0[0], v0[1], v0[2], v0[3]); o.y = pk4_fp8(v1[0], v1[1], v1[2], v1[3]);
                        *(u32x2*)(rowp + bj * HALF) = o; } } }
    }
};

typedef int v8i_t __attribute__((ext_vector_type(8)));
template <class Epi, class Sched, bool ALIGN_EPI = true, bool FP8 = false>
__device__ __forceinline__ void gemm_phase(PG8_LAS unsigned char* lds, const int K, const Sched& S, const Epi& E) {
    const int tid = threadIdx.x, wid = __builtin_amdgcn_readfirstlane(tid >> 6), lane = tid & 63, wr = wid >> 2, wc = wid & 3, fr = lane & 15, fq = lane >> 4;
    constexpr int ES = FP8 ? 1 : 2;
    const int nt = K * ES / (BK * 2);
    unsigned voffA[2], voffB[2]; int sR[2], sC[2];
#pragma unroll
    for (int i = 0; i < 2; ++i) { int R, C; stage_rc(tid * 16 + i * 8192, R, C); const int Rb = Epi::PERM ? ((R & ~31) + perm32(R & 31)) : R; sR[i] = R; sC[i] = C;
        voffA[i] = (unsigned)(R * K) * (unsigned)ES + (unsigned)C * 2u; voffB[i] = (unsigned)(Rb * K) * (unsigned)ES + (unsigned)C * 2u; }
    int sc127 = 0x7f7f7f7f; asm volatile("" : "+v"(sc127));
    constexpr bool GA = Sched::GATHER;
    unsigned oc[2][2], on[2][2];
    const size_t kstep = (size_t)(BK * 2);
    const size_t hstep = (size_t)HALF * K * ES;
    const unsigned ldsw = (unsigned)wid * 1024u;
    const int aoff = lds_byte(wr * 64 + fr, fq * 8), boff = lds_byte(wc * 32 + fr, fq * 8);
#define PG8_SA(b, h) (((b) * 2 + (h)) * HTB)
#define PG8_SB(b, h) ((4 + (b) * 2 + (h)) * HTB)
#define PG8_STAGE(bufoff, gbase, voff) do { _Pragma("unroll") for (int _i = 0; _i < 2; ++_i) \
        __builtin_amdgcn_global_load_lds((const unsigned*)((const char*)(gbase) + (voff)[_i]), (PG8_LAS unsigned*)(lds + (bufoff) + ldsw + _i * 8192), 16, 0, 0); } while (0)
#define PG8_LDA(dst, b, h) do { _Pragma("unroll") for (int m = 0; m < 4; ++m) _Pragma("unroll") for (int k = 0; k < 2; ++k) dst[m][k] = *(const PG8_LAS bf16x8*)(lds + PG8_SA(b, h) + aoff + m * 2048 + k * 1024); } while (0)
#define PG8_LDB(dst, b, h) do { _Pragma("unroll") for (int n = 0; n < 2; ++n) _Pragma("unroll") for (int k = 0; k < 2; ++k) dst[n][k] = *(const PG8_LAS bf16x8*)(lds + PG8_SB(b, h) + boff + n * 2048 + k * 1024); } while (0)
#define PG8_CAT(x0, x1) (v8i_t){ (int)__builtin_bit_cast(u32x4, x0).x, (int)__builtin_bit_cast(u32x4, x0).y, (int)__builtin_bit_cast(u32x4, x0).z, (int)__builtin_bit_cast(u32x4, x0).w, (int)__builtin_bit_cast(u32x4, x1).x, (int)__builtin_bit_cast(u32x4, x1).y, (int)__builtin_bit_cast(u32x4, x1).z, (int)__builtin_bit_cast(u32x4, x1).w }
#define PG8_MMA(ai, bj, At, Bt) do { __builtin_amdgcn_s_setprio(1); _Pragma("unroll") for (int m = 0; m < 4; ++m) _Pragma("unroll") for (int n = 0; n < 2; ++n) { \
        if constexpr (FP8) { const v8i_t b8_ = PG8_CAT(Bt[n][0], Bt[n][1]), a8_ = PG8_CAT(At[m][0], At[m][1]); \
            asm volatile("s_nop 1\n\tv_mfma_scale_f32_16x16x128_f8f6f4 %0, %1, %2, %0, %3, %3 op_sel_hi:[0,0,0]" : "+v"(acc[ai][bj][m][n]) : "v"(b8_), "v"(a8_), "v"(sc127)); } \
        else { _Pragma("unroll") for (int k = 0; k < 2; ++k) acc[ai][bj][m][n] = __builtin_amdgcn_mfma_f32_16x16x32_bf16(Bt[n][k], At[m][k], acc[ai][bj][m][n], 0, 0, 0); } } __builtin_amdgcn_s_setprio(0); } while (0)
#define PG8_WAIT_V(n) asm volatile("s_waitcnt vmcnt(" #n ")" ::: "memory")
#define PG8_WAIT_L(n) asm volatile("s_waitcnt lgkmcnt(" #n ")" ::: "memory")
#define PG8_BAR __builtin_amdgcn_s_barrier()
#define PG8_SCHED __builtin_amdgcn_sched_barrier(0)
    Unit cur, nxt; int ui = 0;
    if (!S.next(0, cur)) return;
    f32x4 acc[2][2][4][2];
#pragma unroll
    for (int a = 0; a < 2; ++a)
#pragma unroll
        for (int b = 0; b < 2; ++b)
#pragma unroll
            for (int m = 0; m < 4; ++m)
#pragma unroll
                for (int n = 0; n < 2; ++n) acc[a][b][m][n] = (f32x4){0.f, 0.f, 0.f, 0.f};
    bf16x8 At[4][2], B0[2][2], B1[2][2];
    const char* cA = cur.a; const char* cB = cur.b;
    const size_t hA = GA ? (size_t)0 : hstep;
    if constexpr (GA) { S.offsets(cur, K, sR, sC, oc); }
#define PG8_OA(h, sel) (GA ? (sel)[h] : voffA)
    PG8_STAGE(PG8_SB(0, 0), cB, voffB); PG8_STAGE(PG8_SB(0, 1), cB + hstep, voffB); PG8_STAGE(PG8_SA(0, 0), cA, PG8_OA(0, oc)); PG8_STAGE(PG8_SA(0, 1), cA + hA, PG8_OA(1, oc));
    if (wr == 1) PG8_BAR;
    PG8_WAIT_V(2); PG8_BAR;
    PG8_STAGE(PG8_SB(1, 0), cB + kstep, voffB); PG8_STAGE(PG8_SA(1, 0), cA + kstep, PG8_OA(0, oc)); PG8_STAGE(PG8_SB(1, 1), cB + hstep + kstep, voffB);
    PG8_WAIT_V(6); PG8_BAR;
    for (;;) {
        const bool has_next = S.next(ui + 1, nxt);
        const char* nA = has_next ? nxt.a : cA; const char* nB = has_next ? nxt.b : cB;
        if constexpr (GA) { if (has_next) S.offsets(nxt, K, sR, sC, on); else {
#pragma unroll
            for (int h = 0; h < 2; ++h)
#pragma unroll
                for (int i = 0; i < 2; ++i) on[h][i] = oc[h][i]; } }
#pragma unroll 1
        for (int t = 0; t < nt; t += 2) {
            const bool last = (t == nt - 2);
            const char* a1 = cA + (size_t)(t + 1) * kstep;
            const char* a2 = last ? nA : cA + (size_t)(t + 2) * kstep; const char* b2 = last ? nB : cB + (size_t)(t + 2) * kstep;
            const char* a3 = a2 + kstep; const char* b3 = b2 + kstep;
            unsigned o2[2][2];
            if constexpr (GA) {
#pragma unroll
                for (int h = 0; h < 2; ++h)
#pragma unroll
                    for (int i = 0; i < 2; ++i) o2[h][i] = last ? on[h][i] : oc[h][i]; }
            PG8_LDB(B0, 0, 0); PG8_LDB(B1, 0, 1); PG8_SCHED; PG8_LDA(At, 0, 0); PG8_STAGE(PG8_SA(1, 1), a1 + hA, PG8_OA(1, oc));
            PG8_WAIT_V(8); PG8_WAIT_L(0); PG8_BAR; PG8_MMA(0, 0, At, B0); PG8_MMA(0, 1, At, B1); PG8_BAR; PG8_SCHED;
            PG8_LDA(At, 0, 1); PG8_STAGE(PG8_SB(0, 0), b2, voffB); PG8_STAGE(PG8_SB(0, 1), b2 + hstep, voffB); PG8_STAGE(PG8_SA(0, 0), a2, PG8_OA(0, o2));
            PG8_WAIT_V(8); PG8_WAIT_L(0); PG8_BAR; PG8_MMA(1, 0, At, B0); PG8_MMA(1, 1, At, B1); PG8_BAR; PG8_SCHED;
            PG8_LDB(B0, 1, 0); PG8_LDB(B1, 1, 1); PG8_SCHED; PG8_LDA(At, 1, 0); PG8_STAGE(PG8_SA(0, 1), a2 + hA, PG8_OA(1, o2));
            PG8_WAIT_V(8); PG8_WAIT_L(0); PG8_BAR; PG8_MMA(0, 0, At, B0); PG8_MMA(0, 1, At, B1); PG8_BAR; PG8_SCHED;
            PG8_LDA(At, 1, 1); PG8_STAGE(PG8_SB(1, 0), b3, voffB); PG8_STAGE(PG8_SB(1, 1), b3 + hstep, voffB); PG8_STAGE(PG8_SA(1, 0), a3, PG8_OA(0, o2));
            PG8_WAIT_V(8); PG8_WAIT_L(0); PG8_BAR; PG8_MMA(1, 0, At, B0); PG8_MMA(1, 1, At, B1); PG8_BAR; PG8_SCHED;
        }
        if constexpr (ALIGN_EPI) { if (wr == 0) PG8_BAR; }
        if constexpr (FP8) asm volatile("s_nop 7\n\ts_nop 7" : "+v"(acc[1][1][0][0]), "+v"(acc[1][1][0][1]), "+v"(acc[1][1][1][0]), "+v"(acc[1][1][1][1]), "+v"(acc[1][1][2][0]), "+v"(acc[1][1][2][1]), "+v"(acc[1][1][3][0]), "+v"(acc[1][1][3][1]) :: "memory");
        E(acc, cur, wr, wc, fr, fq);
        if (!has_next) break;
#pragma unroll
        for (int a = 0; a < 2; ++a)
#pragma unroll
            for (int b = 0; b < 2; ++b)
#pragma unroll
                for (int m = 0; m < 4; ++m)
#pragma unroll
                    for (int n = 0; n < 2; ++n) acc[a][b][m][n] = (f32x4){0.f, 0.f, 0.f, 0.f};
        cur = nxt; cA = nA; cB = nB; ++ui;
        if constexpr (GA) {
#pragma unroll
            for (int h = 0; h < 2; ++h)
#pragma unroll
                for (int i = 0; i < 2; ++i) oc[h][i] = on[h][i]; }
        if constexpr (ALIGN_EPI) { if (wr == 1) PG8_BAR; }
    }
    PG8_WAIT_V(0);
    if constexpr (!ALIGN_EPI) { if (wr == 0) PG8_BAR; }
    PG8_BAR;
#undef PG8_SA
#undef PG8_OA
#undef PG8_CAT
#undef PG8_SB
#undef PG8_STAGE
#undef PG8_LDA
#undef PG8_LDB
#undef PG8_MMA
#undef PG8_WAIT_V
#undef PG8_WAIT_L
#undef PG8_BAR
#undef PG8_SCHED
}
}

#define FDEV __device__ __forceinline__
#define LDSPTR LAS
#define CF_DEFINED
typedef float cf __attribute__((ext_vector_type(2)));
#ifndef FFT_ENGINE_H
#define FFT_ENGINE_H
#ifndef CF_DEFINED
struct cf { float x, y; };
#endif
FDEV cf mkc(float a, float b) { cf r; r.x = a; r.y = b; return r; }
FDEV cf cadd(cf a, cf b) { return mkc(a.x + b.x, a.y + b.y); }
FDEV cf csub(cf a, cf b) { return mkc(a.x - b.x, a.y - b.y); }
FDEV cf cmul(cf a, cf b) { return mkc(a.x * b.x - a.y * b.y, a.x * b.y + a.y * b.x); }
FDEV cf cmulc(cf a, cf b) { return mkc(a.x * b.x + a.y * b.y, a.y * b.x - a.x * b.y); }
FDEV cf mul_mi(cf a) { return mkc(a.y, -a.x); }
FDEV cf mul_pi(cf a) { return mkc(-a.y, a.x); }
constexpr int FFT_N = 4096, FFT_LDS_ELEMS = 16 * 272;
FDEV int fpos(int p) { return 272 * (p >> 8) + 17 * ((p >> 4) & 15) + (p & 15); }

template <bool INV> FDEV void dft16(cf (&v)[16]) {
    const float C1 = 0.92387953251128674f, S1 = 0.38268343236508977f, C2 = 0.70710678118654752f;
#pragma unroll
    for (int n0 = 0; n0 < 4; ++n0) {
        cf x0 = v[n0], x1 = v[4 + n0], x2 = v[8 + n0], x3 = v[12 + n0];
        cf A = cadd(x0, x2), B = csub(x0, x2), C = cadd(x1, x3), D = csub(x1, x3);
        cf Dm = INV ? mul_pi(D) : mul_mi(D);
        v[n0] = cadd(A, C); v[4 + n0] = cadd(B, Dm); v[8 + n0] = csub(A, C); v[12 + n0] = csub(B, Dm);
    }
#define W16(m) (mkc( (m)==0?1.f:(m)==1?C1:(m)==2?C2:(m)==3?S1:(m)==4?0.f:(m)==6?-C2:(m)==9?-C1:0.f, \
                    (INV?1.f:-1.f) * ((m)==0?0.f:(m)==1?S1:(m)==2?C2:(m)==3?C1:(m)==4?1.f:(m)==6?C2:(m)==9?-S1:0.f) ))
    v[4 + 1] = cmul(v[4 + 1], W16(1)); v[4 + 2] = cmul(v[4 + 2], W16(2)); v[4 + 3] = cmul(v[4 + 3], W16(3));
    v[8 + 1] = cmul(v[8 + 1], W16(2)); v[8 + 2] = cmul(v[8 + 2], W16(4)); v[8 + 3] = cmul(v[8 + 3], W16(6));
    v[12 + 1] = cmul(v[12 + 1], W16(3)); v[12 + 2] = cmul(v[12 + 2], W16(6)); v[12 + 3] = cmul(v[12 + 3], W16(9));
#undef W16
    cf o[16];
#pragma unroll
    for (int k1 = 0; k1 < 4; ++k1) {
        cf x0 = v[4 * k1], x1 = v[4 * k1 + 1], x2 = v[4 * k1 + 2], x3 = v[4 * k1 + 3];
        cf A = cadd(x0, x2), B = csub(x0, x2), C = cadd(x1, x3), D = csub(x1, x3);
        cf Dm = INV ? mul_pi(D) : mul_mi(D);
        o[k1] = cadd(A, C); o[k1 + 4] = cadd(B, Dm); o[k1 + 8] = csub(A, C); o[k1 + 12] = csub(B, Dm);
    }
#pragma unroll
    for (int i = 0; i < 16; ++i) v[i] = o[i];
}

template <int GEO> FDEV int geo_idx(int r, int e) {
    if (GEO == 1) return 272 * e + 17 * (r >> 4) + (r & 15);
    if (GEO == 2) return 272 * (r >> 4) + 17 * e + (r & 15);
    return 272 * (r >> 4) + 17 * (r & 15) + e;
}
template <int GEO> FDEV void fft_pass_fwd(LDSPTR cf* buf, const LDSPTR cf* tw, const LDSPTR cf* tw256, int r) {
    cf v[16];
#pragma unroll
    for (int e = 0; e < 16; ++e) v[e] = buf[geo_idx<GEO>(r, e)];
    dft16<false>(v);
    if (GEO == 1) {
#pragma unroll
        for (int s = 1; s < 16; ++s) v[s] = cmul(v[s], tw[(r * s) & 4095]);
    } else if (GEO == 2) {
        const int t = r & 15;
#pragma unroll
        for (int s = 1; s < 16; ++s) v[s] = cmul(v[s], tw256[t * s]);
    }
#pragma unroll
    for (int e = 0; e < 16; ++e) buf[geo_idx<GEO>(r, e)] = v[e];
}
template <int GEO> FDEV void fft_pass_inv(LDSPTR cf* buf, const LDSPTR cf* tw, const LDSPTR cf* tw256, int r) {
    cf v[16];
#pragma unroll
    for (int e = 0; e < 16; ++e) v[e] = buf[geo_idx<GEO>(r, e)];
    if (GEO == 1) {
#pragma unroll
        for (int s = 1; s < 16; ++s) v[s] = cmulc(v[s], tw[(r * s) & 4095]);
    } else if (GEO == 2) {
        const int t = r & 15;
#pragma unroll
        for (int s = 1; s < 16; ++s) v[s] = cmulc(v[s], tw256[t * s]);
    }
    dft16<true>(v);
#pragma unroll
    for (int e = 0; e < 16; ++e) buf[geo_idx<GEO>(r, e)] = v[e];
}
FDEV int freq_pos(int k) { return 256 * (k & 15) + 16 * ((k >> 4) & 15) + (k >> 8); }
#endif

#define XB_TMO      128
#define XB_XCNT(j)  (256  + 64 * (j))
#define XB_XSUB(j)  (1280 + 64 * (j))
#define XB_XGEN(j)  (2304 + 64 * (j))
#define XB_TOP      3328
#define XB_TOPGEN   3392
#define XCD_BAR_WORDS 3456
#define XB_SPIN_CAP (1u << 18)
__device__ __forceinline__ unsigned xb_ld(unsigned* p)              { return __hip_atomic_load(p, __ATOMIC_RELAXED, __HIP_MEMORY_SCOPE_AGENT); }
__device__ __forceinline__ unsigned xb_add(unsigned* p, unsigned v) { return __hip_atomic_fetch_add(p, v, __ATOMIC_RELAXED, __HIP_MEMORY_SCOPE_AGENT); }
__device__ __forceinline__ unsigned xb_xcc_id() { return (unsigned)__builtin_amdgcn_s_getreg((3 << 11) | 20) & 0xFu; }
#define XB_SPIN(cond, bar) do { unsigned _sp = 0; while (cond) { __builtin_amdgcn_s_sleep(1); \
    if ((++_sp & 255u) == 0u) { if (xb_ld(&(bar)[XB_TMO])) break; if (_sp > XB_SPIN_CAP) { atomicAdd(&(bar)[XB_TMO], 1u); break; } } } } while (0)
struct XcdBarrier { unsigned* bar; unsigned x; volatile LAS unsigned* st; };
__device__ __forceinline__ XcdBarrier xcd_barrier_post(unsigned* bar, volatile LAS unsigned* st) {
    XcdBarrier b; b.bar = bar; b.x = xb_xcc_id(); b.st = st;
    if (threadIdx.x == 0) (void)xb_add(&bar[XB_XCNT(b.x)], 1u);
    return b;
}
__device__ __forceinline__ void xcd_barrier_complete(unsigned* bar, unsigned x, unsigned& nloc, unsigned& nx) {
    const unsigned G = gridDim.x * gridDim.y * gridDim.z;
    unsigned sum, cnt, mine, sp = 0u;
    for (;;) {
        sum = 0u; cnt = 0u; mine = 0u;
#pragma unroll
        for (unsigned j = 0; j < 16; ++j) { const unsigned c = xb_ld(&bar[XB_XCNT(j)]); sum += c; cnt += (c > 0u) ? 1u : 0u; mine = (j == x) ? c : mine; }
        if (sum == G) break;
        __builtin_amdgcn_s_sleep(1);
        if ((++sp & 255u) == 0u) { if (xb_ld(&bar[XB_TMO])) break; if (sp > XB_SPIN_CAP) { atomicAdd(&bar[XB_TMO], 1u); break; } }
    }
    nloc = mine > 0u ? mine : 1u; nx = cnt > 0u ? cnt : 1u;
}
__device__ __forceinline__ void xcd_barrier(const XcdBarrier& b) {
    asm volatile("s_waitcnt vmcnt(0)" ::: "memory");
    __syncthreads();
    if (threadIdx.x == 0) {
        unsigned* bar = b.bar;
        __builtin_amdgcn_s_waitcnt(0);
        unsigned nloc = b.st[0], nx = b.st[1];
        if (nloc == 0u) { xcd_barrier_complete(bar, b.x, nloc, nx); b.st[0] = nloc; b.st[1] = nx; }
        const unsigned old = xb_add(&bar[XB_XSUB(b.x)], 1u);
        const unsigned gen = old / nloc;
        if (old + 1u == (gen + 1u) * nloc) {
            __builtin_amdgcn_fence(__ATOMIC_RELEASE, "agent");
            asm volatile("s_waitcnt vmcnt(0)" ::: "memory");
            const unsigned og = xb_add(&bar[XB_TOP], 1u);
            const unsigned tg = og / nx;
            if (og + 1u == (tg + 1u) * nx) xb_add(&bar[XB_TOPGEN], 1u);
            else XB_SPIN(xb_ld(&bar[XB_TOPGEN]) == tg, bar);
            __builtin_amdgcn_fence(__ATOMIC_ACQUIRE, "agent");
            xb_add(&bar[XB_XGEN(b.x)], 1u);
            asm volatile("s_waitcnt vmcnt(0)" ::: "memory");
        } else {
            XB_SPIN(xb_ld(&bar[XB_XGEN(b.x)]) == gen, bar);
            __builtin_amdgcn_fence(__ATOMIC_ACQUIRE, "agent");
            asm volatile("s_waitcnt vmcnt(0)" ::: "memory");
        }
    }
    __syncthreads();
}

struct Frame {
    LAS unsigned char* lds;
    unsigned char* ws;
    int tid, lane, wave, vcu, G, bid;
    const float *x, *norm1_g, *w_in, *conv_w, *conv_b, *f_w_in, *f_b_in, *f_w_mid, *f_b_mid, *f_freq, *f_w_out, *f_bias, *mix_g, *w_out, *norm2_g,
                *w_group, *b_group, *w_router, *b_router, *w_gate, *w_up, *w_down, *final_g;
    float* out;
};
#define WSP(T, off) ((T*)(F.ws + (off)))

__device__ __forceinline__ void transpose_item(const float* W, int ldw, bf16* WT, int ldo, LAS float* scr, int lane, const float* gk = nullptr) {
    asm volatile("" : "+s"(ldw));
    const float* Wl = W + (size_t)(lane >> 5) * ldw + (lane & 31);
    float t[32];
#pragma unroll
    for (int i = 0; i < 32; ++i) t[i] = Wl[(size_t)(2 * i) * ldw];
    if (gk) { const float* gl = gk + (lane >> 5);
#pragma unroll
        for (int i = 0; i < 32; ++i) t[i] *= gl[2 * i]; }
#pragma unroll
    for (int i = 0; i < 32; ++i) { const int kk = 2 * i + (lane >> 5); scr[kk * 33 + (lane & 31)] = t[i]; }
    LDS_WAIT(); asm volatile("" ::: "memory");
    const int c = lane & 7;
#pragma unroll
    for (int j = 0; j < 4; ++j) { const int n = (lane >> 3) + 8 * j; const LAS float* s = scr + (8 * c) * 33 + n;
        u32x4 o; o.x = pk2(s[0 * 33], s[1 * 33]); o.y = pk2(s[2 * 33], s[3 * 33]); o.z = pk2(s[4 * 33], s[5 * 33]); o.w = pk2(s[6 * 33], s[7 * 33]);
        st16_wt(WT + (size_t)n * ldo + 8 * c, o); }
    LDS_WAIT(); asm volatile("" ::: "memory");
}
__device__ __forceinline__ void transpose_item_fp8(const float* W, int ldw, unsigned char* WT, int ldo, LAS float* scr, int lane, const float* gk, float scale) {
    asm volatile("" : "+s"(ldw));
    const float* Wl = W + (size_t)(lane >> 5) * ldw + (lane & 31);
    float t[32];
#pragma unroll
    for (int i = 0; i < 32; ++i) t[i] = Wl[(size_t)(2 * i) * ldw];
    if (gk) { const float* gl = gk + (lane >> 5);
#pragma unroll
        for (int i = 0; i < 32; ++i) t[i] *= gl[2 * i]; }
#pragma unroll
    for (int i = 0; i < 32; ++i) { const int kk = 2 * i + (lane >> 5); scr[kk * 33 + (lane & 31)] = t[i]; }
    LDS_WAIT(); asm volatile("" ::: "memory");
    const int n = lane >> 1, hf = lane & 1; const LAS float* s = scr + (32 * hf) * 33 + n;
    u32x4 o0, o1;
    o0.x = pk4_fp8s(s[0 * 33], s[1 * 33], s[2 * 33], s[3 * 33], scale); o0.y = pk4_fp8s(s[4 * 33], s[5 * 33], s[6 * 33], s[7 * 33], scale);
    o0.z = pk4_fp8s(s[8 * 33], s[9 * 33], s[10 * 33], s[11 * 33], scale); o0.w = pk4_fp8s(s[12 * 33], s[13 * 33], s[14 * 33], s[15 * 33], scale);
    o1.x = pk4_fp8s(s[16 * 33], s[17 * 33], s[18 * 33], s[19 * 33], scale); o1.y = pk4_fp8s(s[20 * 33], s[21 * 33], s[22 * 33], s[23 * 33], scale);
    o1.z = pk4_fp8s(s[24 * 33], s[25 * 33], s[26 * 33], s[27 * 33], scale); o1.w = pk4_fp8s(s[28 * 33], s[29 * 33], s[30 * 33], s[31 * 33], scale);
    unsigned char* d = WT + (size_t)n * ldo + 32 * hf;
    st16_wt(d, o0); st16_wt(d + 16, o1);
    LDS_WAIT(); asm volatile("" ::: "memory");
}
__device__ __forceinline__ void rms_row_to_bf16(const float* xrow, const float* g, bf16* orow, int lane) {
    const GAS f32x4* xr = (const GAS f32x4*)xrow + lane; const GAS f32x4* gr = (const GAS f32x4*)g + lane;
    f32x4 v[4]; float s = 0.f;
#pragma unroll
    for (int j = 0; j < 4; ++j) { v[j] = xr[64 * j]; s += (v[j].x * v[j].x + v[j].y * v[j].y) + (v[j].z * v[j].z + v[j].w * v[j].w); }
    const float rinv = 1.0f / sqrtf(wave_sum(s) * (1.f / 1024.f) + EPS);
    GAS u32x2* o8 = (GAS u32x2*)orow + lane;
#pragma unroll
    for (int j = 0; j < 4; ++j) { const f32x4 gg = gr[64 * j]; u32x2 w; w.x = pk2(v[j].x * rinv * gg.x, v[j].y * rinv * gg.y); w.y = pk2(v[j].z * rinv * gg.z, v[j].w * rinv * gg.w); o8[64 * j] = w; }
}
__device__ __forceinline__ void wave_lds_sync() { asm volatile("s_waitcnt lgkmcnt(0)" ::: "memory"); }
template <int NIN, int astride> __device__ __forceinline__ void mlp_layer(const float* W  , const float* bvec, const float* fvec, const LAS float* ain, LAS float* aout, int lane) {
    float w[64];
    unsigned ul = (unsigned)lane; asm volatile("" : "+v"(ul));
#pragma unroll
    for (int i = 0; i < 64; ++i) w[i] = (i < NIN) ? W[(unsigned)(i * 64) + ul] : 0.f;
    const float b = bvec[lane], fr = fvec[lane];
#pragma unroll 1
    for (int p = 0; p < 16; ++p) {
        const LAS float* ap = ain + p * astride; float s = b;
        if (NIN == 33) {
#pragma unroll
            for (int i = 0; i < 33; ++i) s += ap[i] * w[i];
        } else {
#pragma unroll
            for (int i4 = 0; i4 < 16; ++i4) { const f32x4 hv = *(const LAS f32x4*)(ap + 4 * i4); s += (hv.x * w[4 * i4] + hv.y * w[4 * i4 + 1]) + (hv.z * w[4 * i4 + 2] + hv.w * w[4 * i4 + 3]); }
        }
        aout[p * 64 + lane] = sinf(fr * s);
    }
    asm volatile("s_waitcnt lgkmcnt(0)" ::: "memory");
}
__device__ __forceinline__ void filter_mlp_wave(Frame& F, int pb, int half, unsigned lds_off) {
    const int lane = F.lane;
    asm volatile("" : "+v"(lds_off));
    LAS float* a0 = (LAS float*)(F.lds + lds_off); LAS float* a1 = a0 + 16 * 36; LAS float* a2 = a1 + 1024;
    for (int i = lane; i < 16 * 33; i += 64) { const int p = i / 33, j = i % 33, l = 16 * pb + p; float v;
        if (j == 0) v = (float)l / 4095.0f;
        else { const int q = (j - 1) & 15; const float fq = 1e-4f + (float)q * ((15.0f - 1e-4f) / 15.0f); const float ang = fq * ((2.0f * 3.14159265358979323846f / 4096.0f) * (float)l); v = (j <= 16) ? cosf(ang) : -sinf(ang); }
        a0[p * 36 + j] = v; }
    asm volatile("s_waitcnt lgkmcnt(0)" ::: "memory");
    mlp_layer<33, 36>(F.f_w_in, F.f_b_in, F.f_freq, a0, a1, lane);
    mlp_layer<64, 64>(F.f_w_mid, F.f_b_mid, F.f_freq + 64, a1, a2, lane);
    mlp_layer<64, 64>(F.f_w_mid + 4096, F.f_b_mid + 64, F.f_freq + 128, a2, a1, lane);
    float* KT = WSP(float, WS_KT);
#pragma unroll 1
    for (int m = half; m < 16; m += 4) { const int j = 64 * m + lane;
        float w[64]; unsigned uj = (unsigned)j; asm volatile("" : "+v"(uj));
#pragma unroll
        for (int i = 0; i < 64; ++i) w[i] = F.f_w_out[(unsigned)(i * 1024) + uj];
        const float mind = -3.0701134573253946f, maxd = -15.350567286626973f;
        const float delta = fabsf(mind + (float)(j & 511) * ((maxd - mind) / 511.0f));
        f32x4* o4 = (f32x4*)(KT + (size_t)j * 4096 + 16 * pb);
#pragma unroll 1
        for (int pg = 0; pg < 4; ++pg) {
            float acc[4];
#pragma unroll
            for (int q = 0; q < 4; ++q) { const LAS float* ap = a1 + (4 * pg + q) * 64; float sacc = 0.f;
#pragma unroll
                for (int i4 = 0; i4 < 16; ++i4) { const f32x4 hv = *(const LAS f32x4*)(ap + 4 * i4); sacc += (hv.x * w[4 * i4] + hv.y * w[4 * i4 + 1]) + (hv.z * w[4 * i4 + 2] + hv.w * w[4 * i4 + 3]); }
                acc[q] = sacc * __expf(-((float)(16 * pb + 4 * pg + q) / 4095.0f) * delta); }
            o4[pg] = (f32x4){acc[0], acc[1], acc[2], acc[3]};
        }
    }
}
constexpr int WD_HERE = 0;
__device__ __forceinline__ void phase_prologue(Frame& F) {
    { const int gt = F.bid * NTHREADS + F.tid;
      if (gt < 4096) { f32x2 w; w.x = cospif((float)gt * (1.0f / 2048.0f)); w.y = -sinpif((float)gt * (1.0f / 2048.0f)); WSP(f32x2, WS_TW4096)[gt] = w; }
      else if (gt < 8192) { const int n = gt - 4096; f32x2 w; w.x = cospif((float)n * (1.0f / 4096.0f)); w.y = -sinpif((float)n * (1.0f / 4096.0f)); WSP(f32x2, WS_TW8192)[n] = w; } }
    LAS unsigned* ticket = (LAS unsigned*)(F.lds + 158 * 1024);
    for (int rr_ = 0; rr_ < ((MK_DUP == 15) ? 2 : 1); ++rr_) {
    __syncthreads();
    if (F.tid == 0) ticket[0] = 0u;
    __syncthreads();
    if (F.wave >= 4 && rr_ == 0) { for (int pb = F.bid; pb < 256; pb += F.G) filter_mlp_wave(F, pb, F.wave - 4, (unsigned)((72 + 12 * (F.wave - 4)) * 1024)); }
    {
        LAS float* scr = (LAS float*)(F.lds + F.wave * 8704);
        constexpr int I_IN = 16 * 64, I_OUT = 16 * 32, I_G = 32 * 16 * 16, I_D = 32 * 8 * 32, I_RMS = T_TOK / 4;
        constexpr int NITEMS = I_IN + I_OUT + 2 * I_G + I_RMS + WD_HERE;
        bf16* WIN_T = WSP(bf16, WS_WIN_T); bf16* WOUT_T = WSP(bf16, WS_WOUT_T); unsigned char* WGU8 = WSP(unsigned char, WS_WGU_T); unsigned char* WD8 = WSP(unsigned char, WS_WD_T); bf16* HN = WSP(bf16, WS_HN);
        f32x4 gg[4];
#pragma unroll
        for (int j = 0; j < 4; ++j) gg[j] = ((const GAS f32x4*)F.norm1_g)[64 * j + F.lane];
        for (;;) {
            unsigned tk = 0; if (F.lane == 0) tk = __hip_atomic_fetch_add((unsigned*)ticket, 1u, __ATOMIC_RELAXED, __HIP_MEMORY_SCOPE_WORKGROUP);
            tk = __builtin_amdgcn_readfirstlane(tk);
            const long itl = (long)tk * F.G + F.vcu; if (itl >= NITEMS) break;
            int r = (int)itl;
            if (r < I_RMS) {
                const int m0 = 4 * r; f32x4 v[4][4];
#pragma unroll
                for (int q = 0; q < 4; ++q) { const GAS f32x4* xr = (const GAS f32x4*)(F.x + (size_t)(m0 + q) * 1024) + F.lane;
#pragma unroll
                    for (int j = 0; j < 4; ++j) v[q][j] = xr[64 * j]; }
#pragma unroll
                for (int q = 0; q < 4; ++q) { float s = 0.f;
#pragma unroll
                    for (int j = 0; j < 4; ++j) s += (v[q][j].x * v[q][j].x + v[q][j].y * v[q][j].y) + (v[q][j].z * v[q][j].z + v[q][j].w * v[q][j].w);
                    const float rinv = 1.0f / sqrtf(wave_sum(s) * (1.f / 1024.f) + EPS);
                    GAS u32x2* o8 = (GAS u32x2*)(HN + (size_t)(m0 + q) * 1024) + F.lane;
#pragma unroll
                    for (int j = 0; j < 4; ++j) { u32x2 w; w.x = pk2(v[q][j].x * rinv * gg[j].x, v[q][j].y * rinv * gg[j].y); w.y = pk2(v[q][j].z * rinv * gg[j].z, v[q][j].w * rinv * gg[j].w); o8[64 * j] = w; } }
                continue; } r -= I_RMS;
            if (r < I_IN) { const int kb = r / 64, nb = r % 64; transpose_item(F.w_in + (size_t)(64 * kb) * D_IN_PROJ + 32 * nb, D_IN_PROJ, WIN_T + (size_t)(32 * nb) * 1024 + 64 * kb, 1024, scr, F.lane); continue; } r -= I_IN;
            if (r < I_OUT) { const int kb = r / 32, nb = r % 32; transpose_item(F.w_out + (size_t)(64 * kb) * 1024 + 32 * nb, 1024, WOUT_T + (size_t)(32 * nb) * 1024 + 64 * kb, 1024, scr, F.lane); continue; } r -= I_OUT;
            if (r < 2 * I_G) { const int up = r / I_G; r %= I_G; const int e = r / 256, kb = (r % 256) / 16, nb = r % 16; const int n0 = 32 * nb;
                const float* W = (up ? F.w_up : F.w_gate) + (size_t)e * 1024 * 512 + (size_t)(64 * kb) * 512 + n0;
                const int orow = 256 * (n0 >> 7) + (n0 & 127) + (up ? 128 : 0);
                transpose_item_fp8(W, 512, WGU8 + ((size_t)e * 1024 + orow) * 1024 + 64 * kb, 1024, scr, F.lane, F.norm2_g + 64 * kb, W_SCALE); continue; } r -= 2 * I_G;
            { const int e = r / 256, kb = (r % 256) / 32, nb = r % 32;
              transpose_item_fp8(F.w_down + (size_t)e * 512 * 1024 + (size_t)(64 * kb) * 1024 + 32 * nb, 1024, WD8 + ((size_t)e * 1024 + 32 * nb) * 512 + 64 * kb, 512, scr, F.lane, nullptr, W_SCALE); }
        }
        (void)I_D;
    }
    }
    __syncthreads();
}
__device__ __forceinline__ void wdown_items(Frame& F, int first, int stride) {
    LAS float* scr = (LAS float*)(F.lds + F.wave * 8704); unsigned char* WD8 = WSP(unsigned char, WS_WD_T);
    for (int r = WD_HERE + first; r < 32 * 8 * 32; r += stride) { const int e = r / 256, kb = (r % 256) / 32, nb = r % 32;
        transpose_item_fp8(F.w_down + (size_t)e * 512 * 1024 + (size_t)(64 * kb) * 1024 + 32 * nb, 1024, WD8 + ((size_t)e * 1024 + 32 * nb) * 512 + 64 * kb, 512, scr, F.lane, nullptr, W_SCALE); }
}

__device__ __forceinline__ void load_tw_lds(Frame& F, int tw_off, int tw256_off) {
    __syncthreads();
    LAS f32x2* tw = (LAS f32x2*)(F.lds + tw_off); const f32x2* g = WSP(f32x2, WS_TW4096);
    f32x2 tv[8];
#pragma unroll
    for (int i = 0; i < 8; ++i) tv[i] = g[F.tid + NTHREADS * i];
    const f32x2 t2 = g[16 * (F.tid & 255)];
#pragma unroll
    for (int i = 0; i < 8; ++i) tw[F.tid + NTHREADS * i] = tv[i];
    if (F.tid < 256) ((LAS f32x2*)(F.lds + tw256_off))[F.tid] = t2;
    __syncthreads();
}
__device__ __forceinline__ void fft_fwd3(Frame& F) {
    LAS cf* buf = (LAS cf*)(F.lds + ((F.tid >> 8) ? L_BUFB : L_BUFA)); const LAS cf* tw = (const LAS cf*)(F.lds + L_TW); const LAS cf* t256 = (const LAS cf*)(F.lds + L_TW256); const int r = F.tid & 255;
    fft_pass_fwd<1>(buf, tw, t256, r); __syncthreads(); fft_pass_fwd<2>(buf, tw, t256, r); __syncthreads(); fft_pass_fwd<3>(buf, tw, t256, r); __syncthreads();
}
__device__ __forceinline__ void fft_inv3(Frame& F) {
    LAS cf* buf = (LAS cf*)(F.lds + ((F.tid >> 8) ? L_BUFB : L_BUFA)); const LAS cf* tw = (const LAS cf*)(F.lds + L_TW); const LAS cf* t256 = (const LAS cf*)(F.lds + L_TW256); const int r = F.tid & 255;
    fft_pass_inv<3>(buf, tw, t256, r); __syncthreads(); fft_pass_inv<2>(buf, tw, t256, r); __syncthreads(); fft_pass_inv<1>(buf, tw, t256, r); __syncthreads();
}
__device__ __forceinline__ void filter_item(Frame& F, int c) {
    LAS cf* bufA = (LAS cf*)(F.lds + L_BUFA); LAS cf* bufB = (LAS cf*)(F.lds + L_BUFB);
    LAS float* kfb = (LAS float*)(F.lds + L_SCR);
    LAS float* red = (LAS float*)(F.lds + L_RED);
    const float* KT = WSP(float, WS_KT); const f32x2* tw2 = WSP(f32x2, WS_TW8192);
    float sfv[8], sbv[8]; f32x2 wv[8];
#pragma unroll
    for (int i = 0; i < 8; ++i) { const int l = F.tid + NTHREADS * i; sfv[i] = KT[(size_t)c * 4096 + l]; sbv[i] = KT[(size_t)(512 + c) * 4096 + l]; wv[i] = tw2[l]; }
    float asum = 0.f;
#pragma unroll
    for (int i = 0; i < 8; ++i) { const int l = F.tid + NTHREADS * i; kfb[l] = sfv[i]; kfb[4096 + l] = sbv[i]; asum += fabsf(sfv[i]) + (l >= 1 ? fabsf(sbv[i]) : 0.f); }
    asum = wave_sum(asum);
    if (F.lane == 0) red[128 + F.wave] = asum;
    __syncthreads();
    float tot = 0.f;
#pragma unroll
    for (int i = 0; i < 8; ++i) tot += red[128 + i];
    const float sc = 1.0f / (tot * 8192.0f);
#pragma unroll
    for (int i = 0; i < 8; ++i) { const int n = F.tid + NTHREADS * i;
        const float kf = sfv[i], kbm = (n >= 1) ? kfb[4096 + 4096 - n] : 0.f;
        const float a = (kf + kbm) * sc, d = (kf - kbm) * sc;
        bufA[fpos(n)] = mkc(a, 0.f); bufB[fpos(n)] = mkc(d * wv[i].x, d * wv[i].y); }
    __syncthreads();
    fft_fwd3(F);
    f32x2* KF = WSP(f32x2, WS_KF) + (size_t)c * 8192;
    for (int p = F.tid; p < 4096; p += NTHREADS) { const cf a = bufA[fpos(p)], b = bufB[fpos(p)]; KF[p] = (f32x2){a.x, a.y}; KF[4096 + p] = (f32x2){b.x, b.y}; }
    __syncthreads();
}
__device__ __forceinline__ const bf16* pt_at(const bf16* PT, int row, int tok) { return PT + ((size_t)(tok >> 8) * NPT_ROWS + row) * 256 + (tok & 255); }
struct Row8 { u32x4 w; float lft, rgt; };
__device__ __forceinline__ Row8 row8_load(const bf16* PT, int row, int tb, int l0) {
    Row8 r; r.w = *(const u32x4*)pt_at(PT, row, tb + l0);
    const bf16 a = *pt_at(PT, row, tb + (l0 > 0 ? l0 - 1 : 0)), b = *pt_at(PT, row, tb + (l0 + 8 < 4096 ? l0 + 8 : 4095));
    r.lft = (l0 > 0) ? bf1(a) : 0.f; r.rgt = (l0 + 8 < 4096) ? bf1(b) : 0.f; return r;
}
__device__ __forceinline__ void conv8(const Row8& r, float w0, float w1, float w2, float b, float (&o)[8]) {
    float u[10];
    u[0] = r.lft; u[9] = r.rgt; const u32x4 v = r.w;
    u[1] = bflo(v.x); u[2] = bfhi(v.x); u[3] = bflo(v.y); u[4] = bfhi(v.y); u[5] = bflo(v.z); u[6] = bfhi(v.z); u[7] = bflo(v.w); u[8] = bfhi(v.w);
#pragma unroll
    for (int i = 0; i < 8; ++i) o[i] = b + w0 * u[i] + w1 * u[i + 1] + w2 * u[i + 2];
}
struct HyRaw { Row8 a0, v0, a1, v1; };
__device__ __forceinline__ void hy_load(Frame& F, int it, HyRaw& r) {
    const int c = it >> 2, bp = it & 3, l0 = 8 * F.tid; const bf16* PT = WSP(bf16, WS_PT);
    const int tb = 2 * bp * SEQ;
    r.a0 = row8_load(PT, 512 + c, tb, l0); r.v0 = row8_load(PT, 1024 + c, tb, l0); r.a1 = row8_load(PT, 512 + c, tb + SEQ, l0); r.v1 = row8_load(PT, 1024 + c, tb + SEQ, l0);
}
__device__ __forceinline__ void hyena_items(Frame& F) {
    LAS cf* bufA = (LAS cf*)(F.lds + L_BUFA); LAS cf* bufB = (LAS cf*)(F.lds + L_BUFB); const LAS cf* tw2 = (const LAS cf*)(F.lds + L_SCR);
    const bf16* PT = WSP(bf16, WS_PT); const float* cw = F.conv_w; const float* cb = F.conv_b;
    const int l0 = 8 * F.tid;
    HyRaw nx; int it = F.bid;
    if (it < 2048) hy_load(F, it, nx);
    for (; it < 2048; it += F.G) {
        const int c = it >> 2, bp = it & 3;
        float z0[8], z1[8];
        {
            const float a0 = cw[512 + c], a1 = cw[1536 + 512 + c], a2 = cw[3072 + 512 + c], ab = cb[512 + c];
            const float v0 = cw[1024 + c], v1 = cw[1536 + 1024 + c], v2 = cw[3072 + 1024 + c], vb = cb[1024 + c];
            float t1[8], t2[8];
            conv8(nx.a0, a0, a1, a2, ab, t1); conv8(nx.v0, v0, v1, v2, vb, t2);
#pragma unroll
            for (int i = 0; i < 8; ++i) z0[i] = t1[i] * t2[i];
            conv8(nx.a1, a0, a1, a2, ab, t1); conv8(nx.v1, v0, v1, v2, vb, t2);
#pragma unroll
            for (int i = 0; i < 8; ++i) z1[i] = t1[i] * t2[i];
        }
#pragma unroll
        for (int i = 0; i < 8; ++i) { const int l = l0 + i; const cf z = mkc(z0[i], z1[i]); bufA[fpos(l)] = z; bufB[fpos(l)] = cmul(z, tw2[l]); }
        f32x2 ke[8], ko[8];
        { const f32x2* KF = WSP(f32x2, WS_KF) + (size_t)c * 8192;
#pragma unroll
          for (int i = 0; i < 8; ++i) { ke[i] = KF[F.tid + 512 * i]; ko[i] = KF[4096 + F.tid + 512 * i]; } }
        __syncthreads();
        fft_fwd3(F);
#pragma unroll
        for (int i = 0; i < 8; ++i) { const int q = fpos(F.tid + 512 * i); bufA[q] = cmul(bufA[q], ke[i]); bufB[q] = cmul(bufB[q], ko[i]); }
        Row8 xa, xb;
        { const int tb = 2 * bp * SEQ; xa = row8_load(PT, c, tb, l0); xb = row8_load(PT, c, tb + SEQ, l0); }
        if (it + F.G < 2048) hy_load(F, it + F.G, nx);
        __syncthreads();
        fft_inv3(F);
        {
            const float w0 = cw[c], w1 = cw[1536 + c], w2 = cw[3072 + c], wb = cb[c]; const float bias = F.f_bias[c];
            bf16* YT = WSP(bf16, WS_YT) + (size_t)c * T_TOK + (size_t)(2 * bp) * SEQ;
            float x0a[8], x0b[8], ya[8], yb[8];
            conv8(xa, w0, w1, w2, wb, x0a); conv8(xb, w0, w1, w2, wb, x0b);
#pragma unroll
            for (int i = 0; i < 8; ++i) { const int l = l0 + i; const cf e = bufA[fpos(l)], o = bufB[fpos(l)]; const cf y = cadd(e, cmulc(o, tw2[l]));
                ya[i] = x0a[i] * (y.x + bias * z0[i]); yb[i] = x0b[i] * (y.y + bias * z1[i]); }
            u32x4 oa, ob; oa.x = pk2(ya[0], ya[1]); oa.y = pk2(ya[2], ya[3]); oa.z = pk2(ya[4], ya[5]); oa.w = pk2(ya[6], ya[7]);
            ob.x = pk2(yb[0], yb[1]); ob.y = pk2(yb[2], yb[3]); ob.z = pk2(yb[4], yb[5]); ob.w = pk2(yb[6], yb[7]);
            *(u32x4*)(YT + l0) = oa; *(u32x4*)(YT + SEQ + l0) = ob;
        }
        __syncthreads();
    }
}
struct FoRaw { u32x4 a0, d0, a1, d1; };
__device__ __forceinline__ void fo_load(Frame& F, int q, FoRaw& r) {
    const int f = F.tid >> 8, s = 2 * q + f, b = s >> 9, gc = s & 511, g = gc >> 6, cp = gc & 63, l0 = 16 * (F.tid & 255);
    const bf16* PT = WSP(bf16, WS_PT); const int r1 = 1536 + 128 * g + cp, r2 = r1 + 64, tk = b * SEQ + l0;
    r.a0 = *(const u32x4*)pt_at(PT, r1, tk); r.d0 = *(const u32x4*)pt_at(PT, r2, tk); r.a1 = *(const u32x4*)pt_at(PT, r1, tk + 8); r.d1 = *(const u32x4*)pt_at(PT, r2, tk + 8);
}
__device__ __forceinline__ void fo_put(LAS cf* buf, int l, u32x4 a, u32x4 d) {
    buf[fpos(l + 0)] = mkc(bflo(a.x), bflo(d.x)); buf[fpos(l + 1)] = mkc(bfhi(a.x), bfhi(d.x)); buf[fpos(l + 2)] = mkc(bflo(a.y), bflo(d.y)); buf[fpos(l + 3)] = mkc(bfhi(a.y), bfhi(d.y));
    buf[fpos(l + 4)] = mkc(bflo(a.z), bflo(d.z)); buf[fpos(l + 5)] = mkc(bfhi(a.z), bfhi(d.z)); buf[fpos(l + 6)] = mkc(bflo(a.w), bflo(d.w)); buf[fpos(l + 7)] = mkc(bfhi(a.w), bfhi(d.w));
}
__device__ __forceinline__ void fourier_items(Frame& F) {
    const int f = F.tid >> 8, r = F.tid & 255, l0 = 16 * r;
    LAS cf* buf = (LAS cf*)(F.lds + (f ? L_BUFB : L_BUFA));
    FoRaw nx; int q = F.bid;
    if (q < 2048) fo_load(F, q, nx);
    for (; q < 2048; q += F.G) {
        const int s = 2 * q + f, b = s >> 9, gc = s & 511;
        fo_put(buf, l0, nx.a0, nx.d0); fo_put(buf, l0 + 8, nx.a1, nx.d1);
        if (q + F.G < 2048) fo_load(F, q + F.G, nx);
        __syncthreads();
        fft_fwd3(F);
        bf16* YT = WSP(bf16, WS_YT) + (size_t)(512 + gc) * T_TOK + (size_t)b * SEQ;
        float y[16];
#pragma unroll
        for (int i = 0; i < 16; ++i) y[i] = buf[fpos(freq_pos(l0 + i))].x * (1.0f / 512.0f);
        u32x4 o0, o1; o0.x = pk2(y[0], y[1]); o0.y = pk2(y[2], y[3]); o0.z = pk2(y[4], y[5]); o0.w = pk2(y[6], y[7]);
        o1.x = pk2(y[8], y[9]); o1.y = pk2(y[10], y[11]); o1.z = pk2(y[12], y[13]); o1.w = pk2(y[14], y[15]);
        *(u32x4*)(YT + l0) = o0; *(u32x4*)(YT + l0 + 8) = o1;
        __syncthreads();
    }
}

#define MF_LO 1
constexpr int MF_NS = 288;
constexpr int MF_PS = 24;
constexpr int MF_PLANE = 6144;
typedef short bf16x8v __attribute__((ext_vector_type(8)));
typedef short s16x4v __attribute__((ext_vector_type(4)));
typedef float f32x16 __attribute__((ext_vector_type(16)));
struct DftFrag { bf16x8v hi[2], lo[2]; };
__device__ __forceinline__ void make_dft_frag(DftFrag& f, int lane, bool inv, const LAS cf* tw  ) {
    const int i = lane & 31, h = lane >> 5, ii = i & 15;
#pragma unroll
    for (int st = 0; st < 2; ++st)
#pragma unroll
        for (int j = 0; j < 8; ++j) { const int e = 8 * h + j; const int m = (ii * e) & 15; const cf w = tw[256 * m]; const float c = w.x, s = -w.y;
            const float di = inv ? s : -s;
            const float val = (st == 0) ? ((i < 16) ? c : di) : ((i < 16) ? -di : c);
            const unsigned hb = f2bf(val); const float rem = val - __builtin_bit_cast(float, hb << 16);
            f.hi[st][j] = (short)hb; f.lo[st][j] = (short)f2bf(rem); }
}
__device__ __forceinline__ unsigned cvtpk_v(float lo, float hi) { typedef float f32x2_t __attribute__((ext_vector_type(2))); typedef __bf16 bf16x2_t __attribute__((ext_vector_type(2))); const f32x2_t v = {lo, hi}; const bf16x2_t b = __builtin_convertvector(v, bf16x2_t); return __builtin_bit_cast(unsigned, b); }
__device__ __forceinline__ s16x4v lds_tr16(const LAS bf16* p) { typedef short v4i16_t __attribute__((ext_vector_type(4))); return __builtin_bit_cast(s16x4v, __builtin_amdgcn_ds_read_tr16_b64_v4i16((LAS v4i16_t*)p)); }
template <int PASS, bool INV, int EPI>
__device__ __forceinline__ void mfft_block(const LAS bf16* inR, const LAS bf16* inI, LAS bf16* outR, LAS bf16* outI, const DftFrag& M, const LAS cf* tw, const LAS cf* tw256, int cb, int lane, const cf* kf, float rs) {
    asm volatile("" : "+v"(lane));
    const int n = lane & 31, h = lane >> 5;
    bf16x8v bR, bI;
    if (PASS == 1) {
        const int g = lane >> 4, q = (lane & 15) >> 2, p = lane & 3;
        const int off = (8 * (g >> 1) + q) * MF_NS + 32 * cb + 16 * (g & 1) + 4 * p;
        const LAS bf16* pr = inR + off; const LAS bf16* pi = inI + off;
        const s16x4v r0 = lds_tr16(pr), r1 = lds_tr16(pr + 4 * MF_NS), i0 = lds_tr16(pi), i1 = lds_tr16(pi + 4 * MF_NS);
        asm volatile("" :: "v"(pr), "v"(pi) : "memory");
        bR = (bf16x8v){r0[0], r0[1], r0[2], r0[3], r1[0], r1[1], r1[2], r1[3]}; bI = (bf16x8v){i0[0], i0[1], i0[2], i0[3], i1[0], i1[1], i1[2], i1[3]};
    } else {
        const int off = (32 * cb + n) * MF_PS + 8 * h;
        bR = *(const LAS bf16x8v*)(inR + off); bI = *(const LAS bf16x8v*)(inI + off);
    }
    f32x16 acc = {0.f, 0.f, 0.f, 0.f, 0.f, 0.f, 0.f, 0.f, 0.f, 0.f, 0.f, 0.f, 0.f, 0.f, 0.f, 0.f};
    acc = __builtin_amdgcn_mfma_f32_32x32x16_bf16(M.hi[0], bR, acc, 0, 0, 0);
    acc = __builtin_amdgcn_mfma_f32_32x32x16_bf16(M.hi[1], bI, acc, 0, 0, 0);
#if MF_LO
    acc = __builtin_amdgcn_mfma_f32_32x32x16_bf16(M.lo[0], bR, acc, 0, 0, 0);
    acc = __builtin_amdgcn_mfma_f32_32x32x16_bf16(M.lo[1], bI, acc, 0, 0, 0);
#endif
    const int c = 32 * cb + n;
    int base, qs;
    if (PASS == 1) { base = MF_PS * (c & 15) + (c >> 4) + 64 * MF_PS * h; qs = 16 * MF_PS; }
    else if (PASS == 2) { base = 16 * MF_PS * (c >> 4) + (c & 15) + 4 * MF_PS * h; qs = MF_PS; }
    else { base = (c >> 4) + 16 * (c & 15) + 4 * MF_NS * h; qs = MF_NS; }
    float yr[8], yi[8];
#pragma unroll
    for (int q = 0; q < 8; ++q) { float a = acc[q], b = acc[8 + q];
        if (PASS == 1) { const int s = (q & 3) + 8 * (q >> 2) + 4 * h; const cf w = tw[(c * s) & 4095]; const float wy = INV ? -w.y : w.y; const float t = a * w.x - b * wy; b = a * wy + b * w.x; a = t; }
        else if (PASS == 2) { const int s = (q & 3) + 8 * (q >> 2) + 4 * h; const cf w = tw256[(c & 15) * s]; const float wy = INV ? -w.y : w.y; const float t = a * w.x - b * wy; b = a * wy + b * w.x; a = t; }
        else if (EPI == 1) { const cf w = kf[q]; const float t = a * w.x - b * w.y; b = -(a * w.y + b * w.x); a = t; }
        else if (EPI == 2) { a *= rs; }
        else if (EPI == 3) { a *= rs; b *= rs; }
        yr[q] = a; yi[q] = b; }
#pragma unroll
    for (int q = 0; q < 8; q += 2) { const int o0 = base + qs * ((q & 3) + 8 * (q >> 2)), o1 = o0 + qs;
        const unsigned pr = cvtpk_v(yr[q], yr[q + 1]); outR[o0] = (bf16)(pr & 0xffffu); outR[o1] = (bf16)(pr >> 16);
        if (!(PASS == 3 && EPI == 2)) { const unsigned pi = cvtpk_v(yi[q], yi[q + 1]); outI[o0] = (bf16)(pi & 0xffffu); outI[o1] = (bf16)(pi >> 16); } }
}

__device__ __forceinline__ int mf_nat(int x) { return MF_NS * (x >> 8) + (x & 255); }
__device__ __forceinline__ void fo2_load(Frame& F, int q, FoRaw& r) {
    const int f = F.tid >> 8, pp = 2 * q + f, b = pp >> 8, c = 2 * (pp & 255), l0 = 16 * (F.tid & 255);
    const bf16* PT = WSP(bf16, WS_PT); const int r1 = 1536 + c, r2 = r1 + 1, tk = b * SEQ + l0;
    r.a0 = *(const u32x4*)pt_at(PT, r1, tk); r.d0 = *(const u32x4*)pt_at(PT, r2, tk); r.a1 = *(const u32x4*)pt_at(PT, r1, tk + 8); r.d1 = *(const u32x4*)pt_at(PT, r2, tk + 8);
}
__device__ __forceinline__ void fourier_items_mfma(Frame& F) {
    const int f = F.tid >> 8, r = F.tid & 255, l0 = 16 * r, n0 = mf_nat(l0);
    LAS bf16* S0R = (LAS bf16*)(F.lds + f * 49152); LAS bf16* S0I = S0R + MF_PLANE; LAS bf16* S1R = S0R + 2 * MF_PLANE; LAS bf16* S1I = S0R + 3 * MF_PLANE;
    const LAS cf* tw = (const LAS cf*)(F.lds + M_TW); const LAS cf* t256 = (const LAS cf*)(F.lds + M_TW256);
    DftFrag Mf; make_dft_frag(Mf, F.lane, false, tw);
    const int cb0 = 2 * (F.wave & 3);
    bf16* SP = WSP(bf16, WS_SP);
    FoRaw nx; int q = F.bid;
    if (q < 1024) fo2_load(F, q, nx);
    for (; q < 1024; q += F.G) {
        const int pp = 2 * q + f, b = pp >> 8, c = 2 * (pp & 255);
        *(LAS u32x4*)(S0R + n0) = nx.a0; *(LAS u32x4*)(S0R + n0 + 8) = nx.a1; *(LAS u32x4*)(S0I + n0) = nx.d0; *(LAS u32x4*)(S0I + n0 + 8) = nx.d1;
        if (q + F.G < 1024) fo2_load(F, q + F.G, nx);
        __syncthreads();
        mfft_block<1, false, 0>(S0R, S0I, S1R, S1I, Mf, tw, t256, cb0, F.lane, nullptr, 1.f); mfft_block<1, false, 0>(S0R, S0I, S1R, S1I, Mf, tw, t256, cb0 + 1, F.lane, nullptr, 1.f);
        __syncthreads();
        mfft_block<2, false, 0>(S1R, S1I, S0R, S0I, Mf, tw, t256, cb0, F.lane, nullptr, 1.f); mfft_block<2, false, 0>(S1R, S1I, S0R, S0I, Mf, tw, t256, cb0 + 1, F.lane, nullptr, 1.f);
        __syncthreads();
        mfft_block<3, false, 0>(S0R, S0I, S1R, S1I, Mf, tw, t256, cb0, F.lane, nullptr, 1.f); mfft_block<3, false, 0>(S0R, S0I, S1R, S1I, Mf, tw, t256, cb0 + 1, F.lane, nullptr, 1.f);
        __syncthreads();
        {
            const int k0 = 8 * r, m0 = mf_nat(k0);
            const u32x4 zr = *(const LAS u32x4*)(S1R + m0), zi = *(const LAS u32x4*)(S1I + m0);
            float Zr[8], Zi[8], Mr[8], Mi[8];
            Zr[0] = bflo(zr.x); Zr[1] = bfhi(zr.x); Zr[2] = bflo(zr.y); Zr[3] = bfhi(zr.y); Zr[4] = bflo(zr.z); Zr[5] = bfhi(zr.z); Zr[6] = bflo(zr.w); Zr[7] = bfhi(zr.w);
            Zi[0] = bflo(zi.x); Zi[1] = bfhi(zi.x); Zi[2] = bflo(zi.y); Zi[3] = bfhi(zi.y); Zi[4] = bflo(zi.z); Zi[5] = bfhi(zi.z); Zi[6] = bflo(zi.w); Zi[7] = bfhi(zi.w);
#pragma unroll
            for (int i = 0; i < 8; ++i) { const int km = mf_nat((4096 - k0 - i) & 4095); Mr[i] = bf1(S1R[km]); Mi[i] = bf1(S1I[km]); }
            float Ac[8], Bc[8], Ad[8], Bd[8];
#pragma unroll
            for (int i = 0; i < 8; ++i) { Ac[i] = 0.5f * (Zr[i] + Mr[i]); Bc[i] = 0.5f * (Mi[i] - Zi[i]); Ad[i] = 0.5f * (Zi[i] + Mi[i]); Bd[i] = 0.5f * (Zr[i] - Mr[i]); }
            if (k0 == 0) { const int kn = mf_nat(2048); Bc[0] = bf1(S1R[kn]); Bd[0] = bf1(S1I[kn]); }
            bf16* s0 = SP + ((size_t)(c * 8 + b) * 2) * 2048 + k0; bf16* s1 = SP + ((size_t)((c + 1) * 8 + b) * 2) * 2048 + k0;
            u32x4 o; o.x = pk2(Ac[0], Ac[1]); o.y = pk2(Ac[2], Ac[3]); o.z = pk2(Ac[4], Ac[5]); o.w = pk2(Ac[6], Ac[7]); st16_wt(s0, o);
            o.x = pk2(Bc[0], Bc[1]); o.y = pk2(Bc[2], Bc[3]); o.z = pk2(Bc[4], Bc[5]); o.w = pk2(Bc[6], Bc[7]); st16_wt(s0 + 2048, o);
            o.x = pk2(Ad[0], Ad[1]); o.y = pk2(Ad[2], Ad[3]); o.z = pk2(Ad[4], Ad[5]); o.w = pk2(Ad[6], Ad[7]); st16_wt(s1, o);
            o.x = pk2(Bd[0], Bd[1]); o.y = pk2(Bd[2], Bd[3]); o.z = pk2(Bd[4], Bd[5]); o.w = pk2(Bd[6], Bd[7]); st16_wt(s1 + 2048, o);
        }
        __syncthreads();
    }
    __syncthreads();
}
__device__ __forceinline__ void hyena_items_mfma(Frame& F) {
    const int f = F.tid >> 8;
    LAS bf16* A0R = (LAS bf16*)F.lds; LAS bf16* A0I = A0R + MF_PLANE; LAS bf16* B0R = (LAS bf16*)(F.lds + 49152); LAS bf16* B0I = B0R + MF_PLANE;
    LAS bf16* S0R = (LAS bf16*)(F.lds + f * 49152); LAS bf16* S0I = S0R + MF_PLANE; LAS bf16* S1R = S0R + 2 * MF_PLANE; LAS bf16* S1I = S0R + 3 * MF_PLANE;
    const LAS cf* tw = (const LAS cf*)(F.lds + M_TW); const LAS cf* t256 = (const LAS cf*)(F.lds + M_TW256);
    const cf w81 = mkc(0.99999970586288221916f, -0.00076699031874270453f);
    DftFrag Mf; make_dft_frag(Mf, F.lane, false, tw);
    const bf16* PT = WSP(bf16, WS_PT); const float* cw = F.conv_w; const float* cb = F.conv_b;
    const int l0 = 8 * F.tid, n0 = mf_nat(l0), cb0 = 2 * (F.wave & 3), ln = F.lane & 31, lh = F.lane >> 5;
    HyRaw nx; int it = F.bid;
    if (it < 2048) hy_load(F, it, nx);
    for (; it < 2048; it += F.G) {
        const int c = it >> 2, bp = it & 3;
        float z0[8], z1[8];
        {
            const float a0 = cw[512 + c], a1 = cw[1536 + 512 + c], a2 = cw[3072 + 512 + c], ab = cb[512 + c];
            const float v0 = cw[1024 + c], v1 = cw[1536 + 1024 + c], v2 = cw[3072 + 1024 + c], vb = cb[1024 + c];
            float t1[8], t2[8];
            conv8(nx.a0, a0, a1, a2, ab, t1); conv8(nx.v0, v0, v1, v2, vb, t2);
#pragma unroll
            for (int i = 0; i < 8; ++i) z0[i] = t1[i] * t2[i];
            conv8(nx.a1, a0, a1, a2, ab, t1); conv8(nx.v1, v0, v1, v2, vb, t2);
#pragma unroll
            for (int i = 0; i < 8; ++i) z1[i] = t1[i] * t2[i];
        }
        {
            float br[8], bi[8];
#pragma unroll
            for (int i = 0; i < 8; ++i) { cf w = tw[(l0 >> 1) + (i >> 1)]; if (i & 1) w = cmul(w, w81); br[i] = z0[i] * w.x - z1[i] * w.y; bi[i] = z0[i] * w.y + z1[i] * w.x; }
            u32x4 v; v.x = pk2h(z0[0], z0[1]); v.y = pk2h(z0[2], z0[3]); v.z = pk2h(z0[4], z0[5]); v.w = pk2h(z0[6], z0[7]); *(LAS u32x4*)(A0R + n0) = v;
            v.x = pk2h(z1[0], z1[1]); v.y = pk2h(z1[2], z1[3]); v.z = pk2h(z1[4], z1[5]); v.w = pk2h(z1[6], z1[7]); *(LAS u32x4*)(A0I + n0) = v;
            v.x = pk2h(br[0], br[1]); v.y = pk2h(br[2], br[3]); v.z = pk2h(br[4], br[5]); v.w = pk2h(br[6], br[7]); *(LAS u32x4*)(B0R + n0) = v;
            v.x = pk2h(bi[0], bi[1]); v.y = pk2h(bi[2], bi[3]); v.z = pk2h(bi[4], bi[5]); v.w = pk2h(bi[6], bi[7]); *(LAS u32x4*)(B0I + n0) = v;
        }
        __syncthreads();
        mfft_block<1, false, 0>(S0R, S0I, S1R, S1I, Mf, tw, t256, cb0, F.lane, nullptr, 1.f); mfft_block<1, false, 0>(S0R, S0I, S1R, S1I, Mf, tw, t256, cb0 + 1, F.lane, nullptr, 1.f);
        cf kf[2][8];
        { const f32x4* KF = (const f32x4*)(WSP(f32x2, WS_KF) + (size_t)c * 8192 + (size_t)f * 4096);
#pragma unroll
          for (int j = 0; j < 2; ++j) { const int cc = 32 * (cb0 + j) + ln; const f32x4* kp = KF + (cc * 16 + 4 * lh) / 2;
              const f32x4 k0 = kp[0], k1 = kp[1], k2 = kp[4], k3 = kp[5];
              kf[j][0] = mkc(k0.x, k0.y); kf[j][1] = mkc(k0.z, k0.w); kf[j][2] = mkc(k1.x, k1.y); kf[j][3] = mkc(k1.z, k1.w);
              kf[j][4] = mkc(k2.x, k2.y); kf[j][5] = mkc(k2.z, k2.w); kf[j][6] = mkc(k3.x, k3.y); kf[j][7] = mkc(k3.z, k3.w); } }
        __syncthreads();
        mfft_block<2, false, 0>(S1R, S1I, S0R, S0I, Mf, tw, t256, cb0, F.lane, nullptr, 1.f); mfft_block<2, false, 0>(S1R, S1I, S0R, S0I, Mf, tw, t256, cb0 + 1, F.lane, nullptr, 1.f);
        __syncthreads();
        mfft_block<3, false, 1>(S0R, S0I, S1R, S1I, Mf, tw, t256, cb0, F.lane, kf[0], 1.f); mfft_block<3, false, 1>(S0R, S0I, S1R, S1I, Mf, tw, t256, cb0 + 1, F.lane, kf[1], 1.f);
        __syncthreads();
        mfft_block<1, false, 0>(S1R, S1I, S0R, S0I, Mf, tw, t256, cb0, F.lane, nullptr, 1.f); mfft_block<1, false, 0>(S1R, S1I, S0R, S0I, Mf, tw, t256, cb0 + 1, F.lane, nullptr, 1.f);
        __syncthreads();
        mfft_block<2, false, 0>(S0R, S0I, S1R, S1I, Mf, tw, t256, cb0, F.lane, nullptr, 1.f); mfft_block<2, false, 0>(S0R, S0I, S1R, S1I, Mf, tw, t256, cb0 + 1, F.lane, nullptr, 1.f);
        Row8 xa, xb;
        { const int tb = 2 * bp * SEQ; xa = row8_load(PT, c, tb, l0); xb = row8_load(PT, c, tb + SEQ, l0); }
        if (it + F.G < 2048) hy_load(F, it + F.G, nx);
        __syncthreads();
        mfft_block<3, false, 0>(S1R, S1I, S0R, S0I, Mf, tw, t256, cb0, F.lane, nullptr, 1.f); mfft_block<3, false, 0>(S1R, S1I, S0R, S0I, Mf, tw, t256, cb0 + 1, F.lane, nullptr, 1.f);
        __syncthreads();
        {
            const float w0 = cw[c], w1 = cw[1536 + c], w2 = cw[3072 + c], wb = cb[c]; const float bias = F.f_bias[c];
            bf16* YT = WSP(bf16, WS_YT) + (size_t)c * T_TOK + (size_t)(2 * bp) * SEQ;
            float x0a[8], x0b[8], ya[8], yb[8], er[8], ei[8], orr[8], oi[8];
            conv8(xa, w0, w1, w2, wb, x0a); conv8(xb, w0, w1, w2, wb, x0b);
            { const u32x4 a = *(const LAS u32x4*)(A0R + n0), b = *(const LAS u32x4*)(A0I + n0), d = *(const LAS u32x4*)(B0R + n0), g = *(const LAS u32x4*)(B0I + n0);
              er[0] = bflo(a.x); er[1] = bfhi(a.x); er[2] = bflo(a.y); er[3] = bfhi(a.y); er[4] = bflo(a.z); er[5] = bfhi(a.z); er[6] = bflo(a.w); er[7] = bfhi(a.w);
              ei[0] = bflo(b.x); ei[1] = bfhi(b.x); ei[2] = bflo(b.y); ei[3] = bfhi(b.y); ei[4] = bflo(b.z); ei[5] = bfhi(b.z); ei[6] = bflo(b.w); ei[7] = bfhi(b.w);
              orr[0] = bflo(d.x); orr[1] = bfhi(d.x); orr[2] = bflo(d.y); orr[3] = bfhi(d.y); orr[4] = bflo(d.z); orr[5] = bfhi(d.z); orr[6] = bflo(d.w); orr[7] = bfhi(d.w);
              oi[0] = bflo(g.x); oi[1] = bfhi(g.x); oi[2] = bflo(g.y); oi[3] = bfhi(g.y); oi[4] = bflo(g.z); oi[5] = bfhi(g.z); oi[6] = bflo(g.w); oi[7] = bfhi(g.w); }
#pragma unroll
            for (int i = 0; i < 8; ++i) { cf w = tw[(l0 >> 1) + (i >> 1)]; if (i & 1) w = cmul(w, w81);
                const float eim = -ei[i], oim = -oi[i];
                const float yr = er[i] + (orr[i] * w.x + oim * w.y), yi = eim + (oim * w.x - orr[i] * w.y);
                ya[i] = x0a[i] * (yr + bias * z0[i]); yb[i] = x0b[i] * (yi + bias * z1[i]); }
            u32x4 oa, ob; oa.x = pk2h(ya[0], ya[1]); oa.y = pk2h(ya[2], ya[3]); oa.z = pk2h(ya[4], ya[5]); oa.w = pk2h(ya[6], ya[7]);
            ob.x = pk2h(yb[0], yb[1]); ob.y = pk2h(yb[2], yb[3]); ob.z = pk2h(yb[4], yb[5]); ob.w = pk2h(yb[6], yb[7]);
            st16_wt(YT + l0, oa); st16_wt(YT + SEQ + l0, ob);
        }
        __syncthreads();
    }
}

__device__ __forceinline__ void phase_headnorm(Frame& F) {
    LAS float* tl = (LAS float*)F.lds;
    LAS float* rs = tl + 64 * 257;
    const bf16* YT = WSP(bf16, WS_YT); bf16* YN = WSP(bf16, WS_YN);
    u32x4 nxv[4];
    if (F.bid < 8 * 128) { const int h = F.bid & 7, tok0 = (F.bid >> 3) * 256;
#pragma unroll
        for (int i = 0; i < 4; ++i) { const int idx = F.tid + 512 * i, row = idx >> 5, ch = idx & 31; nxv[i] = *(const u32x4*)(YT + (size_t)(64 * h + row) * T_TOK + tok0 + 8 * ch); } }
    for (int it = F.bid; it < 8 * 128; it += F.G) {
        const int h = it & 7, tt = it >> 3, tok0 = tt * 256;
#pragma unroll
        for (int i = 0; i < 4; ++i) { const int idx = F.tid + 512 * i, row = idx >> 5, ch = idx & 31;
            const u32x4 v = nxv[i]; LAS float* d = tl + row * 257 + 8 * ch;
            d[0] = bflo(v.x); d[1] = bfhi(v.x); d[2] = bflo(v.y); d[3] = bfhi(v.y); d[4] = bflo(v.z); d[5] = bfhi(v.z); d[6] = bflo(v.w); d[7] = bfhi(v.w); }
        if (it + F.G < 8 * 128) { const int it2 = it + F.G, h2 = it2 & 7, tk2 = (it2 >> 3) * 256;
#pragma unroll
            for (int i = 0; i < 4; ++i) { const int idx = F.tid + 512 * i, row = idx >> 5, ch = idx & 31; nxv[i] = *(const u32x4*)(YT + (size_t)(64 * h2 + row) * T_TOK + tk2 + 8 * ch); } }
        __syncthreads();
        if (F.tid < 256) { float s = 0.f;
#pragma unroll 8
            for (int c = 0; c < 64; ++c) { const float v = tl[c * 257 + F.tid]; s += v * v; }
            rs[F.tid] = 1.0f / sqrtf(s * (1.0f / 64.0f) + EPS); }
        __syncthreads();
#pragma unroll
        for (int i = 0; i < 4; ++i) { const int idx = F.tid + 512 * i, tok = idx >> 3, q = idx & 7; const float r = rs[tok]; const float* g = F.mix_g + 64 * h + 8 * q;
            float v[8];
#pragma unroll
            for (int j = 0; j < 8; ++j) v[j] = tl[(8 * q + j) * 257 + tok] * r * g[j];
            u32x4 o; o.x = pk2(v[0], v[1]); o.y = pk2(v[2], v[3]); o.z = pk2(v[4], v[5]); o.w = pk2(v[6], v[7]);
            st16_wt(YN + (size_t)(tok0 + tok) * 1024 + 64 * h + 8 * q, o); }
        __syncthreads();
    }
}

constexpr int MX_NS = 288, MX_XA = 0, MX_XB = 64 * MX_NS * 2, MX_MT = 2 * MX_XB, MX_MTLO = MX_MT + 32768, MX_NYQ = MX_MTLO + 32768, MX_SLOT = 144;
__device__ __forceinline__ void mix_load(Frame& F, int tile, u32x4 (&v)[8]) {
    const int b = tile >> 6, g = (tile >> 3) & 7, kt = tile & 7; const bf16* SP = WSP(bf16, WS_SP);
#pragma unroll
    for (int u = 0; u < 8; ++u) { const int idx = F.tid + NTHREADS * u, row = idx >> 5, ch = idx & 31, ab = row >> 6, c = row & 63;
        v[u] = *(const u32x4*)(SP + ((size_t)((64 * g + c) * 8 + b) * 2 + ab) * 2048 + 256 * kt + 8 * ch); }
}
__device__ __forceinline__ void fourier_mix(Frame& F) {
    LAS bf16* XA = (LAS bf16*)(F.lds + MX_XA); LAS bf16* XB = (LAS bf16*)(F.lds + MX_XB);
    LAS u32x4* MT = (LAS u32x4*)(F.lds + MX_MT); LAS u32x4* MTL = (LAS u32x4*)(F.lds + MX_MTLO); LAS float* nyq = (LAS float*)(F.lds + MX_NYQ);
    LAS unsigned char* STG = F.lds;
    const bf16* SP = WSP(bf16, WS_SP); bf16* YN = WSP(bf16, WS_YN);
    LAS float* cst = nyq + 64;
    __syncthreads();
    if (F.tid < 64) { cst[F.tid] = cospif((float)F.tid * (1.0f / 32.0f)); cst[64 + F.tid] = sinpif((float)F.tid * (1.0f / 32.0f)); }
    __syncthreads();
    for (int idx = F.tid; idx < 32 * 64; idx += NTHREADS) { const int lane = idx & 63, fs = idx >> 6, rb = fs >> 3, s = fs & 7, i = lane & 31, h = lane >> 5;
        unsigned hw[4], lw[4];
#pragma unroll
        for (int jj = 0; jj < 4; ++jj) { unsigned hh[2], ll[2];
#pragma unroll
            for (int u = 0; u < 2; ++u) { const int j = 2 * jj + u, kap = 16 * s + 8 * h + j, c = kap & 63, isB = kap >> 6, cpp = 32 * rb + i, cp = cpp & 63, mir = cpp >> 6;
                const int m = (c * cp) & 63; const float cv = cst[m], sv = cst[64 + m];
                const float val = (isB ? (mir ? sv : -sv) : cv) * (1.0f / 512.0f);
                hh[u] = f2bf(val); ll[u] = f2bf(val - __builtin_bit_cast(float, hh[u] << 16)); }
            hw[jj] = hh[0] | (hh[1] << 16); lw[jj] = ll[0] | (ll[1] << 16); }
        MT[idx] = (u32x4){hw[0], hw[1], hw[2], hw[3]}; MTL[idx] = (u32x4){lw[0], lw[1], lw[2], lw[3]}; }
    u32x4 nxv[8];
    if (F.bid < 512) mix_load(F, F.bid, nxv);
    for (int tile = F.bid; tile < 512; tile += F.G) {
        const int b = tile >> 6, g = (tile >> 3) & 7, kt = tile & 7;
        __syncthreads();
#pragma unroll
        for (int u = 0; u < 8; ++u) { const int idx = F.tid + NTHREADS * u, row = idx >> 5, ch = idx & 31, ab = row >> 6, c = row & 63;
            u32x4 v = nxv[u];
            if (kt == 0 && ab == 1 && ch == 0) { nyq[c] = bflo(v.x); v.x &= 0xffff0000u; }
            *(LAS u32x4*)((ab ? XB : XA) + c * MX_NS + 8 * ch) = v; }
        if (tile + F.G < 512) mix_load(F, tile + F.G, nxv);
        __syncthreads();
        f32x16 acc[4];
#pragma unroll
        for (int rb = 0; rb < 4; ++rb) acc[rb] = (f32x16){0.f, 0.f, 0.f, 0.f, 0.f, 0.f, 0.f, 0.f, 0.f, 0.f, 0.f, 0.f, 0.f, 0.f, 0.f, 0.f};
        { int lane = F.lane; asm volatile("" : "+v"(lane));
          const int gq = lane >> 4, q = (lane & 15) >> 2, p = lane & 3;
#pragma unroll
          for (int s = 0; s < 8; ++s) {
              const LAS bf16* pr = ((s < 4) ? XA : XB) + (16 * (s & 3) + 8 * (gq >> 1) + q) * MX_NS + 32 * F.wave + 16 * (gq & 1) + 4 * p;
              const s16x4v r0 = lds_tr16(pr), r1 = lds_tr16(pr + 4 * MX_NS);
              asm volatile("" :: "v"(pr) : "memory");
              const bf16x8v bfr = (bf16x8v){r0[0], r0[1], r0[2], r0[3], r1[0], r1[1], r1[2], r1[3]};
#pragma unroll
              for (int rb = 0; rb < 4; ++rb) { const bf16x8v mh = __builtin_bit_cast(bf16x8v, MT[(rb * 8 + s) * 64 + lane]), ml = __builtin_bit_cast(bf16x8v, MTL[(rb * 8 + s) * 64 + lane]);
                  acc[rb] = __builtin_amdgcn_mfma_f32_32x32x16_bf16(mh, bfr, acc[rb], 0, 0, 0); acc[rb] = __builtin_amdgcn_mfma_f32_32x32x16_bf16(ml, bfr, acc[rb], 0, 0, 0); } } }
        float sk = 0.f, sm = 0.f;
#pragma unroll
        for (int r = 0; r < 16; ++r) { sk += acc[0][r] * acc[0][r] + acc[1][r] * acc[1][r]; sm += acc[2][r] * acc[2][r] + acc[3][r] * acc[3][r]; }
        sk += __shfl_xor(sk, 32); sm += __shfl_xor(sm, 32);
        const float rk = 1.0f / sqrtf(sk * (1.0f / 64.0f) + EPS), rm = 1.0f / sqrtf(sm * (1.0f / 64.0f) + EPS);
        __syncthreads();
        { const int n = F.lane & 31, hi = F.lane >> 5; const float* mg = F.mix_g + 512 + 64 * g;
#pragma unroll
          for (int rb = 0; rb < 4; ++rb) { const int slot = 32 * F.wave + n + ((rb >> 1) ? 256 : 0); const float rr = (rb >> 1) ? rm : rk;
#pragma unroll
              for (int rg = 0; rg < 4; ++rg) { const int cp = 32 * (rb & 1) + 8 * rg + 4 * hi; const f32x4 gg = *(const f32x4*)(mg + cp);
                  u32x2 w; w.x = pk2(acc[rb][4 * rg] * rr * gg.x, acc[rb][4 * rg + 1] * rr * gg.y); w.y = pk2(acc[rb][4 * rg + 2] * rr * gg.z, acc[rb][4 * rg + 3] * rr * gg.w);
                  *(LAS u32x2*)(STG + slot * MX_SLOT + 2 * cp) = w; } } }
        __syncthreads();
#pragma unroll
        for (int u = 0; u < 8; ++u) { const int idx = F.tid + NTHREADS * u, slot = idx >> 3, ch = idx & 7; const int kk = 256 * kt + (slot & 255);
            const int tok = b * SEQ + ((slot < 256) ? kk : (4096 - kk));
            if (!(slot >= 256 && kk == 0)) st16_wt(YN + (size_t)tok * 1024 + 512 + 64 * g + 8 * ch, *(const LAS u32x4*)(STG + slot * MX_SLOT + 16 * ch)); }
        if (kt == 0 && F.wave == 0) {
            const int cp = F.lane; float y = 0.f;
            for (int c = 0; c < 64; ++c) y += nyq[c] * cst[(c * cp) & 63];
            y *= (1.0f / 512.0f);
            const float r2 = 1.0f / sqrtf(wave_sum(y * y) * (1.0f / 64.0f) + EPS);
            YN[(size_t)(b * SEQ + 2048) * 1024 + 512 + 64 * g + cp] = (bf16)f2bf(y * r2 * F.mix_g[512 + 64 * g + cp]);
        }
    }
    __syncthreads();
}

__device__ __forceinline__ float wave_reduce8(const float (&a)[8], int lane) {
    const bool h5 = (lane & 32) != 0, h4 = (lane & 16) != 0, h3 = (lane & 8) != 0;
    float b[4], c[2], d;
#pragma unroll
    for (int i = 0; i < 4; ++i) { const float snd = h5 ? a[i] : a[4 + i], keep = h5 ? a[4 + i] : a[i]; b[i] = keep + __shfl_xor(snd, 32); }
#pragma unroll
    for (int i = 0; i < 2; ++i) { const float snd = h4 ? b[i] : b[2 + i], keep = h4 ? b[2 + i] : b[i]; c[i] = keep + __shfl_xor(snd, 16); }
    { const float snd = h3 ? c[0] : c[1], keep = h3 ? c[1] : c[0]; d = keep + __shfl_xor(snd, 8); }
    d += __shfl_xor(d, 4); d += __shfl_xor(d, 2); d += __shfl_xor(d, 1);
    return d;
}
__device__ __forceinline__ float rdlane(float v, int l) { return __builtin_bit_cast(float, __builtin_amdgcn_readlane(__builtin_bit_cast(int, v), l)); }
__device__ __forceinline__ void phase_route(Frame& F, const bf16* X1) {
    LAS f32x4* wrl = (LAS f32x4*)F.lds;
    LAS f32x4* wgl = (LAS f32x4*)(F.lds + 131072);
    LAS int* lcnt = (LAS int*)(F.lds + 147456);
    LAS int* lbase = lcnt + 32;
    LAS int* pe = lcnt + 64;
    LAS float* pw = (LAS float*)(pe + 256);
    LAS float* prr = pw + 256;
    LAS int* prow = (LAS int*)(prr + 256);
    LAS float* lbr = (LAS float*)(prow + 256);
    int* TOT = WSP(int, WS_TOT); int* LIST = WSP(int, WS_LIST); float* ROWW = WSP(float, WS_ROWW); float* ROWR = WSP(float, WS_ROWR);
    __syncthreads();
    { const f32x4* w4 = (const f32x4*)F.w_router;
      f32x4 wv0[8], wv1[8];
#pragma unroll
      for (int u = 0; u < 8; ++u) { const int i = F.tid + NTHREADS * u; wv0[u] = w4[2 * i]; wv1[u] = w4[2 * i + 1]; }
#pragma unroll
      for (int u = 0; u < 8; ++u) { const int i = F.tid + NTHREADS * u; const int g = i >> 10, k = i & 1023; const int slot = (4 * (k >> 8) + (k & 3)) * 64 + ((k >> 2) & 63);
          wrl[(g * 2 + 0) * 1024 + slot] = wv0[u]; wrl[(g * 2 + 1) * 1024 + slot] = wv1[u]; }
      const f32x4* wg = (const f32x4*)F.w_group;
      for (int k = F.tid; k < 1024; k += NTHREADS) wgl[(4 * (k >> 8) + (k & 3)) * 64 + ((k >> 2) & 63)] = wg[k];
      if (F.tid < 32) lbr[F.tid] = F.b_router[F.tid]; }
    f32x4 g4[4];
    { const GAS f32x4* gr = (const GAS f32x4*)F.norm2_g + F.lane;
#pragma unroll
      for (int j = 0; j < 4; ++j) g4[j] = gr[64 * j]; }
    const float bg0 = F.b_group[0], bg1 = F.b_group[1], bg2 = F.b_group[2], bg3 = F.b_group[3];
    for (int blk = F.bid; blk < 256; blk += F.G) {
        __syncthreads();
        if (F.tid < 32) lcnt[F.tid] = 0;
        __syncthreads();
        const int t0 = blk * 128 + F.wave * 16;
        u32x2 vn[2][4];
#pragma unroll
        for (int u = 0; u < 2; ++u) { const GAS u32x2* xr = (const GAS u32x2*)(X1 + (size_t)(t0 + u) * 1024) + F.lane;
#pragma unroll
          for (int j = 0; j < 4; ++j) vn[u][j] = xr[64 * j]; }
#pragma unroll 1
        for (int i0 = 0; i0 < 16; i0 += 2) {
#pragma unroll
          for (int u = 0; u < 2; ++u) {
            const int i = i0 + u; const int t = t0 + i;
            f32x4 v[4];
#pragma unroll
            for (int j = 0; j < 4; ++j) { v[j].x = bflo(vn[u][j].x); v[j].y = bfhi(vn[u][j].x); v[j].z = bflo(vn[u][j].y); v[j].w = bfhi(vn[u][j].y); }
            { GAS unsigned* xq = (GAS unsigned*)(WSP(unsigned char, WS_X1Q) + (size_t)t * 1024) + F.lane;
#pragma unroll
              for (int j = 0; j < 4; ++j) xq[64 * j] = pk4_fp8s(v[j].x, v[j].y, v[j].z, v[j].w, 1.0f); }
            if (i + 2 < 16) { const GAS u32x2* xr = (const GAS u32x2*)(X1 + (size_t)(t + 2) * 1024) + F.lane;
#pragma unroll
                for (int j = 0; j < 4; ++j) vn[u][j] = xr[64 * j]; }
            float a[8];
#pragma unroll
            for (int e = 0; e < 8; ++e) a[e] = 0.f;
#pragma unroll
            for (int j = 0; j < 4; ++j) { a[0] += (v[j].x * v[j].x + v[j].y * v[j].y) + (v[j].z * v[j].z + v[j].w * v[j].w); v[j] = v[j] * g4[j];
#pragma unroll
                for (int q = 0; q < 4; ++q) { const float hv = v[j][q]; const f32x4 w = wgl[(4 * j + q) * 64 + F.lane]; a[1] += hv * w.x; a[2] += hv * w.y; a[3] += hv * w.z; a[4] += hv * w.w; } }
            const float d = wave_reduce8(a, F.lane);
            const float rinv = 1.0f / sqrtf(rdlane(d, 0) * (1.f / 1024.f) + EPS);
            const float gl0 = rdlane(d, 8) * rinv + bg0, gl1 = rdlane(d, 16) * rinv + bg1, gl2 = rdlane(d, 24) * rinv + bg2, gl3 = rdlane(d, 32) * rinv + bg3;
            int gs = 0; float gm = gl0; if (gl1 > gm) { gm = gl1; gs = 1; } if (gl2 > gm) { gm = gl2; gs = 2; } if (gl3 > gm) { gm = gl3; gs = 3; }
            const float pg = 1.0f / (expf(gl0 - gm) + expf(gl1 - gm) + expf(gl2 - gm) + expf(gl3 - gm));
            float el[8];
#pragma unroll
            for (int e = 0; e < 8; ++e) el[e] = 0.f;
            const LAS f32x4* wb = wrl + gs * 2048 + F.lane;
#pragma unroll
            for (int j = 0; j < 4; ++j) {
#pragma unroll
                for (int q = 0; q < 4; ++q) { const f32x4 wa = wb[(4 * j + q) * 64], wc = wb[1024 + (4 * j + q) * 64]; const float hv = v[j][q];
                    el[0] += hv * wa.x; el[1] += hv * wa.y; el[2] += hv * wa.z; el[3] += hv * wa.w; el[4] += hv * wc.x; el[5] += hv * wc.y; el[6] += hv * wc.z; el[7] += hv * wc.w; } }
            const float d2 = wave_reduce8(el, F.lane);
            float er[8];
#pragma unroll
            for (int e = 0; e < 8; ++e) er[e] = rdlane(d2, 8 * e) * rinv + lbr[gs * 8 + e];
            int i1 = 0; float m1 = er[0];
#pragma unroll
            for (int e = 1; e < 8; ++e) if (er[e] > m1) { m1 = er[e]; i1 = e; }
            int i2 = -1; float m2 = -3.0e38f;
#pragma unroll
            for (int e = 0; e < 8; ++e) if (e != i1 && er[e] > m2) { m2 = er[e]; i2 = e; }
            const float e2 = expf(m2 - m1); const float wa1 = pg / (1.0f + e2), wa2 = pg * e2 / (1.0f + e2);
            if (F.lane == 0) { const int lp = 2 * (F.wave * 16 + i); pe[lp] = gs * 8 + i1; pe[lp + 1] = gs * 8 + i2; pw[lp] = wa1; pw[lp + 1] = wa2; prr[lp] = rinv; prr[lp + 1] = rinv;
                atomicAdd((int*)&lcnt[gs * 8 + i1], 1); atomicAdd((int*)&lcnt[gs * 8 + i2], 1); }
          }
        }
        __syncthreads();
        if (F.tid < 32) lbase[F.tid] = atomicAdd(&TOT[F.tid], lcnt[F.tid]);
        __syncthreads();
        if (F.tid < 32) { int n = lbase[F.tid]; for (int p = 0; p < 256; ++p) if (pe[p] == F.tid) prow[p] = n++; }
        __syncthreads();
        if (F.tid < 256) { const int row = pe[F.tid] * ECAP + prow[F.tid]; LIST[row] = blk * 256 + F.tid; ROWW[row] = pw[F.tid]; ROWR[row] = prr[F.tid]; }
    }
    __syncthreads();
}

__device__ __forceinline__ int build_tiles(Frame& F) {
    LAS int* tl = (LAS int*)(F.lds + L_TILES); LAS int* tnv = tl + MAX_TILES; LAS int* misc = tnv + MAX_TILES;
    const int* TOT = WSP(int, WS_TOT);
    __syncthreads();
    if (F.tid < 32) misc[33 + F.tid] = TOT[F.tid];
    __syncthreads();
    if (F.tid == 0) { int s = 0; for (int e = 0; e < 32; ++e) { misc[e] = s; s += (misc[33 + e] + 255) >> 8; } misc[32] = s; }
    __syncthreads();
    if (F.tid < 32) { const int e = F.tid, tot = misc[33 + e]; for (int j = 0, t = misc[e]; t < misc[e + 1]; ++j, ++t) { tl[t] = e * ECAP + 256 * j; tnv[t] = (tot - 256 * j) < 256 ? (tot - 256 * j) : 256; } }
    __syncthreads();
    return misc[32];
}

__device__ __forceinline__ void phase_final(Frame& F, const bf16* X1, float* OUT) {
    typedef float f2v __attribute__((ext_vector_type(2)));
    const int gw = F.vcu * NWAVES + F.wave, NGW = F.G * NWAVES; const unsigned char* YP = WSP(unsigned char, WS_YP);
    f32x4 gg[4];
#pragma unroll
    for (int j = 0; j < 4; ++j) gg[j] = ((const GAS f32x4*)F.final_g)[64 * j + F.lane];
    for (int t0 = 4 * gw; t0 < T_TOK; t0 += 4 * NGW) {
        u32x2 xw[4][4]; unsigned ya[4][4], yb[4][4];
#pragma unroll
        for (int r = 0; r < 4; ++r) { const int t = t0 + r;
            const GAS u32x2* xr = (const GAS u32x2*)(X1 + (size_t)t * 1024) + F.lane;
            const GAS unsigned* y0 = (const GAS unsigned*)(YP + (size_t)(2 * t) * 1024) + F.lane; const GAS unsigned* y1 = (const GAS unsigned*)(YP + (size_t)(2 * t + 1) * 1024) + F.lane;
#pragma unroll
            for (int j = 0; j < 4; ++j) { xw[r][j] = xr[64 * j]; ya[r][j] = y0[64 * j]; yb[r][j] = y1[64 * j]; } }
#pragma unroll
        for (int r = 0; r < 4; ++r) { const int t = t0 + r; GAS f32x4* orow = (GAS f32x4*)(OUT + (size_t)t * 1024) + F.lane;
            f32x4 v[4]; float s = 0.f;
#pragma unroll
            for (int j = 0; j < 4; ++j) { const u32x2 x = xw[r][j];
                const f2v a0 = __builtin_amdgcn_cvt_pk_f32_fp8((int)ya[r][j], false), a1 = __builtin_amdgcn_cvt_pk_f32_fp8((int)ya[r][j], true);
                const f2v b0 = __builtin_amdgcn_cvt_pk_f32_fp8((int)yb[r][j], false), b1 = __builtin_amdgcn_cvt_pk_f32_fp8((int)yb[r][j], true);
                const float is = 1.0f / pg8::YP_SCALE;
                v[j].x = bflo(x.x) + (a0[0] + b0[0]) * is; v[j].y = bfhi(x.x) + (a0[1] + b0[1]) * is; v[j].z = bflo(x.y) + (a1[0] + b1[0]) * is; v[j].w = bfhi(x.y) + (a1[1] + b1[1]) * is;
                s += (v[j].x * v[j].x + v[j].y * v[j].y) + (v[j].z * v[j].z + v[j].w * v[j].w); }
            const float rinv = 1.0f / sqrtf(wave_sum(s) * (1.f / 1024.f) + EPS);
#pragma unroll
            for (int j = 0; j < 4; ++j) { f32x4 o; o.x = v[j].x * rinv * gg[j].x; o.y = v[j].y * rinv * gg[j].y; o.z = v[j].z * rinv * gg[j].z; o.w = v[j].w * rinv * gg[j].w; orow[64 * j] = o; } }
    }
}

constexpr int N_PHASES = 10;
#ifndef MK_STAGGER1
#define MK_STAGGER1 1
#endif
struct Args { const float* in[23]; float* out; unsigned char* ws; int ph_lo, ph_hi; };
static_assert(sizeof(Args) == 23 * 8 + 8 + 8 + 8, "Args has no padding");

__global__ void __launch_bounds__(NTHREADS, 2) mk_fwd(Args args) {
    extern __shared__ __attribute__((aligned(16))) unsigned char lds_raw[];
    Frame F;
    F.lds = (LAS unsigned char*)lds_raw; F.ws = args.ws;
    F.tid = threadIdx.x; F.lane = F.tid & 63; F.wave = __builtin_amdgcn_readfirstlane(F.tid >> 6);
    F.G = gridDim.x; F.bid = blockIdx.x; F.vcu = (F.G % 8 == 0) ? (F.bid % 8) * (F.G / 8) + F.bid / 8 : F.bid;
    F.x = args.in[0]; F.norm1_g = args.in[1]; F.w_in = args.in[2]; F.conv_w = args.in[3]; F.conv_b = args.in[4]; F.f_w_in = args.in[5]; F.f_b_in = args.in[6];
    F.f_w_mid = args.in[7]; F.f_b_mid = args.in[8]; F.f_freq = args.in[9]; F.f_w_out = args.in[10]; F.f_bias = args.in[11]; F.mix_g = args.in[12]; F.w_out = args.in[13];
    F.norm2_g = args.in[14]; F.w_group = args.in[15]; F.b_group = args.in[16]; F.w_router = args.in[17]; F.b_router = args.in[18]; F.w_gate = args.in[19]; F.w_up = args.in[20];
    F.w_down = args.in[21]; F.final_g = args.in[22]; F.out = args.out;
    volatile LAS unsigned* bst = (volatile LAS unsigned*)(F.lds + BARST_OFF);
    if (F.tid < 16) bst[F.tid] = 0u;
    __syncthreads();
    const int lo = args.ph_lo, hi = args.ph_hi;
    const bool need_bar = (hi - lo) > 1;
    XcdBarrier bar; bar.bar = (unsigned*)(F.ws + WS_CTL); bar.x = 0; bar.st = bst;
    if (need_bar) bar = xcd_barrier_post((unsigned*)(F.ws + WS_CTL), bst);
#define IN(k) (lo <= (k) && (k) < hi)
#ifndef MK_DUP
#define MK_DUP -1
#endif
#define REPS(k) (((k) == MK_DUP) ? 2 : 1)
#define SEAM(k) do { if (IN(k) && IN((k) + 1)) xcd_barrier(bar); } while (0)
    bf16* X1 = WSP(bf16, WS_X1);

    if (IN(0)) for (int rep_ = 0; rep_ < REPS(0); ++rep_) { if (rep_) xcd_barrier(bar); phase_prologue(F); } SEAM(0);

    if (IN(1)) {
        pg8::StaticOrder S; S.init(F.ws + WS_WIN_T, F.ws + WS_HN, NPT_ROWS, T_TOK, 1024, F.G, F.bid); S.reps = (MK_DUP == 11) ? 2 : REPS(1);
        pg8::EpiStorePT E{WSP(bf16, WS_PT), NPT_ROWS};
        int fc = F.bid; const bool pre = MK_STAGGER1 && ((F.bid >> 3) & 1);
        if (pre && fc < 512) { load_tw_lds(F, L_TW, L_TW256); filter_item(F, fc); fc += F.G; __syncthreads(); }
        pg8::gemm_phase<pg8::EpiStorePT, pg8::StaticOrder>(F.lds, 1024, S, E);
        load_tw_lds(F, L_TW, L_TW256);
        for (; fc < 512; fc += F.G) filter_item(F, fc);
    } SEAM(1);

    if (IN(2)) for (int rep_ = 0; rep_ < REPS(2); ++rep_) { if (rep_) xcd_barrier(bar);
        load_tw_lds(F, M_TW, M_TW256);
        hyena_items_mfma(F);
        fourier_items_mfma(F);
    } SEAM(2);

    if (IN(3)) for (int rep_ = 0; rep_ < REPS(3); ++rep_) { if (rep_) xcd_barrier(bar); phase_headnorm(F); if (MK_DUP == 13) phase_headnorm(F); for (int rr_ = 0; rr_ < ((MK_DUP == 14) ? 2 : 1); ++rr_) fourier_mix(F); } SEAM(3);

    if (IN(4)) for (int rep_ = 0; rep_ < REPS(4); ++rep_) { if (rep_) xcd_barrier(bar);
        pg8::StaticOrder S; S.init(F.ws + WS_YN, F.ws + WS_WOUT_T, T_TOK, 1024, 1024, F.G, F.bid);
        pg8::EpiResBf16 E{F.x, X1, 1024};
        pg8::gemm_phase<pg8::EpiResBf16, pg8::StaticOrder>(F.lds, 1024, S, E);
    } SEAM(4);

    if (IN(5)) { phase_route(F, X1); } if (IN(5) && IN(7)) xcd_barrier(bar);


    if (IN(7)) for (int rep_ = 0; rep_ < REPS(7); ++rep_) { if (rep_) xcd_barrier(bar);
        const int ntiles = __builtin_amdgcn_readfirstlane(build_tiles(F)); const LAS int* tl = (const LAS int*)(F.lds + L_TILES);
        pg8::MoeGatherOrder S; S.init(F.ws + WS_X1Q, F.ws + WS_WGU_T, tl, tl + MAX_TILES, WSP(int, WS_LIST), ntiles, 1024, F.G, F.bid, 1);
        pg8::EpiSwiGLU E{WSP(unsigned char, WS_YT), WSP(float, WS_ROWR)};
        pg8::gemm_phase<pg8::EpiSwiGLU, pg8::MoeGatherOrder, true, true>(F.lds, 1024, S, E);
        if (rep_ == 0) {
            const int nwg = ntiles * 4, R = (nwg + F.G - 1) / F.G, nheavy = nwg - (R - 1) * F.G; const bool all = (nheavy >= F.G) || (nheavy <= 0);
            const int nl = all ? F.G : F.G - nheavy, li = all ? F.bid : F.bid - nheavy;
            if (li >= 0) wdown_items(F, li * NWAVES + F.wave, nl * NWAVES);
        }
    } SEAM(7);

    if (IN(8)) for (int rep_ = 0; rep_ < REPS(8); ++rep_) { if (rep_) xcd_barrier(bar);
        const int ntiles = __builtin_amdgcn_readfirstlane(build_tiles(F)); const LAS int* tl = (const LAS int*)(F.lds + L_TILES);
        pg8::MoeOrder S; S.init(F.ws + WS_YT, F.ws + WS_WD_T, tl, tl + MAX_TILES, ntiles, 512, F.G, F.bid, 1);
        pg8::EpiMoeDown E{WSP(unsigned char, WS_YP), WSP(int, WS_LIST), WSP(float, WS_ROWW)};
        pg8::gemm_phase<pg8::EpiMoeDown, pg8::MoeOrder, true, true>(F.lds, 512, S, E);
    } SEAM(8);

    if (IN(9)) { if (REPS(9) == 2) { phase_final(F, X1, WSP(float, WS_YT)); xcd_barrier(bar); } phase_final(F, X1, F.out); }
#undef IN
#undef SEAM
}


extern "C" void kernel_launch(void* const* d_in, const int* in_sizes, int n_in, void* d_out, int out_size, void* d_ws, size_t ws_size, hipStream_t stream) {
    static int grid = 0;
    if (grid == 0) {
        if (n_in != 23 || in_sizes[0] != T_TOK * D_MODEL || out_size != T_TOK * D_MODEL || ws_size < WS_END) { fprintf(stderr, "kernel_launch: unexpected shapes (n_in %d, in0 %d, out %d, ws %zu)\n", n_in, n_in > 0 ? in_sizes[0] : -1, out_size, ws_size); grid = -1; return; }
        int dev = 0, cus = 0;
        if (hipGetDevice(&dev) != hipSuccess || hipDeviceGetAttribute(&cus, hipDeviceAttributeMultiprocessorCount, dev) != hipSuccess) { grid = -1; return; }
        if (hipFuncSetAttribute((const void*)mk_fwd, hipFuncAttributeMaxDynamicSharedMemorySize, LDS_BYTES) != hipSuccess) { fprintf(stderr, "kernel_launch: hipFuncSetAttribute failed\n"); grid = -1; return; }
        int per_cu = 0;
        if (hipOccupancyMaxActiveBlocksPerMultiprocessor(&per_cu, (const void*)mk_fwd, NTHREADS, LDS_BYTES) != hipSuccess || per_cu < 1) fprintf(stderr, "kernel_launch: occupancy query reports %d\n", per_cu);
        (void)hipGetLastError();
        grid = cus;
    }
    if (grid < 0) return;
    (void)hipMemsetAsync((char*)d_ws + WS_CTL, 0, CTL_ZERO_BYTES, stream);
    Args a{};
    for (int i = 0; i < 23; ++i) a.in[i] = (const float*)d_in[i];
    a.out = (float*)d_out; a.ws = (unsigned char*)d_ws;
#if MK_N_LAUNCHES == 1
    a.ph_lo = 0; a.ph_hi = N_PHASES;
    hipLaunchKernelGGL(mk_fwd, dim3(grid), dim3(NTHREADS), LDS_BYTES, stream, a);
#else
    for (int p = 0; p < N_PHASES; ++p) {
        a.ph_lo = p; a.ph_hi = p + 1;
        hipLaunchKernelGGL(mk_fwd, dim3(grid), dim3(NTHREADS), LDS_BYTES, stream, a);
#ifdef MK_DUPLAUNCH
        if (p == MK_DUPLAUNCH) hipLaunchKernelGGL(mk_fwd, dim3(grid), dim3(NTHREADS), LDS_BYTES, stream, a);
#endif
#if MK_CHECK
        launch_checks(p, a, grid, stream);
#endif
    }
#if MK_CHECK
    launch_encode(a, grid, stream);
#endif
#endif
}
```

```cpp
#include <hip/hip_runtime.h>
#include <cstdio>
#include <cstdint>

#define MK_N_LAUNCHES 1
#define MK_DUP -1
#define MK_CHECK 0

#ifndef MK_DUP
#define MK_DUP -1
#endif
constexpr int D_MODEL = 1024, BATCH = 8, SEQ = 4096, T_TOK = BATCH * SEQ;
constexpr int D_HYENA = 512, D_FOURIER = 512, D_IN_PROJ = 2048, N_EXP = 32, D_EXPERT = 512;
constexpr int NPT_ROWS = 2048;
constexpr float EPS = 1e-6f;
constexpr int MAX_ROWS = 65536 + 32 * 256;
constexpr int MAX_TILES = MAX_ROWS / 256;
constexpr int NWAVES = 8, NTHREADS = 512;

constexpr size_t MiB = 1u << 20;
constexpr size_t WS_CTL = 0, CTL_ZERO_BYTES = 64 * 1024;
constexpr size_t WS_TOT = 48 * 1024;
constexpr size_t WS_CHK = 192 * 1024;
constexpr size_t WS_TW4096 = 3 * MiB;
constexpr size_t WS_TW8192 = 3 * MiB + 32 * 1024;
constexpr size_t WS_H3 = 4 * MiB;
constexpr size_t WS_WIN_T = 8 * MiB;
constexpr size_t WS_WOUT_T = 13 * MiB;
constexpr size_t WS_WGU_T = 16 * MiB;
constexpr size_t WS_WD_T = 80 * MiB;
constexpr size_t WS_KF = 112 * MiB;
constexpr size_t WS_HN = 144 * MiB;
constexpr size_t WS_PT = 208 * MiB;
constexpr size_t WS_X1Q = 208 * MiB;
constexpr size_t WS_YP = 144 * MiB;
constexpr size_t WS_X1 = 272 * MiB;
constexpr int ECAP = 32768;
constexpr size_t WS_LIST = 336 * MiB;
constexpr size_t WS_ROWW = 340 * MiB;
constexpr size_t WS_ROWR = 344 * MiB;
constexpr size_t WS_YT = 368 * MiB;
constexpr size_t WS_YN = 440 * MiB;
constexpr size_t WS_KT = WS_YN;
constexpr size_t WS_SP = WS_YT + (size_t)512 * T_TOK * 2;
constexpr size_t WS_END = 504 * MiB;

constexpr int LDS_BYTES = 163840;
constexpr int BARST_OFF = LDS_BYTES - 64;
constexpr int FFT_BUF_BYTES = 4352 * 8;
constexpr int L_BUFA = 0, L_BUFB = FFT_BUF_BYTES, L_TW = 2 * FFT_BUF_BYTES, L_SCR = L_TW + 32768, L_RED = L_SCR + 32768, L_TW256 = L_RED + 1024;
static_assert(L_TW256 + 2048 <= BARST_OFF, "LDS map");
constexpr int M_TW = 98304, M_TW256 = M_TW + 32768;
constexpr int L_TILES = 132 * 1024;

#define GAS __attribute__((address_space(1)))
#define LAS __attribute__((address_space(3)))
typedef unsigned short bf16;
typedef float f32x4 __attribute__((ext_vector_type(4)));
typedef float f32x2 __attribute__((ext_vector_type(2)));
typedef unsigned u32x4 __attribute__((ext_vector_type(4)));
typedef unsigned u32x2 __attribute__((ext_vector_type(2)));
#ifndef MK_WT
#define MK_WT 1
#endif
__device__ __forceinline__ void st16_plain(void* p, u32x4 v) { *(u32x4*)p = v; }
__device__ __forceinline__ void st16_wt(void* p, u32x4 v) {
#if MK_WT
    asm volatile("global_store_dwordx4 %0, %1, off sc1\n\ts_nop 1" :: "v"(p), "v"(v) : "memory");
#else
    *(u32x4*)p = v;
#endif
}
constexpr float W_SCALE = 16.0f, H_SCALE = 8.0f;
__device__ __forceinline__ unsigned pk4_fp8s(float a, float b, float c, float d, float sc) {
    a = __builtin_amdgcn_fmed3f(a * sc, -448.f, 448.f); b = __builtin_amdgcn_fmed3f(b * sc, -448.f, 448.f); c = __builtin_amdgcn_fmed3f(c * sc, -448.f, 448.f); d = __builtin_amdgcn_fmed3f(d * sc, -448.f, 448.f);
    int t = __builtin_amdgcn_cvt_pk_fp8_f32(a, b, 0, false); t = __builtin_amdgcn_cvt_pk_fp8_f32(c, d, t, true); return (unsigned)t;
}
#define LDS_WAIT() asm volatile("s_waitcnt lgkmcnt(0)" ::: "memory")
__device__ __forceinline__ unsigned f2bf(float f) { unsigned u = __builtin_bit_cast(unsigned, f); return (u + 0x7fffu + ((u >> 16) & 1u)) >> 16; }
__device__ __forceinline__ unsigned pk2(float lo, float hi) { return f2bf(lo) | (f2bf(hi) << 16); }
__device__ __forceinline__ unsigned pk2h(float lo, float hi) { typedef float f32x2_t __attribute__((ext_vector_type(2))); typedef __bf16 bf16x2_t __attribute__((ext_vector_type(2))); const f32x2_t v = {lo, hi}; const bf16x2_t b = __builtin_convertvector(v, bf16x2_t); return __builtin_bit_cast(unsigned, b); }
__device__ __forceinline__ float bflo(unsigned w) { return __builtin_bit_cast(float, w << 16); }
__device__ __forceinline__ float bfhi(unsigned w) { return __builtin_bit_cast(float, w & 0xffff0000u); }
__device__ __forceinline__ float bf1(bf16 h) { return __builtin_bit_cast(float, (unsigned)h << 16); }
__device__ __forceinline__ float wave_sum(float v) {
#pragma unroll
    for (int o = 1; o < 64; o <<= 1) v += __shfl_xor(v, o);
    return v;
}

namespace pg8 {
#define PG8_LAS __attribute__((address_space(3)))
typedef unsigned short bf16_t;
typedef short bf16x8 __attribute__((ext_vector_type(8)));
typedef float f32x4 __attribute__((ext_vector_type(4)));
typedef unsigned u32x4 __attribute__((ext_vector_type(4)));
typedef unsigned u32x2 __attribute__((ext_vector_type(2)));
constexpr int BM = 256, BK = 64, HALF = 128, HTB = HALF * BK * 2  , STAGE_BYTES = 8 * HTB, NXCD = 8, WGM = 8;

__host__ __device__ __forceinline__ int lds_byte(int r, int c) { const int st = (r >> 4) * 2 + (c >> 5), rr = r & 15, cc = c & 31, ob = rr * 64 + cc * 2; return st * 1024 + (ob ^ (((ob >> 9) & 1) << 5)); }
__host__ __device__ __forceinline__ void stage_rc(int b, int& R, int& C) { const int st = b / 1024, sb = b % 1024, swz = sb ^ (((sb >> 9) & 1) << 5); R = (st >> 1) * 16 + swz / 64; C = (st & 1) * 32 + (swz % 64) / 2; }
__host__ __device__ __forceinline__ int perm32(int rho) { const int n = rho >> 4, i = rho & 15; return 8 * (i >> 2) + 4 * n + (i & 3); }

struct Unit { int pm, pn; const char* a; const char* b; int lrow, nv; };

struct StaticOrder {
    static constexpr bool GATHER = false;
    int nM, nN, nwg, G, c, reps = 1; const char* A; const char* Bt; size_t tstep;
    __device__ void init(const void* A_, const void* Bt_, int M, int N, int K, int G_, int c_) { A = (const char*)A_; Bt = (const char*)Bt_; nM = M / BM; nN = N / BM; nwg = nM * nN; G = G_; c = c_; tstep = (size_t)BM * K * 2; }
    __device__ bool next(int i, Unit& u) const {
        long L = (long)i * G + c; if (L >= (long)nwg * reps) return false; if (L >= nwg) L -= nwg;
        int wgid = (int)L; { const int q = nwg / NXCD, r = nwg % NXCD, xcd = wgid % NXCD, off = wgid / NXCD; wgid = (xcd < r ? xcd * (q + 1) : r * (q + 1) + (xcd - r) * q) + off; }
        const int nig = WGM * nN, gid = wgid / nig, fm = gid * WGM, gsz = (nM - fm) < WGM ? (nM - fm) : WGM;
        u.pm = fm + ((wgid % nig) % gsz); u.pn = (wgid % nig) / gsz; u.a = A + (size_t)u.pm * tstep; u.b = Bt + (size_t)u.pn * tstep; u.lrow = 0; u.nv = BM; return true;
    }
};
struct MoeOrder {
    static constexpr bool GATHER = false;
    int nwg, G, c; const char* A; const char* Bt; const PG8_LAS int* tl; const PG8_LAS int* tnv; size_t a_tstep, b_tstep;
    __device__ void init(const void* A_, const void* Bt_, const PG8_LAS int* tl_, const PG8_LAS int* tnv_, int ntiles, int K, int G_, int c_, int ES = 2) { A = (const char*)A_; Bt = (const char*)Bt_; tl = tl_; tnv = tnv_; nwg = ntiles * 4; G = G_; c = c_; a_tstep = (size_t)BM * K * ES; b_tstep = (size_t)BM * K * ES; }
    __device__ bool next(int i, Unit& u) const {
        const long L = (long)i * G + c; if (L >= nwg) return false;
        int wgid = (int)L; { const int q = nwg / NXCD, r = nwg % NXCD, xcd = wgid % NXCD, off = wgid / NXCD; wgid = (xcd < r ? xcd * (q + 1) : r * (q + 1) + (xcd - r) * q) + off; }
        u.pm = wgid >> 2; u.pn = wgid & 3; u.lrow = __builtin_amdgcn_readfirstlane(tl[u.pm]); u.nv = __builtin_amdgcn_readfirstlane(tnv[u.pm]); const int e = u.lrow >> 15;
        u.a = A + (size_t)u.pm * a_tstep; u.b = Bt + (size_t)(e * 4 + u.pn) * b_tstep; return true;
    }
};

struct MoeGatherOrder {
    static constexpr bool GATHER = true;
    int nwg, G, c, es; const char* A; const char* Bt; const PG8_LAS int* tl; const PG8_LAS int* tnv; const int* list; size_t b_tstep;
    __device__ void init(const void* A_, const void* Bt_, const PG8_LAS int* tl_, const PG8_LAS int* tnv_, const int* list_, int ntiles, int K, int G_, int c_, int ES = 2) { A = (const char*)A_; Bt = (const char*)Bt_; tl = tl_; tnv = tnv_; list = list_; nwg = ntiles * 4; G = G_; c = c_; es = ES; b_tstep = (size_t)BM * K * ES; }
    __device__ bool next(int i, Unit& u) const {
        const long L = (long)i * G + c; if (L >= nwg) return false;
        int wgid = (int)L; { const int q = nwg / NXCD, r = nwg % NXCD, xcd = wgid % NXCD, off = wgid / NXCD; wgid = (xcd < r ? xcd * (q + 1) : r * (q + 1) + (xcd - r) * q) + off; }
        u.pm = wgid >> 2; u.pn = wgid & 3; u.lrow = __builtin_amdgcn_readfirstlane(tl[u.pm]); u.nv = __builtin_amdgcn_readfirstlane(tnv[u.pm]); const int e = u.lrow >> 15;
        u.a = A; u.b = Bt + (size_t)(e * 4 + u.pn) * b_tstep; return true;
    }
    __device__ __forceinline__ void offsets(const Unit& u, int K, const int (&R)[2], const int (&C)[2], unsigned (&o)[2][2]) const {
#pragma unroll
        for (int h = 0; h < 2; ++h)
#pragma unroll
            for (int i = 0; i < 2; ++i) { const int lr = h * HALF + R[i]; const int pr = list[u.lrow + (lr < u.nv ? lr : 0)]; const int tok = (lr < u.nv ? pr : 0) >> 1; o[h][i] = (unsigned)(tok * K) * (unsigned)es + (unsigned)C[i] * 2u; }
    }
};

__device__ __forceinline__ unsigned cvt_pk_bf16(float lo, float hi) { unsigned r; asm volatile("v_cvt_pk_bf16_f32 %0, %1, %2" : "=v"(r) : "v"(lo), "v"(hi)); return r; }

struct EpiStoreBf16 {
    static constexpr bool PERM = true;
    bf16_t* O; int ldc;
    __device__ __forceinline__ void operator()(const f32x4 (&acc)[2][2][4][2], const Unit& u, int wr, int wc, int fr, int fq) const {
        const int row0 = u.pm * BM + wr * 64 + fr; const int col0 = u.pn * BM + wc * 32 + 8 * fq;
#pragma unroll
        for (int ai = 0; ai < 2; ++ai)
#pragma unroll
            for (int m = 0; m < 4; ++m) { bf16_t* rowp = O + (size_t)(row0 + ai * HALF + m * 16) * ldc + col0;
#pragma unroll
                for (int bj = 0; bj < 2; ++bj) { const f32x4 v0 = acc[ai][bj][m][0], v1 = acc[ai][bj][m][1];
                    u32x4 w; w.x = cvt_pk_bf16(v0[0], v0[1]); w.y = cvt_pk_bf16(v0[2], v0[3]); w.z = cvt_pk_bf16(v1[0], v1[1]); w.w = cvt_pk_bf16(v1[2], v1[3]);
                    *(u32x4*)(rowp + bj * HALF) = w; } }
    }
};
struct EpiStorePT {
    static constexpr bool PERM = true;
    bf16_t* O; int nrows;
    __device__ __forceinline__ void operator()(const f32x4 (&acc)[2][2][4][2], const Unit& u, int wr, int wc, int fr, int fq) const {
        const int row0 = u.pm * BM + wr * 64 + fr; const int col0 = wc * 32 + 8 * fq; bf16_t* base = O + (size_t)u.pn * nrows * 256;
#pragma unroll
        for (int ai = 0; ai < 2; ++ai)
#pragma unroll
            for (int m = 0; m < 4; ++m) { bf16_t* rowp = base + (size_t)(row0 + ai * HALF + m * 16) * 256 + col0;
#pragma unroll
                for (int bj = 0; bj < 2; ++bj) { const f32x4 v0 = acc[ai][bj][m][0], v1 = acc[ai][bj][m][1];
                    u32x4 w; w.x = cvt_pk_bf16(v0[0], v0[1]); w.y = cvt_pk_bf16(v0[2], v0[3]); w.z = cvt_pk_bf16(v1[0], v1[1]); w.w = cvt_pk_bf16(v1[2], v1[3]);
                    st16_plain(rowp + bj * HALF, w); } }
    }
};
struct EpiResF32 {
    static constexpr bool PERM = false;
    const float* base; float* out; int ldc;
    __device__ __forceinline__ void operator()(const f32x4 (&acc)[2][2][4][2], const Unit& u, int wr, int wc, int fr, int fq) const {
        const int row0 = u.pm * BM + wr * 64 + fr; const int col0 = u.pn * BM + wc * 32 + 4 * fq;
#pragma unroll
        for (int ai = 0; ai < 2; ++ai)
#pragma unroll
            for (int m = 0; m < 4; ++m) { const size_t off = (size_t)(row0 + ai * HALF + m * 16) * ldc + col0;
#pragma unroll
                for (int bj = 0; bj < 2; ++bj)
#pragma unroll
                    for (int n = 0; n < 2; ++n) { const f32x4 bs = *(const f32x4*)(base + off + bj * HALF + n * 16); *(f32x4*)(out + off + bj * HALF + n * 16) = bs + acc[ai][bj][m][n]; } }
    }
};
struct EpiResBf16 {
    static constexpr bool PERM = true;
    const float* __restrict__ base; bf16_t* __restrict__ out; int ldc;
    __device__ __forceinline__ void operator()(const f32x4 (&acc)[2][2][4][2], const Unit& u, int wr, int wc, int fr, int fq) const {
        const int row0 = u.pm * BM + wr * 64 + fr; const int col0 = u.pn * BM + wc * 32 + 8 * fq;
#pragma unroll
        for (int ai = 0; ai < 2; ++ai) {
            f32x4 r0[4][2], r1[4][2];
#pragma unroll
            for (int m = 0; m < 4; ++m) { const size_t off = (size_t)(row0 + ai * HALF + m * 16) * ldc + col0;
#pragma unroll
                for (int bj = 0; bj < 2; ++bj) { r0[m][bj] = *(const f32x4*)(base + off + bj * HALF); r1[m][bj] = *(const f32x4*)(base + off + bj * HALF + 4); } }
#pragma unroll
            for (int m = 0; m < 4; ++m) { const size_t off = (size_t)(row0 + ai * HALF + m * 16) * ldc + col0;
#pragma unroll
                for (int bj = 0; bj < 2; ++bj) { const f32x4 v0 = acc[ai][bj][m][0] + r0[m][bj], v1 = acc[ai][bj][m][1] + r1[m][bj];
                    u32x4 w; w.x = cvt_pk_bf16(v0[0], v0[1]); w.y = cvt_pk_bf16(v0[2], v0[3]); w.z = cvt_pk_bf16(v1[0], v1[1]); w.w = cvt_pk_bf16(v1[2], v1[3]);
                    st16_plain(out + off + bj * HALF, w); } }
        }
    }
};
struct EpiSwiGLU {
    static constexpr bool PERM = false;
    unsigned char* __restrict__ H; const float* __restrict__ rowr;
    __device__ __forceinline__ void operator()(const f32x4 (&acc)[2][2][4][2], const Unit& u, int wr, int wc, int fr, int fq) const {
        const int row0 = u.pm * BM + wr * 64 + fr;
#pragma unroll
        for (int ai = 0; ai < 2; ++ai)
#pragma unroll
            for (int m = 0; m < 4; ++m) { const int lr = wr * 64 + fr + ai * HALF + m * 16; const int row = row0 + ai * HALF + m * 16; const float rr = ((lr < u.nv) ? rowr[u.lrow + lr] : 0.f) * (1.0f / W_SCALE); unsigned char* rowp = H + (size_t)row * 512 + u.pn * 128 + wc * 32 + 4 * fq;
#pragma unroll
                for (int n = 0; n < 2; ++n) { const f32x4 g = acc[ai][0][m][n] * rr, up = acc[ai][1][m][n] * rr; f32x4 h;
#pragma unroll
                    for (int q = 0; q < 4; ++q) h[q] = g[q] * __builtin_amdgcn_rcpf(1.0f + __expf(-g[q])) * up[q];
                    *(unsigned*)(rowp + n * 16) = pk4_fp8s(h[0], h[1], h[2], h[3], H_SCALE); } }
    }
};
constexpr float YP_SCALE = 32.0f;
__device__ __forceinline__ unsigned pk4_fp8(float a, float b, float c, float d) {
    a = __builtin_amdgcn_fmed3f(a * YP_SCALE, -448.f, 448.f); b = __builtin_amdgcn_fmed3f(b * YP_SCALE, -448.f, 448.f); c = __builtin_amdgcn_fmed3f(c * YP_SCALE, -448.f, 448.f); d = __builtin_amdgcn_fmed3f(d * YP_SCALE, -448.f, 448.f);
    int t = __builtin_amdgcn_cvt_pk_fp8_f32(a, b, 0, false); t = __builtin_amdgcn_cvt_pk_fp8_f32(c, d, t, true); return (unsigned)t;
}
struct EpiMoeDown {
    static constexpr bool PERM = true;
    unsigned char* __restrict__ YP; const int* __restrict__ list; const float* __restrict__ roww;
    __device__ __forceinline__ void operator()(const f32x4 (&acc)[2][2][4][2], const Unit& u, int wr, int wc, int fr, int fq) const {
        const int col0 = u.pn * BM + wc * 32 + 8 * fq;
        int prv[2][4]; float wv[2][4];
#pragma unroll
        for (int ai = 0; ai < 2; ++ai)
#pragma unroll
            for (int m = 0; m < 4; ++m) { const int lr = wr * 64 + fr + ai * HALF + m * 16; const int li = u.lrow + (lr < u.nv ? lr : 0); prv[ai][m] = list[li]; wv[ai][m] = roww[li]; }
#pragma unroll
        for (int ai = 0; ai < 2; ++ai)
#pragma unroll
            for (int m = 0; m < 4; ++m) { const int lr = wr * 64 + fr + ai * HALF + m * 16; const bool ok = lr < u.nv; const int pair = ok ? prv[ai][m] : 0; const float w = ok ? wv[ai][m] : 0.f;
                if (ok) { unsigned char* rowp = YP + (size_t)pair * 1024 + col0;
#pragma unroll
                    for (int bj = 0; bj < 2; ++bj) { const f32x4 v0 = acc[ai][bj][m][0] * (w * (1.0f / (W_SCALE * H_SCALE))), v1 = acc[ai][bj][m][1] * (w * (1.0f / (W_SCALE * H_SCALE)));
                        u32x2 o; o.x = pk4_fp8(v0[0], v0[1], v0[2], v0[3]); o.y = pk4_fp8(v1[0], v1[1], v1[2], v1[3]);
                        *(u32x2*)(rowp + bj * HALF) = o; } } }
    }
};

typedef int v8i_t __attribute__((ext_vector_type(8)));
template <class Epi, class Sched, bool ALIGN_EPI = true, bool FP8 = false>
__device__ __forceinline__ void gemm_phase(PG8_LAS unsigned char* lds, const int K, const Sched& S, const Epi& E) {
    const int tid = threadIdx.x, wid = __builtin_amdgcn_readfirstlane(tid >> 6), lane = tid & 63, wr = wid >> 2, wc = wid & 3, fr = lane & 15, fq = lane >> 4;
    constexpr int ES = FP8 ? 1 : 2;
    const int nt = K * ES / (BK * 2);
    unsigned voffA[2], voffB[2]; int sR[2], sC[2];
#pragma unroll
    for (int i = 0; i < 2; ++i) { int R, C; stage_rc(tid * 16 + i * 8192, R, C); const int Rb = Epi::PERM ? ((R & ~31) + perm32(R & 31)) : R; sR[i] = R; sC[i] = C;
        voffA[i] = (unsigned)(R * K) * (unsigned)ES + (unsigned)C * 2u; voffB[i] = (unsigned)(Rb * K) * (unsigned)ES + (unsigned)C * 2u; }
    int sc127 = 0x7f7f7f7f; asm volatile("" : "+v"(sc127));
    constexpr bool GA = Sched::GATHER;
    unsigned oc[2][2], on[2][2];
    const size_t kstep = (size_t)(BK * 2);
    const size_t hstep = (size_t)HALF * K * ES;
    const unsigned ldsw = (unsigned)wid * 1024u;
    const int aoff = lds_byte(wr * 64 + fr, fq * 8), boff = lds_byte(wc * 32 + fr, fq * 8);
#define PG8_SA(b, h) (((b) * 2 + (h)) * HTB)
#define PG8_SB(b, h) ((4 + (b) * 2 + (h)) * HTB)
#define PG8_STAGE(bufoff, gbase, voff) do { _Pragma("unroll") for (int _i = 0; _i < 2; ++_i) \
        __builtin_amdgcn_global_load_lds((const unsigned*)((const char*)(gbase) + (voff)[_i]), (PG8_LAS unsigned*)(lds + (bufoff) + ldsw + _i * 8192), 16, 0, 0); } while (0)
#define PG8_LDA(dst, b, h) do { _Pragma("unroll") for (int m = 0; m < 4; ++m) _Pragma("unroll") for (int k = 0; k < 2; ++k) dst[m][k] = *(const PG8_LAS bf16x8*)(lds + PG8_SA(b, h) + aoff + m * 2048 + k * 1024); } while (0)
#define PG8_LDB(dst, b, h) do { _Pragma("unroll") for (int n = 0; n < 2; ++n) _Pragma("unroll") for (int k = 0; k < 2; ++k) dst[n][k] = *(const PG8_LAS bf16x8*)(lds + PG8_SB(b, h) + boff + n * 2048 + k * 1024); } while (0)
#define PG8_CAT(x0, x1) (v8i_t){ (int)__builtin_bit_cast(u32x4, x0).x, (int)__builtin_bit_cast(u32x4, x0).y, (int)__builtin_bit_cast(u32x4, x0).z, (int)__builtin_bit_cast(u32x4, x0).w, (int)__builtin_bit_cast(u32x4, x1).x, (int)__builtin_bit_cast(u32x4, x1).y, (int)__builtin_bit_cast(u32x4, x1).z, (int)__builtin_bit_cast(u32x4, x1).w }
#define PG8_MMA(ai, bj, At, Bt) do { __builtin_amdgcn_s_setprio(1); _Pragma("unroll") for (int m = 0; m < 4; ++m) _Pragma("unroll") for (int n = 0; n < 2; ++n) { \
        if constexpr (FP8) { const v8i_t b8_ = PG8_CAT(Bt[n][0], Bt[n][1]), a8_ = PG8_CAT(At[m][0], At[m][1]); \
            asm volatile("s_nop 1\n\tv_mfma_scale_f32_16x16x128_f8f6f4 %0, %1, %2, %0, %3, %3 op_sel_hi:[0,0,0]" : "+v"(acc[ai][bj][m][n]) : "v"(b8_), "v"(a8_), "v"(sc127)); } \
        else { _Pragma("unroll") for (int k = 0; k < 2; ++k) acc[ai][bj][m][n] = __builtin_amdgcn_mfma_f32_16x16x32_bf16(Bt[n][k], At[m][k], acc[ai][bj][m][n], 0, 0, 0); } } __builtin_amdgcn_s_setprio(0); } while (0)
#define PG8_WAIT_V(n) asm volatile("s_waitcnt vmcnt(" #n ")" ::: "memory")
#define PG8_WAIT_L(n) asm volatile("s_waitcnt lgkmcnt(" #n ")" ::: "memory")
#define PG8_BAR __builtin_amdgcn_s_barrier()
#define PG8_SCHED __builtin_amdgcn_sched_barrier(0)
    Unit cur, nxt; int ui = 0;
    if (!S.next(0, cur)) return;
    f32x4 acc[2][2][4][2];
#pragma unroll
    for (int a = 0; a < 2; ++a)
#pragma unroll
        for (int b = 0; b < 2; ++b)
#pragma unroll
            for (int m = 0; m < 4; ++m)
#pragma unroll
                for (int n = 0; n < 2; ++n) acc[a][b][m][n] = (f32x4){0.f, 0.f, 0.f, 0.f};
    bf16x8 At[4][2], B0[2][2], B1[2][2];
    const char* cA = cur.a; const char* cB = cur.b;
    const size_t hA = GA ? (size_t)0 : hstep;
    if constexpr (GA) { S.offsets(cur, K, sR, sC, oc); }
#define PG8_OA(h, sel) (GA ? (sel)[h] : voffA)
    PG8_STAGE(PG8_SB(0, 0), cB, voffB); PG8_STAGE(PG8_SB(0, 1), cB + hstep, voffB); PG8_STAGE(PG8_SA(0, 0), cA, PG8_OA(0, oc)); PG8_STAGE(PG8_SA(0, 1), cA + hA, PG8_OA(1, oc));
    if (wr == 1) PG8_BAR;
    PG8_WAIT_V(2); PG8_BAR;
    PG8_STAGE(PG8_SB(1, 0), cB + kstep, voffB); PG8_STAGE(PG8_SA(1, 0), cA + kstep, PG8_OA(0, oc)); PG8_STAGE(PG8_SB(1, 1), cB + hstep + kstep, voffB);
    PG8_WAIT_V(6); PG8_BAR;
    for (;;) {
        const bool has_next = S.next(ui + 1, nxt);
        const char* nA = has_next ? nxt.a : cA; const char* nB = has_next ? nxt.b : cB;
        if constexpr (GA) { if (has_next) S.offsets(nxt, K, sR, sC, on); else {
#pragma unroll
            for (int h = 0; h < 2; ++h)
#pragma unroll
                for (int i = 0; i < 2; ++i) on[h][i] = oc[h][i]; } }
#pragma unroll 1
        for (int t = 0; t < nt; t += 2) {
            const bool last = (t == nt - 2);
            const char* a1 = cA + (size_t)(t + 1) * kstep;
            const char* a2 = last ? nA : cA + (size_t)(t + 2) * kstep; const char* b2 = last ? nB : cB + (size_t)(t + 2) * kstep;
            const char* a3 = a2 + kstep; const char* b3 = b2 + kstep;
            unsigned o2[2][2];
            if constexpr (GA) {
#pragma unroll
                for (int h = 0; h < 2; ++h)
#pragma unroll
                    for (int i = 0; i < 2; ++i) o2[h][i] = last ? on[h][i] : oc[h][i]; }
            PG8_LDB(B0, 0, 0); PG8_LDB(B1, 0, 1); PG8_SCHED; PG8_LDA(At, 0, 0); PG8_STAGE(PG8_SA(1, 1), a1 + hA, PG8_OA(1, oc));
            PG8_WAIT_V(8); PG8_WAIT_L(0); PG8_BAR; PG8_MMA(0, 0, At, B0); PG8_MMA(0, 1, At, B1); PG8_BAR; PG8_SCHED;
            PG8_LDA(At, 0, 1); PG8_STAGE(PG8_SB(0, 0), b2, voffB); PG8_STAGE(PG8_SB(0, 1), b2 + hstep, voffB); PG8_STAGE(PG8_SA(0, 0), a2, PG8_OA(0, o2));
            PG8_WAIT_V(8); PG8_WAIT_L(0); PG8_BAR; PG8_MMA(1, 0, At, B0); PG8_MMA(1, 1, At, B1); PG8_BAR; PG8_SCHED;
            PG8_LDB(B0, 1, 0); PG8_LDB(B1, 1, 1); PG8_SCHED; PG8_LDA(At, 1, 0); PG8_STAGE(PG8_SA(0, 1), a2 + hA, PG8_OA(1, o2));
            PG8_WAIT_V(8); PG8_WAIT_L(0); PG8_BAR; PG8_MMA(0, 0, At, B0); PG8_MMA(0, 1, At, B1); PG8_BAR; PG8_SCHED;
            PG8_LDA(At, 1, 1); PG8_STAGE(PG8_SB(1, 0), b3, voffB); PG8_STAGE(PG8_SB(1, 1), b3 + hstep, voffB); PG8_STAGE(PG8_SA(1, 0), a3, PG8_OA(0, o2));
            PG8_WAIT_V(8); PG8_WAIT_L(0); PG8_BAR; PG8_MMA(1, 0, At, B0); PG8_MMA(1, 1, At, B1); PG8_BAR; PG8_SCHED;
        }
        if constexpr (ALIGN_EPI) { if (wr == 0) PG8_BAR; }
        if constexpr (FP8) asm volatile("s_nop 7\n\ts_nop 7" : "+v"(acc[1][1][0][0]), "+v"(acc[1][1][0][1]), "+v"(acc[1][1][1][0]), "+v"(acc[1][1][1][1]), "+v"(acc[1][1][2][0]), "+v"(acc[1][1][2][1]), "+v"(acc[1][1][3][0]), "+v"(acc[1][1][3][1]) :: "memory");
        E(acc, cur, wr, wc, fr, fq);
        if (!has_next) break;
#pragma unroll
        for (int a = 0; a < 2; ++a)
#pragma unroll
            for (int b = 0; b < 2; ++b)
#pragma unroll
                for (int m = 0; m < 4; ++m)
#pragma unroll
                    for (int n = 0; n < 2; ++n) acc[a][b][m][n] = (f32x4){0.f, 0.f, 0.f, 0.f};
        cur = nxt; cA = nA; cB = nB; ++ui;
        if constexpr (GA) {
#pragma unroll
            for (int h = 0; h < 2; ++h)
#pragma unroll
                for (int i = 0; i < 2; ++i) oc[h][i] = on[h][i]; }
        if constexpr (ALIGN_EPI) { if (wr == 1) PG8_BAR; }
    }
    PG8_WAIT_V(0);
    if constexpr (!ALIGN_EPI) { if (wr == 0) PG8_BAR; }
    PG8_BAR;
#undef PG8_SA
#undef PG8_OA
#undef PG8_CAT
#undef PG8_SB
#undef PG8_STAGE
#undef PG8_LDA
#undef PG8_LDB
#undef PG8_MMA
#undef PG8_WAIT_V
#undef PG8_WAIT_L
#undef PG8_BAR
#undef PG8_SCHED
}
}

#define FDEV __device__ __forceinline__
#define LDSPTR LAS
#define CF_DEFINED
typedef float cf __attribute__((ext_vector_type(2)));
#ifndef FFT_ENGINE_H
#define FFT_ENGINE_H
#ifndef CF_DEFINED
struct cf { float x, y; };
#endif
FDEV cf mkc(float a, float b) { cf r; r.x = a; r.y = b; return r; }
FDEV cf cadd(cf a, cf b) { return mkc(a.x + b.x, a.y + b.y); }
FDEV cf csub(cf a, cf b) { return mkc(a.x - b.x, a.y - b.y); }
FDEV cf cmul(cf a, cf b) { return mkc(a.x * b.x - a.y * b.y, a.x * b.y + a.y * b.x); }
FDEV cf cmulc(cf a, cf b) { return mkc(a.x * b.x + a.y * b.y, a.y * b.x - a.x * b.y); }
FDEV cf mul_mi(cf a) { return mkc(a.y, -a.x); }
FDEV cf mul_pi(cf a) { return mkc(-a.y, a.x); }
constexpr int FFT_N = 4096, FFT_LDS_ELEMS = 16 * 272;
FDEV int fpos(int p) { return 272 * (p >> 8) + 17 * ((p >> 4) & 15) + (p & 15); }

template <bool INV> FDEV void dft16(cf (&v)[16]) {
    const float C1 = 0.92387953251128674f, S1 = 0.38268343236508977f, C2 = 0.70710678118654752f;
#pragma unroll
    for (int n0 = 0; n0 < 4; ++n0) {
        cf x0 = v[n0], x1 = v[4 + n0], x2 = v[8 + n0], x3 = v[12 + n0];
        cf A = cadd(x0, x2), B = csub(x0, x2), C = cadd(x1, x3), D = csub(x1, x3);
        cf Dm = INV ? mul_pi(D) : mul_mi(D);
        v[n0] = cadd(A, C); v[4 + n0] = cadd(B, Dm); v[8 + n0] = csub(A, C); v[12 + n0] = csub(B, Dm);
    }
#define W16(m) (mkc( (m)==0?1.f:(m)==1?C1:(m)==2?C2:(m)==3?S1:(m)==4?0.f:(m)==6?-C2:(m)==9?-C1:0.f, \
                    (INV?1.f:-1.f) * ((m)==0?0.f:(m)==1?S1:(m)==2?C2:(m)==3?C1:(m)==4?1.f:(m)==6?C2:(m)==9?-S1:0.f) ))
    v[4 + 1] = cmul(v[4 + 1], W16(1)); v[4 + 2] = cmul(v[4 + 2], W16(2)); v[4 + 3] = cmul(v[4 + 3], W16(3));
    v[8 + 1] = cmul(v[8 + 1], W16(2)); v[8 + 2] = cmul(v[8 + 2], W16(4)); v[8 + 3] = cmul(v[8 + 3], W16(6));
    v[12 + 1] = cmul(v[12 + 1], W16(3)); v[12 + 2] = cmul(v[12 + 2], W16(6)); v[12 + 3] = cmul(v[12 + 3], W16(9));
#undef W16
    cf o[16];
#pragma unroll
    for (int k1 = 0; k1 < 4; ++k1) {
        cf x0 = v[4 * k1], x1 = v[4 * k1 + 1], x2 = v[4 * k1 + 2], x3 = v[4 * k1 + 3];
        cf A = cadd(x0, x2), B = csub(x0, x2), C = cadd(x1, x3), D = csub(x1, x3);
        cf Dm = INV ? mul_pi(D) : mul_mi(D);
        o[k1] = cadd(A, C); o[k1 + 4] = cadd(B, Dm); o[k1 + 8] = csub(A, C); o[k1 + 12] = csub(B, Dm);
    }
#pragma unroll
    for (int i = 0; i < 16; ++i) v[i] = o[i];
}

template <int GEO> FDEV int geo_idx(int r, int e) {
    if (GEO == 1) return 272 * e + 17 * (r >> 4) + (r & 15);
    if (GEO == 2) return 272 * (r >> 4) + 17 * e + (r & 15);
    return 272 * (r >> 4) + 17 * (r & 15) + e;
}
template <int GEO> FDEV void fft_pass_fwd(LDSPTR cf* buf, const LDSPTR cf* tw, const LDSPTR cf* tw256, int r) {
    cf v[16];
#pragma unroll
    for (int e = 0; e < 16; ++e) v[e] = buf[geo_idx<GEO>(r, e)];
    dft16<false>(v);
    if (GEO == 1) {
#pragma unroll
        for (int s = 1; s < 16; ++s) v[s] = cmul(v[s], tw[(r * s) & 4095]);
    } else if (GEO == 2) {
        const int t = r & 15;
#pragma unroll
        for (int s = 1; s < 16; ++s) v[s] = cmul(v[s], tw256[t * s]);
    }
#pragma unroll
    for (int e = 0; e < 16; ++e) buf[geo_idx<GEO>(r, e)] = v[e];
}
template <int GEO> FDEV void fft_pass_inv(LDSPTR cf* buf, const LDSPTR cf* tw, const LDSPTR cf* tw256, int r) {
    cf v[16];
#pragma unroll
    for (int e = 0; e < 16; ++e) v[e] = buf[geo_idx<GEO>(r, e)];
    if (GEO == 1) {
#pragma unroll
        for (int s = 1; s < 16; ++s) v[s] = cmulc(v[s], tw[(r * s) & 4095]);
    } else if (GEO == 2) {
        const int t = r & 15;
#pragma unroll
        for (int s = 1; s < 16; ++s) v[s] = cmulc(v[s], tw256[t * s]);
    }
    dft16<true>(v);
#pragma unroll
    for (int e = 0; e < 16; ++e) buf[geo_idx<GEO>(r, e)] = v[e];
}
FDEV int freq_pos(int k) { return 256 * (k & 15) + 16 * ((k >> 4) & 15) + (k >> 8); }
#endif

#define XB_TMO      128
#define XB_XCNT(j)  (256  + 64 * (j))
#define XB_XSUB(j)  (1280 + 64 * (j))
#define XB_XGEN(j)  (2304 + 64 * (j))
#define XB_TOP      3328
#define XB_TOPGEN   3392
#define XCD_BAR_WORDS 3456
#define XB_SPIN_CAP (1u << 18)
__device__ __forceinline__ unsigned xb_ld(unsigned* p)              { return __hip_atomic_load(p, __ATOMIC_RELAXED, __HIP_MEMORY_SCOPE_AGENT); }
__device__ __forceinline__ unsigned xb_add(unsigned* p, unsigned v) { return __hip_atomic_fetch_add(p, v, __ATOMIC_RELAXED, __HIP_MEMORY_SCOPE_AGENT); }
__device__ __forceinline__ unsigned xb_xcc_id() { return (unsigned)__builtin_amdgcn_s_getreg((3 << 11) | 20) & 0xFu; }
#define XB_SPIN(cond, bar) do { unsigned _sp = 0; while (cond) { __builtin_amdgcn_s_sleep(1); \
    if ((++_sp & 255u) == 0u) { if (xb_ld(&(bar)[XB_TMO])) break; if (_sp > XB_SPIN_CAP) { atomicAdd(&(bar)[XB_TMO], 1u); break; } } } } while (0)
struct XcdBarrier { unsigned* bar; unsigned x; volatile LAS unsigned* st; };
__device__ __forceinline__ XcdBarrier xcd_barrier_post(unsigned* bar, volatile LAS unsigned* st) {
    XcdBarrier b; b.bar = bar; b.x = xb_xcc_id(); b.st = st;
    if (threadIdx.x == 0) (void)xb_add(&bar[XB_XCNT(b.x)], 1u);
    return b;
}
__device__ __forceinline__ void xcd_barrier_complete(unsigned* bar, unsigned x, unsigned& nloc, unsigned& nx) {
    const unsigned G = gridDim.x * gridDim.y * gridDim.z;
    unsigned sum, cnt, mine, sp = 0u;
    for (;;) {
        sum = 0u; cnt = 0u; mine = 0u;
#pragma unroll
        for (unsigned j = 0; j < 16; ++j) { const unsigned c = xb_ld(&bar[XB_XCNT(j)]); sum += c; cnt += (c > 0u) ? 1u : 0u; mine = (j == x) ? c : mine; }
        if (sum == G) break;
        __builtin_amdgcn_s_sleep(1);
        if ((++sp & 255u) == 0u) { if (xb_ld(&bar[XB_TMO])) break; if (sp > XB_SPIN_CAP) { atomicAdd(&bar[XB_TMO], 1u); break; } }
    }
    nloc = mine > 0u ? mine : 1u; nx = cnt > 0u ? cnt : 1u;
}
__device__ __forceinline__ void xcd_barrier(const XcdBarrier& b) {
    asm volatile("s_waitcnt vmcnt(0)" ::: "memory");
    __syncthreads();
    if (threadIdx.x == 0) {
        unsigned* bar = b.bar;
        __builtin_amdgcn_s_waitcnt(0);
        unsigned nloc = b.st[0], nx = b.st[1];
        if (nloc == 0u) { xcd_barrier_complete(bar, b.x, nloc, nx); b.st[0] = nloc; b.st[1] = nx; }
        const unsigned old = xb_add(&bar[XB_XSUB(b.x)], 1u);
        const unsigned gen = old / nloc;
        if (old + 1u == (gen + 1u) * nloc) {
            __builtin_amdgcn_fence(__ATOMIC_RELEASE, "agent");
            asm volatile("s_waitcnt vmcnt(0)" ::: "memory");
            const unsigned og = xb_add(&bar[XB_TOP], 1u);
            const unsigned tg = og / nx;
            if (og + 1u == (tg + 1u) * nx) xb_add(&bar[XB_TOPGEN], 1u);
            else XB_SPIN(xb_ld(&bar[XB_TOPGEN]) == tg, bar);
            __builtin_amdgcn_fence(__ATOMIC_ACQUIRE, "agent");
            xb_add(&bar[XB_XGEN(b.x)], 1u);
            asm volatile("s_waitcnt vmcnt(0)" ::: "memory");
        } else {
            XB_SPIN(xb_ld(&bar[XB_XGEN(b.x)]) == gen, bar);
            __builtin_amdgcn_fence(__ATOMIC_ACQUIRE, "agent");
            asm volatile("s_waitcnt vmcnt(0)" ::: "memory");
        }
    }
    __syncthreads();
}

struct Frame {
    LAS unsigned char* lds;
    unsigned char* ws;
    int tid, lane, wave, vcu, G, bid;
    const float *x, *norm1_g, *w_in, *conv_w, *conv_b, *f_w_in, *f_b_in, *f_w_mid, *f_b_mid, *f_freq, *f_w_out, *f_bias, *mix_g, *w_out, *norm2_g,
                *w_group, *b_group, *w_router, *b_router, *w_gate, *w_up, *w_down, *final_g;
    float* out;
};
#define WSP(T, off) ((T*)(F.ws + (off)))

__device__ __forceinline__ void transpose_item(const float* W, int ldw, bf16* WT, int ldo, LAS float* scr, int lane, const float* gk = nullptr) {
    asm volatile("" : "+s"(ldw));
    const float* Wl = W + (size_t)(lane >> 5) * ldw + (lane & 31);
    float t[32];
#pragma unroll
    for (int i = 0; i < 32; ++i) t[i] = Wl[(size_t)(2 * i) * ldw];
    if (gk) { const float* gl = gk + (lane >> 5);
#pragma unroll
        for (int i = 0; i < 32; ++i) t[i] *= gl[2 * i]; }
#pragma unroll
    for (int i = 0; i < 32; ++i) { const int kk = 2 * i + (lane >> 5); scr[kk * 33 + (lane & 31)] = t[i]; }
    LDS_WAIT(); asm volatile("" ::: "memory");
    const int c = lane & 7;
#pragma unroll
    for (int j = 0; j < 4; ++j) { const int n = (lane >> 3) + 8 * j; const LAS float* s = scr + (8 * c) * 33 + n;
        u32x4 o; o.x = pk2(s[0 * 33], s[1 * 33]); o.y = pk2(s[2 * 33], s[3 * 33]); o.z = pk2(s[4 * 33], s[5 * 33]); o.w = pk2(s[6 * 33], s[7 * 33]);
        st16_wt(WT + (size_t)n * ldo + 8 * c, o); }
    LDS_WAIT(); asm volatile("" ::: "memory");
}
__device__ __forceinline__ void transpose_item_fp8(const float* W, int ldw, unsigned char* WT, int ldo, LAS float* scr, int lane, const float* gk, float scale) {
    asm volatile("" : "+s"(ldw));
    const float* Wl = W + (size_t)(lane >> 5) * ldw + (lane & 31);
    float t[32];
#pragma unroll
    for (int i = 0; i < 32; ++i) t[i] = Wl[(size_t)(2 * i) * ldw];
    if (gk) { const float* gl = gk + (lane >> 5);
#pragma unroll
        for (int i = 0; i < 32; ++i) t[i] *= gl[2 * i]; }
#pragma unroll
    for (int i = 0; i < 32; ++i) { const int kk = 2 * i + (lane >> 5); scr[kk * 33 + (lane & 31)] = t[i]; }
    LDS_WAIT(); asm volatile("" ::: "memory");
    const int n = lane >> 1, hf = lane & 1; const LAS float* s = scr + (32 * hf) * 33 + n;
    u32x4 o0, o1;
    o0.x = pk4_fp8s(s[0 * 33], s[1 * 33], s[2 * 33], s[3 * 33], scale); o0.y = pk4_fp8s(s[4 * 33], s[5 * 33], s[6 * 33], s[7 * 33], scale);
    o0.z = pk4_fp8s(s[8 * 33], s[9 * 33], s[10 * 33], s[11 * 33], scale); o0.w = pk4_fp8s(s[12 * 33], s[13 * 33], s[14 * 33], s[15 * 33], scale);
    o1.x = pk4_fp8s(s[16 * 33], s[17 * 33], s[18 * 33], s[19 * 33], scale); o1.y = pk4_fp8s(s[20 * 33], s[21 * 33], s[22 * 33], s[23 * 33], scale);
    o1.z = pk4_fp8s(s[24 * 33], s[25 * 33], s[26 * 33], s[27 * 33], scale); o1.w = pk4_fp8s(s[28 * 33], s[29 * 33], s[30 * 33], s[31 * 33], scale);
    unsigned char* d = WT + (size_t)n * ldo + 32 * hf;
    st16_wt(d, o0); st16_wt(d + 16, o1);
    LDS_WAIT(); asm volatile("" ::: "memory");
}
__device__ __forceinline__ void rms_row_to_bf16(const float* xrow, const float* g, bf16* orow, int lane) {
    const GAS f32x4* xr = (const GAS f32x4*)xrow + lane; const GAS f32x4* gr = (const GAS f32x4*)g + lane;
    f32x4 v[4]; float s = 0.f;
#pragma unroll
    for (int j = 0; j < 4; ++j) { v[j] = xr[64 * j]; s += (v[j].x * v[j].x + v[j].y * v[j].y) + (v[j].z * v[j].z + v[j].w * v[j].w); }
    const float rinv = 1.0f / sqrtf(wave_sum(s) * (1.f / 1024.f) + EPS);
    GAS u32x2* o8 = (GAS u32x2*)orow + lane;
#pragma unroll
    for (int j = 0; j < 4; ++j) { const f32x4 gg = gr[64 * j]; u32x2 w; w.x = pk2(v[j].x * rinv * gg.x, v[j].y * rinv * gg.y); w.y = pk2(v[j].z * rinv * gg.z, v[j].w * rinv * gg.w); o8[64 * j] = w; }
}
__device__ __forceinline__ void wave_lds_sync() { asm volatile("s_waitcnt lgkmcnt(0)" ::: "memory"); }
template <int NIN, int astride> __device__ __forceinline__ void mlp_layer(const float* W  , const float* bvec, const float* fvec, const LAS float* ain, LAS float* aout, int lane) {
    float w[64];
    unsigned ul = (unsigned)lane; asm volatile("" : "+v"(ul));
#pragma unroll
    for (int i = 0; i < 64; ++i) w[i] = (i < NIN) ? W[(unsigned)(i * 64) + ul] : 0.f;
    const float b = bvec[lane], fr = fvec[lane];
#pragma unroll 1
    for (int p = 0; p < 16; ++p) {
        const LAS float* ap = ain + p * astride; float s = b;
        if (NIN == 33) {
#pragma unroll
            for (int i = 0; i < 33; ++i) s += ap[i] * w[i];
        } else {
#pragma unroll
            for (int i4 = 0; i4 < 16; ++i4) { const f32x4 hv = *(const LAS f32x4*)(ap + 4 * i4); s += (hv.x * w[4 * i4] + hv.y * w[4 * i4 + 1]) + (hv.z * w[4 * i4 + 2] + hv.w * w[4 * i4 + 3]); }
        }
        aout[p * 64 + lane] = sinf(fr * s);
    }
    asm volatile("s_waitcnt lgkmcnt(0)" ::: "memory");
}
__device__ __forceinline__ void filter_mlp_wave(Frame& F, int pb, int half, unsigned lds_off) {
    const int lane = F.lane;
    asm volatile("" : "+v"(lds_off));
    LAS float* a0 = (LAS float*)(F.lds + lds_off); LAS float* a1 = a0 + 16 * 36; LAS float* a2 = a1 + 1024;
    for (int i = lane; i < 16 * 33; i += 64) { const int p = i / 33, j = i % 33, l = 16 * pb + p; float v;
        if (j == 0) v = (float)l / 4095.0f;
        else { const int q = (j - 1) & 15; const float fq = 1e-4f + (float)q * ((15.0f - 1e-4f) / 15.0f); const float ang = fq * ((2.0f * 3.14159265358979323846f / 4096.0f) * (float)l); v = (j <= 16) ? cosf(ang) : -sinf(ang); }
        a0[p * 36 + j] = v; }
    asm volatile("s_waitcnt lgkmcnt(0)" ::: "memory");
    mlp_layer<33, 36>(F.f_w_in, F.f_b_in, F.f_freq, a0, a1, lane);
    mlp_layer<64, 64>(F.f_w_mid, F.f_b_mid, F.f_freq + 64, a1, a2, lane);
    mlp_layer<64, 64>(F.f_w_mid + 4096, F.f_b_mid + 64, F.f_freq + 128, a2, a1, lane);
    float* KT = WSP(float, WS_KT);
#pragma unroll 1
    for (int m = half; m < 16; m += 4) { const int j = 64 * m + lane;
        float w[64]; unsigned uj = (unsigned)j; asm volatile("" : "+v"(uj));
#pragma unroll
        for (int i = 0; i < 64; ++i) w[i] = F.f_w_out[(unsigned)(i * 1024) + uj];
        const float mind = -3.0701134573253946f, maxd = -15.350567286626973f;
        const float delta = fabsf(mind + (float)(j & 511) * ((maxd - mind) / 511.0f));
        f32x4* o4 = (f32x4*)(KT + (size_t)j * 4096 + 16 * pb);
#pragma unroll 1
        for (int pg = 0; pg < 4; ++pg) {
            float acc[4];
#pragma unroll
            for (int q = 0; q < 4; ++q) { const LAS float* ap = a1 + (4 * pg + q) * 64; float sacc = 0.f;
#pragma unroll
                for (int i4 = 0; i4 < 16; ++i4) { const f32x4 hv = *(const LAS f32x4*)(ap + 4 * i4); sacc += (hv.x * w[4 * i4] + hv.y * w[4 * i4 + 1]) + (hv.z * w[4 * i4 + 2] + hv.w * w[4 * i4 + 3]); }
                acc[q] = sacc * __expf(-((float)(16 * pb + 4 * pg + q) / 4095.0f) * delta); }
            o4[pg] = (f32x4){acc[0], acc[1], acc[2], acc[3]};
        }
    }
}
constexpr int WD_HERE = 0;
__device__ __forceinline__ void phase_prologue(Frame& F) {
    { const int gt = F.bid * NTHREADS + F.tid;
      if (gt < 4096) { f32x2 w; w.x = cospif((float)gt * (1.0f / 2048.0f)); w.y = -sinpif((float)gt * (1.0f / 2048.0f)); WSP(f32x2, WS_TW4096)[gt] = w; }
      else if (gt < 8192) { const int n = gt - 4096; f32x2 w; w.x = cospif((float)n * (1.0f / 4096.0f)); w.y = -sinpif((float)n * (1.0f / 4096.0f)); WSP(f32x2, WS_TW8192)[n] = w; } }
    LAS unsigned* ticket = (LAS unsigned*)(F.lds + 158 * 1024);
    for (int rr_ = 0; rr_ < ((MK_DUP == 15) ? 2 : 1); ++rr_) {
    __syncthreads();
    if (F.tid == 0) ticket[0] = 0u;
    __syncthreads();
    if (F.wave >= 4 && rr_ == 0) { for (int pb = F.bid; pb < 256; pb += F.G) filter_mlp_wave(F, pb, F.wave - 4, (unsigned)((72 + 12 * (F.wave - 4)) * 1024)); }
    {
        LAS float* scr = (LAS float*)(F.lds + F.wave * 8704);
        constexpr int I_IN = 16 * 64, I_OUT = 16 * 32, I_G = 32 * 16 * 16, I_D = 32 * 8 * 32, I_RMS = T_TOK / 4;
        constexpr int NITEMS = I_IN + I_OUT + 2 * I_G + I_RMS + WD_HERE;
        bf16* WIN_T = WSP(bf16, WS_WIN_T); bf16* WOUT_T = WSP(bf16, WS_WOUT_T); unsigned char* WGU8 = WSP(unsigned char, WS_WGU_T); unsigned char* WD8 = WSP(unsigned char, WS_WD_T); bf16* HN = WSP(bf16, WS_HN);
        f32x4 gg[4];
#pragma unroll
        for (int j = 0; j < 4; ++j) gg[j] = ((const GAS f32x4*)F.norm1_g)[64 * j + F.lane];
        for (;;) {
            unsigned tk = 0; if (F.lane == 0) tk = __hip_atomic_fetch_add((unsigned*)ticket, 1u, __ATOMIC_RELAXED, __HIP_MEMORY_SCOPE_WORKGROUP);
            tk = __builtin_amdgcn_readfirstlane(tk);
            const long itl = (long)tk * F.G + F.vcu; if (itl >= NITEMS) break;
            int r = (int)itl;
            if (r < I_RMS) {
                const int m0 = 4 * r; f32x4 v[4][4];
#pragma unroll
                for (int q = 0; q < 4; ++q) { const GAS f32x4* xr = (const GAS f32x4*)(F.x + (size_t)(m0 + q) * 1024) + F.lane;
#pragma unroll
                    for (int j = 0; j < 4; ++j) v[q][j] = xr[64 * j]; }
#pragma unroll
                for (int q = 0; q < 4; ++q) { float s = 0.f;
#pragma unroll
                    for (int j = 0; j < 4; ++j) s += (v[q][j].x * v[q][j].x + v[q][j].y * v[q][j].y) + (v[q][j].z * v[q][j].z + v[q][j].w * v[q][j].w);
                    const float rinv = 1.0f / sqrtf(wave_sum(s) * (1.f / 1024.f) + EPS);
                    GAS u32x2* o8 = (GAS u32x2*)(HN + (size_t)(m0 + q) * 1024) + F.lane;
#pragma unroll
                    for (int j = 0; j < 4; ++j) { u32x2 w; w.x = pk2(v[q][j].x * rinv * gg[j].x, v[q][j].y * rinv * gg[j].y); w.y = pk2(v[q][j].z * rinv * gg[j].z, v[q][j].w * rinv * gg[j].w); o8[64 * j] = w; } }
                continue; } r -= I_RMS;
            if (r < I_IN) { const int kb = r / 64, nb = r % 64; transpose_item(F.w_in + (size_t)(64 * kb) * D_IN_PROJ + 32 * nb, D_IN_PROJ, WIN_T + (size_t)(32 * nb) * 1024 + 64 * kb, 1024, scr, F.lane); continue; } r -= I_IN;
            if (r < I_OUT) { const int kb = r / 32, nb = r % 32; transpose_item(F.w_out + (size_t)(64 * kb) * 1024 + 32 * nb, 1024, WOUT_T + (size_t)(32 * nb) * 1024 + 64 * kb, 1024, scr, F.lane); continue; } r -= I_OUT;
            if (r < 2 * I_G) { const int up = r / I_G; r %= I_G; const int e = r / 256, kb = (r % 256) / 16, nb = r % 16; const int n0 = 32 * nb;
                const float* W = (up ? F.w_up : F.w_gate) + (size_t)e * 1024 * 512 + (size_t)(64 * kb) * 512 + n0;
                const int orow = 256 * (n0 >> 7) + (n0 & 127) + (up ? 128 : 0);
                transpose_item_fp8(W, 512, WGU8 + ((size_t)e * 1024 + orow) * 1024 + 64 * kb, 1024, scr, F.lane, F.norm2_g + 64 * kb, W_SCALE); continue; } r -= 2 * I_G;
            { const int e = r / 256, kb = (r % 256) / 32, nb = r % 32;
              transpose_item_fp8(F.w_down + (size_t)e * 512 * 1024 + (size_t)(64 * kb) * 1024 + 32 * nb, 1024, WD8 + ((size_t)e * 1024 + 32 * nb) * 512 + 64 * kb, 512, scr, F.lane, nullptr, W_SCALE); }
        }
        (void)I_D;
    }
    }
    __syncthreads();
}
__device__ __forceinline__ void wdown_items(Frame& F, int first, int stride) {
    LAS float* scr = (LAS float*)(F.lds + F.wave * 8704); unsigned char* WD8 = WSP(unsigned char, WS_WD_T);
    for (int r = WD_HERE + first; r < 32 * 8 * 32; r += stride) { const int e = r / 256, kb = (r % 256) / 32, nb = r % 32;
        transpose_item_fp8(F.w_down + (size_t)e * 512 * 1024 + (size_t)(64 * kb) * 1024 + 32 * nb, 1024, WD8 + ((size_t)e * 1024 + 32 * nb) * 512 + 64 * kb, 512, scr, F.lane, nullptr, W_SCALE); }
}

__device__ __forceinline__ void load_tw_lds(Frame& F, int tw_off, int tw256_off) {
    __syncthreads();
    LAS f32x2* tw = (LAS f32x2*)(F.lds + tw_off); const f32x2* g = WSP(f32x2, WS_TW4096);
    f32x2 tv[8];
#pragma unroll
    for (int i = 0; i < 8; ++i) tv[i] = g[F.tid + NTHREADS * i];
    const f32x2 t2 = g[16 * (F.tid & 255)];
#pragma unroll
    for (int i = 0; i < 8; ++i) tw[F.tid + NTHREADS * i] = tv[i];
    if (F.tid < 256) ((LAS f32x2*)(F.lds + tw256_off))[F.tid] = t2;
    __syncthreads();
}
__device__ __forceinline__ void fft_fwd3(Frame& F) {
    LAS cf* buf = (LAS cf*)(F.lds + ((F.tid >> 8) ? L_BUFB : L_BUFA)); const LAS cf* tw = (const LAS cf*)(F.lds + L_TW); const LAS cf* t256 = (const LAS cf*)(F.lds + L_TW256); const int r = F.tid & 255;
    fft_pass_fwd<1>(buf, tw, t256, r); __syncthreads(); fft_pass_fwd<2>(buf, tw, t256, r); __syncthreads(); fft_pass_fwd<3>(buf, tw, t256, r); __syncthreads();
}
__device__ __forceinline__ void fft_inv3(Frame& F) {
    LAS cf* buf = (LAS cf*)(F.lds + ((F.tid >> 8) ? L_BUFB : L_BUFA)); const LAS cf* tw = (const LAS cf*)(F.lds + L_TW); const LAS cf* t256 = (const LAS cf*)(F.lds + L_TW256); const int r = F.tid & 255;
    fft_pass_inv<3>(buf, tw, t256, r); __syncthreads(); fft_pass_inv<2>(buf, tw, t256, r); __syncthreads(); fft_pass_inv<1>(buf, tw, t256, r); __syncthreads();
}
__device__ __forceinline__ void filter_item(Frame& F, int c) {
    LAS cf* bufA = (LAS cf*)(F.lds + L_BUFA); LAS cf* bufB = (LAS cf*)(F.lds + L_BUFB);
    LAS float* kfb = (LAS float*)(F.lds + L_SCR);
    LAS float* red = (LAS float*)(F.lds + L_RED);
    const float* KT = WSP(float, WS_KT); const f32x2* tw2 = WSP(f32x2, WS_TW8192);
    float sfv[8], sbv[8]; f32x2 wv[8];
#pragma unroll
    for (int i = 0; i < 8; ++i) { const int l = F.tid + NTHREADS * i; sfv[i] = KT[(size_t)c * 4096 + l]; sbv[i] = KT[(size_t)(512 + c) * 4096 + l]; wv[i] = tw2[l]; }
    float asum = 0.f;
#pragma unroll
    for (int i = 0; i < 8; ++i) { const int l = F.tid + NTHREADS * i; kfb[l] = sfv[i]; kfb[4096 + l] = sbv[i]; asum += fabsf(sfv[i]) + (l >= 1 ? fabsf(sbv[i]) : 0.f); }
    asum = wave_sum(asum);
    if (F.lane == 0) red[128 + F.wave] = asum;
    __syncthreads();
    float tot = 0.f;
#pragma unroll
    for (int i = 0; i < 8; ++i) tot += red[128 + i];
    const float sc = 1.0f / (tot * 8192.0f);
#pragma unroll
    for (int i = 0; i < 8; ++i) { const int n = F.tid + NTHREADS * i;
        const float kf = sfv[i], kbm = (n >= 1) ? kfb[4096 + 4096 - n] : 0.f;
        const float a = (kf + kbm) * sc, d = (kf - kbm) * sc;
        bufA[fpos(n)] = mkc(a, 0.f); bufB[fpos(n)] = mkc(d * wv[i].x, d * wv[i].y); }
    __syncthreads();
    fft_fwd3(F);
    f32x2* KF = WSP(f32x2, WS_KF) + (size_t)c * 8192;
    for (int p = F.tid; p < 4096; p += NTHREADS) { const cf a = bufA[fpos(p)], b = bufB[fpos(p)]; KF[p] = (f32x2){a.x, a.y}; KF[4096 + p] = (f32x2){b.x, b.y}; }
    __syncthreads();
}
__device__ __forceinline__ const bf16* pt_at(const bf16* PT, int row, int tok) { return PT + ((size_t)(tok >> 8) * NPT_ROWS + row) * 256 + (tok & 255); }
struct Row8 { u32x4 w; float lft, rgt; };
__device__ __forceinline__ Row8 row8_load(const bf16* PT, int row, int tb, int l0) {
    Row8 r; r.w = *(const u32x4*)pt_at(PT, row, tb + l0);
    const bf16 a = *pt_at(PT, row, tb + (l0 > 0 ? l0 - 1 : 0)), b = *pt_at(PT, row, tb + (l0 + 8 < 4096 ? l0 + 8 : 4095));
    r.lft = (l0 > 0) ? bf1(a) : 0.f; r.rgt = (l0 + 8 < 4096) ? bf1(b) : 0.f; return r;
}
__device__ __forceinline__ void conv8(const Row8& r, float w0, float w1, float w2, float b, float (&o)[8]) {
    float u[10];
    u[0] = r.lft; u[9] = r.rgt; const u32x4 v = r.w;
    u[1] = bflo(v.x); u[2] = bfhi(v.x); u[3] = bflo(v.y); u[4] = bfhi(v.y); u[5] = bflo(v.z); u[6] = bfhi(v.z); u[7] = bflo(v.w); u[8] = bfhi(v.w);
#pragma unroll
    for (int i = 0; i < 8; ++i) o[i] = b + w0 * u[i] + w1 * u[i + 1] + w2 * u[i + 2];
}
struct HyRaw { Row8 a0, v0, a1, v1; };
__device__ __forceinline__ void hy_load(Frame& F, int it, HyRaw& r) {
    const int c = it >> 2, bp = it & 3, l0 = 8 * F.tid; const bf16* PT = WSP(bf16, WS_PT);
    const int tb = 2 * bp * SEQ;
    r.a0 = row8_load(PT, 512 + c, tb, l0); r.v0 = row8_load(PT, 1024 + c, tb, l0); r.a1 = row8_load(PT, 512 + c, tb + SEQ, l0); r.v1 = row8_load(PT, 1024 + c, tb + SEQ, l0);
}
__device__ __forceinline__ void hyena_items(Frame& F) {
    LAS cf* bufA = (LAS cf*)(F.lds + L_BUFA); LAS cf* bufB = (LAS cf*)(F.lds + L_BUFB); const LAS cf* tw2 = (const LAS cf*)(F.lds + L_SCR);
    const bf16* PT = WSP(bf16, WS_PT); const float* cw = F.conv_w; const float* cb = F.conv_b;
    const int l0 = 8 * F.tid;
    HyRaw nx; int it = F.bid;
    if (it < 2048) hy_load(F, it, nx);
    for (; it < 2048; it += F.G) {
        const int c = it >> 2, bp = it & 3;
        float z0[8], z1[8];
        {
            const float a0 = cw[512 + c], a1 = cw[1536 + 512 + c], a2 = cw[3072 + 512 + c], ab = cb[512 + c];
            const float v0 = cw[1024 + c], v1 = cw[1536 + 1024 + c], v2 = cw[3072 + 1024 + c], vb = cb[1024 + c];
            float t1[8], t2[8];
            conv8(nx.a0, a0, a1, a2, ab, t1); conv8(nx.v0, v0, v1, v2, vb, t2);
#pragma unroll
            for (int i = 0; i < 8; ++i) z0[i] = t1[i] * t2[i];
            conv8(nx.a1, a0, a1, a2, ab, t1); conv8(nx.v1, v0, v1, v2, vb, t2);
#pragma unroll
            for (int i = 0; i < 8; ++i) z1[i] = t1[i] * t2[i];
        }
#pragma unroll
        for (int i = 0; i < 8; ++i) { const int l = l0 + i; const cf z = mkc(z0[i], z1[i]); bufA[fpos(l)] = z; bufB[fpos(l)] = cmul(z, tw2[l]); }
        f32x2 ke[8], ko[8];
        { const f32x2* KF = WSP(f32x2, WS_KF) + (size_t)c * 8192;
#pragma unroll
          for (int i = 0; i < 8; ++i) { ke[i] = KF[F.tid + 512 * i]; ko[i] = KF[4096 + F.tid + 512 * i]; } }
        __syncthreads();
        fft_fwd3(F);
#pragma unroll
        for (int i = 0; i < 8; ++i) { const int q = fpos(F.tid + 512 * i); bufA[q] = cmul(bufA[q], ke[i]); bufB[q] = cmul(bufB[q], ko[i]); }
        Row8 xa, xb;
        { const int tb = 2 * bp * SEQ; xa = row8_load(PT, c, tb, l0); xb = row8_load(PT, c, tb + SEQ, l0); }
        if (it + F.G < 2048) hy_load(F, it + F.G, nx);
        __syncthreads();
        fft_inv3(F);
        {
            const float w0 = cw[c], w1 = cw[1536 + c], w2 = cw[3072 + c], wb = cb[c]; const float bias = F.f_bias[c];
            bf16* YT = WSP(bf16, WS_YT) + (size_t)c * T_TOK + (size_t)(2 * bp) * SEQ;
            float x0a[8], x0b[8], ya[8], yb[8];
            conv8(xa, w0, w1, w2, wb, x0a); conv8(xb, w0, w1, w2, wb, x0b);
#pragma unroll
            for (int i = 0; i < 8; ++i) { const int l = l0 + i; const cf e = bufA[fpos(l)], o = bufB[fpos(l)]; const cf y = cadd(e, cmulc(o, tw2[l]));
                ya[i] = x0a[i] * (y.x + bias * z0[i]); yb[i] = x0b[i] * (y.y + bias * z1[i]); }
            u32x4 oa, ob; oa.x = pk2(ya[0], ya[1]); oa.y = pk2(ya[2], ya[3]); oa.z = pk2(ya[4], ya[5]); oa.w = pk2(ya[6], ya[7]);
            ob.x = pk2(yb[0], yb[1]); ob.y = pk2(yb[2], yb[3]); ob.z = pk2(yb[4], yb[5]); ob.w = pk2(yb[6], yb[7]);
            *(u32x4*)(YT + l0) = oa; *(u32x4*)(YT + SEQ + l0) = ob;
        }
        __syncthreads();
    }
}
struct FoRaw { u32x4 a0, d0, a1, d1; };
__device__ __forceinline__ void fo_load(Frame& F, int q, FoRaw& r) {
    const int f = F.tid >> 8, s = 2 * q + f, b = s >> 9, gc = s & 511, g = gc >> 6, cp = gc & 63, l0 = 16 * (F.tid & 255);
    const bf16* PT = WSP(bf16, WS_PT); const int r1 = 1536 + 128 * g + cp, r2 = r1 + 64, tk = b * SEQ + l0;
    r.a0 = *(const u32x4*)pt_at(PT, r1, tk); r.d0 = *(const u32x4*)pt_at(PT, r2, tk); r.a1 = *(const u32x4*)pt_at(PT, r1, tk + 8); r.d1 = *(const u32x4*)pt_at(PT, r2, tk + 8);
}
__device__ __forceinline__ void fo_put(LAS cf* buf, int l, u32x4 a, u32x4 d) {
    buf[fpos(l + 0)] = mkc(bflo(a.x), bflo(d.x)); buf[fpos(l + 1)] = mkc(bfhi(a.x), bfhi(d.x)); buf[fpos(l + 2)] = mkc(bflo(a.y), bflo(d.y)); buf[fpos(l + 3)] = mkc(bfhi(a.y), bfhi(d.y));
    buf[fpos(l + 4)] = mkc(bflo(a.z), bflo(d.z)); buf[fpos(l + 5)] = mkc(bfhi(a.z), bfhi(d.z)); buf[fpos(l + 6)] = mkc(bflo(a.w), bflo(d.w)); buf[fpos(l + 7)] = mkc(bfhi(a.w), bfhi(d.w));
}
__device__ __forceinline__ void fourier_items(Frame& F) {
    const int f = F.tid >> 8, r = F.tid & 255, l0 = 16 * r;
    LAS cf* buf = (LAS cf*)(F.lds + (f ? L_BUFB : L_BUFA));
    FoRaw nx; int q = F.bid;
    if (q < 2048) fo_load(F, q, nx);
    for (; q < 2048; q += F.G) {
        const int s = 2 * q + f, b = s >> 9, gc = s & 511;
        fo_put(buf, l0, nx.a0, nx.d0); fo_put(buf, l0 + 8, nx.a1, nx.d1);
        if (q + F.G < 2048) fo_load(F, q + F.G, nx);
        __syncthreads();
        fft_fwd3(F);
        bf16* YT = WSP(bf16, WS_YT) + (size_t)(512 + gc) * T_TOK + (size_t)b * SEQ;
        float y[16];
#pragma unroll
        for (int i = 0; i < 16; ++i) y[i] = buf[fpos(freq_pos(l0 + i))].x * (1.0f / 512.0f);
        u32x4 o0, o1; o0.x = pk2(y[0], y[1]); o0.y = pk2(y[2], y[3]); o0.z = pk2(y[4], y[5]); o0.w = pk2(y[6], y[7]);
        o1.x = pk2(y[8], y[9]); o1.y = pk2(y[10], y[11]); o1.z = pk2(y[12], y[13]); o1.w = pk2(y[14], y[15]);
        *(u32x4*)(YT + l0) = o0; *(u32x4*)(YT + l0 + 8) = o1;
        __syncthreads();
    }
}

#define MF_LO 1
constexpr int MF_NS = 288;
constexpr int MF_PS = 24;
constexpr int MF_PLANE = 6144;
typedef short bf16x8v __attribute__((ext_vector_type(8)));
typedef short s16x4v __attribute__((ext_vector_type(4)));
typedef float f32x16 __attribute__((ext_vector_type(16)));
struct DftFrag { bf16x8v hi[2], lo[2]; };
__device__ __forceinline__ void make_dft_frag(DftFrag& f, int lane, bool inv, const LAS cf* tw  ) {
    const int i = lane & 31, h = lane >> 5, ii = i & 15;
#pragma unroll
    for (int st = 0; st < 2; ++st)
#pragma unroll
        for (int j = 0; j < 8; ++j) { const int e = 8 * h + j; const int m = (ii * e) & 15; const cf w = tw[256 * m]; const float c = w.x, s = -w.y;
            const float di = inv ? s : -s;
            const float val = (st == 0) ? ((i < 16) ? c : di) : ((i < 16) ? -di : c);
            const unsigned hb = f2bf(val); const float rem = val - __builtin_bit_cast(float, hb << 16);
            f.hi[st][j] = (short)hb; f.lo[st][j] = (short)f2bf(rem); }
}
__device__ __forceinline__ unsigned cvtpk_v(float lo, float hi) { typedef float f32x2_t __attribute__((ext_vector_type(2))); typedef __bf16 bf16x2_t __attribute__((ext_vector_type(2))); const f32x2_t v = {lo, hi}; const bf16x2_t b = __builtin_convertvector(v, bf16x2_t); return __builtin_bit_cast(unsigned, b); }
__device__ __forceinline__ s16x4v lds_tr16(const LAS bf16* p) { typedef short v4i16_t __attribute__((ext_vector_type(4))); return __builtin_bit_cast(s16x4v, __builtin_amdgcn_ds_read_tr16_b64_v4i16((LAS v4i16_t*)p)); }
template <int PASS, bool INV, int EPI>
__device__ __forceinline__ void mfft_block(const LAS bf16* inR, const LAS bf16* inI, LAS bf16* outR, LAS bf16* outI, const DftFrag& M, const LAS cf* tw, const LAS cf* tw256, int cb, int lane, const cf* kf, float rs) {
    asm volatile("" : "+v"(lane));
    const int n = lane & 31, h = lane >> 5;
    bf16x8v bR, bI;
    if (PASS == 1) {
        const int g = lane >> 4, q = (lane & 15) >> 2, p = lane & 3;
        const int off = (8 * (g >> 1) + q) * MF_NS + 32 * cb + 16 * (g & 1) + 4 * p;
        const LAS bf16* pr = inR + off; const LAS bf16* pi = inI + off;
        const s16x4v r0 = lds_tr16(pr), r1 = lds_tr16(pr + 4 * MF_NS), i0 = lds_tr16(pi), i1 = lds_tr16(pi + 4 * MF_NS);
        asm volatile("" :: "v"(pr), "v"(pi) : "memory");
        bR = (bf16x8v){r0[0], r0[1], r0[2], r0[3], r1[0], r1[1], r1[2], r1[3]}; bI = (bf16x8v){i0[0], i0[1], i0[2], i0[3], i1[0], i1[1], i1[2], i1[3]};
    } else {
        const int off = (32 * cb + n) * MF_PS + 8 * h;
        bR = *(const LAS bf16x8v*)(inR + off); bI = *(const LAS bf16x8v*)(inI + off);
    }
    f32x16 acc = {0.f, 0.f, 0.f, 0.f, 0.f, 0.f, 0.f, 0.f, 0.f, 0.f, 0.f, 0.f, 0.f, 0.f, 0.f, 0.f};
    acc = __builtin_amdgcn_mfma_f32_32x32x16_bf16(M.hi[0], bR, acc, 0, 0, 0);
    acc = __builtin_amdgcn_mfma_f32_32x32x16_bf16(M.hi[1], bI, acc, 0, 0, 0);
#if MF_LO
    acc = __builtin_amdgcn_mfma_f32_32x32x16_bf16(M.lo[0], bR, acc, 0, 0, 0);
    acc = __builtin_amdgcn_mfma_f32_32x32x16_bf16(M.lo[1], bI, acc, 0, 0, 0);
#endif
    const int c = 32 * cb + n;
    int base, qs;
    if (PASS == 1) { base = MF_PS * (c & 15) + (c >> 4) + 64 * MF_PS * h; qs = 16 * MF_PS; }
    else if (PASS == 2) { base = 16 * MF_PS * (c >> 4) + (c & 15) + 4 * MF_PS * h; qs = MF_PS; }
    else { base = (c >> 4) + 16 * (c & 15) + 4 * MF_NS * h; qs = MF_NS; }
    float yr[8], yi[8];
#pragma unroll
    for (int q = 0; q < 8; ++q) { float a = acc[q], b = acc[8 + q];
        if (PASS == 1) { const int s = (q & 3) + 8 * (q >> 2) + 4 * h; const cf w = tw[(c * s) & 4095]; const float wy = INV ? -w.y : w.y; const float t = a * w.x - b * wy; b = a * wy + b * w.x; a = t; }
        else if (PASS == 2) { const int s = (q & 3) + 8 * (q >> 2) + 4 * h; const cf w = tw256[(c & 15) * s]; const float wy = INV ? -w.y : w.y; const float t = a * w.x - b * wy; b = a * wy + b * w.x; a = t; }
        else if (EPI == 1) { const cf w = kf[q]; const float t = a * w.x - b * w.y; b = -(a * w.y + b * w.x); a = t; }
        else if (EPI == 2) { a *= rs; }
        else if (EPI == 3) { a *= rs; b *= rs; }
        yr[q] = a; yi[q] = b; }
#pragma unroll
    for (int q = 0; q < 8; q += 2) { const int o0 = base + qs * ((q & 3) + 8 * (q >> 2)), o1 = o0 + qs;
        const unsigned pr = cvtpk_v(yr[q], yr[q + 1]); outR[o0] = (bf16)(pr & 0xffffu); outR[o1] = (bf16)(pr >> 16);
        if (!(PASS == 3 && EPI == 2)) { const unsigned pi = cvtpk_v(yi[q], yi[q + 1]); outI[o0] = (bf16)(pi & 0xffffu); outI[o1] = (bf16)(pi >> 16); } }
}

__device__ __forceinline__ int mf_nat(int x) { return MF_NS * (x >> 8) + (x & 255); }
__device__ __forceinline__ void fo2_load(Frame& F, int q, FoRaw& r) {
    const int f = F.tid >> 8, pp = 2 * q + f, b = pp >> 8, c = 2 * (pp & 255), l0 = 16 * (F.tid & 255);
    const bf16* PT = WSP(bf16, WS_PT); const int r1 = 1536 + c, r2 = r1 + 1, tk = b * SEQ + l0;
    r.a0 = *(const u32x4*)pt_at(PT, r1, tk); r.d0 = *(const u32x4*)pt_at(PT, r2, tk); r.a1 = *(const u32x4*)pt_at(PT, r1, tk + 8); r.d1 = *(const u32x4*)pt_at(PT, r2, tk + 8);
}
__device__ __forceinline__ void fourier_items_mfma(Frame& F) {
    const int f = F.tid >> 8, r = F.tid & 255, l0 = 16 * r, n0 = mf_nat(l0);
    LAS bf16* S0R = (LAS bf16*)(F.lds + f * 49152); LAS bf16* S0I = S0R + MF_PLANE; LAS bf16* S1R = S0R + 2 * MF_PLANE; LAS bf16* S1I = S0R + 3 * MF_PLANE;
    const LAS cf* tw = (const LAS cf*)(F.lds + M_TW); const LAS cf* t256 = (const LAS cf*)(F.lds + M_TW256);
    DftFrag Mf; make_dft_frag(Mf, F.lane, false, tw);
    const int cb0 = 2 * (F.wave & 3);
    bf16* SP = WSP(bf16, WS_SP);
    FoRaw nx; int q = F.bid;
    if (q < 1024) fo2_load(F, q, nx);
    for (; q < 1024; q += F.G) {
        const int pp = 2 * q + f, b = pp >> 8, c = 2 * (pp & 255);
        *(LAS u32x4*)(S0R + n0) = nx.a0; *(LAS u32x4*)(S0R + n0 + 8) = nx.a1; *(LAS u32x4*)(S0I + n0) = nx.d0; *(LAS u32x4*)(S0I + n0 + 8) = nx.d1;
        if (q + F.G < 1024) fo2_load(F, q + F.G, nx);
        __syncthreads();
        mfft_block<1, false, 0>(S0R, S0I, S1R, S1I, Mf, tw, t256, cb0, F.lane, nullptr, 1.f); mfft_block<1, false, 0>(S0R, S0I, S1R, S1I, Mf, tw, t256, cb0 + 1, F.lane, nullptr, 1.f);
        __syncthreads();
        mfft_block<2, false, 0>(S1R, S1I, S0R, S0I, Mf, tw, t256, cb0, F.lane, nullptr, 1.f); mfft_block<2, false, 0>(S1R, S1I, S0R, S0I, Mf, tw, t256, cb0 + 1, F.lane, nullptr, 1.f);
        __syncthreads();
        mfft_block<3, false, 0>(S0R, S0I, S1R, S1I, Mf, tw, t256, cb0, F.lane, nullptr, 1.f); mfft_block<3, false, 0>(S0R, S0I, S1R, S1I, Mf, tw, t256, cb0 + 1, F.lane, nullptr, 1.f);
        __syncthreads();
        {
            const int k0 = 8 * r, m0 = mf_nat(k0);
            const u32x4 zr = *(const LAS u32x4*)(S1R + m0), zi = *(const LAS u32x4*)(S1I + m0);
            float Zr[8], Zi[8], Mr[8], Mi[8];
            Zr[0] = bflo(zr.x); Zr[1] = bfhi(zr.x); Zr[2] = bflo(zr.y); Zr[3] = bfhi(zr.y); Zr[4] = bflo(zr.z); Zr[5] = bfhi(zr.z); Zr[6] = bflo(zr.w); Zr[7] = bfhi(zr.w);
            Zi[0] = bflo(zi.x); Zi[1] = bfhi(zi.x); Zi[2] = bflo(zi.y); Zi[3] = bfhi(zi.y); Zi[4] = bflo(zi.z); Zi[5] = bfhi(zi.z); Zi[6] = bflo(zi.w); Zi[7] = bfhi(zi.w);
#pragma unroll
            for (int i = 0; i < 8; ++i) { const int km = mf_nat((4096 - k0 - i) & 4095); Mr[i] = bf1(S1R[km]); Mi[i] = bf1(S1I[km]); }
            float Ac[8], Bc[8], Ad[8], Bd[8];
#pragma unroll
            for (int i = 0; i < 8; ++i) { Ac[i] = 0.5f * (Zr[i] + Mr[i]); Bc[i] = 0.5f * (Mi[i] - Zi[i]); Ad[i] = 0.5f * (Zi[i] + Mi[i]); Bd[i] = 0.5f * (Zr[i] - Mr[i]); }
            if (k0 == 0) { const int kn = mf_nat(2048); Bc[0] = bf1(S1R[kn]); Bd[0] = bf1(S1I[kn]); }
            bf16* s0 = SP + ((size_t)(c * 8 + b) * 2) * 2048 + k0; bf16* s1 = SP + ((size_t)((c + 1) * 8 + b) * 2) * 2048 + k0;
            u32x4 o; o.x = pk2(Ac[0], Ac[1]); o.y = pk2(Ac[2], Ac[3]); o.z = pk2(Ac[4], Ac[5]); o.w = pk2(Ac[6], Ac[7]); st16_wt(s0, o);
            o.x = pk2(Bc[0], Bc[1]); o.y = pk2(Bc[2], Bc[3]); o.z = pk2(Bc[4], Bc[5]); o.w = pk2(Bc[6], Bc[7]); st16_wt(s0 + 2048, o);
            o.x = pk2(Ad[0], Ad[1]); o.y = pk2(Ad[2], Ad[3]); o.z = pk2(Ad[4], Ad[5]); o.w = pk2(Ad[6], Ad[7]); st16_wt(s1, o);
            o.x = pk2(Bd[0], Bd[1]); o.y = pk2(Bd[2], Bd[3]); o.z = pk2(Bd[4], Bd[5]); o.w = pk2(Bd[6], Bd[7]); st16_wt(s1 + 2048, o);
        }
        __syncthreads();
    }
    __syncthreads();
}
__device__ __forceinline__ void hyena_items_mfma(Frame& F) {
    const int f = F.tid >> 8;
    LAS bf16* A0R = (LAS bf16*)F.lds; LAS bf16* A0I = A0R + MF_PLANE; LAS bf16* B0R = (LAS bf16*)(F.lds + 49152); LAS bf16* B0I = B0R + MF_PLANE;
    LAS bf16* S0R = (LAS bf16*)(F.lds + f * 49152); LAS bf16* S0I = S0R + MF_PLANE; LAS bf16* S1R = S0R + 2 * MF_PLANE; LAS bf16* S1I = S0R + 3 * MF_PLANE;
    const LAS cf* tw = (const LAS cf*)(F.lds + M_TW); const LAS cf* t256 = (const LAS cf*)(F.lds + M_TW256);
    const cf w81 = mkc(0.99999970586288221916f, -0.00076699031874270453f);
    DftFrag Mf; make_dft_frag(Mf, F.lane, false, tw);
    const bf16* PT = WSP(bf16, WS_PT); const float* cw = F.conv_w; const float* cb = F.conv_b;
    const int l0 = 8 * F.tid, n0 = mf_nat(l0), cb0 = 2 * (F.wave & 3), ln = F.lane & 31, lh = F.lane >> 5;
    HyRaw nx; int it = F.bid;
    if (it < 2048) hy_load(F, it, nx);
    for (; it < 2048; it += F.G) {
        const int c = it >> 2, bp = it & 3;
        float z0[8], z1[8];
        {
            const float a0 = cw[512 + c], a1 = cw[1536 + 512 + c], a2 = cw[3072 + 512 + c], ab = cb[512 + c];
            const float v0 = cw[1024 + c], v1 = cw[1536 + 1024 + c], v2 = cw[3072 + 1024 + c], vb = cb[1024 + c];
            float t1[8], t2[8];
            conv8(nx.a0, a0, a1, a2, ab, t1); conv8(nx.v0, v0, v1, v2, vb, t2);
#pragma unroll
            for (int i = 0; i < 8; ++i) z0[i] = t1[i] * t2[i];
            conv8(nx.a1, a0, a1, a2, ab, t1); conv8(nx.v1, v0, v1, v2, vb, t2);
#pragma unroll
            for (int i = 0; i < 8; ++i) z1[i] = t1[i] * t2[i];
        }
        {
            float br[8], bi[8];
#pragma unroll
            for (int i = 0; i < 8; ++i) { cf w = tw[(l0 >> 1) + (i >> 1)]; if (i & 1) w = cmul(w, w81); br[i] = z0[i] * w.x - z1[i] * w.y; bi[i] = z0[i] * w.y + z1[i] * w.x; }
            u32x4 v; v.x = pk2h(z0[0], z0[1]); v.y = pk2h(z0[2], z0[3]); v.z = pk2h(z0[4], z0[5]); v.w = pk2h(z0[6], z0[7]); *(LAS u32x4*)(A0R + n0) = v;
            v.x = pk2h(z1[0], z1[1]); v.y = pk2h(z1[2], z1[3]); v.z = pk2h(z1[4], z1[5]); v.w = pk2h(z1[6], z1[7]); *(LAS u32x4*)(A0I + n0) = v;
            v.x = pk2h(br[0], br[1]); v.y = pk2h(br[2], br[3]); v.z = pk2h(br[4], br[5]); v.w = pk2h(br[6], br[7]); *(LAS u32x4*)(B0R + n0) = v;
            v.x = pk2h(bi[0], bi[1]); v.y = pk2h(bi[2], bi[3]); v.z = pk2h(bi[4], bi[5]); v.w = pk2h(bi[6], bi[7]); *(LAS u32x4*)(B0I + n0) = v;
        }
        __syncthreads();
        mfft_block<1, false, 0>(S0R, S0I, S1R, S1I, Mf, tw, t256, cb0, F.lane, nullptr, 1.f); mfft_block<1, false, 0>(S0R, S0I, S1R, S1I, Mf, tw, t256, cb0 + 1, F.lane, nullptr, 1.f);
        cf kf[2][8];
        { const f32x4* KF = (const f32x4*)(WSP(f32x2, WS_KF) + (size_t)c * 8192 + (size_t)f * 4096);
#pragma unroll
          for (int j = 0; j < 2; ++j) { const int cc = 32 * (cb0 + j) + ln; const f32x4* kp = KF + (cc * 16 + 4 * lh) / 2;
              const f32x4 k0 = kp[0], k1 = kp[1], k2 = kp[4], k3 = kp[5];
              kf[j][0] = mkc(k0.x, k0.y); kf[j][1] = mkc(k0.z, k0.w); kf[j][2] = mkc(k1.x, k1.y); kf[j][3] = mkc(k1.z, k1.w);
              kf[j][4] = mkc(k2.x, k2.y); kf[j][5] = mkc(k2.z, k2.w); kf[j][6] = mkc(k3.x, k3.y); kf[j][7] = mkc(k3.z, k3.w); } }
        __syncthreads();
        mfft_block<2, false, 0>(S1R, S1I, S0R, S0I, Mf, tw, t256, cb0, F.lane, nullptr, 1.f); mfft_block<2, false, 0>(S1R, S1I, S0R, S0I, Mf, tw, t256, cb0 + 1, F.lane, nullptr, 1.f);
        __syncthreads();
        mfft_block<3, false, 1>(S0R, S0I, S1R, S1I, Mf, tw, t256, cb0, F.lane, kf[0], 1.f); mfft_block<3, false, 1>(S0R, S0I, S1R, S1I, Mf, tw, t256, cb0 + 1, F.lane, kf[1], 1.f);
        __syncthreads();
        mfft_block<1, false, 0>(S1R, S1I, S0R, S0I, Mf, tw, t256, cb0, F.lane, nullptr, 1.f); mfft_block<1, false, 0>(S1R, S1I, S0R, S0I, Mf, tw, t256, cb0 + 1, F.lane, nullptr, 1.f);
        __syncthreads();
        mfft_block<2, false, 0>(S0R, S0I, S1R, S1I, Mf, tw, t256, cb0, F.lane, nullptr, 1.f); mfft_block<2, false, 0>(S0R, S0I, S1R, S1I, Mf, tw, t256, cb0 + 1, F.lane, nullptr, 1.f);
        Row8 xa, xb;
        { const int tb = 2 * bp * SEQ; xa = row8_load(PT, c, tb, l0); xb = row8_load(PT, c, tb + SEQ, l0); }
        if (it + F.G < 2048) hy_load(F, it + F.G, nx);
        __syncthreads();
        mfft_block<3, false, 0>(S1R, S1I, S0R, S0I, Mf, tw, t256, cb0, F.lane, nullptr, 1.f); mfft_block<3, false, 0>(S1R, S1I, S0R, S0I, Mf, tw, t256, cb0 + 1, F.lane, nullptr, 1.f);
        __syncthreads();
        {
            const float w0 = cw[c], w1 = cw[1536 + c], w2 = cw[3072 + c], wb = cb[c]; const float bias = F.f_bias[c];
            bf16* YT = WSP(bf16, WS_YT) + (size_t)c * T_TOK + (size_t)(2 * bp) * SEQ;
            float x0a[8], x0b[8], ya[8], yb[8], er[8], ei[8], orr[8], oi[8];
            conv8(xa, w0, w1, w2, wb, x0a); conv8(xb, w0, w1, w2, wb, x0b);
            { const u32x4 a = *(const LAS u32x4*)(A0R + n0), b = *(const LAS u32x4*)(A0I + n0), d = *(const LAS u32x4*)(B0R + n0), g = *(const LAS u32x4*)(B0I + n0);
              er[0] = bflo(a.x); er[1] = bfhi(a.x); er[2] = bflo(a.y); er[3] = bfhi(a.y); er[4] = bflo(a.z); er[5] = bfhi(a.z); er[6] = bflo(a.w); er[7] = bfhi(a.w);
              ei[0] = bflo(b.x); ei[1] = bfhi(b.x); ei[2] = bflo(b.y); ei[3] = bfhi(b.y); ei[4] = bflo(b.z); ei[5] = bfhi(b.z); ei[6] = bflo(b.w); ei[7] = bfhi(b.w);
              orr[0] = bflo(d.x); orr[1] = bfhi(d.x); orr[2] = bflo(d.y); orr[3] = bfhi(d.y); orr[4] = bflo(d.z); orr[5] = bfhi(d.z); orr[6] = bflo(d.w); orr[7] = bfhi(d.w);
              oi[0] = bflo(g.x); oi[1] = bfhi(g.x); oi[2] = bflo(g.y); oi[3] = bfhi(g.y); oi[4] = bflo(g.z); oi[5] = bfhi(g.z); oi[6] = bflo(g.w); oi[7] = bfhi(g.w); }
#pragma unroll
            for (int i = 0; i < 8; ++i) { cf w = tw[(l0 >> 1) + (i >> 1)]; if (i & 1) w = cmul(w, w81);
                const float eim = -ei[i], oim = -oi[i];
                const float yr = er[i] + (orr[i] * w.x + oim * w.y), yi = eim + (oim * w.x - orr[i] * w.y);
                ya[i] = x0a[i] * (yr + bias * z0[i]); yb[i] = x0b[i] * (yi + bias * z1[i]); }
            u32x4 oa, ob; oa.x = pk2h(ya[0], ya[1]); oa.y = pk2h(ya[2], ya[3]); oa.z = pk2h(ya[4], ya[5]); oa.w = pk2h(ya[6], ya[7]);
            ob.x = pk2h(yb[0], yb[1]); ob.y = pk2h(yb[2], yb[3]); ob.z = pk2h(yb[4], yb[5]); ob.w = pk2h(yb[6], yb[7]);
            st16_wt(YT + l0, oa); st16_wt(YT + SEQ + l0, ob);
        }
        __syncthreads();
    }
}

__device__ __forceinline__ void phase_headnorm(Frame& F) {
    LAS float* tl = (LAS float*)F.lds;
    LAS float* rs = tl + 64 * 257;
    const bf16* YT = WSP(bf16, WS_YT); bf16* YN = WSP(bf16, WS_YN);
    u32x4 nxv[4];
    if (F.bid < 8 * 128) { const int h = F.bid & 7, tok0 = (F.bid >> 3) * 256;
#pragma unroll
        for (int i = 0; i < 4; ++i) { const int idx = F.tid + 512 * i, row = idx >> 5, ch = idx & 31; nxv[i] = *(const u32x4*)(YT + (size_t)(64 * h + row) * T_TOK + tok0 + 8 * ch); } }
    for (int it = F.bid; it < 8 * 128; it += F.G) {
        const int h = it & 7, tt = it >> 3, tok0 = tt * 256;
#pragma unroll
        for (int i = 0; i < 4; ++i) { const int idx = F.tid + 512 * i, row = idx >> 5, ch = idx & 31;
            const u32x4 v = nxv[i]; LAS float* d = tl + row * 257 + 8 * ch;
            d[0] = bflo(v.x); d[1] = bfhi(v.x); d[2] = bflo(v.y); d[3] = bfhi(v.y); d[4] = bflo(v.z); d[5] = bfhi(v.z); d[6] = bflo(v.w); d[7] = bfhi(v.w); }
        if (it + F.G < 8 * 128) { const int it2 = it + F.G, h2 = it2 & 7, tk2 = (it2 >> 3) * 256;
#pragma unroll
            for (int i = 0; i < 4; ++i) { const int idx = F.tid + 512 * i, row = idx >> 5, ch = idx & 31; nxv[i] = *(const u32x4*)(YT + (size_t)(64 * h2 + row) * T_TOK + tk2 + 8 * ch); } }
        __syncthreads();
        if (F.tid < 256) { float s = 0.f;
#pragma unroll 8
            for (int c = 0; c < 64; ++c) { const float v = tl[c * 257 + F.tid]; s += v * v; }
            rs[F.tid] = 1.0f / sqrtf(s * (1.0f / 64.0f) + EPS); }
        __syncthreads();
#pragma unroll
        for (int i = 0; i < 4; ++i) { const int idx = F.tid + 512 * i, tok = idx >> 3, q = idx & 7; const float r = rs[tok]; const float* g = F.mix_g + 64 * h + 8 * q;
            float v[8];
#pragma unroll
            for (int j = 0; j < 8; ++j) v[j] = tl[(8 * q + j) * 257 + tok] * r * g[j];
            u32x4 o; o.x = pk2(v[0], v[1]); o.y = pk2(v[2], v[3]); o.z = pk2(v[4], v[5]); o.w = pk2(v[6], v[7]);
            st16_wt(YN + (size_t)(tok0 + tok) * 1024 + 64 * h + 8 * q, o); }
        __syncthreads();
    }
}

constexpr int MX_NS = 288, MX_XA = 0, MX_XB = 64 * MX_NS * 2, MX_MT = 2 * MX_XB, MX_MTLO = MX_MT + 32768, MX_NYQ = MX_MTLO + 32768, MX_SLOT = 144;
__device__ __forceinline__ void mix_load(Frame& F, int tile, u32x4 (&v)[8]) {
    const int b = tile >> 6, g = (tile >> 3) & 7, kt = tile & 7; const bf16* SP = WSP(bf16, WS_SP);
#pragma unroll
    for (int u = 0; u < 8; ++u) { const int idx = F.tid + NTHREADS * u, row = idx >> 5, ch = idx & 31, ab = row >> 6, c = row & 63;
        v[u] = *(const u32x4*)(SP + ((size_t)((64 * g + c) * 8 + b) * 2 + ab) * 2048 + 256 * kt + 8 * ch); }
}
__device__ __forceinline__ void fourier_mix(Frame& F) {
    LAS bf16* XA = (LAS bf16*)(F.lds + MX_XA); LAS bf16* XB = (LAS bf16*)(F.lds + MX_XB);
    LAS u32x4* MT = (LAS u32x4*)(F.lds + MX_MT); LAS u32x4* MTL = (LAS u32x4*)(F.lds + MX_MTLO); LAS float* nyq = (LAS float*)(F.lds + MX_NYQ);
    LAS unsigned char* STG = F.lds;
    const bf16* SP = WSP(bf16, WS_SP); bf16* YN = WSP(bf16, WS_YN);
    LAS float* cst = nyq + 64;
    __syncthreads();
    if (F.tid < 64) { cst[F.tid] = cospif((float)F.tid * (1.0f / 32.0f)); cst[64 + F.tid] = sinpif((float)F.tid * (1.0f / 32.0f)); }
    __syncthreads();
    for (int idx = F.tid; idx < 32 * 64; idx += NTHREADS) { const int lane = idx & 63, fs = idx >> 6, rb = fs >> 3, s = fs & 7, i = lane & 31, h = lane >> 5;
        unsigned hw[4], lw[4];
#pragma unroll
        for (int jj = 0; jj < 4; ++jj) { unsigned hh[2], ll[2];
#pragma unroll
            for (int u = 0; u < 2; ++u) { const int j = 2 * jj + u, kap = 16 * s + 8 * h + j, c = kap & 63, isB = kap >> 6, cpp = 32 * rb + i, cp = cpp & 63, mir = cpp >> 6;
                const int m = (c * cp) & 63; const float cv = cst[m], sv = cst[64 + m];
                const float val = (isB ? (mir ? sv : -sv) : cv) * (1.0f / 512.0f);
                hh[u] = f2bf(val); ll[u] = f2bf(val - __builtin_bit_cast(float, hh[u] << 16)); }
            hw[jj] = hh[0] | (hh[1] << 16); lw[jj] = ll[0] | (ll[1] << 16); }
        MT[idx] = (u32x4){hw[0], hw[1], hw[2], hw[3]}; MTL[idx] = (u32x4){lw[0], lw[1], lw[2], lw[3]}; }
    u32x4 nxv[8];
    if (F.bid < 512) mix_load(F, F.bid, nxv);
    for (int tile = F.bid; tile < 512; tile += F.G) {
        const int b = tile >> 6, g = (tile >> 3) & 7, kt = tile & 7;
        __syncthreads();
#pragma unroll
        for (int u = 0; u < 8; ++u) { const int idx = F.tid + NTHREADS * u, row = idx >> 5, ch = idx & 31, ab = row >> 6, c = row & 63;
            u32x4 v = nxv[u];
            if (kt == 0 && ab == 1 && ch == 0) { nyq[c] = bflo(v.x); v.x &= 0xffff0000u; }
            *(LAS u32x4*)((ab ? XB : XA) + c * MX_NS + 8 * ch) = v; }
        if (tile + F.G < 512) mix_load(F, tile + F.G, nxv);
        __syncthreads();
        f32x16 acc[4];
#pragma unroll
        for (int rb = 0; rb < 4; ++rb) acc[rb] = (f32x16){0.f, 0.f, 0.f, 0.f, 0.f, 0.f, 0.f, 0.f, 0.f, 0.f, 0.f, 0.f, 0.f, 0.f, 0.f, 0.f};
        { int lane = F.lane; asm volatile("" : "+v"(lane));
          const int gq = lane >> 4, q = (lane & 15) >> 2, p = lane & 3;
#pragma unroll
          for (int s = 0; s < 8; ++s) {
              const LAS bf16* pr = ((s < 4) ? XA : XB) + (16 * (s & 3) + 8 * (gq >> 1) + q) * MX_NS + 32 * F.wave + 16 * (gq & 1) + 4 * p;
              const s16x4v r0 = lds_tr16(pr), r1 = lds_tr16(pr + 4 * MX_NS);
              asm volatile("" :: "v"(pr) : "memory");
              const bf16x8v bfr = (bf16x8v){r0[0], r0[1], r0[2], r0[3], r1[0], r1[1], r1[2], r1[3]};
#pragma unroll
              for (int rb = 0; rb < 4; ++rb) { const bf16x8v mh = __builtin_bit_cast(bf16x8v, MT[(rb * 8 + s) * 64 + lane]), ml = __builtin_bit_cast(bf16x8v, MTL[(rb * 8 + s) * 64 + lane]);
                  acc[rb] = __builtin_amdgcn_mfma_f32_32x32x16_bf16(mh, bfr, acc[rb], 0, 0, 0); acc[rb] = __builtin_amdgcn_mfma_f32_32x32x16_bf16(ml, bfr, acc[rb], 0, 0, 0); } } }
        float sk = 0.f, sm = 0.f;
#pragma unroll
        for (int r = 0; r < 16; ++r) { sk += acc[0][r] * acc[0][r] + acc[1][r] * acc[1][r]; sm += acc[2][r] * acc[2][r] + acc[3][r] * acc[3][r]; }
        sk += __shfl_xor(sk, 32); sm += __shfl_xor(sm, 32);
        const float rk = 1.0f / sqrtf(sk * (1.0f / 64.0f) + EPS), rm = 1.0f / sqrtf(sm * (1.0f / 64.0f) + EPS);
        __syncthreads();
        { const int n = F.lane & 31, hi = F.lane >> 5; const float* mg = F.mix_g + 512 + 64 * g;
#pragma unroll
          for (int rb = 0; rb < 4; ++rb) { const int slot = 32 * F.wave + n + ((rb >> 1) ? 256 : 0); const float rr = (rb >> 1) ? rm : rk;
#pragma unroll
              for (int rg = 0; rg < 4; ++rg) { const int cp = 32 * (rb & 1) + 8 * rg + 4 * hi; const f32x4 gg = *(const f32x4*)(mg + cp);
                  u32x2 w; w.x = pk2(acc[rb][4 * rg] * rr * gg.x, acc[rb][4 * rg + 1] * rr * gg.y); w.y = pk2(acc[rb][4 * rg + 2] * rr * gg.z, acc[rb][4 * rg + 3] * rr * gg.w);
                  *(LAS u32x2*)(STG + slot * MX_SLOT + 2 * cp) = w; } } }
        __syncthreads();
#pragma unroll
        for (int u = 0; u < 8; ++u) { const int idx = F.tid + NTHREADS * u, slot = idx >> 3, ch = idx & 7; const int kk = 256 * kt + (slot & 255);
            const int tok = b * SEQ + ((slot < 256) ? kk : (4096 - kk));
            if (!(slot >= 256 && kk == 0)) st16_wt(YN + (size_t)tok * 1024 + 512 + 64 * g + 8 * ch, *(const LAS u32x4*)(STG + slot * MX_SLOT + 16 * ch)); }
        if (kt == 0 && F.wave == 0) {
            const int cp = F.lane; float y = 0.f;
            for (int c = 0; c < 64; ++c) y += nyq[c] * cst[(c * cp) & 63];
            y *= (1.0f / 512.0f);
            const float r2 = 1.0f / sqrtf(wave_sum(y * y) * (1.0f / 64.0f) + EPS);
            YN[(size_t)(b * SEQ + 2048) * 1024 + 512 + 64 * g + cp] = (bf16)f2bf(y * r2 * F.mix_g[512 + 64 * g + cp]);
        }
    }
    __syncthreads();
}

__device__ __forceinline__ float wave_reduce8(const float (&a)[8], int lane) {
    const bool h5 = (lane & 32) != 0, h4 = (lane & 16) != 0, h3 = (lane & 8) != 0;
    float b[4], c[2], d;
#pragma unroll
    for (int i = 0; i < 4; ++i) { const float snd = h5 ? a[i] : a[4 + i], keep = h5 ? a[4 + i] : a[i]; b[i] = keep + __shfl_xor(snd, 32); }
#pragma unroll
    for (int i = 0; i < 2; ++i) { const float snd = h4 ? b[i] : b[2 + i], keep = h4 ? b[2 + i] : b[i]; c[i] = keep + __shfl_xor(snd, 16); }
    { const float snd = h3 ? c[0] : c[1], keep = h3 ? c[1] : c[0]; d = keep + __shfl_xor(snd, 8); }
    d += __shfl_xor(d, 4); d += __shfl_xor(d, 2); d += __shfl_xor(d, 1);
    return d;
}
__device__ __forceinline__ float rdlane(float v, int l) { return __builtin_bit_cast(float, __builtin_amdgcn_readlane(__builtin_bit_cast(int, v), l)); }
__device__ __forceinline__ void phase_route(Frame& F, const bf16* X1) {
    LAS float* slab = (LAS float*)F.lds;
    LAS float* fin = (LAS float*)(F.lds + 106496);
    LAS int* lcnt = (LAS int*)(F.lds + 147456);
    LAS int* lbase = lcnt + 32;
    LAS int* pe = lcnt + 64;
    LAS float* pw = (LAS float*)(pe + 256);
    LAS float* prr = pw + 256;
    LAS int* prow = (LAS int*)(prr + 256);
    LAS float* lbr = (LAS float*)(prow + 256);
    int* TOT = WSP(int, WS_TOT); int* LIST = WSP(int, WS_LIST); float* ROWW = WSP(float, WS_ROWW); float* ROWR = WSP(float, WS_ROWR);
    unsigned char* X1Q = WSP(unsigned char, WS_X1Q);
    const int n = F.lane & 15, fq = F.lane >> 4, w = F.wave;
    __syncthreads();
    if (F.tid < 32) lbr[F.tid] = F.b_router[F.tid];
    bf16x8v bh[4][3], bl[4][3];
#pragma unroll
    for (int s_ = 0; s_ < 4; ++s_)
#pragma unroll
        for (int c = 0; c < 3; ++c) { const int col = 16 * c + n;
#pragma unroll
            for (int j = 0; j < 8; ++j) { const int k = 128 * w + 32 * s_ + 8 * fq + j; float val = 0.f;
                if (col < 4) val = F.w_group[k * 4 + col]; else if (col < 36) val = F.w_router[((col - 4) >> 3) * 8192 + k * 8 + ((col - 4) & 7)];
                val *= F.norm2_g[k];
                const unsigned hb = f2bf(val); const float rem = val - __builtin_bit_cast(float, hb << 16);
                bh[s_][c][j] = (short)hb; bl[s_][c][j] = (short)f2bf(rem); } }
    const float bg0 = F.b_group[0], bg1 = F.b_group[1], bg2 = F.b_group[2], bg3 = F.b_group[3];
    for (int blk = F.bid; blk < 256; blk += F.G) {
        __syncthreads();
        if (F.tid < 32) lcnt[F.tid] = 0;
        __syncthreads();
        u32x4 a[2][2][4];
#define RT_LOAD(buf, pr) do { _Pragma("unroll") for (int tl_ = 0; tl_ < 2; ++tl_) { const GAS u32x4* xr = (const GAS u32x4*)(X1 + (size_t)(blk * 128 + (pr) * 32 + tl_ * 16 + n) * 1024 + 128 * w + 8 * fq); \
            _Pragma("unroll") for (int s_ = 0; s_ < 4; ++s_) a[buf][tl_][s_] = xr[4 * s_]; } } while (0)
        RT_LOAD(0, 0); RT_LOAD(1, 1);
#pragma unroll
        for (int pr = 0; pr < 4; ++pr) {
#pragma unroll
            for (int tl_ = 0; tl_ < 2; ++tl_) {
                const int tloc = (pr & 1) * 32 + tl_ * 16;
                const int tok = blk * 128 + pr * 32 + tl_ * 16 + n;
                f32x4 acc[3];
#pragma unroll
                for (int c = 0; c < 3; ++c) acc[c] = (f32x4){0.f, 0.f, 0.f, 0.f};
                float ss = 0.f;
#pragma unroll
                for (int s_ = 0; s_ < 4; ++s_) { const u32x4 av = a[pr & 1][tl_][s_]; const bf16x8v ab = __builtin_bit_cast(bf16x8v, av);
#pragma unroll
                    for (int c = 0; c < 3; ++c) { acc[c] = __builtin_amdgcn_mfma_f32_16x16x32_bf16(ab, bh[s_][c], acc[c], 0, 0, 0); acc[c] = __builtin_amdgcn_mfma_f32_16x16x32_bf16(ab, bl[s_][c], acc[c], 0, 0, 0); }
                    const float x0 = bflo(av.x), x1_ = bfhi(av.x), x2 = bflo(av.y), x3 = bfhi(av.y), x4 = bflo(av.z), x5 = bfhi(av.z), x6 = bflo(av.w), x7 = bfhi(av.w);
                    ss += ((x0 * x0 + x1_ * x1_) + (x2 * x2 + x3 * x3)) + ((x4 * x4 + x5 * x5) + (x6 * x6 + x7 * x7));
                    u32x2 o; o.x = pk4_fp8s(x0, x1_, x2, x3, 1.0f); o.y = pk4_fp8s(x4, x5, x6, x7, 1.0f);
                    *(GAS u32x2*)(X1Q + (size_t)tok * 1024 + 128 * w + 32 * s_ + 8 * fq) = o; }
                LAS float* sl = slab + ((w * 64 + tloc + 4 * fq) * 52 + n);
#pragma unroll
                for (int c = 0; c < 3; ++c)
#pragma unroll
                    for (int q = 0; q < 4; ++q) sl[q * 52 + 16 * c] = acc[c][q];
                ss += __shfl_xor(ss, 16); ss += __shfl_xor(ss, 32);
                if (fq == 0) slab[(w * 64 + tloc + n) * 52 + 48] = ss;
            }
            if (pr + 2 < 4) RT_LOAD(pr & 1, pr + 2);
            if (pr & 1) {
                __syncthreads();
                { const int tk = F.tid & 63, p = F.tid >> 6;
#pragma unroll
                  for (int i = 0; i < 5; ++i) { const int ci = p + 8 * i; if (ci < 37) { const int col = ci < 36 ? ci : 48; float sum = 0.f;
#pragma unroll
                          for (int ww = 0; ww < 8; ++ww) sum += slab[(ww * 64 + tk) * 52 + col];
                          fin[tk * 41 + ci] = sum; } } }
                __syncthreads();
                if (F.tid < 64) { const LAS float* f = fin + F.tid * 41;
                    const float rinv = 1.0f / sqrtf(f[36] * (1.f / 1024.f) + EPS);
                    const float gl0 = f[0] * rinv + bg0, gl1 = f[1] * rinv + bg1, gl2 = f[2] * rinv + bg2, gl3 = f[3] * rinv + bg3;
                    int gs = 0; float gm = gl0; if (gl1 > gm) { gm = gl1; gs = 1; } if (gl2 > gm) { gm = gl2; gs = 2; } if (gl3 > gm) { gm = gl3; gs = 3; }
                    const float pg = 1.0f / (expf(gl0 - gm) + expf(gl1 - gm) + expf(gl2 - gm) + expf(gl3 - gm));
                    float er[8];
#pragma unroll
                    for (int e = 0; e < 8; ++e) er[e] = f[4 + 8 * gs + e] * rinv + lbr[gs * 8 + e];
                    int i1 = 0; float m1 = er[0];
#pragma unroll
                    for (int e = 1; e < 8; ++e) if (er[e] > m1) { m1 = er[e]; i1 = e; }
                    int i2 = -1; float m2 = -3.0e38f;
#pragma unroll
                    for (int e = 0; e < 8; ++e) if (e != i1 && er[e] > m2) { m2 = er[e]; i2 = e; }
                    const float e2 = expf(m2 - m1); const float wa1 = pg / (1.0f + e2), wa2 = pg * e2 / (1.0f + e2);
                    const int lp = 2 * ((pr >> 1) * 64 + F.tid); pe[lp] = gs * 8 + i1; pe[lp + 1] = gs * 8 + i2; pw[lp] = wa1; pw[lp + 1] = wa2; prr[lp] = rinv; prr[lp + 1] = rinv;
                    atomicAdd((int*)&lcnt[gs * 8 + i1], 1); atomicAdd((int*)&lcnt[gs * 8 + i2], 1); }
            }
        }
#undef RT_LOAD
        __syncthreads();
        if (F.tid < 32) lbase[F.tid] = atomicAdd(&TOT[F.tid], lcnt[F.tid]);
        __syncthreads();
        if (F.tid < 32) { int nn = lbase[F.tid]; for (int p = 0; p < 256; ++p) if (pe[p] == F.tid) prow[p] = nn++; }
        __syncthreads();
        if (F.tid < 256) { const int row = pe[F.tid] * ECAP + prow[F.tid]; LIST[row] = blk * 256 + F.tid; ROWW[row] = pw[F.tid]; ROWR[row] = prr[F.tid]; }
    }
    __syncthreads();
}

__device__ __forceinline__ int build_tiles(Frame& F) {
    LAS int* tl = (LAS int*)(F.lds + L_TILES); LAS int* tnv = tl + MAX_TILES; LAS int* misc = tnv + MAX_TILES;
    const int* TOT = WSP(int, WS_TOT);
    __syncthreads();
    if (F.tid < 32) misc[33 + F.tid] = TOT[F.tid];
    __syncthreads();
    if (F.tid == 0) { int s = 0; for (int e = 0; e < 32; ++e) { misc[e] = s; s += (misc[33 + e] + 255) >> 8; } misc[32] = s; }
    __syncthreads();
    if (F.tid < 32) { const int e = F.tid, tot = misc[33 + e]; for (int j = 0, t = misc[e]; t < misc[e + 1]; ++j, ++t) { tl[t] = e * ECAP + 256 * j; tnv[t] = (tot - 256 * j) < 256 ? (tot - 256 * j) : 256; } }
    __syncthreads();
    return misc[32];
}

__device__ __forceinline__ void phase_final(Frame& F, const bf16* X1, float* OUT) {
    typedef float f2v __attribute__((ext_vector_type(2)));
    const int gw = F.vcu * NWAVES + F.wave, NGW = F.G * NWAVES; const unsigned char* YP = WSP(unsigned char, WS_YP);
    f32x4 gg[4];
#pragma unroll
    for (int j = 0; j < 4; ++j) gg[j] = ((const GAS f32x4*)F.final_g)[64 * j + F.lane];
    for (int t0 = 4 * gw; t0 < T_TOK; t0 += 4 * NGW) {
        u32x2 xw[4][4]; unsigned ya[4][4], yb[4][4];
#pragma unroll
        for (int r = 0; r < 4; ++r) { const int t = t0 + r;
            const GAS u32x2* xr = (const GAS u32x2*)(X1 + (size_t)t * 1024) + F.lane;
            const GAS unsigned* y0 = (const GAS unsigned*)(YP + (size_t)(2 * t) * 1024) + F.lane; const GAS unsigned* y1 = (const GAS unsigned*)(YP + (size_t)(2 * t + 1) * 1024) + F.lane;
#pragma unroll
            for (int j = 0; j < 4; ++j) { xw[r][j] = xr[64 * j]; ya[r][j] = y0[64 * j]; yb[r][j] = y1[64 * j]; } }
#pragma unroll
        for (int r = 0; r < 4; ++r) { const int t = t0 + r; GAS f32x4* orow = (GAS f32x4*)(OUT + (size_t)t * 1024) + F.lane;
            f32x4 v[4]; float s = 0.f;
#pragma unroll
            for (int j = 0; j < 4; ++j) { const u32x2 x = xw[r][j];
                const f2v a0 = __builtin_amdgcn_cvt_pk_f32_fp8((int)ya[r][j], false), a1 = __builtin_amdgcn_cvt_pk_f32_fp8((int)ya[r][j], true);
                const f2v b0 = __builtin_amdgcn_cvt_pk_f32_fp8((int)yb[r][j], false), b1 = __builtin_amdgcn_cvt_pk_f32_fp8((int)yb[r][j], true);
                const float is = 1.0f / pg8::YP_SCALE;
                v[j].x = bflo(x.x) + (a0[0] + b0[0]) * is; v[j].y = bfhi(x.x) + (a0[1] + b0[1]) * is; v[j].z = bflo(x.y) + (a1[0] + b1[0]) * is; v[j].w = bfhi(x.y) + (a1[1] + b1[1]) * is;
                s += (v[j].x * v[j].x + v[j].y * v[j].y) + (v[j].z * v[j].z + v[j].w * v[j].w); }
            const float rinv = 1.0f / sqrtf(wave_sum(s) * (1.f / 1024.f) + EPS);
#pragma unroll
            for (int j = 0; j < 4; ++j) { f32x4 o; o.x = v[j].x * rinv * gg[j].x; o.y = v[j].y * rinv * gg[j].y; o.z = v[j].z * rinv * gg[j].z; o.w = v[j].w * rinv * gg[j].w; orow[64 * j] = o; } }
    }
}

constexpr int N_PHASES = 10;
#ifndef MK_STAGGER1
#define MK_STAGGER1 0
#endif
struct Args { const float* in[23]; float* out; unsigned char* ws; int ph_lo, ph_hi; };
static_assert(sizeof(Args) == 23 * 8 + 8 + 8 + 8, "Args has no padding");

__global__ void __launch_bounds__(NTHREADS, 2) mk_fwd(Args args) {
    extern __shared__ __attribute__((aligned(16))) unsigned char lds_raw[];
    Frame F;
    F.lds = (LAS unsigned char*)lds_raw; F.ws = args.ws;
    F.tid = threadIdx.x; F.lane = F.tid & 63; F.wave = __builtin_amdgcn_readfirstlane(F.tid >> 6);
    F.G = gridDim.x; F.bid = blockIdx.x; F.vcu = (F.G % 8 == 0) ? (F.bid % 8) * (F.G / 8) + F.bid / 8 : F.bid;
    F.x = args.in[0]; F.norm1_g = args.in[1]; F.w_in = args.in[2]; F.conv_w = args.in[3]; F.conv_b = args.in[4]; F.f_w_in = args.in[5]; F.f_b_in = args.in[6];
    F.f_w_mid = args.in[7]; F.f_b_mid = args.in[8]; F.f_freq = args.in[9]; F.f_w_out = args.in[10]; F.f_bias = args.in[11]; F.mix_g = args.in[12]; F.w_out = args.in[13];
    F.norm2_g = args.in[14]; F.w_group = args.in[15]; F.b_group = args.in[16]; F.w_router = args.in[17]; F.b_router = args.in[18]; F.w_gate = args.in[19]; F.w_up = args.in[20];
    F.w_down = args.in[21]; F.final_g = args.in[22]; F.out = args.out;
    volatile LAS unsigned* bst = (volatile LAS unsigned*)(F.lds + BARST_OFF);
    if (F.tid < 16) bst[F.tid] = 0u;
    __syncthreads();
    const int lo = args.ph_lo, hi = args.ph_hi;
    const bool need_bar = (hi - lo) > 1;
    XcdBarrier bar; bar.bar = (unsigned*)(F.ws + WS_CTL); bar.x = 0; bar.st = bst;
    if (need_bar) bar = xcd_barrier_post((unsigned*)(F.ws + WS_CTL), bst);
#define IN(k) (lo <= (k) && (k) < hi)
#ifndef MK_DUP
#define MK_DUP -1
#endif
#define REPS(k) (((k) == MK_DUP) ? 2 : 1)
#define SEAM(k) do { if (IN(k) && IN((k) + 1)) xcd_barrier(bar); } while (0)
    bf16* X1 = WSP(bf16, WS_X1);

    if (IN(0)) for (int rep_ = 0; rep_ < REPS(0); ++rep_) { if (rep_) xcd_barrier(bar); phase_prologue(F); } SEAM(0);

    if (IN(1)) {
        pg8::StaticOrder S; S.init(F.ws + WS_WIN_T, F.ws + WS_HN, NPT_ROWS, T_TOK, 1024, F.G, F.bid); S.reps = (MK_DUP == 11) ? 2 : REPS(1);
        pg8::EpiStorePT E{WSP(bf16, WS_PT), NPT_ROWS};
        int fc = F.bid; const bool pre = MK_STAGGER1 && ((F.bid >> 3) & 1);
        if (pre && fc < 512) { load_tw_lds(F, L_TW, L_TW256); filter_item(F, fc); fc += F.G; __syncthreads(); }
        pg8::gemm_phase<pg8::EpiStorePT, pg8::StaticOrder>(F.lds, 1024, S, E);
        load_tw_lds(F, L_TW, L_TW256);
        for (; fc < 512; fc += F.G) filter_item(F, fc);
    } SEAM(1);

    if (IN(2)) for (int rep_ = 0; rep_ < REPS(2); ++rep_) { if (rep_) xcd_barrier(bar);
        load_tw_lds(F, M_TW, M_TW256);
        hyena_items_mfma(F);
        fourier_items_mfma(F);
    } SEAM(2);

    if (IN(3)) for (int rep_ = 0; rep_ < REPS(3); ++rep_) { if (rep_) xcd_barrier(bar); phase_headnorm(F); if (MK_DUP == 13) phase_headnorm(F); for (int rr_ = 0; rr_ < ((MK_DUP == 14) ? 2 : 1); ++rr_) fourier_mix(F); } SEAM(3);

    if (IN(4)) for (int rep_ = 0; rep_ < REPS(4); ++rep_) { if (rep_) xcd_barrier(bar);
        pg8::StaticOrder S; S.init(F.ws + WS_YN, F.ws + WS_WOUT_T, T_TOK, 1024, 1024, F.G, F.bid);
        pg8::EpiResBf16 E{F.x, X1, 1024};
        pg8::gemm_phase<pg8::EpiResBf16, pg8::StaticOrder>(F.lds, 1024, S, E);
    } SEAM(4);

    if (IN(5)) { phase_route(F, X1); } if (IN(5) && IN(7)) xcd_barrier(bar);


    if (IN(7)) for (int rep_ = 0; rep_ < REPS(7); ++rep_) { if (rep_) xcd_barrier(bar);
        const int ntiles = __builtin_amdgcn_readfirstlane(build_tiles(F)); const LAS int* tl = (const LAS int*)(F.lds + L_TILES);
        pg8::MoeGatherOrder S; S.init(F.ws + WS_X1Q, F.ws + WS_WGU_T, tl, tl + MAX_TILES, WSP(int, WS_LIST), ntiles, 1024, F.G, F.bid, 1);
        pg8::EpiSwiGLU E{WSP(unsigned char, WS_YT), WSP(float, WS_ROWR)};
        pg8::gemm_phase<pg8::EpiSwiGLU, pg8::MoeGatherOrder, true, true>(F.lds, 1024, S, E);
        if (rep_ == 0) {
            const int nwg = ntiles * 4, R = (nwg + F.G - 1) / F.G, nheavy = nwg - (R - 1) * F.G; const bool all = (nheavy >= F.G) || (nheavy <= 0);
            const int nl = all ? F.G : F.G - nheavy, li = all ? F.bid : F.bid - nheavy;
            if (li >= 0) wdown_items(F, li * NWAVES + F.wave, nl * NWAVES);
        }
    } SEAM(7);

    if (IN(8)) for (int rep_ = 0; rep_ < REPS(8); ++rep_) { if (rep_) xcd_barrier(bar);
        const int ntiles = __builtin_amdgcn_readfirstlane(build_tiles(F)); const LAS int* tl = (const LAS int*)(F.lds + L_TILES);
        pg8::MoeOrder S; S.init(F.ws + WS_YT, F.ws + WS_WD_T, tl, tl + MAX_TILES, ntiles, 512, F.G, F.bid, 1);
        pg8::EpiMoeDown E{WSP(unsigned char, WS_YP), WSP(int, WS_LIST), WSP(float, WS_ROWW)};
        pg8::gemm_phase<pg8::EpiMoeDown, pg8::MoeOrder, true, true>(F.lds, 512, S, E);
    } SEAM(8);

    if (IN(9)) { if (REPS(9) == 2) { phase_final(F, X1, WSP(float, WS_YT)); xcd_barrier(bar); } phase_final(F, X1, F.out); }
#undef IN
#undef SEAM
}


extern "C" void kernel_launch(void* const* d_in, const int* in_sizes, int n_in, void* d_out, int out_size, void* d_ws, size_t ws_size, hipStream_t stream) {
    static int grid = 0;
    if (grid == 0) {
        if (n_in != 23 || in_sizes[0] != T_TOK * D_MODEL || out_size != T_TOK * D_MODEL || ws_size < WS_END) { fprintf(stderr, "kernel_launch: unexpected shapes (n_in %d, in0 %d, out %d, ws %zu)\n", n_in, n_in > 0 ? in_sizes[0] : -1, out_size, ws_size); grid = -1; return; }
        int dev = 0, cus = 0;
        if (hipGetDevice(&dev) != hipSuccess || hipDeviceGetAttribute(&cus, hipDeviceAttributeMultiprocessorCount, dev) != hipSuccess) { grid = -1; return; }
        if (hipFuncSetAttribute((const void*)mk_fwd, hipFuncAttributeMaxDynamicSharedMemorySize, LDS_BYTES) != hipSuccess) { fprintf(stderr, "kernel_launch: hipFuncSetAttribute failed\n"); grid = -1; return; }
        int per_cu = 0;
        if (hipOccupancyMaxActiveBlocksPerMultiprocessor(&per_cu, (const void*)mk_fwd, NTHREADS, LDS_BYTES) != hipSuccess || per_cu < 1) fprintf(stderr, "kernel_launch: occupancy query reports %d\n", per_cu);
        (void)hipGetLastError();
        grid = cus;
    }
    if (grid < 0) return;
    (void)hipMemsetAsync((char*)d_ws + WS_CTL, 0, CTL_ZERO_BYTES, stream);
    Args a{};
    for (int i = 0; i < 23; ++i) a.in[i] = (const float*)d_in[i];
    a.out = (float*)d_out; a.ws = (unsigned char*)d_ws;
#if MK_N_LAUNCHES == 1
    a.ph_lo = 0; a.ph_hi = N_PHASES;
    hipLaunchKernelGGL(mk_fwd, dim3(grid), dim3(NTHREADS), LDS_BYTES, stream, a);
#else
    for (int p = 0; p < N_PHASES; ++p) {
        a.ph_lo = p; a.ph_hi = p + 1;
        hipLaunchKernelGGL(mk_fwd, dim3(grid), dim3(NTHREADS), LDS_BYTES, stream, a);
#ifdef MK_DUPLAUNCH
        if (p == MK_DUPLAUNCH) hipLaunchKernelGGL(mk_fwd, dim3(grid), dim3(NTHREADS), LDS_BYTES, stream, a);
#endif
#if MK_CHECK
        launch_checks(p, a, grid, stream);
#endif
    }
#if MK_CHECK
    launch_encode(a, grid, stream);
#endif
#endif
}
```

```cpp
#include <hip/hip_runtime.h>
#include <cstdio>
#include <cstdint>

#define MK_N_LAUNCHES 1
#define MK_DUP -1
#define MK_CHECK 0

#ifndef MK_DUP
#define MK_DUP -1
#endif
constexpr int D_MODEL = 1024, BATCH = 8, SEQ = 4096, T_TOK = BATCH * SEQ;
constexpr int D_HYENA = 512, D_FOURIER = 512, D_IN_PROJ = 2048, N_EXP = 32, D_EXPERT = 512;
constexpr int NPT_ROWS = 2048;
constexpr float EPS = 1e-6f;
constexpr int MAX_ROWS = 65536 + 32 * 256;
constexpr int MAX_TILES = MAX_ROWS / 256;
constexpr int NWAVES = 8, NTHREADS = 512;

constexpr size_t MiB = 1u << 20;
constexpr size_t WS_CTL = 0, CTL_ZERO_BYTES = 64 * 1024;
constexpr size_t WS_TOT = 48 * 1024;
constexpr size_t WS_CHK = 192 * 1024;
constexpr size_t WS_TW4096 = 3 * MiB;
constexpr size_t WS_TW8192 = 3 * MiB + 32 * 1024;
constexpr size_t WS_H3 = 4 * MiB;
constexpr size_t WS_WIN_T = 8 * MiB;
constexpr size_t WS_WOUT_T = 13 * MiB;
constexpr size_t WS_WGU_T = 16 * MiB;
constexpr size_t WS_WD_T = 80 * MiB;
constexpr size_t WS_KF = 112 * MiB;
constexpr size_t WS_HN = 144 * MiB;
constexpr size_t WS_PT = 208 * MiB;
constexpr size_t WS_X1Q = 208 * MiB;
constexpr size_t WS_YP = 144 * MiB;
constexpr size_t WS_X1 = 272 * MiB;
constexpr int ECAP = 32768;
constexpr size_t WS_LIST = 336 * MiB;
constexpr size_t WS_ROWW = 340 * MiB;
constexpr size_t WS_ROWR = 344 * MiB;
constexpr size_t WS_YT = 368 * MiB;
constexpr size_t WS_YN = 440 * MiB;
constexpr size_t WS_KT = WS_YN;
constexpr size_t WS_SP = WS_YT + (size_t)512 * T_TOK * 2;
constexpr size_t WS_END = 504 * MiB;

constexpr int LDS_BYTES = 163840;
constexpr int BARST_OFF = LDS_BYTES - 64;
constexpr int FFT_BUF_BYTES = 4352 * 8;
constexpr int L_BUFA = 0, L_BUFB = FFT_BUF_BYTES, L_TW = 2 * FFT_BUF_BYTES, L_SCR = L_TW + 32768, L_RED = L_SCR + 32768, L_TW256 = L_RED + 1024;
static_assert(L_TW256 + 2048 <= BARST_OFF, "LDS map");
constexpr int M_TW = 98304, M_TW256 = M_TW + 32768;
constexpr int L_TILES = 132 * 1024;

#define GAS __attribute__((address_space(1)))
#define LAS __attribute__((address_space(3)))
typedef unsigned short bf16;
typedef float f32x4 __attribute__((ext_vector_type(4)));
typedef float f32x2 __attribute__((ext_vector_type(2)));
typedef unsigned u32x4 __attribute__((ext_vector_type(4)));
typedef unsigned u32x2 __attribute__((ext_vector_type(2)));
#ifndef MK_WT
#define MK_WT 1
#endif
__device__ __forceinline__ void st16_plain(void* p, u32x4 v) { *(u32x4*)p = v; }
__device__ __forceinline__ void st16_wt(void* p, u32x4 v) {
#if MK_WT
    asm volatile("global_store_dwordx4 %0, %1, off sc1\n\ts_nop 1" :: "v"(p), "v"(v) : "memory");
#else
    *(u32x4*)p = v;
#endif
}
constexpr float W_SCALE = 16.0f, H_SCALE = 8.0f;
__device__ __forceinline__ unsigned pk4_fp8s(float a, float b, float c, float d, float sc) {
    a = __builtin_amdgcn_fmed3f(a * sc, -448.f, 448.f); b = __builtin_amdgcn_fmed3f(b * sc, -448.f, 448.f); c = __builtin_amdgcn_fmed3f(c * sc, -448.f, 448.f); d = __builtin_amdgcn_fmed3f(d * sc, -448.f, 448.f);
    int t = __builtin_amdgcn_cvt_pk_fp8_f32(a, b, 0, false); t = __builtin_amdgcn_cvt_pk_fp8_f32(c, d, t, true); return (unsigned)t;
}
#define LDS_WAIT() asm volatile("s_waitcnt lgkmcnt(0)" ::: "memory")
__device__ __forceinline__ unsigned f2bf(float f) { unsigned u = __builtin_bit_cast(unsigned, f); return (u + 0x7fffu + ((u >> 16) & 1u)) >> 16; }
__device__ __forceinline__ unsigned pk2(float lo, float hi) { return f2bf(lo) | (f2bf(hi) << 16); }
__device__ __forceinline__ unsigned pk2h(float lo, float hi) { typedef float f32x2_t __attribute__((ext_vector_type(2))); typedef __bf16 bf16x2_t __attribute__((ext_vector_type(2))); const f32x2_t v = {lo, hi}; const bf16x2_t b = __builtin_convertvector(v, bf16x2_t); return __builtin_bit_cast(unsigned, b); }
__device__ __forceinline__ float bflo(unsigned w) { return __builtin_bit_cast(float, w << 16); }
__device__ __forceinline__ float bfhi(unsigned w) { return __builtin_bit_cast(float, w & 0xffff0000u); }
__device__ __forceinline__ float bf1(bf16 h) { return __builtin_bit_cast(float, (unsigned)h << 16); }
__device__ __forceinline__ float wave_sum(float v) {
#pragma unroll
    for (int o = 1; o < 64; o <<= 1) v += __shfl_xor(v, o);
    return v;
}

namespace pg8 {
#define PG8_LAS __attribute__((address_space(3)))
typedef unsigned short bf16_t;
typedef short bf16x8 __attribute__((ext_vector_type(8)));
typedef float f32x4 __attribute__((ext_vector_type(4)));
typedef unsigned u32x4 __attribute__((ext_vector_type(4)));
typedef unsigned u32x2 __attribute__((ext_vector_type(2)));
constexpr int BM = 256, BK = 64, HALF = 128, HTB = HALF * BK * 2  , STAGE_BYTES = 8 * HTB, NXCD = 8, WGM = 8;

__host__ __device__ __forceinline__ int lds_byte(int r, int c) { const int st = (r >> 4) * 2 + (c >> 5), rr = r & 15, cc = c & 31, ob = rr * 64 + cc * 2; return st * 1024 + (ob ^ (((ob >> 9) & 1) << 5)); }
__host__ __device__ __forceinline__ void stage_rc(int b, int& R, int& C) { const int st = b / 1024, sb = b % 1024, swz = sb ^ (((sb >> 9) & 1) << 5); R = (st >> 1) * 16 + swz / 64; C = (st & 1) * 32 + (swz % 64) / 2; }
__host__ __device__ __forceinline__ int perm32(int rho) { const int n = rho >> 4, i = rho & 15; return 8 * (i >> 2) + 4 * n + (i & 3); }

struct Unit { int pm, pn; const char* a; const char* b; int lrow, nv; };

struct StaticOrder {
    static constexpr bool GATHER = false;
    int nM, nN, nwg, G, c, reps = 1; const char* A; const char* Bt; size_t tstep;
    __device__ void init(const void* A_, const void* Bt_, int M, int N, int K, int G_, int c_) { A = (const char*)A_; Bt = (const char*)Bt_; nM = M / BM; nN = N / BM; nwg = nM * nN; G = G_; c = c_; tstep = (size_t)BM * K * 2; }
    __device__ bool next(int i, Unit& u) const {
        long L = (long)i * G + c; if (L >= (long)nwg * reps) return false; if (L >= nwg) L -= nwg;
        int wgid = (int)L; { const int q = nwg / NXCD, r = nwg % NXCD, xcd = wgid % NXCD, off = wgid / NXCD; wgid = (xcd < r ? xcd * (q + 1) : r * (q + 1) + (xcd - r) * q) + off; }
        const int nig = WGM * nN, gid = wgid / nig, fm = gid * WGM, gsz = (nM - fm) < WGM ? (nM - fm) : WGM;
        u.pm = fm + ((wgid % nig) % gsz); u.pn = (wgid % nig) / gsz; u.a = A + (size_t)u.pm * tstep; u.b = Bt + (size_t)u.pn * tstep; u.lrow = 0; u.nv = BM; return true;
    }
};
struct MoeOrder {
    static constexpr bool GATHER = false;
    int nwg, G, c; const char* A; const char* Bt; const PG8_LAS int* tl; const PG8_LAS int* tnv; size_t a_tstep, b_tstep;
    __device__ void init(const void* A_, const void* Bt_, const PG8_LAS int* tl_, const PG8_LAS int* tnv_, int ntiles, int K, int G_, int c_, int ES = 2) { A = (const char*)A_; Bt = (const char*)Bt_; tl = tl_; tnv = tnv_; nwg = ntiles * 4; G = G_; c = c_; a_tstep = (size_t)BM * K * ES; b_tstep = (size_t)BM * K * ES; }
    __device__ bool next(int i, Unit& u) const {
        const long L = (long)i * G + c; if (L >= nwg) return false;
        int wgid = (int)L; { const int q = nwg / NXCD, r = nwg % NXCD, xcd = wgid % NXCD, off = wgid / NXCD; wgid = (xcd < r ? xcd * (q + 1) : r * (q + 1) + (xcd - r) * q) + off; }
        u.pm = wgid >> 2; u.pn = wgid & 3; u.lrow = __builtin_amdgcn_readfirstlane(tl[u.pm]); u.nv = __builtin_amdgcn_readfirstlane(tnv[u.pm]); const int e = u.lrow >> 15;
        u.a = A + (size_t)u.pm * a_tstep; u.b = Bt + (size_t)(e * 4 + u.pn) * b_tstep; return true;
    }
};

struct MoeGatherOrder {
    static constexpr bool GATHER = true;
    int nwg, G, c, es; const char* A; const char* Bt; const PG8_LAS int* tl; const PG8_LAS int* tnv; const int* list; size_t b_tstep;
    __device__ void init(const void* A_, const void* Bt_, const PG8_LAS int* tl_, const PG8_LAS int* tnv_, const int* list_, int ntiles, int K, int G_, int c_, int ES = 2) { A = (const char*)A_; Bt = (const char*)Bt_; tl = tl_; tnv = tnv_; list = list_; nwg = ntiles * 4; G = G_; c = c_; es = ES; b_tstep = (size_t)BM * K * ES; }
    __device__ bool next(int i, Unit& u) const {
        const long L = (long)i * G + c; if (L >= nwg) return false;
        int wgid = (int)L; { const int q = nwg / NXCD, r = nwg % NXCD, xcd = wgid % NXCD, off = wgid / NXCD; wgid = (xcd < r ? xcd * (q + 1) : r * (q + 1) + (xcd - r) * q) + off; }
        u.pm = wgid >> 2; u.pn = wgid & 3; u.lrow = __builtin_amdgcn_readfirstlane(tl[u.pm]); u.nv = __builtin_amdgcn_readfirstlane(tnv[u.pm]); const int e = u.lrow >> 15;
        u.a = A; u.b = Bt + (size_t)(e * 4 + u.pn) * b_tstep; return true;
    }
    __device__ __forceinline__ void offsets(const Unit& u, int K, const int (&R)[2], const int (&C)[2], unsigned (&o)[2][2]) const {
#pragma unroll
        for (int h = 0; h < 2; ++h)
#pragma unroll
            for (int i = 0; i < 2; ++i) { const int lr = h * HALF + R[i]; const int pr = list[u.lrow + (lr < u.nv ? lr : 0)]; const int tok = (lr < u.nv ? pr : 0) >> 1; o[h][i] = (unsigned)(tok * K) * (unsigned)es + (unsigned)C[i] * 2u; }
    }
};

__device__ __forceinline__ unsigned cvt_pk_bf16(float lo, float hi) { unsigned r; asm volatile("v_cvt_pk_bf16_f32 %0, %1, %2" : "=v"(r) : "v"(lo), "v"(hi)); return r; }

struct EpiStoreBf16 {
    static constexpr bool PERM = true;
    bf16_t* O; int ldc;
    __device__ __forceinline__ void operator()(const f32x4 (&acc)[2][2][4][2], const Unit& u, int wr, int wc, int fr, int fq) const {
        const int row0 = u.pm * BM + wr * 64 + fr; const int col0 = u.pn * BM + wc * 32 + 8 * fq;
#pragma unroll
        for (int ai = 0; ai < 2; ++ai)
#pragma unroll
            for (int m = 0; m < 4; ++m) { bf16_t* rowp = O + (size_t)(row0 + ai * HALF + m * 16) * ldc + col0;
#pragma unroll
                for (int bj = 0; bj < 2; ++bj) { const f32x4 v0 = acc[ai][bj][m][0], v1 = acc[ai][bj][m][1];
                    u32x4 w; w.x = cvt_pk_bf16(v0[0], v0[1]); w.y = cvt_pk_bf16(v0[2], v0[3]); w.z = cvt_pk_bf16(v1[0], v1[1]); w.w = cvt_pk_bf16(v1[2], v1[3]);
                    *(u32x4*)(rowp + bj * HALF) = w; } }
    }
};
struct EpiStorePT {
    static constexpr bool PERM = true;
    bf16_t* O; int nrows;
    __device__ __forceinline__ void operator()(const f32x4 (&acc)[2][2][4][2], const Unit& u, int wr, int wc, int fr, int fq) const {
        const int row0 = u.pm * BM + wr * 64 + fr; const int col0 = wc * 32 + 8 * fq; bf16_t* base = O + (size_t)u.pn * nrows * 256;
#pragma unroll
        for (int ai = 0; ai < 2; ++ai)
#pragma unroll
            for (int m = 0; m < 4; ++m) { bf16_t* rowp = base + (size_t)(row0 + ai * HALF + m * 16) * 256 + col0;
#pragma unroll
                for (int bj = 0; bj < 2; ++bj) { const f32x4 v0 = acc[ai][bj][m][0], v1 = acc[ai][bj][m][1];
                    u32x4 w; w.x = cvt_pk_bf16(v0[0], v0[1]); w.y = cvt_pk_bf16(v0[2], v0[3]); w.z = cvt_pk_bf16(v1[0], v1[1]); w.w = cvt_pk_bf16(v1[2], v1[3]);
                    st16_plain(rowp + bj * HALF, w); } }
    }
};
struct EpiResF32 {
    static constexpr bool PERM = false;
    const float* base; float* out; int ldc;
    __device__ __forceinline__ void operator()(const f32x4 (&acc)[2][2][4][2], const Unit& u, int wr, int wc, int fr, int fq) const {
        const int row0 = u.pm * BM + wr * 64 + fr; const int col0 = u.pn * BM + wc * 32 + 4 * fq;
#pragma unroll
        for (int ai = 0; ai < 2; ++ai)
#pragma unroll
            for (int m = 0; m < 4; ++m) { const size_t off = (size_t)(row0 + ai * HALF + m * 16) * ldc + col0;
#pragma unroll
                for (int bj = 0; bj < 2; ++bj)
#pragma unroll
                    for (int n = 0; n < 2; ++n) { const f32x4 bs = *(const f32x4*)(base + off + bj * HALF + n * 16); *(f32x4*)(out + off + bj * HALF + n * 16) = bs + acc[ai][bj][m][n]; } }
    }
};
struct EpiResBf16 {
    static constexpr bool PERM = true;
    const float* __restrict__ base; bf16_t* __restrict__ out; int ldc;
    __device__ __forceinline__ void operator()(const f32x4 (&acc)[2][2][4][2], const Unit& u, int wr, int wc, int fr, int fq) const {
        const int row0 = u.pm * BM + wr * 64 + fr; const int col0 = u.pn * BM + wc * 32 + 8 * fq;
#pragma unroll
        for (int ai = 0; ai < 2; ++ai) {
            f32x4 r0[4][2], r1[4][2];
#pragma unroll
            for (int m = 0; m < 4; ++m) { const size_t off = (size_t)(row0 + ai * HALF + m * 16) * ldc + col0;
#pragma unroll
                for (int bj = 0; bj < 2; ++bj) { r0[m][bj] = *(const f32x4*)(base + off + bj * HALF); r1[m][bj] = *(const f32x4*)(base + off + bj * HALF + 4); } }
#pragma unroll
            for (int m = 0; m < 4; ++m) { const size_t off = (size_t)(row0 + ai * HALF + m * 16) * ldc + col0;
#pragma unroll
                for (int bj = 0; bj < 2; ++bj) { const f32x4 v0 = acc[ai][bj][m][0] + r0[m][bj], v1 = acc[ai][bj][m][1] + r1[m][bj];
                    u32x4 w; w.x = cvt_pk_bf16(v0[0], v0[1]); w.y = cvt_pk_bf16(v0[2], v0[3]); w.z = cvt_pk_bf16(v1[0], v1[1]); w.w = cvt_pk_bf16(v1[2], v1[3]);
                    st16_plain(out + off + bj * HALF, w); } }
        }
    }
};
struct EpiSwiGLU {
    static constexpr bool PERM = false;
    unsigned char* __restrict__ H; const float* __restrict__ rowr;
    __device__ __forceinline__ void operator()(const f32x4 (&acc)[2][2][4][2], const Unit& u, int wr, int wc, int fr, int fq) const {
        const int row0 = u.pm * BM + wr * 64 + fr;
#pragma unroll
        for (int ai = 0; ai < 2; ++ai)
#pragma unroll
            for (int m = 0; m < 4; ++m) { const int lr = wr * 64 + fr + ai * HALF + m * 16; const int row = row0 + ai * HALF + m * 16; const float rr = ((lr < u.nv) ? rowr[u.lrow + lr] : 0.f) * (1.0f / W_SCALE); unsigned char* rowp = H + (size_t)row * 512 + u.pn * 128 + wc * 32 + 4 * fq;
#pragma unroll
                for (int n = 0; n < 2; ++n) { const f32x4 g = acc[ai][0][m][n] * rr, up = acc[ai][1][m][n] * rr; f32x4 h;
#pragma unroll
                    for (int q = 0; q < 4; ++q) h[q] = g[q] * __builtin_amdgcn_rcpf(1.0f + __expf(-g[q])) * up[q];
                    *(unsigned*)(rowp + n * 16) = pk4_fp8s(h[0], h[1], h[2], h[3], H_SCALE); } }
    }
};
constexpr float YP_SCALE = 32.0f;
__device__ __forceinline__ unsigned pk4_fp8(float a, float b, float c, float d) {
    a = __builtin_amdgcn_fmed3f(a * YP_SCALE, -448.f, 448.f); b = __builtin_amdgcn_fmed3f(b * YP_SCALE, -448.f, 448.f); c = __builtin_amdgcn_fmed3f(c * YP_SCALE, -448.f, 448.f); d = __builtin_amdgcn_fmed3f(d * YP_SCALE, -448.f, 448.f);
    int t = __builtin_amdgcn_cvt_pk_fp8_f32(a, b, 0, false); t = __builtin_amdgcn_cvt_pk_fp8_f32(c, d, t, true); return (unsigned)t;
}
struct EpiMoeDown {
    static constexpr bool PERM = true;
    unsigned char* __restrict__ YP; const int* __restrict__ list; const float* __restrict__ roww;
    __device__ __forceinline__ void operator()(const f32x4 (&acc)[2][2][4][2], const Unit& u, int wr, int wc, int fr, int fq) const {
        const int col0 = u.pn * BM + wc * 32 + 8 * fq;
        int prv[2][4]; float wv[2][4];
#pragma unroll
        for (int ai = 0; ai < 2; ++ai)
#pragma unroll
            for (int m = 0; m < 4; ++m) { const int lr = wr * 64 + fr + ai * HALF + m * 16; const int li = u.lrow + (lr < u.nv ? lr : 0); prv[ai][m] = list[li]; wv[ai][m] = roww[li]; }
#pragma unroll
        for (int ai = 0; ai < 2; ++ai)
#pragma unroll
            for (int m = 0; m < 4; ++m) { const int lr = wr * 64 + fr + ai * HALF + m * 16; const bool ok = lr < u.nv; const int pair = ok ? prv[ai][m] : 0; const float w = ok ? wv[ai][m] : 0.f;
                if (ok) { unsigned char* rowp = YP + (size_t)pair * 1024 + col0;
#pragma unroll
                    for (int bj = 0; bj < 2; ++bj) { const f32x4 v0 = acc[ai][bj][m][0] * (w * (1.0f / (W_SCALE * H_SCALE))), v1 = acc[ai][bj][m][1] * (w * (1.0f / (W_SCALE * H_SCALE)));
                        u32x2 o; o.x = pk4_fp8(v0[0], v0[1], v0[2], v0[3]); o.y = pk4_fp8(v1[0], v1[1], v1[2], v1[3]);
                        *(u32x2*)(rowp + bj * HALF) = o; } } }
    }
};

typedef int v8i_t __attribute__((ext_vector_type(8)));
template <class Epi, class Sched, bool ALIGN_EPI = true, bool FP8 = false>
__device__ __forceinline__ void gemm_phase(PG8_LAS unsigned char* lds, const int K, const Sched& S, const Epi& E) {
    const int tid = threadIdx.x, wid = __builtin_amdgcn_readfirstlane(tid >> 6), lane = tid & 63, wr = wid >> 2, wc = wid & 3, fr = lane & 15, fq = lane >> 4;
    constexpr int ES = FP8 ? 1 : 2;
    const int nt = K * ES / (BK * 2);
    unsigned voffA[2], voffB[2]; int sR[2], sC[2];
#pragma unroll
    for (int i = 0; i < 2; ++i) { int R, C; stage_rc(tid * 16 + i * 8192, R, C); const int Rb = Epi::PERM ? ((R & ~31) + perm32(R & 31)) : R; sR[i] = R; sC[i] = C;
        voffA[i] = (unsigned)(R * K) * (unsigned)ES + (unsigned)C * 2u; voffB[i] = (unsigned)(Rb * K) * (unsigned)ES + (unsigned)C * 2u; }
    int sc127 = 0x7f7f7f7f; asm volatile("" : "+v"(sc127));
    constexpr bool GA = Sched::GATHER;
    unsigned oc[2][2], on[2][2];
    const size_t kstep = (size_t)(BK * 2);
    const size_t hstep = (size_t)HALF * K * ES;
    const unsigned ldsw = (unsigned)wid * 1024u;
    const int aoff = lds_byte(wr * 64 + fr, fq * 8), boff = lds_byte(wc * 32 + fr, fq * 8);
#define PG8_SA(b, h) (((b) * 2 + (h)) * HTB)
#define PG8_SB(b, h) ((4 + (b) * 2 + (h)) * HTB)
#define PG8_STAGE(bufoff, gbase, voff) do { _Pragma("unroll") for (int _i = 0; _i < 2; ++_i) \
        __builtin_amdgcn_global_load_lds((const unsigned*)((const char*)(gbase) + (voff)[_i]), (PG8_LAS unsigned*)(lds + (bufoff) + ldsw + _i * 8192), 16, 0, 0); } while (0)
#define PG8_LDA(dst, b, h) do { _Pragma("unroll") for (int m = 0; m < 4; ++m) _Pragma("unroll") for (int k = 0; k < 2; ++k) dst[m][k] = *(const PG8_LAS bf16x8*)(lds + PG8_SA(b, h) + aoff + m * 2048 + k * 1024); } while (0)
#define PG8_LDB(dst, b, h) do { _Pragma("unroll") for (int n = 0; n < 2; ++n) _Pragma("unroll") for (int k = 0; k < 2; ++k) dst[n][k] = *(const PG8_LAS bf16x8*)(lds + PG8_SB(b, h) + boff + n * 2048 + k * 1024); } while (0)
#define PG8_CAT(x0, x1) (v8i_t){ (int)__builtin_bit_cast(u32x4, x0).x, (int)__builtin_bit_cast(u32x4, x0).y, (int)__builtin_bit_cast(u32x4, x0).z, (int)__builtin_bit_cast(u32x4, x0).w, (int)__builtin_bit_cast(u32x4, x1).x, (int)__builtin_bit_cast(u32x4, x1).y, (int)__builtin_bit_cast(u32x4, x1).z, (int)__builtin_bit_cast(u32x4, x1).w }
#define PG8_MMA(ai, bj, At, Bt) do { __builtin_amdgcn_s_setprio(1); _Pragma("unroll") for (int m = 0; m < 4; ++m) _Pragma("unroll") for (int n = 0; n < 2; ++n) { \
        if constexpr (FP8) { const v8i_t b8_ = PG8_CAT(Bt[n][0], Bt[n][1]), a8_ = PG8_CAT(At[m][0], At[m][1]); \
            asm volatile("s_nop 1\n\tv_mfma_scale_f32_16x16x128_f8f6f4 %0, %1, %2, %0, %3, %3 op_sel_hi:[0,0,0]" : "+v"(acc[ai][bj][m][n]) : "v"(b8_), "v"(a8_), "v"(sc127)); } \
        else { _Pragma("unroll") for (int k = 0; k < 2; ++k) acc[ai][bj][m][n] = __builtin_amdgcn_mfma_f32_16x16x32_bf16(Bt[n][k], At[m][k], acc[ai][bj][m][n], 0, 0, 0); } } __builtin_amdgcn_s_setprio(0); } while (0)
#define PG8_WAIT_V(n) asm volatile("s_waitcnt vmcnt(" #n ")" ::: "memory")
#define PG8_WAIT_L(n) asm volatile("s_waitcnt lgkmcnt(" #n ")" ::: "memory")
#define PG8_BAR __builtin_amdgcn_s_barrier()
#define PG8_SCHED __builtin_amdgcn_sched_barrier(0)
    Unit cur, nxt; int ui = 0;
    if (!S.next(0, cur)) return;
    f32x4 acc[2][2][4][2];
#pragma unroll
    for (int a = 0; a < 2; ++a)
#pragma unroll
        for (int b = 0; b < 2; ++b)
#pragma unroll
            for (int m = 0; m < 4; ++m)
#pragma unroll
                for (int n = 0; n < 2; ++n) acc[a][b][m][n] = (f32x4){0.f, 0.f, 0.f, 0.f};
    bf16x8 At[4][2], B0[2][2], B1[2][2];
    const char* cA = cur.a; const char* cB = cur.b;
    const size_t hA = GA ? (size_t)0 : hstep;
    if constexpr (GA) { S.offsets(cur, K, sR, sC, oc); }
#define PG8_OA(h, sel) (GA ? (sel)[h] : voffA)
    PG8_STAGE(PG8_SB(0, 0), cB, voffB); PG8_STAGE(PG8_SB(0, 1), cB + hstep, voffB); PG8_STAGE(PG8_SA(0, 0), cA, PG8_OA(0, oc)); PG8_STAGE(PG8_SA(0, 1), cA + hA, PG8_OA(1, oc));
    if (wr == 1) PG8_BAR;
    PG8_WAIT_V(2); PG8_BAR;
    PG8_STAGE(PG8_SB(1, 0), cB + kstep, voffB); PG8_STAGE(PG8_SA(1, 0), cA + kstep, PG8_OA(0, oc)); PG8_STAGE(PG8_SB(1, 1), cB + hstep + kstep, voffB);
    PG8_WAIT_V(6); PG8_BAR;
    for (;;) {
        const bool has_next = S.next(ui + 1, nxt);
        const char* nA = has_next ? nxt.a : cA; const char* nB = has_next ? nxt.b : cB;
        if constexpr (GA) { if (has_next) S.offsets(nxt, K, sR, sC, on); else {
#pragma unroll
            for (int h = 0; h < 2; ++h)
#pragma unroll
                for (int i = 0; i < 2; ++i) on[h][i] = oc[h][i]; } }
#pragma unroll 1
        for (int t = 0; t < nt; t += 2) {
            const bool last = (t == nt - 2);
            const char* a1 = cA + (size_t)(t + 1) * kstep;
            const char* a2 = last ? nA : cA + (size_t)(t + 2) * kstep; const char* b2 = last ? nB : cB + (size_t)(t + 2) * kstep;
            const char* a3 = a2 + kstep; const char* b3 = b2 + kstep;
            unsigned o2[2][2];
            if constexpr (GA) {
#pragma unroll
                for (int h = 0; h < 2; ++h)
#pragma unroll
                    for (int i = 0; i < 2; ++i) o2[h][i] = last ? on[h][i] : oc[h][i]; }
            PG8_LDB(B0, 0, 0); PG8_LDB(B1, 0, 1); PG8_SCHED; PG8_LDA(At, 0, 0); PG8_STAGE(PG8_SA(1, 1), a1 + hA, PG8_OA(1, oc));
            PG8_WAIT_V(8); PG8_WAIT_L(0); PG8_BAR; PG8_MMA(0, 0, At, B0); PG8_MMA(0, 1, At, B1); PG8_BAR; PG8_SCHED;
            PG8_LDA(At, 0, 1); PG8_STAGE(PG8_SB(0, 0), b2, voffB); PG8_STAGE(PG8_SB(0, 1), b2 + hstep, voffB); PG8_STAGE(PG8_SA(0, 0), a2, PG8_OA(0, o2));
            PG8_WAIT_V(8); PG8_WAIT_L(0); PG8_BAR; PG8_MMA(1, 0, At, B0); PG8_MMA(1, 1, At, B1); PG8_BAR; PG8_SCHED;
            PG8_LDB(B0, 1, 0); PG8_LDB(B1, 1, 1); PG8_SCHED; PG8_LDA(At, 1, 0); PG8_STAGE(PG8_SA(0, 1), a2 + hA, PG8_OA(1, o2));
            PG8_WAIT_V(8); PG8_WAIT_L(0); PG8_BAR; PG8_MMA(0, 0, At, B0); PG8_MMA(0, 1, At, B1); PG8_BAR; PG8_SCHED;
            PG8_LDA(At, 1, 1); PG8_STAGE(PG8_SB(1, 0), b3, voffB); PG8_STAGE(PG8_SB(1, 1), b3 + hstep, voffB); PG8_STAGE(PG8_SA(1, 0), a3, PG8_OA(0, o2));
            PG8_WAIT_V(8); PG8_WAIT_L(0); PG8_BAR; PG8_MMA(1, 0, At, B0); PG8_MMA(1, 1, At, B1); PG8_BAR; PG8_SCHED;
        }
        if constexpr (ALIGN_EPI) { if (wr == 0) PG8_BAR; }
        if constexpr (FP8) asm volatile("s_nop 7\n\ts_nop 7" : "+v"(acc[1][1][0][0]), "+v"(acc[1][1][0][1]), "+v"(acc[1][1][1][0]), "+v"(acc[1][1][1][1]), "+v"(acc[1][1][2][0]), "+v"(acc[1][1][2][1]), "+v"(acc[1][1][3][0]), "+v"(acc[1][1][3][1]) :: "memory");
        E(acc, cur, wr, wc, fr, fq);
        if (!has_next) break;
#pragma unroll
        for (int a = 0; a < 2; ++a)
#pragma unroll
            for (int b = 0; b < 2; ++b)
#pragma unroll
                for (int m = 0; m < 4; ++m)
#pragma unroll
                    for (int n = 0; n < 2; ++n) acc[a][b][m][n] = (f32x4){0.f, 0.f, 0.f, 0.f};
        cur = nxt; cA = nA; cB = nB; ++ui;
        if constexpr (GA) {
#pragma unroll
            for (int h = 0; h < 2; ++h)
#pragma unroll
                for (int i = 0; i < 2; ++i) oc[h][i] = on[h][i]; }
        if constexpr (ALIGN_EPI) { if (wr == 1) PG8_BAR; }
    }
    PG8_WAIT_V(0);
    if constexpr (!ALIGN_EPI) { if (wr == 0) PG8_BAR; }
    PG8_BAR;
#undef PG8_SA
#undef PG8_OA
#undef PG8_CAT
#undef PG8_SB
#undef PG8_STAGE
#undef PG8_LDA
#undef PG8_LDB
#undef PG8_MMA
#undef PG8_WAIT_V
#undef PG8_WAIT_L
#undef PG8_BAR
#undef PG8_SCHED
}
}

#define FDEV __device__ __forceinline__
#define LDSPTR LAS
#define CF_DEFINED
typedef float cf __attribute__((ext_vector_type(2)));
#ifndef FFT_ENGINE_H
#define FFT_ENGINE_H
#ifndef CF_DEFINED
struct cf { float x, y; };
#endif
FDEV cf mkc(float a, float b) { cf r; r.x = a; r.y = b; return r; }
FDEV cf cadd(cf a, cf b) { return mkc(a.x + b.x, a.y + b.y); }
FDEV cf csub(cf a, cf b) { return mkc(a.x - b.x, a.y - b.y); }
FDEV cf cmul(cf a, cf b) { return mkc(a.x * b.x - a.y * b.y, a.x * b.y + a.y * b.x); }
FDEV cf cmulc(cf a, cf b) { return mkc(a.x * b.x + a.y * b.y, a.y * b.x - a.x * b.y); }
FDEV cf mul_mi(cf a) { return mkc(a.y, -a.x); }
FDEV cf mul_pi(cf a) { return mkc(-a.y, a.x); }
constexpr int FFT_N = 4096, FFT_LDS_ELEMS = 16 * 272;
FDEV int fpos(int p) { return 272 * (p >> 8) + 17 * ((p >> 4) & 15) + (p & 15); }

template <bool INV> FDEV void dft16(cf (&v)[16]) {
    const float C1 = 0.92387953251128674f, S1 = 0.38268343236508977f, C2 = 0.70710678118654752f;
#pragma unroll
    for (int n0 = 0; n0 < 4; ++n0) {
        cf x0 = v[n0], x1 = v[4 + n0], x2 = v[8 + n0], x3 = v[12 + n0];
        cf A = cadd(x0, x2), B = csub(x0, x2), C = cadd(x1, x3), D = csub(x1, x3);
        cf Dm = INV ? mul_pi(D) : mul_mi(D);
        v[n0] = cadd(A, C); v[4 + n0] = cadd(B, Dm); v[8 + n0] = csub(A, C); v[12 + n0] = csub(B, Dm);
    }
#define W16(m) (mkc( (m)==0?1.f:(m)==1?C1:(m)==2?C2:(m)==3?S1:(m)==4?0.f:(m)==6?-C2:(m)==9?-C1:0.f, \
                    (INV?1.f:-1.f) * ((m)==0?0.f:(m)==1?S1:(m)==2?C2:(m)==3?C1:(m)==4?1.f:(m)==6?C2:(m)==9?-S1:0.f) ))
    v[4 + 1] = cmul(v[4 + 1], W16(1)); v[4 + 2] = cmul(v[4 + 2], W16(2)); v[4 + 3] = cmul(v[4 + 3], W16(3));
    v[8 + 1] = cmul(v[8 + 1], W16(2)); v[8 + 2] = cmul(v[8 + 2], W16(4)); v[8 + 3] = cmul(v[8 + 3], W16(6));
    v[12 + 1] = cmul(v[12 + 1], W16(3)); v[12 + 2] = cmul(v[12 + 2], W16(6)); v[12 + 3] = cmul(v[12 + 3], W16(9));
#undef W16
    cf o[16];
#pragma unroll
    for (int k1 = 0; k1 < 4; ++k1) {
        cf x0 = v[4 * k1], x1 = v[4 * k1 + 1], x2 = v[4 * k1 + 2], x3 = v[4 * k1 + 3];
        cf A = cadd(x0, x2), B = csub(x0, x2), C = cadd(x1, x3), D = csub(x1, x3);
        cf Dm = INV ? mul_pi(D) : mul_mi(D);
        o[k1] = cadd(A, C); o[k1 + 4] = cadd(B, Dm); o[k1 + 8] = csub(A, C); o[k1 + 12] = csub(B, Dm);
    }
#pragma unroll
    for (int i = 0; i < 16; ++i) v[i] = o[i];
}

template <int GEO> FDEV int geo_idx(int r, int e) {
    if (GEO == 1) return 272 * e + 17 * (r >> 4) + (r & 15);
    if (GEO == 2) return 272 * (r >> 4) + 17 * e + (r & 15);
    return 272 * (r >> 4) + 17 * (r & 15) + e;
}
template <int GEO> FDEV void fft_pass_fwd(LDSPTR cf* buf, const LDSPTR cf* tw, const LDSPTR cf* tw256, int r) {
    cf v[16];
#pragma unroll
    for (int e = 0; e < 16; ++e) v[e] = buf[geo_idx<GEO>(r, e)];
    dft16<false>(v);
    if (GEO == 1) {
#pragma unroll
        for (int s = 1; s < 16; ++s) v[s] = cmul(v[s], tw[(r * s) & 4095]);
    } else if (GEO == 2) {
        const int t = r & 15;
#pragma unroll
        for (int s = 1; s < 16; ++s) v[s] = cmul(v[s], tw256[t * s]);
    }
#pragma unroll
    for (int e = 0; e < 16; ++e) buf[geo_idx<GEO>(r, e)] = v[e];
}
template <int GEO> FDEV void fft_pass_inv(LDSPTR cf* buf, const LDSPTR cf* tw, const LDSPTR cf* tw256, int r) {
    cf v[16];
#pragma unroll
    for (int e = 0; e < 16; ++e) v[e] = buf[geo_idx<GEO>(r, e)];
    if (GEO == 1) {
#pragma unroll
        for (int s = 1; s < 16; ++s) v[s] = cmulc(v[s], tw[(r * s) & 4095]);
    } else if (GEO == 2) {
        const int t = r & 15;
#pragma unroll
        for (int s = 1; s < 16; ++s) v[s] = cmulc(v[s], tw256[t * s]);
    }
    dft16<true>(v);
#pragma unroll
    for (int e = 0; e < 16; ++e) buf[geo_idx<GEO>(r, e)] = v[e];
}
FDEV int freq_pos(int k) { return 256 * (k & 15) + 16 * ((k >> 4) & 15) + (k >> 8); }
#endif

#define XB_TMO      128
#define XB_XCNT(j)  (256  + 64 * (j))
#define XB_XSUB(j)  (1280 + 64 * (j))
#define XB_XGEN(j)  (2304 + 64 * (j))
#define XB_TOP      3328
#define XB_TOPGEN   3392
#define XCD_BAR_WORDS 3456
#define XB_SPIN_CAP (1u << 18)
__device__ __forceinline__ unsigned xb_ld(unsigned* p)              { return __hip_atomic_load(p, __ATOMIC_RELAXED, __HIP_MEMORY_SCOPE_AGENT); }
__device__ __forceinline__ unsigned xb_add(unsigned* p, unsigned v) { return __hip_atomic_fetch_add(p, v, __ATOMIC_RELAXED, __HIP_MEMORY_SCOPE_AGENT); }
__device__ __forceinline__ unsigned xb_xcc_id() { return (unsigned)__builtin_amdgcn_s_getreg((3 << 11) | 20) & 0xFu; }
#define XB_SPIN(cond, bar) do { unsigned _sp = 0; while (cond) { __builtin_amdgcn_s_sleep(1); \
    if ((++_sp & 255u) == 0u) { if (xb_ld(&(bar)[XB_TMO])) break; if (_sp > XB_SPIN_CAP) { atomicAdd(&(bar)[XB_TMO], 1u); break; } } } } while (0)
struct XcdBarrier { unsigned* bar; unsigned x; volatile LAS unsigned* st; };
__device__ __forceinline__ XcdBarrier xcd_barrier_post(unsigned* bar, volatile LAS unsigned* st) {
    XcdBarrier b; b.bar = bar; b.x = xb_xcc_id(); b.st = st;
    if (threadIdx.x == 0) (void)xb_add(&bar[XB_XCNT(b.x)], 1u);
    return b;
}
__device__ __forceinline__ void xcd_barrier_complete(unsigned* bar, unsigned x, unsigned& nloc, unsigned& nx) {
    const unsigned G = gridDim.x * gridDim.y * gridDim.z;
    unsigned sum, cnt, mine, sp = 0u;
    for (;;) {
        sum = 0u; cnt = 0u; mine = 0u;
#pragma unroll
        for (unsigned j = 0; j < 16; ++j) { const unsigned c = xb_ld(&bar[XB_XCNT(j)]); sum += c; cnt += (c > 0u) ? 1u : 0u; mine = (j == x) ? c : mine; }
        if (sum == G) break;
        __builtin_amdgcn_s_sleep(1);
        if ((++sp & 255u) == 0u) { if (xb_ld(&bar[XB_TMO])) break; if (sp > XB_SPIN_CAP) { atomicAdd(&bar[XB_TMO], 1u); break; } }
    }
    nloc = mine > 0u ? mine : 1u; nx = cnt > 0u ? cnt : 1u;
}
__device__ __forceinline__ void xcd_barrier(const XcdBarrier& b) {
    asm volatile("s_waitcnt vmcnt(0)" ::: "memory");
    __syncthreads();
    if (threadIdx.x == 0) {
        unsigned* bar = b.bar;
        __builtin_amdgcn_s_waitcnt(0);
        unsigned nloc = b.st[0], nx = b.st[1];
        if (nloc == 0u) { xcd_barrier_complete(bar, b.x, nloc, nx); b.st[0] = nloc; b.st[1] = nx; }
        const unsigned old = xb_add(&bar[XB_XSUB(b.x)], 1u);
        const unsigned gen = old / nloc;
        if (old + 1u == (gen + 1u) * nloc) {
            __builtin_amdgcn_fence(__ATOMIC_RELEASE, "agent");
            asm volatile("s_waitcnt vmcnt(0)" ::: "memory");
            const unsigned og = xb_add(&bar[XB_TOP], 1u);
            const unsigned tg = og / nx;
            if (og + 1u == (tg + 1u) * nx) xb_add(&bar[XB_TOPGEN], 1u);
            else XB_SPIN(xb_ld(&bar[XB_TOPGEN]) == tg, bar);
            __builtin_amdgcn_fence(__ATOMIC_ACQUIRE, "agent");
            xb_add(&bar[XB_XGEN(b.x)], 1u);
            asm volatile("s_waitcnt vmcnt(0)" ::: "memory");
        } else {
            XB_SPIN(xb_ld(&bar[XB_XGEN(b.x)]) == gen, bar);
            __builtin_amdgcn_fence(__ATOMIC_ACQUIRE, "agent");
            asm volatile("s_waitcnt vmcnt(0)" ::: "memory");
        }
    }
    __syncthreads();
}

struct Frame {
    LAS unsigned char* lds;
    unsigned char* ws;
    int tid, lane, wave, vcu, G, bid;
    const float *x, *norm1_g, *w_in, *conv_w, *conv_b, *f_w_in, *f_b_in, *f_w_mid, *f_b_mid, *f_freq, *f_w_out, *f_bias, *mix_g, *w_out, *norm2_g,
                *w_group, *b_group, *w_router, *b_router, *w_gate, *w_up, *w_down, *final_g;
    float* out;
};
#define WSP(T, off) ((T*)(F.ws + (off)))

__device__ __forceinline__ void transpose_item(const float* W, int ldw, bf16* WT, int ldo, LAS float* scr, int lane, const float* gk = nullptr) {
    asm volatile("" : "+s"(ldw));
    const float* Wl = W + (size_t)(lane >> 5) * ldw + (lane & 31);
    float t[32];
#pragma unroll
    for (int i = 0; i < 32; ++i) t[i] = Wl[(size_t)(2 * i) * ldw];
    if (gk) { const float* gl = gk + (lane >> 5);
#pragma unroll
        for (int i = 0; i < 32; ++i) t[i] *= gl[2 * i]; }
#pragma unroll
    for (int i = 0; i < 32; ++i) { const int kk = 2 * i + (lane >> 5); scr[kk * 33 + (lane & 31)] = t[i]; }
    LDS_WAIT(); asm volatile("" ::: "memory");
    const int c = lane & 7;
#pragma unroll
    for (int j = 0; j < 4; ++j) { const int n = (lane >> 3) + 8 * j; const LAS float* s = scr + (8 * c) * 33 + n;
        u32x4 o; o.x = pk2(s[0 * 33], s[1 * 33]); o.y = pk2(s[2 * 33], s[3 * 33]); o.z = pk2(s[4 * 33], s[5 * 33]); o.w = pk2(s[6 * 33], s[7 * 33]);
        st16_wt(WT + (size_t)n * ldo + 8 * c, o); }
    LDS_WAIT(); asm volatile("" ::: "memory");
}
__device__ __forceinline__ void transpose_item_fp8(const float* W, int ldw, unsigned char* WT, int ldo, LAS float* scr, int lane, const float* gk, float scale) {
    asm volatile("" : "+s"(ldw));
    const float* Wl = W + (size_t)(lane >> 5) * ldw + (lane & 31);
    float t[32];
#pragma unroll
    for (int i = 0; i < 32; ++i) t[i] = Wl[(size_t)(2 * i) * ldw];
    if (gk) { const float* gl = gk + (lane >> 5);
#pragma unroll
        for (int i = 0; i < 32; ++i) t[i] *= gl[2 * i]; }
#pragma unroll
    for (int i = 0; i < 32; ++i) { const int kk = 2 * i + (lane >> 5); scr[kk * 33 + (lane & 31)] = t[i]; }
    LDS_WAIT(); asm volatile("" ::: "memory");
    const int n = lane >> 1, hf = lane & 1; const LAS float* s = scr + (32 * hf) * 33 + n;
    u32x4 o0, o1;
    o0.x = pk4_fp8s(s[0 * 33], s[1 * 33], s[2 * 33], s[3 * 33], scale); o0.y = pk4_fp8s(s[4 * 33], s[5 * 33], s[6 * 33], s[7 * 33], scale);
    o0.z = pk4_fp8s(s[8 * 33], s[9 * 33], s[10 * 33], s[11 * 33], scale); o0.w = pk4_fp8s(s[12 * 33], s[13 * 33], s[14 * 33], s[15 * 33], scale);
    o1.x = pk4_fp8s(s[16 * 33], s[17 * 33], s[18 * 33], s[19 * 33], scale); o1.y = pk4_fp8s(s[20 * 33], s[21 * 33], s[22 * 33], s[23 * 33], scale);
    o1.z = pk4_fp8s(s[24 * 33], s[25 * 33], s[26 * 33], s[27 * 33], scale); o1.w = pk4_fp8s(s[28 * 33], s[29 * 33], s[30 * 33], s[31 * 33], scale);
    unsigned char* d = WT + (size_t)n * ldo + 32 * hf;
    st16_plain(d, o0); st16_plain(d + 16, o1);
    LDS_WAIT(); asm volatile("" ::: "memory");
}
__device__ __forceinline__ void rms_row_to_bf16(const float* xrow, const float* g, bf16* orow, int lane) {
    const GAS f32x4* xr = (const GAS f32x4*)xrow + lane; const GAS f32x4* gr = (const GAS f32x4*)g + lane;
    f32x4 v[4]; float s = 0.f;
#pragma unroll
    for (int j = 0; j < 4; ++j) { v[j] = xr[64 * j]; s += (v[j].x * v[j].x + v[j].y * v[j].y) + (v[j].z * v[j].z + v[j].w * v[j].w); }
    const float rinv = 1.0f / sqrtf(wave_sum(s) * (1.f / 1024.f) + EPS);
    GAS u32x2* o8 = (GAS u32x2*)orow + lane;
#pragma unroll
    for (int j = 0; j < 4; ++j) { const f32x4 gg = gr[64 * j]; u32x2 w; w.x = pk2(v[j].x * rinv * gg.x, v[j].y * rinv * gg.y); w.y = pk2(v[j].z * rinv * gg.z, v[j].w * rinv * gg.w); o8[64 * j] = w; }
}
__device__ __forceinline__ void wave_lds_sync() { asm volatile("s_waitcnt lgkmcnt(0)" ::: "memory"); }
template <int NIN, int astride> __device__ __forceinline__ void mlp_layer(const float* W  , const float* bvec, const float* fvec, const LAS float* ain, LAS float* aout, int lane) {
    float w[64];
    unsigned ul = (unsigned)lane; asm volatile("" : "+v"(ul));
#pragma unroll
    for (int i = 0; i < 64; ++i) w[i] = (i < NIN) ? W[(unsigned)(i * 64) + ul] : 0.f;
    const float b = bvec[lane], fr = fvec[lane];
#pragma unroll 1
    for (int p = 0; p < 16; ++p) {
        const LAS float* ap = ain + p * astride; float s = b;
        if (NIN == 33) {
#pragma unroll
            for (int i = 0; i < 33; ++i) s += ap[i] * w[i];
        } else {
#pragma unroll
            for (int i4 = 0; i4 < 16; ++i4) { const f32x4 hv = *(const LAS f32x4*)(ap + 4 * i4); s += (hv.x * w[4 * i4] + hv.y * w[4 * i4 + 1]) + (hv.z * w[4 * i4 + 2] + hv.w * w[4 * i4 + 3]); }
        }
        aout[p * 64 + lane] = sinf(fr * s);
    }
    asm volatile("s_waitcnt lgkmcnt(0)" ::: "memory");
}
__device__ __forceinline__ void filter_mlp_wave(Frame& F, int pb, int half, unsigned lds_off) {
    const int lane = F.lane;
    asm volatile("" : "+v"(lds_off));
    LAS float* a0 = (LAS float*)(F.lds + lds_off); LAS float* a1 = a0 + 16 * 36; LAS float* a2 = a1 + 1024;
    for (int i = lane; i < 16 * 33; i += 64) { const int p = i / 33, j = i % 33, l = 16 * pb + p; float v;
        if (j == 0) v = (float)l / 4095.0f;
        else { const int q = (j - 1) & 15; const float fq = 1e-4f + (float)q * ((15.0f - 1e-4f) / 15.0f); const float ang = fq * ((2.0f * 3.14159265358979323846f / 4096.0f) * (float)l); v = (j <= 16) ? cosf(ang) : -sinf(ang); }
        a0[p * 36 + j] = v; }
    asm volatile("s_waitcnt lgkmcnt(0)" ::: "memory");
    mlp_layer<33, 36>(F.f_w_in, F.f_b_in, F.f_freq, a0, a1, lane);
    mlp_layer<64, 64>(F.f_w_mid, F.f_b_mid, F.f_freq + 64, a1, a2, lane);
    mlp_layer<64, 64>(F.f_w_mid + 4096, F.f_b_mid + 64, F.f_freq + 128, a2, a1, lane);
    float* KT = WSP(float, WS_KT);
#pragma unroll 1
    for (int m = half; m < 16; m += 4) { const int j = 64 * m + lane;
        float w[64]; unsigned uj = (unsigned)j; asm volatile("" : "+v"(uj));
#pragma unroll
        for (int i = 0; i < 64; ++i) w[i] = F.f_w_out[(unsigned)(i * 1024) + uj];
        const float mind = -3.0701134573253946f, maxd = -15.350567286626973f;
        const float delta = fabsf(mind + (float)(j & 511) * ((maxd - mind) / 511.0f));
        f32x4* o4 = (f32x4*)(KT + (size_t)j * 4096 + 16 * pb);
#pragma unroll 1
        for (int pg = 0; pg < 4; ++pg) {
            float acc[4];
#pragma unroll
            for (int q = 0; q < 4; ++q) { const LAS float* ap = a1 + (4 * pg + q) * 64; float sacc = 0.f;
#pragma unroll
                for (int i4 = 0; i4 < 16; ++i4) { const f32x4 hv = *(const LAS f32x4*)(ap + 4 * i4); sacc += (hv.x * w[4 * i4] + hv.y * w[4 * i4 + 1]) + (hv.z * w[4 * i4 + 2] + hv.w * w[4 * i4 + 3]); }
                acc[q] = sacc * __expf(-((float)(16 * pb + 4 * pg + q) / 4095.0f) * delta); }
            o4[pg] = (f32x4){acc[0], acc[1], acc[2], acc[3]};
        }
    }
}
constexpr int WD_HERE = 0;
__device__ __forceinline__ void phase_prologue(Frame& F) {
    { const int gt = F.bid * NTHREADS + F.tid;
      if (gt < 4096) { f32x2 w; w.x = cospif((float)gt * (1.0f / 2048.0f)); w.y = -sinpif((float)gt * (1.0f / 2048.0f)); WSP(f32x2, WS_TW4096)[gt] = w; }
      else if (gt < 8192) { const int n = gt - 4096; f32x2 w; w.x = cospif((float)n * (1.0f / 4096.0f)); w.y = -sinpif((float)n * (1.0f / 4096.0f)); WSP(f32x2, WS_TW8192)[n] = w; } }
    LAS unsigned* ticket = (LAS unsigned*)(F.lds + 158 * 1024);
    for (int rr_ = 0; rr_ < ((MK_DUP == 15) ? 2 : 1); ++rr_) {
    __syncthreads();
    if (F.tid == 0) ticket[0] = 0u;
    __syncthreads();
    if (F.wave >= 4 && rr_ == 0) { for (int pb = F.bid; pb < 256; pb += F.G) filter_mlp_wave(F, pb, F.wave - 4, (unsigned)((72 + 12 * (F.wave - 4)) * 1024)); }
    {
        LAS float* scr = (LAS float*)(F.lds + F.wave * 8704);
        constexpr int I_IN = 16 * 64, I_OUT = 16 * 32, I_G = 32 * 16 * 16, I_D = 32 * 8 * 32, I_RMS = T_TOK / 4;
        constexpr int NITEMS = I_IN + I_OUT + 2 * I_G + I_RMS + WD_HERE;
        bf16* WIN_T = WSP(bf16, WS_WIN_T); bf16* WOUT_T = WSP(bf16, WS_WOUT_T); unsigned char* WGU8 = WSP(unsigned char, WS_WGU_T); unsigned char* WD8 = WSP(unsigned char, WS_WD_T); bf16* HN = WSP(bf16, WS_HN);
        f32x4 gg[4];
#pragma unroll
        for (int j = 0; j < 4; ++j) gg[j] = ((const GAS f32x4*)F.norm1_g)[64 * j + F.lane];
        for (;;) {
            unsigned tk = 0; if (F.lane == 0) tk = __hip_atomic_fetch_add((unsigned*)ticket, 1u, __ATOMIC_RELAXED, __HIP_MEMORY_SCOPE_WORKGROUP);
            tk = __builtin_amdgcn_readfirstlane(tk);
            const long itl = (long)tk * F.G + F.vcu; if (itl >= NITEMS) break;
            int r = (int)itl;
            if (r < I_RMS) {
                const int m0 = 4 * r; f32x4 v[4][4];
#pragma unroll
                for (int q = 0; q < 4; ++q) { const GAS f32x4* xr = (const GAS f32x4*)(F.x + (size_t)(m0 + q) * 1024) + F.lane;
#pragma unroll
                    for (int j = 0; j < 4; ++j) v[q][j] = xr[64 * j]; }
#pragma unroll
                for (int q = 0; q < 4; ++q) { float s = 0.f;
#pragma unroll
                    for (int j = 0; j < 4; ++j) s += (v[q][j].x * v[q][j].x + v[q][j].y * v[q][j].y) + (v[q][j].z * v[q][j].z + v[q][j].w * v[q][j].w);
                    const float rinv = 1.0f / sqrtf(wave_sum(s) * (1.f / 1024.f) + EPS);
                    GAS u32x2* o8 = (GAS u32x2*)(HN + (size_t)(m0 + q) * 1024) + F.lane;
#pragma unroll
                    for (int j = 0; j < 4; ++j) { u32x2 w; w.x = pk2(v[q][j].x * rinv * gg[j].x, v[q][j].y * rinv * gg[j].y); w.y = pk2(v[q][j].z * rinv * gg[j].z, v[q][j].w * rinv * gg[j].w); o8[64 * j] = w; } }
                continue; } r -= I_RMS;
            if (r < I_IN) { const int kb = r / 64, nb = r % 64; transpose_item(F.w_in + (size_t)(64 * kb) * D_IN_PROJ + 32 * nb, D_IN_PROJ, WIN_T + (size_t)(32 * nb) * 1024 + 64 * kb, 1024, scr, F.lane); continue; } r -= I_IN;
            if (r < I_OUT) { const int kb = r / 32, nb = r % 32; transpose_item(F.w_out + (size_t)(64 * kb) * 1024 + 32 * nb, 1024, WOUT_T + (size_t)(32 * nb) * 1024 + 64 * kb, 1024, scr, F.lane); continue; } r -= I_OUT;
            if (r < 2 * I_G) { const int up = r / I_G; r %= I_G; const int e = r / 256, kb = (r % 256) / 16, nb = r % 16; const int n0 = 32 * nb;
                const float* W = (up ? F.w_up : F.w_gate) + (size_t)e * 1024 * 512 + (size_t)(64 * kb) * 512 + n0;
                const int orow = 256 * (n0 >> 7) + (n0 & 127) + (up ? 128 : 0);
                transpose_item_fp8(W, 512, WGU8 + ((size_t)e * 1024 + orow) * 1024 + 64 * kb, 1024, scr, F.lane, F.norm2_g + 64 * kb, W_SCALE); continue; } r -= 2 * I_G;
            { const int e = r / 256, kb = (r % 256) / 32, nb = r % 32;
              transpose_item_fp8(F.w_down + (size_t)e * 512 * 1024 + (size_t)(64 * kb) * 1024 + 32 * nb, 1024, WD8 + ((size_t)e * 1024 + 32 * nb) * 512 + 64 * kb, 512, scr, F.lane, nullptr, W_SCALE); }
        }
        (void)I_D;
    }
    }
    __syncthreads();
}
__device__ __forceinline__ void wdown_items(Frame& F, int first, int stride) {
    LAS float* scr = (LAS float*)(F.lds + F.wave * 8704); unsigned char* WD8 = WSP(unsigned char, WS_WD_T);
    for (int r = WD_HERE + first; r < 32 * 8 * 32; r += stride) { const int e = r / 256, kb = (r % 256) / 32, nb = r % 32;
        transpose_item_fp8(F.w_down + (size_t)e * 512 * 1024 + (size_t)(64 * kb) * 1024 + 32 * nb, 1024, WD8 + ((size_t)e * 1024 + 32 * nb) * 512 + 64 * kb, 512, scr, F.lane, nullptr, W_SCALE); }
}

__device__ __forceinline__ void load_tw_lds(Frame& F, int tw_off, int tw256_off) {
    __syncthreads();
    LAS f32x2* tw = (LAS f32x2*)(F.lds + tw_off); const f32x2* g = WSP(f32x2, WS_TW4096);
    f32x2 tv[8];
#pragma unroll
    for (int i = 0; i < 8; ++i) tv[i] = g[F.tid + NTHREADS * i];
    const f32x2 t2 = g[16 * (F.tid & 255)];
#pragma unroll
    for (int i = 0; i < 8; ++i) tw[F.tid + NTHREADS * i] = tv[i];
    if (F.tid < 256) ((LAS f32x2*)(F.lds + tw256_off))[F.tid] = t2;
    __syncthreads();
}
__device__ __forceinline__ void fft_fwd3(Frame& F) {
    LAS cf* buf = (LAS cf*)(F.lds + ((F.tid >> 8) ? L_BUFB : L_BUFA)); const LAS cf* tw = (const LAS cf*)(F.lds + L_TW); const LAS cf* t256 = (const LAS cf*)(F.lds + L_TW256); const int r = F.tid & 255;
    fft_pass_fwd<1>(buf, tw, t256, r); __syncthreads(); fft_pass_fwd<2>(buf, tw, t256, r); __syncthreads(); fft_pass_fwd<3>(buf, tw, t256, r); __syncthreads();
}
__device__ __forceinline__ void fft_inv3(Frame& F) {
    LAS cf* buf = (LAS cf*)(F.lds + ((F.tid >> 8) ? L_BUFB : L_BUFA)); const LAS cf* tw = (const LAS cf*)(F.lds + L_TW); const LAS cf* t256 = (const LAS cf*)(F.lds + L_TW256); const int r = F.tid & 255;
    fft_pass_inv<3>(buf, tw, t256, r); __syncthreads(); fft_pass_inv<2>(buf, tw, t256, r); __syncthreads(); fft_pass_inv<1>(buf, tw, t256, r); __syncthreads();
}
__device__ __forceinline__ void filter_item(Frame& F, int c) {
    LAS cf* bufA = (LAS cf*)(F.lds + L_BUFA); LAS cf* bufB = (LAS cf*)(F.lds + L_BUFB);
    LAS float* kfb = (LAS float*)(F.lds + L_SCR);
    LAS float* red = (LAS float*)(F.lds + L_RED);
    const float* KT = WSP(float, WS_KT); const f32x2* tw2 = WSP(f32x2, WS_TW8192);
    float sfv[8], sbv[8]; f32x2 wv[8];
#pragma unroll
    for (int i = 0; i < 8; ++i) { const int l = F.tid + NTHREADS * i; sfv[i] = KT[(size_t)c * 4096 + l]; sbv[i] = KT[(size_t)(512 + c) * 4096 + l]; wv[i] = tw2[l]; }
    float asum = 0.f;
#pragma unroll
    for (int i = 0; i < 8; ++i) { const int l = F.tid + NTHREADS * i; kfb[l] = sfv[i]; kfb[4096 + l] = sbv[i]; asum += fabsf(sfv[i]) + (l >= 1 ? fabsf(sbv[i]) : 0.f); }
    asum = wave_sum(asum);
    if (F.lane == 0) red[128 + F.wave] = asum;
    __syncthreads();
    float tot = 0.f;
#pragma unroll
    for (int i = 0; i < 8; ++i) tot += red[128 + i];
    const float sc = 1.0f / (tot * 8192.0f);
#pragma unroll
    for (int i = 0; i < 8; ++i) { const int n = F.tid + NTHREADS * i;
        const float kf = sfv[i], kbm = (n >= 1) ? kfb[4096 + 4096 - n] : 0.f;
        const float a = (kf + kbm) * sc, d = (kf - kbm) * sc;
        bufA[fpos(n)] = mkc(a, 0.f); bufB[fpos(n)] = mkc(d * wv[i].x, d * wv[i].y); }
    __syncthreads();
    fft_fwd3(F);
    f32x2* KF = WSP(f32x2, WS_KF) + (size_t)c * 8192;
    for (int p = F.tid; p < 4096; p += NTHREADS) { const cf a = bufA[fpos(p)], b = bufB[fpos(p)]; KF[p] = (f32x2){a.x, a.y}; KF[4096 + p] = (f32x2){b.x, b.y}; }
    __syncthreads();
}
__device__ __forceinline__ const bf16* pt_at(const bf16* PT, int row, int tok) { return PT + ((size_t)(tok >> 8) * NPT_ROWS + row) * 256 + (tok & 255); }
struct Row8 { u32x4 w; float lft, rgt; };
__device__ __forceinline__ Row8 row8_load(const bf16* PT, int row, int tb, int l0) {
    Row8 r; r.w = *(const u32x4*)pt_at(PT, row, tb + l0);
    const bf16 a = *pt_at(PT, row, tb + (l0 > 0 ? l0 - 1 : 0)), b = *pt_at(PT, row, tb + (l0 + 8 < 4096 ? l0 + 8 : 4095));
    r.lft = (l0 > 0) ? bf1(a) : 0.f; r.rgt = (l0 + 8 < 4096) ? bf1(b) : 0.f; return r;
}
__device__ __forceinline__ void conv8(const Row8& r, float w0, float w1, float w2, float b, float (&o)[8]) {
    float u[10];
    u[0] = r.lft; u[9] = r.rgt; const u32x4 v = r.w;
    u[1] = bflo(v.x); u[2] = bfhi(v.x); u[3] = bflo(v.y); u[4] = bfhi(v.y); u[5] = bflo(v.z); u[6] = bfhi(v.z); u[7] = bflo(v.w); u[8] = bfhi(v.w);
#pragma unroll
    for (int i = 0; i < 8; ++i) o[i] = b + w0 * u[i] + w1 * u[i + 1] + w2 * u[i + 2];
}
struct HyRaw { Row8 a0, v0, a1, v1; };
__device__ __forceinline__ void hy_load(Frame& F, int it, HyRaw& r) {
    const int c = it >> 2, bp = it & 3, l0 = 8 * F.tid; const bf16* PT = WSP(bf16, WS_PT);
    const int tb = 2 * bp * SEQ;
    r.a0 = row8_load(PT, 512 + c, tb, l0); r.v0 = row8_load(PT, 1024 + c, tb, l0); r.a1 = row8_load(PT, 512 + c, tb + SEQ, l0); r.v1 = row8_load(PT, 1024 + c, tb + SEQ, l0);
}
__device__ __forceinline__ void hyena_items(Frame& F) {
    LAS cf* bufA = (LAS cf*)(F.lds + L_BUFA); LAS cf* bufB = (LAS cf*)(F.lds + L_BUFB); const LAS cf* tw2 = (const LAS cf*)(F.lds + L_SCR);
    const bf16* PT = WSP(bf16, WS_PT); const float* cw = F.conv_w; const float* cb = F.conv_b;
    const int l0 = 8 * F.tid;
    HyRaw nx; int it = F.bid;
    if (it < 2048) hy_load(F, it, nx);
    for (; it < 2048; it += F.G) {
        const int c = it >> 2, bp = it & 3;
        float z0[8], z1[8];
        {
            const float a0 = cw[512 + c], a1 = cw[1536 + 512 + c], a2 = cw[3072 + 512 + c], ab = cb[512 + c];
            const float v0 = cw[1024 + c], v1 = cw[1536 + 1024 + c], v2 = cw[3072 + 1024 + c], vb = cb[1024 + c];
            float t1[8], t2[8];
            conv8(nx.a0, a0, a1, a2, ab, t1); conv8(nx.v0, v0, v1, v2, vb, t2);
#pragma unroll
            for (int i = 0; i < 8; ++i) z0[i] = t1[i] * t2[i];
            conv8(nx.a1, a0, a1, a2, ab, t1); conv8(nx.v1, v0, v1, v2, vb, t2);
#pragma unroll
            for (int i = 0; i < 8; ++i) z1[i] = t1[i] * t2[i];
        }
#pragma unroll
        for (int i = 0; i < 8; ++i) { const int l = l0 + i; const cf z = mkc(z0[i], z1[i]); bufA[fpos(l)] = z; bufB[fpos(l)] = cmul(z, tw2[l]); }
        f32x2 ke[8], ko[8];
        { const f32x2* KF = WSP(f32x2, WS_KF) + (size_t)c * 8192;
#pragma unroll
          for (int i = 0; i < 8; ++i) { ke[i] = KF[F.tid + 512 * i]; ko[i] = KF[4096 + F.tid + 512 * i]; } }
        __syncthreads();
        fft_fwd3(F);
#pragma unroll
        for (int i = 0; i < 8; ++i) { const int q = fpos(F.tid + 512 * i); bufA[q] = cmul(bufA[q], ke[i]); bufB[q] = cmul(bufB[q], ko[i]); }
        Row8 xa, xb;
        { const int tb = 2 * bp * SEQ; xa = row8_load(PT, c, tb, l0); xb = row8_load(PT, c, tb + SEQ, l0); }
        if (it + F.G < 2048) hy_load(F, it + F.G, nx);
        __syncthreads();
        fft_inv3(F);
        {
            const float w0 = cw[c], w1 = cw[1536 + c], w2 = cw[3072 + c], wb = cb[c]; const float bias = F.f_bias[c];
            bf16* YT = WSP(bf16, WS_YT) + (size_t)c * T_TOK + (size_t)(2 * bp) * SEQ;
            float x0a[8], x0b[8], ya[8], yb[8];
            conv8(xa, w0, w1, w2, wb, x0a); conv8(xb, w0, w1, w2, wb, x0b);
#pragma unroll
            for (int i = 0; i < 8; ++i) { const int l = l0 + i; const cf e = bufA[fpos(l)], o = bufB[fpos(l)]; const cf y = cadd(e, cmulc(o, tw2[l]));
                ya[i] = x0a[i] * (y.x + bias * z0[i]); yb[i] = x0b[i] * (y.y + bias * z1[i]); }
            u32x4 oa, ob; oa.x = pk2(ya[0], ya[1]); oa.y = pk2(ya[2], ya[3]); oa.z = pk2(ya[4], ya[5]); oa.w = pk2(ya[6], ya[7]);
            ob.x = pk2(yb[0], yb[1]); ob.y = pk2(yb[2], yb[3]); ob.z = pk2(yb[4], yb[5]); ob.w = pk2(yb[6], yb[7]);
            *(u32x4*)(YT + l0) = oa; *(u32x4*)(YT + SEQ + l0) = ob;
        }
        __syncthreads();
    }
}
struct FoRaw { u32x4 a0, d0, a1, d1; };
__device__ __forceinline__ void fo_load(Frame& F, int q, FoRaw& r) {
    const int f = F.tid >> 8, s = 2 * q + f, b = s >> 9, gc = s & 511, g = gc >> 6, cp = gc & 63, l0 = 16 * (F.tid & 255);
    const bf16* PT = WSP(bf16, WS_PT); const int r1 = 1536 + 128 * g + cp, r2 = r1 + 64, tk = b * SEQ + l0;
    r.a0 = *(const u32x4*)pt_at(PT, r1, tk); r.d0 = *(const u32x4*)pt_at(PT, r2, tk); r.a1 = *(const u32x4*)pt_at(PT, r1, tk + 8); r.d1 = *(const u32x4*)pt_at(PT, r2, tk + 8);
}
__device__ __forceinline__ void fo_put(LAS cf* buf, int l, u32x4 a, u32x4 d) {
    buf[fpos(l + 0)] = mkc(bflo(a.x), bflo(d.x)); buf[fpos(l + 1)] = mkc(bfhi(a.x), bfhi(d.x)); buf[fpos(l + 2)] = mkc(bflo(a.y), bflo(d.y)); buf[fpos(l + 3)] = mkc(bfhi(a.y), bfhi(d.y));
    buf[fpos(l + 4)] = mkc(bflo(a.z), bflo(d.z)); buf[fpos(l + 5)] = mkc(bfhi(a.z), bfhi(d.z)); buf[fpos(l + 6)] = mkc(bflo(a.w), bflo(d.w)); buf[fpos(l + 7)] = mkc(bfhi(a.w), bfhi(d.w));
}
__device__ __forceinline__ void fourier_items(Frame& F) {
    const int f = F.tid >> 8, r = F.tid & 255, l0 = 16 * r;
    LAS cf* buf = (LAS cf*)(F.lds + (f ? L_BUFB : L_BUFA));
    FoRaw nx; int q = F.bid;
    if (q < 2048) fo_load(F, q, nx);
    for (; q < 2048; q += F.G) {
        const int s = 2 * q + f, b = s >> 9, gc = s & 511;
        fo_put(buf, l0, nx.a0, nx.d0); fo_put(buf, l0 + 8, nx.a1, nx.d1);
        if (q + F.G < 2048) fo_load(F, q + F.G, nx);
        __syncthreads();
        fft_fwd3(F);
        bf16* YT = WSP(bf16, WS_YT) + (size_t)(512 + gc) * T_TOK + (size_t)b * SEQ;
        float y[16];
#pragma unroll
        for (int i = 0; i < 16; ++i) y[i] = buf[fpos(freq_pos(l0 + i))].x * (1.0f / 512.0f);
        u32x4 o0, o1; o0.x = pk2(y[0], y[1]); o0.y = pk2(y[2], y[3]); o0.z = pk2(y[4], y[5]); o0.w = pk2(y[6], y[7]);
        o1.x = pk2(y[8], y[9]); o1.y = pk2(y[10], y[11]); o1.z = pk2(y[12], y[13]); o1.w = pk2(y[14], y[15]);
        *(u32x4*)(YT + l0) = o0; *(u32x4*)(YT + l0 + 8) = o1;
        __syncthreads();
    }
}

#define MF_LO 1
constexpr int MF_NS = 288;
constexpr int MF_PS = 24;
constexpr int MF_PLANE = 6144;
typedef short bf16x8v __attribute__((ext_vector_type(8)));
typedef short s16x4v __attribute__((ext_vector_type(4)));
typedef float f32x16 __attribute__((ext_vector_type(16)));
struct DftFrag { bf16x8v hi[2], lo[2]; };
__device__ __forceinline__ void make_dft_frag(DftFrag& f, int lane, bool inv, const LAS cf* tw  ) {
    const int i = lane & 31, h = lane >> 5, ii = i & 15;
#pragma unroll
    for (int st = 0; st < 2; ++st)
#pragma unroll
        for (int j = 0; j < 8; ++j) { const int e = 8 * h + j; const int m = (ii * e) & 15; const cf w = tw[256 * m]; const float c = w.x, s = -w.y;
            const float di = inv ? s : -s;
            const float val = (st == 0) ? ((i < 16) ? c : di) : ((i < 16) ? -di : c);
            const unsigned hb = f2bf(val); const float rem = val - __builtin_bit_cast(float, hb << 16);
            f.hi[st][j] = (short)hb; f.lo[st][j] = (short)f2bf(rem); }
}
__device__ __forceinline__ unsigned cvtpk_v(float lo, float hi) { typedef float f32x2_t __attribute__((ext_vector_type(2))); typedef __bf16 bf16x2_t __attribute__((ext_vector_type(2))); const f32x2_t v = {lo, hi}; const bf16x2_t b = __builtin_convertvector(v, bf16x2_t); return __builtin_bit_cast(unsigned, b); }
__device__ __forceinline__ s16x4v lds_tr16(const LAS bf16* p) { typedef short v4i16_t __attribute__((ext_vector_type(4))); return __builtin_bit_cast(s16x4v, __builtin_amdgcn_ds_read_tr16_b64_v4i16((LAS v4i16_t*)p)); }
template <int PASS, bool INV, int EPI>
__device__ __forceinline__ void mfft_block(const LAS bf16* inR, const LAS bf16* inI, LAS bf16* outR, LAS bf16* outI, const DftFrag& M, const LAS cf* tw, const LAS cf* tw256, int cb, int lane, const cf* kf, float rs) {
    asm volatile("" : "+v"(lane));
    const int n = lane & 31, h = lane >> 5;
    bf16x8v bR, bI;
    if (PASS == 1) {
        const int g = lane >> 4, q = (lane & 15) >> 2, p = lane & 3;
        const int off = (8 * (g >> 1) + q) * MF_NS + 32 * cb + 16 * (g & 1) + 4 * p;
        const LAS bf16* pr = inR + off; const LAS bf16* pi = inI + off;
        const s16x4v r0 = lds_tr16(pr), r1 = lds_tr16(pr + 4 * MF_NS), i0 = lds_tr16(pi), i1 = lds_tr16(pi + 4 * MF_NS);
        asm volatile("" :: "v"(pr), "v"(pi) : "memory");
        bR = (bf16x8v){r0[0], r0[1], r0[2], r0[3], r1[0], r1[1], r1[2], r1[3]}; bI = (bf16x8v){i0[0], i0[1], i0[2], i0[3], i1[0], i1[1], i1[2], i1[3]};
    } else {
        const int off = (32 * cb + n) * MF_PS + 8 * h;
        bR = *(const LAS bf16x8v*)(inR + off); bI = *(const LAS bf16x8v*)(inI + off);
    }
    f32x16 acc = {0.f, 0.f, 0.f, 0.f, 0.f, 0.f, 0.f, 0.f, 0.f, 0.f, 0.f, 0.f, 0.f, 0.f, 0.f, 0.f};
    acc = __builtin_amdgcn_mfma_f32_32x32x16_bf16(M.hi[0], bR, acc, 0, 0, 0);
    acc = __builtin_amdgcn_mfma_f32_32x32x16_bf16(M.hi[1], bI, acc, 0, 0, 0);
#if MF_LO
    acc = __builtin_amdgcn_mfma_f32_32x32x16_bf16(M.lo[0], bR, acc, 0, 0, 0);
    acc = __builtin_amdgcn_mfma_f32_32x32x16_bf16(M.lo[1], bI, acc, 0, 0, 0);
#endif
    const int c = 32 * cb + n;
    int base, qs;
    if (PASS == 1) { base = MF_PS * (c & 15) + (c >> 4) + 64 * MF_PS * h; qs = 16 * MF_PS; }
    else if (PASS == 2) { base = 16 * MF_PS * (c >> 4) + (c & 15) + 4 * MF_PS * h; qs = MF_PS; }
    else { base = (c >> 4) + 16 * (c & 15) + 4 * MF_NS * h; qs = MF_NS; }
    float yr[8], yi[8];
#pragma unroll
    for (int q = 0; q < 8; ++q) { float a = acc[q], b = acc[8 + q];
        if (PASS == 1) { const int s = (q & 3) + 8 * (q >> 2) + 4 * h; const cf w = tw[(c * s) & 4095]; const float wy = INV ? -w.y : w.y; const float t = a * w.x - b * wy; b = a * wy + b * w.x; a = t; }
        else if (PASS == 2) { const int s = (q & 3) + 8 * (q >> 2) + 4 * h; const cf w = tw256[(c & 15) * s]; const float wy = INV ? -w.y : w.y; const float t = a * w.x - b * wy; b = a * wy + b * w.x; a = t; }
        else if (EPI == 1) { const cf w = kf[q]; const float t = a * w.x - b * w.y; b = -(a * w.y + b * w.x); a = t; }
        else if (EPI == 2) { a *= rs; }
        else if (EPI == 3) { a *= rs; b *= rs; }
        yr[q] = a; yi[q] = b; }
#pragma unroll
    for (int q = 0; q < 8; q += 2) { const int o0 = base + qs * ((q & 3) + 8 * (q >> 2)), o1 = o0 + qs;
        const unsigned pr = cvtpk_v(yr[q], yr[q + 1]); outR[o0] = (bf16)(pr & 0xffffu); outR[o1] = (bf16)(pr >> 16);
        if (!(PASS == 3 && EPI == 2)) { const unsigned pi = cvtpk_v(yi[q], yi[q + 1]); outI[o0] = (bf16)(pi & 0xffffu); outI[o1] = (bf16)(pi >> 16); } }
}

__device__ __forceinline__ int mf_nat(int x) { return MF_NS * (x >> 8) + (x & 255); }
__device__ __forceinline__ void fo2_load(Frame& F, int q, FoRaw& r) {
    const int f = F.tid >> 8, pp = 2 * q + f, b = pp >> 8, c = 2 * (pp & 255), l0 = 16 * (F.tid & 255);
    const bf16* PT = WSP(bf16, WS_PT); const int r1 = 1536 + c, r2 = r1 + 1, tk = b * SEQ + l0;
    r.a0 = *(const u32x4*)pt_at(PT, r1, tk); r.d0 = *(const u32x4*)pt_at(PT, r2, tk); r.a1 = *(const u32x4*)pt_at(PT, r1, tk + 8); r.d1 = *(const u32x4*)pt_at(PT, r2, tk + 8);
}
__device__ __forceinline__ void fourier_items_mfma(Frame& F) {
    const int f = F.tid >> 8, r = F.tid & 255, l0 = 16 * r, n0 = mf_nat(l0);
    LAS bf16* S0R = (LAS bf16*)(F.lds + f * 49152); LAS bf16* S0I = S0R + MF_PLANE; LAS bf16* S1R = S0R + 2 * MF_PLANE; LAS bf16* S1I = S0R + 3 * MF_PLANE;
    const LAS cf* tw = (const LAS cf*)(F.lds + M_TW); const LAS cf* t256 = (const LAS cf*)(F.lds + M_TW256);
    DftFrag Mf; make_dft_frag(Mf, F.lane, false, tw);
    const int cb0 = 2 * (F.wave & 3);
    bf16* SP = WSP(bf16, WS_SP);
    FoRaw nx; int q = F.bid;
    if (q < 1024) fo2_load(F, q, nx);
    for (; q < 1024; q += F.G) {
        const int pp = 2 * q + f, b = pp >> 8, c = 2 * (pp & 255);
        *(LAS u32x4*)(S0R + n0) = nx.a0; *(LAS u32x4*)(S0R + n0 + 8) = nx.a1; *(LAS u32x4*)(S0I + n0) = nx.d0; *(LAS u32x4*)(S0I + n0 + 8) = nx.d1;
        if (q + F.G < 1024) fo2_load(F, q + F.G, nx);
        __syncthreads();
        mfft_block<1, false, 0>(S0R, S0I, S1R, S1I, Mf, tw, t256, cb0, F.lane, nullptr, 1.f); mfft_block<1, false, 0>(S0R, S0I, S1R, S1I, Mf, tw, t256, cb0 + 1, F.lane, nullptr, 1.f);
        __syncthreads();
        mfft_block<2, false, 0>(S1R, S1I, S0R, S0I, Mf, tw, t256, cb0, F.lane, nullptr, 1.f); mfft_block<2, false, 0>(S1R, S1I, S0R, S0I, Mf, tw, t256, cb0 + 1, F.lane, nullptr, 1.f);
        __syncthreads();
        mfft_block<3, false, 0>(S0R, S0I, S1R, S1I, Mf, tw, t256, cb0, F.lane, nullptr, 1.f); mfft_block<3, false, 0>(S0R, S0I, S1R, S1I, Mf, tw, t256, cb0 + 1, F.lane, nullptr, 1.f);
        __syncthreads();
        {
            const int k0 = 8 * r, m0 = mf_nat(k0);
            const u32x4 zr = *(const LAS u32x4*)(S1R + m0), zi = *(const LAS u32x4*)(S1I + m0);
            float Zr[8], Zi[8], Mr[8], Mi[8];
            Zr[0] = bflo(zr.x); Zr[1] = bfhi(zr.x); Zr[2] = bflo(zr.y); Zr[3] = bfhi(zr.y); Zr[4] = bflo(zr.z); Zr[5] = bfhi(zr.z); Zr[6] = bflo(zr.w); Zr[7] = bfhi(zr.w);
            Zi[0] = bflo(zi.x); Zi[1] = bfhi(zi.x); Zi[2] = bflo(zi.y); Zi[3] = bfhi(zi.y); Zi[4] = bflo(zi.z); Zi[5] = bfhi(zi.z); Zi[6] = bflo(zi.w); Zi[7] = bfhi(zi.w);
#pragma unroll
            for (int i = 0; i < 8; ++i) { const int km = mf_nat((4096 - k0 - i) & 4095); Mr[i] = bf1(S1R[km]); Mi[i] = bf1(S1I[km]); }
            float Ac[8], Bc[8], Ad[8], Bd[8];
#pragma unroll
            for (int i = 0; i < 8; ++i) { Ac[i] = 0.5f * (Zr[i] + Mr[i]); Bc[i] = 0.5f * (Mi[i] - Zi[i]); Ad[i] = 0.5f * (Zi[i] + Mi[i]); Bd[i] = 0.5f * (Zr[i] - Mr[i]); }
            if (k0 == 0) { const int kn = mf_nat(2048); Bc[0] = bf1(S1R[kn]); Bd[0] = bf1(S1I[kn]); }
            bf16* s0 = SP + ((size_t)(c * 8 + b) * 2) * 2048 + k0; bf16* s1 = SP + ((size_t)((c + 1) * 8 + b) * 2) * 2048 + k0;
            u32x4 o; o.x = pk2(Ac[0], Ac[1]); o.y = pk2(Ac[2], Ac[3]); o.z = pk2(Ac[4], Ac[5]); o.w = pk2(Ac[6], Ac[7]); st16_wt(s0, o);
            o.x = pk2(Bc[0], Bc[1]); o.y = pk2(Bc[2], Bc[3]); o.z = pk2(Bc[4], Bc[5]); o.w = pk2(Bc[6], Bc[7]); st16_wt(s0 + 2048, o);
            o.x = pk2(Ad[0], Ad[1]); o.y = pk2(Ad[2], Ad[3]); o.z = pk2(Ad[4], Ad[5]); o.w = pk2(Ad[6], Ad[7]); st16_wt(s1, o);
            o.x = pk2(Bd[0], Bd[1]); o.y = pk2(Bd[2], Bd[3]); o.z = pk2(Bd[4], Bd[5]); o.w = pk2(Bd[6], Bd[7]); st16_wt(s1 + 2048, o);
        }
        __syncthreads();
    }
    __syncthreads();
}
__device__ __forceinline__ void hyena_items_mfma(Frame& F) {
    const int f = F.tid >> 8;
    LAS bf16* A0R = (LAS bf16*)F.lds; LAS bf16* A0I = A0R + MF_PLANE; LAS bf16* B0R = (LAS bf16*)(F.lds + 49152); LAS bf16* B0I = B0R + MF_PLANE;
    LAS bf16* S0R = (LAS bf16*)(F.lds + f * 49152); LAS bf16* S0I = S0R + MF_PLANE; LAS bf16* S1R = S0R + 2 * MF_PLANE; LAS bf16* S1I = S0R + 3 * MF_PLANE;
    const LAS cf* tw = (const LAS cf*)(F.lds + M_TW); const LAS cf* t256 = (const LAS cf*)(F.lds + M_TW256);
    const cf w81 = mkc(0.99999970586288221916f, -0.00076699031874270453f);
    DftFrag Mf; make_dft_frag(Mf, F.lane, false, tw);
    const bf16* PT = WSP(bf16, WS_PT); const float* cw = F.conv_w; const float* cb = F.conv_b;
    const int l0 = 8 * F.tid, n0 = mf_nat(l0), cb0 = 2 * (F.wave & 3), ln = F.lane & 31, lh = F.lane >> 5;
    HyRaw nx; int it = F.bid;
    if (it < 2048) hy_load(F, it, nx);
    for (; it < 2048; it += F.G) {
        const int c = it >> 2, bp = it & 3;
        float z0[8], z1[8];
        {
            const float a0 = cw[512 + c], a1 = cw[1536 + 512 + c], a2 = cw[3072 + 512 + c], ab = cb[512 + c];
            const float v0 = cw[1024 + c], v1 = cw[1536 + 1024 + c], v2 = cw[3072 + 1024 + c], vb = cb[1024 + c];
            float t1[8], t2[8];
            conv8(nx.a0, a0, a1, a2, ab, t1); conv8(nx.v0, v0, v1, v2, vb, t2);
#pragma unroll
            for (int i = 0; i < 8; ++i) z0[i] = t1[i] * t2[i];
            conv8(nx.a1, a0, a1, a2, ab, t1); conv8(nx.v1, v0, v1, v2, vb, t2);
#pragma unroll
            for (int i = 0; i < 8; ++i) z1[i] = t1[i] * t2[i];
        }
        {
            float br[8], bi[8];
#pragma unroll
            for (int i = 0; i < 8; ++i) { cf w = tw[(l0 >> 1) + (i >> 1)]; if (i & 1) w = cmul(w, w81); br[i] = z0[i] * w.x - z1[i] * w.y; bi[i] = z0[i] * w.y + z1[i] * w.x; }
            u32x4 v; v.x = pk2h(z0[0], z0[1]); v.y = pk2h(z0[2], z0[3]); v.z = pk2h(z0[4], z0[5]); v.w = pk2h(z0[6], z0[7]); *(LAS u32x4*)(A0R + n0) = v;
            v.x = pk2h(z1[0], z1[1]); v.y = pk2h(z1[2], z1[3]); v.z = pk2h(z1[4], z1[5]); v.w = pk2h(z1[6], z1[7]); *(LAS u32x4*)(A0I + n0) = v;
            v.x = pk2h(br[0], br[1]); v.y = pk2h(br[2], br[3]); v.z = pk2h(br[4], br[5]); v.w = pk2h(br[6], br[7]); *(LAS u32x4*)(B0R + n0) = v;
            v.x = pk2h(bi[0], bi[1]); v.y = pk2h(bi[2], bi[3]); v.z = pk2h(bi[4], bi[5]); v.w = pk2h(bi[6], bi[7]); *(LAS u32x4*)(B0I + n0) = v;
        }
        __syncthreads();
        mfft_block<1, false, 0>(S0R, S0I, S1R, S1I, Mf, tw, t256, cb0, F.lane, nullptr, 1.f); mfft_block<1, false, 0>(S0R, S0I, S1R, S1I, Mf, tw, t256, cb0 + 1, F.lane, nullptr, 1.f);
        cf kf[2][8];
        { const f32x4* KF = (const f32x4*)(WSP(f32x2, WS_KF) + (size_t)c * 8192 + (size_t)f * 4096);
#pragma unroll
          for (int j = 0; j < 2; ++j) { const int cc = 32 * (cb0 + j) + ln; const f32x4* kp = KF + (cc * 16 + 4 * lh) / 2;
              const f32x4 k0 = kp[0], k1 = kp[1], k2 = kp[4], k3 = kp[5];
              kf[j][0] = mkc(k0.x, k0.y); kf[j][1] = mkc(k0.z, k0.w); kf[j][2] = mkc(k1.x, k1.y); kf[j][3] = mkc(k1.z, k1.w);
              kf[j][4] = mkc(k2.x, k2.y); kf[j][5] = mkc(k2.z, k2.w); kf[j][6] = mkc(k3.x, k3.y); kf[j][7] = mkc(k3.z, k3.w); } }
        __syncthreads();
        mfft_block<2, false, 0>(S1R, S1I, S0R, S0I, Mf, tw, t256, cb0, F.lane, nullptr, 1.f); mfft_block<2, false, 0>(S1R, S1I, S0R, S0I, Mf, tw, t256, cb0 + 1, F.lane, nullptr, 1.f);
        __syncthreads();
        mfft_block<3, false, 1>(S0R, S0I, S1R, S1I, Mf, tw, t256, cb0, F.lane, kf[0], 1.f); mfft_block<3, false, 1>(S0R, S0I, S1R, S1I, Mf, tw, t256, cb0 + 1, F.lane, kf[1], 1.f);
        __syncthreads();
        mfft_block<1, false, 0>(S1R, S1I, S0R, S0I, Mf, tw, t256, cb0, F.lane, nullptr, 1.f); mfft_block<1, false, 0>(S1R, S1I, S0R, S0I, Mf, tw, t256, cb0 + 1, F.lane, nullptr, 1.f);
        __syncthreads();
        mfft_block<2, false, 0>(S0R, S0I, S1R, S1I, Mf, tw, t256, cb0, F.lane, nullptr, 1.f); mfft_block<2, false, 0>(S0R, S0I, S1R, S1I, Mf, tw, t256, cb0 + 1, F.lane, nullptr, 1.f);
        Row8 xa, xb;
        { const int tb = 2 * bp * SEQ; xa = row8_load(PT, c, tb, l0); xb = row8_load(PT, c, tb + SEQ, l0); }
        if (it + F.G < 2048) hy_load(F, it + F.G, nx);
        __syncthreads();
        mfft_block<3, false, 0>(S1R, S1I, S0R, S0I, Mf, tw, t256, cb0, F.lane, nullptr, 1.f); mfft_block<3, false, 0>(S1R, S1I, S0R, S0I, Mf, tw, t256, cb0 + 1, F.lane, nullptr, 1.f);
        __syncthreads();
        {
            const float w0 = cw[c], w1 = cw[1536 + c], w2 = cw[3072 + c], wb = cb[c]; const float bias = F.f_bias[c];
            bf16* YT = WSP(bf16, WS_YT) + (size_t)c * T_TOK + (size_t)(2 * bp) * SEQ;
            float x0a[8], x0b[8], ya[8], yb[8], er[8], ei[8], orr[8], oi[8];
            conv8(xa, w0, w1, w2, wb, x0a); conv8(xb, w0, w1, w2, wb, x0b);
            { const u32x4 a = *(const LAS u32x4*)(A0R + n0), b = *(const LAS u32x4*)(A0I + n0), d = *(const LAS u32x4*)(B0R + n0), g = *(const LAS u32x4*)(B0I + n0);
              er[0] = bflo(a.x); er[1] = bfhi(a.x); er[2] = bflo(a.y); er[3] = bfhi(a.y); er[4] = bflo(a.z); er[5] = bfhi(a.z); er[6] = bflo(a.w); er[7] = bfhi(a.w);
              ei[0] = bflo(b.x); ei[1] = bfhi(b.x); ei[2] = bflo(b.y); ei[3] = bfhi(b.y); ei[4] = bflo(b.z); ei[5] = bfhi(b.z); ei[6] = bflo(b.w); ei[7] = bfhi(b.w);
              orr[0] = bflo(d.x); orr[1] = bfhi(d.x); orr[2] = bflo(d.y); orr[3] = bfhi(d.y); orr[4] = bflo(d.z); orr[5] = bfhi(d.z); orr[6] = bflo(d.w); orr[7] = bfhi(d.w);
              oi[0] = bflo(g.x); oi[1] = bfhi(g.x); oi[2] = bflo(g.y); oi[3] = bfhi(g.y); oi[4] = bflo(g.z); oi[5] = bfhi(g.z); oi[6] = bflo(g.w); oi[7] = bfhi(g.w); }
#pragma unroll
            for (int i = 0; i < 8; ++i) { cf w = tw[(l0 >> 1) + (i >> 1)]; if (i & 1) w = cmul(w, w81);
                const float eim = -ei[i], oim = -oi[i];
                const float yr = er[i] + (orr[i] * w.x + oim * w.y), yi = eim + (oim * w.x - orr[i] * w.y);
                ya[i] = x0a[i] * (yr + bias * z0[i]); yb[i] = x0b[i] * (yi + bias * z1[i]); }
            u32x4 oa, ob; oa.x = pk2h(ya[0], ya[1]); oa.y = pk2h(ya[2], ya[3]); oa.z = pk2h(ya[4], ya[5]); oa.w = pk2h(ya[6], ya[7]);
            ob.x = pk2h(yb[0], yb[1]); ob.y = pk2h(yb[2], yb[3]); ob.z = pk2h(yb[4], yb[5]); ob.w = pk2h(yb[6], yb[7]);
            st16_wt(YT + l0, oa); st16_wt(YT + SEQ + l0, ob);
        }
        __syncthreads();
    }
}

__device__ __forceinline__ void phase_headnorm(Frame& F) {
    LAS float* tl = (LAS float*)F.lds;
    LAS float* rs = tl + 64 * 257;
    const bf16* YT = WSP(bf16, WS_YT); bf16* YN = WSP(bf16, WS_YN);
    u32x4 nxv[4];
    if (F.bid < 8 * 128) { const int h = F.bid & 7, tok0 = (F.bid >> 3) * 256;
#pragma unroll
        for (int i = 0; i < 4; ++i) { const int idx = F.tid + 512 * i, row = idx >> 5, ch = idx & 31; nxv[i] = *(const u32x4*)(YT + (size_t)(64 * h + row) * T_TOK + tok0 + 8 * ch); } }
    for (int it = F.bid; it < 8 * 128; it += F.G) {
        const int h = it & 7, tt = it >> 3, tok0 = tt * 256;
#pragma unroll
        for (int i = 0; i < 4; ++i) { const int idx = F.tid + 512 * i, row = idx >> 5, ch = idx & 31;
            const u32x4 v = nxv[i]; LAS float* d = tl + row * 257 + 8 * ch;
            d[0] = bflo(v.x); d[1] = bfhi(v.x); d[2] = bflo(v.y); d[3] = bfhi(v.y); d[4] = bflo(v.z); d[5] = bfhi(v.z); d[6] = bflo(v.w); d[7] = bfhi(v.w); }
        if (it + F.G < 8 * 128) { const int it2 = it + F.G, h2 = it2 & 7, tk2 = (it2 >> 3) * 256;
#pragma unroll
            for (int i = 0; i < 4; ++i) { const int idx = F.tid + 512 * i, row = idx >> 5, ch = idx & 31; nxv[i] = *(const u32x4*)(YT + (size_t)(64 * h2 + row) * T_TOK + tk2 + 8 * ch); } }
        __syncthreads();
        if (F.tid < 256) { float s = 0.f;
#pragma unroll 8
            for (int c = 0; c < 64; ++c) { const float v = tl[c * 257 + F.tid]; s += v * v; }
            rs[F.tid] = 1.0f / sqrtf(s * (1.0f / 64.0f) + EPS); }
        __syncthreads();
#pragma unroll
        for (int i = 0; i < 4; ++i) { const int idx = F.tid + 512 * i, tok = idx >> 3, q = idx & 7; const float r = rs[tok]; const float* g = F.mix_g + 64 * h + 8 * q;
            float v[8];
#pragma unroll
            for (int j = 0; j < 8; ++j) v[j] = tl[(8 * q + j) * 257 + tok] * r * g[j];
            u32x4 o; o.x = pk2(v[0], v[1]); o.y = pk2(v[2], v[3]); o.z = pk2(v[4], v[5]); o.w = pk2(v[6], v[7]);
            st16_wt(YN + (size_t)(tok0 + tok) * 1024 + 64 * h + 8 * q, o); }
        __syncthreads();
    }
}

constexpr int MX_NS = 288, MX_XA = 0, MX_XB = 64 * MX_NS * 2, MX_MT = 2 * MX_XB, MX_MTLO = MX_MT + 32768, MX_NYQ = MX_MTLO + 32768, MX_SLOT = 144;
__device__ __forceinline__ void mix_load(Frame& F, int tile, u32x4 (&v)[8]) {
    const int b = tile >> 6, g = (tile >> 3) & 7, kt = tile & 7; const bf16* SP = WSP(bf16, WS_SP);
#pragma unroll
    for (int u = 0; u < 8; ++u) { const int idx = F.tid + NTHREADS * u, row = idx >> 5, ch = idx & 31, ab = row >> 6, c = row & 63;
        v[u] = *(const u32x4*)(SP + ((size_t)((64 * g + c) * 8 + b) * 2 + ab) * 2048 + 256 * kt + 8 * ch); }
}
__device__ __forceinline__ void fourier_mix(Frame& F) {
    LAS bf16* XA = (LAS bf16*)(F.lds + MX_XA); LAS bf16* XB = (LAS bf16*)(F.lds + MX_XB);
    LAS u32x4* MT = (LAS u32x4*)(F.lds + MX_MT); LAS u32x4* MTL = (LAS u32x4*)(F.lds + MX_MTLO); LAS float* nyq = (LAS float*)(F.lds + MX_NYQ);
    LAS unsigned char* STG = F.lds;
    const bf16* SP = WSP(bf16, WS_SP); bf16* YN = WSP(bf16, WS_YN);
    LAS float* cst = nyq + 64;
    __syncthreads();
    if (F.tid < 64) { cst[F.tid] = cospif((float)F.tid * (1.0f / 32.0f)); cst[64 + F.tid] = sinpif((float)F.tid * (1.0f / 32.0f)); }
    __syncthreads();
    for (int idx = F.tid; idx < 32 * 64; idx += NTHREADS) { const int lane = idx & 63, fs = idx >> 6, rb = fs >> 3, s = fs & 7, i = lane & 31, h = lane >> 5;
        unsigned hw[4], lw[4];
#pragma unroll
        for (int jj = 0; jj < 4; ++jj) { unsigned hh[2], ll[2];
#pragma unroll
            for (int u = 0; u < 2; ++u) { const int j = 2 * jj + u, kap = 16 * s + 8 * h + j, c = kap & 63, isB = kap >> 6, cpp = 32 * rb + i, cp = cpp & 63, mir = cpp >> 6;
                const int m = (c * cp) & 63; const float cv = cst[m], sv = cst[64 + m];
                const float val = (isB ? (mir ? sv : -sv) : cv) * (1.0f / 512.0f);
                hh[u] = f2bf(val); ll[u] = f2bf(val - __builtin_bit_cast(float, hh[u] << 16)); }
            hw[jj] = hh[0] | (hh[1] << 16); lw[jj] = ll[0] | (ll[1] << 16); }
        MT[idx] = (u32x4){hw[0], hw[1], hw[2], hw[3]}; MTL[idx] = (u32x4){lw[0], lw[1], lw[2], lw[3]}; }
    u32x4 nxv[8];
    if (F.bid < 512) mix_load(F, F.bid, nxv);
    for (int tile = F.bid; tile < 512; tile += F.G) {
        const int b = tile >> 6, g = (tile >> 3) & 7, kt = tile & 7;
        __syncthreads();
#pragma unroll
        for (int u = 0; u < 8; ++u) { const int idx = F.tid + NTHREADS * u, row = idx >> 5, ch = idx & 31, ab = row >> 6, c = row & 63;
            u32x4 v = nxv[u];
            if (kt == 0 && ab == 1 && ch == 0) { nyq[c] = bflo(v.x); v.x &= 0xffff0000u; }
            *(LAS u32x4*)((ab ? XB : XA) + c * MX_NS + 8 * ch) = v; }
        if (tile + F.G < 512) mix_load(F, tile + F.G, nxv);
        __syncthreads();
        f32x16 acc[4];
#pragma unroll
        for (int rb = 0; rb < 4; ++rb) acc[rb] = (f32x16){0.f, 0.f, 0.f, 0.f, 0.f, 0.f, 0.f, 0.f, 0.f, 0.f, 0.f, 0.f, 0.f, 0.f, 0.f, 0.f};
        { int lane = F.lane; asm volatile("" : "+v"(lane));
          const int gq = lane >> 4, q = (lane & 15) >> 2, p = lane & 3;
#pragma unroll
          for (int s = 0; s < 8; ++s) {
              const LAS bf16* pr = ((s < 4) ? XA : XB) + (16 * (s & 3) + 8 * (gq >> 1) + q) * MX_NS + 32 * F.wave + 16 * (gq & 1) + 4 * p;
              const s16x4v r0 = lds_tr16(pr), r1 = lds_tr16(pr + 4 * MX_NS);
              asm volatile("" :: "v"(pr) : "memory");
              const bf16x8v bfr = (bf16x8v){r0[0], r0[1], r0[2], r0[3], r1[0], r1[1], r1[2], r1[3]};
#pragma unroll
              for (int rb = 0; rb < 4; ++rb) { const bf16x8v mh = __builtin_bit_cast(bf16x8v, MT[(rb * 8 + s) * 64 + lane]), ml = __builtin_bit_cast(bf16x8v, MTL[(rb * 8 + s) * 64 + lane]);
                  acc[rb] = __builtin_amdgcn_mfma_f32_32x32x16_bf16(mh, bfr, acc[rb], 0, 0, 0); acc[rb] = __builtin_amdgcn_mfma_f32_32x32x16_bf16(ml, bfr, acc[rb], 0, 0, 0); } } }
        float sk = 0.f, sm = 0.f;
#pragma unroll
        for (int r = 0; r < 16; ++r) { sk += acc[0][r] * acc[0][r] + acc[1][r] * acc[1][r]; sm += acc[2][r] * acc[2][r] + acc[3][r] * acc[3][r]; }
        sk += __shfl_xor(sk, 32); sm += __shfl_xor(sm, 32);
        const float rk = 1.0f / sqrtf(sk * (1.0f / 64.0f) + EPS), rm = 1.0f / sqrtf(sm * (1.0f / 64.0f) + EPS);
        __syncthreads();
        { const int n = F.lane & 31, hi = F.lane >> 5; const float* mg = F.mix_g + 512 + 64 * g;
#pragma unroll
          for (int rb = 0; rb < 4; ++rb) { const int slot = 32 * F.wave + n + ((rb >> 1) ? 256 : 0); const float rr = (rb >> 1) ? rm : rk;
#pragma unroll
              for (int rg = 0; rg < 4; ++rg) { const int cp = 32 * (rb & 1) + 8 * rg + 4 * hi; const f32x4 gg = *(const f32x4*)(mg + cp);
                  u32x2 w; w.x = pk2(acc[rb][4 * rg] * rr * gg.x, acc[rb][4 * rg + 1] * rr * gg.y); w.y = pk2(acc[rb][4 * rg + 2] * rr * gg.z, acc[rb][4 * rg + 3] * rr * gg.w);
                  *(LAS u32x2*)(STG + slot * MX_SLOT + 2 * cp) = w; } } }
        __syncthreads();
#pragma unroll
        for (int u = 0; u < 8; ++u) { const int idx = F.tid + NTHREADS * u, slot = idx >> 3, ch = idx & 7; const int kk = 256 * kt + (slot & 255);
            const int tok = b * SEQ + ((slot < 256) ? kk : (4096 - kk));
            if (!(slot >= 256 && kk == 0)) st16_wt(YN + (size_t)tok * 1024 + 512 + 64 * g + 8 * ch, *(const LAS u32x4*)(STG + slot * MX_SLOT + 16 * ch)); }
        if (kt == 0 && F.wave == 0) {
            const int cp = F.lane; float y = 0.f;
            for (int c = 0; c < 64; ++c) y += nyq[c] * cst[(c * cp) & 63];
            y *= (1.0f / 512.0f);
            const float r2 = 1.0f / sqrtf(wave_sum(y * y) * (1.0f / 64.0f) + EPS);
            YN[(size_t)(b * SEQ + 2048) * 1024 + 512 + 64 * g + cp] = (bf16)f2bf(y * r2 * F.mix_g[512 + 64 * g + cp]);
        }
    }
    __syncthreads();
}

__device__ __forceinline__ float wave_reduce8(const float (&a)[8], int lane) {
    const bool h5 = (lane & 32) != 0, h4 = (lane & 16) != 0, h3 = (lane & 8) != 0;
    float b[4], c[2], d;
#pragma unroll
    for (int i = 0; i < 4; ++i) { const float snd = h5 ? a[i] : a[4 + i], keep = h5 ? a[4 + i] : a[i]; b[i] = keep + __shfl_xor(snd, 32); }
#pragma unroll
    for (int i = 0; i < 2; ++i) { const float snd = h4 ? b[i] : b[2 + i], keep = h4 ? b[2 + i] : b[i]; c[i] = keep + __shfl_xor(snd, 16); }
    { const float snd = h3 ? c[0] : c[1], keep = h3 ? c[1] : c[0]; d = keep + __shfl_xor(snd, 8); }
    d += __shfl_xor(d, 4); d += __shfl_xor(d, 2); d += __shfl_xor(d, 1);
    return d;
}
__device__ __forceinline__ float rdlane(float v, int l) { return __builtin_bit_cast(float, __builtin_amdgcn_readlane(__builtin_bit_cast(int, v), l)); }
__device__ __forceinline__ void phase_route(Frame& F, const bf16* X1) {
    LAS float* slab = (LAS float*)F.lds;
    LAS float* fin = (LAS float*)(F.lds + 106496);
    LAS int* lcnt = (LAS int*)(F.lds + 147456);
    LAS int* lbase = lcnt + 32;
    LAS int* pe = lcnt + 64;
    LAS float* pw = (LAS float*)(pe + 256);
    LAS float* prr = pw + 256;
    LAS int* prow = (LAS int*)(prr + 256);
    LAS float* lbr = (LAS float*)(prow + 256);
    int* TOT = WSP(int, WS_TOT); int* LIST = WSP(int, WS_LIST); float* ROWW = WSP(float, WS_ROWW); float* ROWR = WSP(float, WS_ROWR);
    unsigned char* X1Q = WSP(unsigned char, WS_X1Q);
    const int n = F.lane & 15, fq = F.lane >> 4, w = F.wave;
    __syncthreads();
    if (F.tid < 32) lbr[F.tid] = F.b_router[F.tid];
    bf16x8v bh[4][3], bl[4][3];
#pragma unroll
    for (int s_ = 0; s_ < 4; ++s_)
#pragma unroll
        for (int c = 0; c < 3; ++c) { const int col = 16 * c + n;
#pragma unroll
            for (int j = 0; j < 8; ++j) { const int k = 128 * w + 32 * s_ + 8 * fq + j; float val = 0.f;
                if (col < 4) val = F.w_group[k * 4 + col]; else if (col < 36) val = F.w_router[((col - 4) >> 3) * 8192 + k * 8 + ((col - 4) & 7)];
                val *= F.norm2_g[k];
                const unsigned hb = f2bf(val); const float rem = val - __builtin_bit_cast(float, hb << 16);
                bh[s_][c][j] = (short)hb; bl[s_][c][j] = (short)f2bf(rem); } }
    const float bg0 = F.b_group[0], bg1 = F.b_group[1], bg2 = F.b_group[2], bg3 = F.b_group[3];
    for (int blk = F.bid; blk < 256; blk += F.G) {
        __syncthreads();
        if (F.tid < 32) lcnt[F.tid] = 0;
        __syncthreads();
        u32x4 a[2][2][4];
#define RT_LOAD(buf, pr) do { _Pragma("unroll") for (int tl_ = 0; tl_ < 2; ++tl_) { const GAS u32x4* xr = (const GAS u32x4*)(X1 + (size_t)(blk * 128 + (pr) * 32 + tl_ * 16 + n) * 1024 + 128 * w + 8 * fq); \
            _Pragma("unroll") for (int s_ = 0; s_ < 4; ++s_) a[buf][tl_][s_] = xr[4 * s_]; } } while (0)
        RT_LOAD(0, 0); RT_LOAD(1, 1);
#pragma unroll
        for (int pr = 0; pr < 4; ++pr) {
#pragma unroll
            for (int tl_ = 0; tl_ < 2; ++tl_) {
                const int tloc = (pr & 1) * 32 + tl_ * 16;
                const int tok = blk * 128 + pr * 32 + tl_ * 16 + n;
                f32x4 acc[3];
#pragma unroll
                for (int c = 0; c < 3; ++c) acc[c] = (f32x4){0.f, 0.f, 0.f, 0.f};
                float ss = 0.f;
#pragma unroll
                for (int s_ = 0; s_ < 4; ++s_) { const u32x4 av = a[pr & 1][tl_][s_]; const bf16x8v ab = __builtin_bit_cast(bf16x8v, av);
#pragma unroll
                    for (int c = 0; c < 3; ++c) { acc[c] = __builtin_amdgcn_mfma_f32_16x16x32_bf16(ab, bh[s_][c], acc[c], 0, 0, 0); acc[c] = __builtin_amdgcn_mfma_f32_16x16x32_bf16(ab, bl[s_][c], acc[c], 0, 0, 0); }
                    const float x0 = bflo(av.x), x1_ = bfhi(av.x), x2 = bflo(av.y), x3 = bfhi(av.y), x4 = bflo(av.z), x5 = bfhi(av.z), x6 = bflo(av.w), x7 = bfhi(av.w);
                    ss += ((x0 * x0 + x1_ * x1_) + (x2 * x2 + x3 * x3)) + ((x4 * x4 + x5 * x5) + (x6 * x6 + x7 * x7));
                    u32x2 o; o.x = pk4_fp8s(x0, x1_, x2, x3, 1.0f); o.y = pk4_fp8s(x4, x5, x6, x7, 1.0f);
                    *(GAS u32x2*)(X1Q + (size_t)tok * 1024 + 128 * w + 32 * s_ + 8 * fq) = o; }
                LAS float* sl = slab + ((w * 64 + tloc + 4 * fq) * 52 + n);
#pragma unroll
                for (int c = 0; c < 3; ++c)
#pragma unroll
                    for (int q = 0; q < 4; ++q) sl[q * 52 + 16 * c] = acc[c][q];
                ss += __shfl_xor(ss, 16); ss += __shfl_xor(ss, 32);
                if (fq == 0) slab[(w * 64 + tloc + n) * 52 + 48] = ss;
            }
            if (pr + 2 < 4) RT_LOAD(pr & 1, pr + 2);
            if (pr & 1) {
                __syncthreads();
                { const int tk = F.tid & 63, p = F.tid >> 6;
#pragma unroll
                  for (int i = 0; i < 5; ++i) { const int ci = p + 8 * i; if (ci < 37) { const int col = ci < 36 ? ci : 48; float sum = 0.f;
#pragma unroll
                          for (int ww = 0; ww < 8; ++ww) sum += slab[(ww * 64 + tk) * 52 + col];
                          fin[tk * 41 + ci] = sum; } } }
                __syncthreads();
                if (F.tid < 64) { const LAS float* f = fin + F.tid * 41;
                    const float rinv = 1.0f / sqrtf(f[36] * (1.f / 1024.f) + EPS);
                    const float gl0 = f[0] * rinv + bg0, gl1 = f[1] * rinv + bg1, gl2 = f[2] * rinv + bg2, gl3 = f[3] * rinv + bg3;
                    int gs = 0; float gm = gl0; if (gl1 > gm) { gm = gl1; gs = 1; } if (gl2 > gm) { gm = gl2; gs = 2; } if (gl3 > gm) { gm = gl3; gs = 3; }
                    const float pg = 1.0f / (expf(gl0 - gm) + expf(gl1 - gm) + expf(gl2 - gm) + expf(gl3 - gm));
                    float er[8];
#pragma unroll
                    for (int e = 0; e < 8; ++e) er[e] = f[4 + 8 * gs + e] * rinv + lbr[gs * 8 + e];
                    int i1 = 0; float m1 = er[0];
#pragma unroll
                    for (int e = 1; e < 8; ++e) if (er[e] > m1) { m1 = er[e]; i1 = e; }
                    int i2 = -1; float m2 = -3.0e38f;
#pragma unroll
                    for (int e = 0; e < 8; ++e) if (e != i1 && er[e] > m2) { m2 = er[e]; i2 = e; }
                    const float e2 = expf(m2 - m1); const float wa1 = pg / (1.0f + e2), wa2 = pg * e2 / (1.0f + e2);
                    const int lp = 2 * ((pr >> 1) * 64 + F.tid); pe[lp] = gs * 8 + i1; pe[lp + 1] = gs * 8 + i2; pw[lp] = wa1; pw[lp + 1] = wa2; prr[lp] = rinv; prr[lp + 1] = rinv;
                    atomicAdd((int*)&lcnt[gs * 8 + i1], 1); atomicAdd((int*)&lcnt[gs * 8 + i2], 1); }
            }
        }
#undef RT_LOAD
        __syncthreads();
        if (F.tid < 32) lbase[F.tid] = atomicAdd(&TOT[F.tid], lcnt[F.tid]);
        __syncthreads();
        if (F.tid < 32) { int nn = lbase[F.tid]; for (int p = 0; p < 256; ++p) if (pe[p] == F.tid) prow[p] = nn++; }
        __syncthreads();
        if (F.tid < 256) { const int row = pe[F.tid] * ECAP + prow[F.tid]; LIST[row] = blk * 256 + F.tid; ROWW[row] = pw[F.tid]; ROWR[row] = prr[F.tid]; }
    }
    __syncthreads();
}

__device__ __forceinline__ int build_tiles(Frame& F) {
    LAS int* tl = (LAS int*)(F.lds + L_TILES); LAS int* tnv = tl + MAX_TILES; LAS int* misc = tnv + MAX_TILES;
    const int* TOT = WSP(int, WS_TOT);
    __syncthreads();
    if (F.tid < 32) misc[33 + F.tid] = TOT[F.tid];
    __syncthreads();
    if (F.tid == 0) { int s = 0; for (int e = 0; e < 32; ++e) { misc[e] = s; s += (misc[33 + e] + 255) >> 8; } misc[32] = s; }
    __syncthreads();
    if (F.tid < 32) { const int e = F.tid, tot = misc[33 + e]; for (int j = 0, t = misc[e]; t < misc[e + 1]; ++j, ++t) { tl[t] = e * ECAP + 256 * j; tnv[t] = (tot - 256 * j) < 256 ? (tot - 256 * j) : 256; } }
    __syncthreads();
    return misc[32];
}

__device__ __forceinline__ void phase_final(Frame& F, const bf16* X1, float* OUT) {
    typedef float f2v __attribute__((ext_vector_type(2)));
    const int gw = F.vcu * NWAVES + F.wave, NGW = F.G * NWAVES; const unsigned char* YP = WSP(unsigned char, WS_YP);
    f32x4 gg[4];
#pragma unroll
    for (int j = 0; j < 4; ++j) gg[j] = ((const GAS f32x4*)F.final_g)[64 * j + F.lane];
    for (int t0 = 4 * gw; t0 < T_TOK; t0 += 4 * NGW) {
        u32x2 xw[4][4]; unsigned ya[4][4], yb[4][4];
#pragma unroll
        for (int r = 0; r < 4; ++r) { const int t = t0 + r;
            const GAS u32x2* xr = (const GAS u32x2*)(X1 + (size_t)t * 1024) + F.lane;
            const GAS unsigned* y0 = (const GAS unsigned*)(YP + (size_t)(2 * t) * 1024) + F.lane; const GAS unsigned* y1 = (const GAS unsigned*)(YP + (size_t)(2 * t + 1) * 1024) + F.lane;
#pragma unroll
            for (int j = 0; j < 4; ++j) { xw[r][j] = xr[64 * j]; ya[r][j] = y0[64 * j]; yb[r][j] = y1[64 * j]; } }
#pragma unroll
        for (int r = 0; r < 4; ++r) { const int t = t0 + r; GAS f32x4* orow = (GAS f32x4*)(OUT + (size_t)t * 1024) + F.lane;
            f32x4 v[4]; float s = 0.f;
#pragma unroll
            for (int j = 0; j < 4; ++j) { const u32x2 x = xw[r][j];
                const f2v a0 = __builtin_amdgcn_cvt_pk_f32_fp8((int)ya[r][j], false), a1 = __builtin_amdgcn_cvt_pk_f32_fp8((int)ya[r][j], true);
                const f2v b0 = __builtin_amdgcn_cvt_pk_f32_fp8((int)yb[r][j], false), b1 = __builtin_amdgcn_cvt_pk_f32_fp8((int)yb[r][j], true);
                const float is = 1.0f / pg8::YP_SCALE;
                v[j].x = bflo(x.x) + (a0[0] + b0[0]) * is; v[j].y = bfhi(x.x) + (a0[1] + b0[1]) * is; v[j].z = bflo(x.y) + (a1[0] + b1[0]) * is; v[j].w = bfhi(x.y) + (a1[1] + b1[1]) * is;
                s += (v[j].x * v[j].x + v[j].y * v[j].y) + (v[j].z * v[j].z + v[j].w * v[j].w); }
            const float rinv = 1.0f / sqrtf(wave_sum(s) * (1.f / 1024.f) + EPS);
#pragma unroll
            for (int j = 0; j < 4; ++j) { f32x4 o; o.x = v[j].x * rinv * gg[j].x; o.y = v[j].y * rinv * gg[j].y; o.z = v[j].z * rinv * gg[j].z; o.w = v[j].w * rinv * gg[j].w; orow[64 * j] = o; } }
    }
}

constexpr int N_PHASES = 10;
#ifndef MK_STAGGER1
#define MK_STAGGER1 0
#endif
struct Args { const float* in[23]; float* out; unsigned char* ws; int ph_lo, ph_hi; };
static_assert(sizeof(Args) == 23 * 8 + 8 + 8 + 8, "Args has no padding");

__global__ void __launch_bounds__(NTHREADS, 2) mk_fwd(Args args) {
    extern __shared__ __attribute__((aligned(16))) unsigned char lds_raw[];
    Frame F;
    F.lds = (LAS unsigned char*)lds_raw; F.ws = args.ws;
    F.tid = threadIdx.x; F.lane = F.tid & 63; F.wave = __builtin_amdgcn_readfirstlane(F.tid >> 6);
    F.G = gridDim.x; F.bid = blockIdx.x; F.vcu = (F.G % 8 == 0) ? (F.bid % 8) * (F.G / 8) + F.bid / 8 : F.bid;
    F.x = args.in[0]; F.norm1_g = args.in[1]; F.w_in = args.in[2]; F.conv_w = args.in[3]; F.conv_b = args.in[4]; F.f_w_in = args.in[5]; F.f_b_in = args.in[6];
    F.f_w_mid = args.in[7]; F.f_b_mid = args.in[8]; F.f_freq = args.in[9]; F.f_w_out = args.in[10]; F.f_bias = args.in[11]; F.mix_g = args.in[12]; F.w_out = args.in[13];
    F.norm2_g = args.in[14]; F.w_group = args.in[15]; F.b_group = args.in[16]; F.w_router = args.in[17]; F.b_router = args.in[18]; F.w_gate = args.in[19]; F.w_up = args.in[20];
    F.w_down = args.in[21]; F.final_g = args.in[22]; F.out = args.out;
    volatile LAS unsigned* bst = (volatile LAS unsigned*)(F.lds + BARST_OFF);
    if (F.tid < 16) bst[F.tid] = 0u;
    __syncthreads();
    const int lo = args.ph_lo, hi = args.ph_hi;
    const bool need_bar = (hi - lo) > 1;
    XcdBarrier bar; bar.bar = (unsigned*)(F.ws + WS_CTL); bar.x = 0; bar.st = bst;
    if (need_bar) bar = xcd_barrier_post((unsigned*)(F.ws + WS_CTL), bst);
#define IN(k) (lo <= (k) && (k) < hi)
#ifndef MK_DUP
#define MK_DUP -1
#endif
#define REPS(k) (((k) == MK_DUP) ? 2 : 1)
#define SEAM(k) do { if (IN(k) && IN((k) + 1)) xcd_barrier(bar); } while (0)
    bf16* X1 = WSP(bf16, WS_X1);

    if (IN(0)) for (int rep_ = 0; rep_ < REPS(0); ++rep_) { if (rep_) xcd_barrier(bar); phase_prologue(F); } SEAM(0);

    if (IN(1)) {
        pg8::StaticOrder S; S.init(F.ws + WS_WIN_T, F.ws + WS_HN, NPT_ROWS, T_TOK, 1024, F.G, F.bid); S.reps = (MK_DUP == 11) ? 2 : REPS(1);
        pg8::EpiStorePT E{WSP(bf16, WS_PT), NPT_ROWS};
        int fc = F.bid; const bool pre = MK_STAGGER1 && ((F.bid >> 3) & 1);
        if (pre && fc < 512) { load_tw_lds(F, L_TW, L_TW256); filter_item(F, fc); fc += F.G; __syncthreads(); }
        pg8::gemm_phase<pg8::EpiStorePT, pg8::StaticOrder>(F.lds, 1024, S, E);
        load_tw_lds(F, L_TW, L_TW256);
        for (; fc < 512; fc += F.G) filter_item(F, fc);
    } SEAM(1);

    if (IN(2)) for (int rep_ = 0; rep_ < REPS(2); ++rep_) { if (rep_) xcd_barrier(bar);
        load_tw_lds(F, M_TW, M_TW256);
        hyena_items_mfma(F);
        fourier_items_mfma(F);
    } SEAM(2);

    if (IN(3)) for (int rep_ = 0; rep_ < REPS(3); ++rep_) { if (rep_) xcd_barrier(bar); phase_headnorm(F); if (MK_DUP == 13) phase_headnorm(F); for (int rr_ = 0; rr_ < ((MK_DUP == 14) ? 2 : 1); ++rr_) fourier_mix(F); } SEAM(3);

    if (IN(4)) for (int rep_ = 0; rep_ < REPS(4); ++rep_) { if (rep_) xcd_barrier(bar);
        pg8::StaticOrder S; S.init(F.ws + WS_YN, F.ws + WS_WOUT_T, T_TOK, 1024, 1024, F.G, F.bid);
        pg8::EpiResBf16 E{F.x, X1, 1024};
        pg8::gemm_phase<pg8::EpiResBf16, pg8::StaticOrder>(F.lds, 1024, S, E);
    } SEAM(4);

    if (IN(5)) { phase_route(F, X1); } if (IN(5) && IN(7)) xcd_barrier(bar);


    if (IN(7)) for (int rep_ = 0; rep_ < REPS(7); ++rep_) { if (rep_) xcd_barrier(bar);
        const int ntiles = __builtin_amdgcn_readfirstlane(build_tiles(F)); const LAS int* tl = (const LAS int*)(F.lds + L_TILES);
        pg8::MoeGatherOrder S; S.init(F.ws + WS_X1Q, F.ws + WS_WGU_T, tl, tl + MAX_TILES, WSP(int, WS_LIST), ntiles, 1024, F.G, F.bid, 1);
        pg8::EpiSwiGLU E{WSP(unsigned char, WS_YT), WSP(float, WS_ROWR)};
        pg8::gemm_phase<pg8::EpiSwiGLU, pg8::MoeGatherOrder, true, true>(F.lds, 1024, S, E);
        if (rep_ == 0) {
            const int nwg = ntiles * 4, R = (nwg + F.G - 1) / F.G, nheavy = nwg - (R - 1) * F.G; const bool all = (nheavy >= F.G) || (nheavy <= 0);
            const int nl = all ? F.G : F.G - nheavy, li = all ? F.bid : F.bid - nheavy;
            if (li >= 0) wdown_items(F, li * NWAVES + F.wave, nl * NWAVES);
        }
    } SEAM(7);

    if (IN(8)) for (int rep_ = 0; rep_ < REPS(8); ++rep_) { if (rep_) xcd_barrier(bar);
        const int ntiles = __builtin_amdgcn_readfirstlane(build_tiles(F)); const LAS int* tl = (const LAS int*)(F.lds + L_TILES);
        pg8::MoeOrder S; S.init(F.ws + WS_YT, F.ws + WS_WD_T, tl, tl + MAX_TILES, ntiles, 512, F.G, F.bid, 1);
        pg8::EpiMoeDown E{WSP(unsigned char, WS_YP), WSP(int, WS_LIST), WSP(float, WS_ROWW)};
        pg8::gemm_phase<pg8::EpiMoeDown, pg8::MoeOrder, true, true>(F.lds, 512, S, E);
    } SEAM(8);

    if (IN(9)) { if (REPS(9) == 2) { phase_final(F, X1, WSP(float, WS_YT)); xcd_barrier(bar); } phase_final(F, X1, F.out); }
#undef IN
#undef SEAM
}


extern "C" void kernel_launch(void* const* d_in, const int* in_sizes, int n_in, void* d_out, int out_size, void* d_ws, size_t ws_size, hipStream_t stream) {
    static int grid = 0;
    if (grid == 0) {
        if (n_in != 23 || in_sizes[0] != T_TOK * D_MODEL || out_size != T_TOK * D_MODEL || ws_size < WS_END) { fprintf(stderr, "kernel_launch: unexpected shapes (n_in %d, in0 %d, out %d, ws %zu)\n", n_in, n_in > 0 ? in_sizes[0] : -1, out_size, ws_size); grid = -1; return; }
        int dev = 0, cus = 0;
        if (hipGetDevice(&dev) != hipSuccess || hipDeviceGetAttribute(&cus, hipDeviceAttributeMultiprocessorCount, dev) != hipSuccess) { grid = -1; return; }
        if (hipFuncSetAttribute((const void*)mk_fwd, hipFuncAttributeMaxDynamicSharedMemorySize, LDS_BYTES) != hipSuccess) { fprintf(stderr, "kernel_launch: hipFuncSetAttribute failed\n"); grid = -1; return; }
        int per_cu = 0;
        if (hipOccupancyMaxActiveBlocksPerMultiprocessor(&per_cu, (const void*)mk_fwd, NTHREADS, LDS_BYTES) != hipSuccess || per_cu < 1) fprintf(stderr, "kernel_launch: occupancy query reports %d\n", per_cu);
        (void)hipGetLastError();
        grid = cus;
    }
    if (grid < 0) return;
    (void)hipMemsetAsync((char*)d_ws + WS_CTL, 0, CTL_ZERO_BYTES, stream);
    Args a{};
    for (int i = 0; i < 23; ++i) a.in[i] = (const float*)d_in[i];
    a.out = (float*)d_out; a.ws = (unsigned char*)d_ws;
#if MK_N_LAUNCHES == 1
    a.ph_lo = 0; a.ph_hi = N_PHASES;
    hipLaunchKernelGGL(mk_fwd, dim3(grid), dim3(NTHREADS), LDS_BYTES, stream, a);
#else
    for (int p = 0; p < N_PHASES; ++p) {
        a.ph_lo = p; a.ph_hi = p + 1;
        hipLaunchKernelGGL(mk_fwd, dim3(grid), dim3(NTHREADS), LDS_BYTES, stream, a);
#ifdef MK_DUPLAUNCH
        if (p == MK_DUPLAUNCH) hipLaunchKernelGGL(mk_fwd, dim3(grid), dim3(NTHREADS), LDS_BYTES, stream, a);
#endif
#if MK_CHECK
        launch_checks(p, a, grid, stream);
#endif
    }
#if MK_CHECK
    launch_encode(a, grid, stream);
#endif
#endif
}
```

```cpp
#include <hip/hip_runtime.h>
#include <cstdio>
#include <cstdint>

#define MK_N_LAUNCHES 1
#define MK_DUP -1
#define MK_CHECK 0

#ifndef MK_DUP
#define MK_DUP -1
#endif
constexpr int D_MODEL = 1024, BATCH = 8, SEQ = 4096, T_TOK = BATCH * SEQ;
constexpr int D_HYENA = 512, D_FOURIER = 512, D_IN_PROJ = 2048, N_EXP = 32, D_EXPERT = 512;
constexpr int NPT_ROWS = 2048;
constexpr float EPS = 1e-6f;
constexpr int MAX_ROWS = 65536 + 32 * 256;
constexpr int MAX_TILES = MAX_ROWS / 256;
constexpr int NWAVES = 8, NTHREADS = 512;

constexpr size_t MiB = 1u << 20;
constexpr size_t WS_CTL = 0, CTL_ZERO_BYTES = 64 * 1024;
constexpr size_t WS_TOT = 48 * 1024;
constexpr size_t WS_RINV1 = 1 * MiB;
constexpr size_t WS_CHK = 192 * 1024;
constexpr size_t WS_TW4096 = 3 * MiB;
constexpr size_t WS_TW8192 = 3 * MiB + 32 * 1024;
constexpr size_t WS_H3 = 4 * MiB;
constexpr size_t WS_WIN_T = 8 * MiB;
constexpr size_t WS_WOUT_T = 13 * MiB;
constexpr size_t WS_WGU_T = 16 * MiB;
constexpr size_t WS_WD_T = 80 * MiB;
constexpr size_t WS_KF = 112 * MiB;
constexpr size_t WS_HN = 144 * MiB;
constexpr size_t WS_PT = 208 * MiB;
constexpr size_t WS_X1Q = 208 * MiB;
constexpr size_t WS_YP = 144 * MiB;
constexpr size_t WS_X1 = 272 * MiB;
constexpr int ECAP = 32768;
constexpr size_t WS_LIST = 336 * MiB;
constexpr size_t WS_ROWW = 340 * MiB;
constexpr size_t WS_ROWR = 344 * MiB;
constexpr size_t WS_YT = 368 * MiB;
constexpr size_t WS_YN = 440 * MiB;
constexpr size_t WS_KT = WS_YN;
constexpr size_t WS_SP = WS_YT + (size_t)512 * T_TOK * 2;
constexpr size_t WS_END = 504 * MiB;

constexpr int LDS_BYTES = 163840;
constexpr int BARST_OFF = LDS_BYTES - 64;
constexpr int FFT_BUF_BYTES = 4352 * 8;
constexpr int L_BUFA = 0, L_BUFB = FFT_BUF_BYTES, L_TW = 2 * FFT_BUF_BYTES, L_SCR = L_TW + 32768, L_RED = L_SCR + 32768, L_TW256 = L_RED + 1024;
static_assert(L_TW256 + 2048 <= BARST_OFF, "LDS map");
constexpr int M_TW = 98304, M_TW256 = M_TW + 32768;
constexpr int L_TILES = 132 * 1024;

#define GAS __attribute__((address_space(1)))
#define LAS __attribute__((address_space(3)))
typedef unsigned short bf16;
typedef float f32x4 __attribute__((ext_vector_type(4)));
typedef float f32x2 __attribute__((ext_vector_type(2)));
typedef unsigned u32x4 __attribute__((ext_vector_type(4)));
typedef unsigned u32x2 __attribute__((ext_vector_type(2)));
#ifndef MK_WT
#define MK_WT 1
#endif
__device__ __forceinline__ void st16_plain(void* p, u32x4 v) { *(u32x4*)p = v; }
__device__ __forceinline__ void st16_wt(void* p, u32x4 v) {
#if MK_WT
    asm volatile("global_store_dwordx4 %0, %1, off sc1\n\ts_nop 1" :: "v"(p), "v"(v) : "memory");
#else
    *(u32x4*)p = v;
#endif
}
constexpr float W_SCALE = 16.0f, H_SCALE = 8.0f;
__device__ __forceinline__ unsigned pk4_fp8s(float a, float b, float c, float d, float sc) {
    a = __builtin_amdgcn_fmed3f(a * sc, -448.f, 448.f); b = __builtin_amdgcn_fmed3f(b * sc, -448.f, 448.f); c = __builtin_amdgcn_fmed3f(c * sc, -448.f, 448.f); d = __builtin_amdgcn_fmed3f(d * sc, -448.f, 448.f);
    int t = __builtin_amdgcn_cvt_pk_fp8_f32(a, b, 0, false); t = __builtin_amdgcn_cvt_pk_fp8_f32(c, d, t, true); return (unsigned)t;
}
#define LDS_WAIT() asm volatile("s_waitcnt lgkmcnt(0)" ::: "memory")
__device__ __forceinline__ unsigned f2bf(float f) { unsigned u = __builtin_bit_cast(unsigned, f); return (u + 0x7fffu + ((u >> 16) & 1u)) >> 16; }
__device__ __forceinline__ unsigned pk2(float lo, float hi) { return f2bf(lo) | (f2bf(hi) << 16); }
__device__ __forceinline__ unsigned pk2h(float lo, float hi) { typedef float f32x2_t __attribute__((ext_vector_type(2))); typedef __bf16 bf16x2_t __attribute__((ext_vector_type(2))); const f32x2_t v = {lo, hi}; const bf16x2_t b = __builtin_convertvector(v, bf16x2_t); return __builtin_bit_cast(unsigned, b); }
__device__ __forceinline__ float bflo(unsigned w) { return __builtin_bit_cast(float, w << 16); }
__device__ __forceinline__ float bfhi(unsigned w) { return __builtin_bit_cast(float, w & 0xffff0000u); }
__device__ __forceinline__ float bf1(bf16 h) { return __builtin_bit_cast(float, (unsigned)h << 16); }
__device__ __forceinline__ float wave_sum(float v) {
#pragma unroll
    for (int o = 1; o < 64; o <<= 1) v += __shfl_xor(v, o);
    return v;
}

namespace pg8 {
#define PG8_LAS __attribute__((address_space(3)))
typedef unsigned short bf16_t;
typedef short bf16x8 __attribute__((ext_vector_type(8)));
typedef float f32x4 __attribute__((ext_vector_type(4)));
typedef unsigned u32x4 __attribute__((ext_vector_type(4)));
typedef unsigned u32x2 __attribute__((ext_vector_type(2)));
constexpr int BM = 256, BK = 64, HALF = 128, HTB = HALF * BK * 2  , STAGE_BYTES = 8 * HTB, NXCD = 8, WGM = 8;

__host__ __device__ __forceinline__ int lds_byte(int r, int c) { const int st = (r >> 4) * 2 + (c >> 5), rr = r & 15, cc = c & 31, ob = rr * 64 + cc * 2; return st * 1024 + (ob ^ (((ob >> 9) & 1) << 5)); }
__host__ __device__ __forceinline__ void stage_rc(int b, int& R, int& C) { const int st = b / 1024, sb = b % 1024, swz = sb ^ (((sb >> 9) & 1) << 5); R = (st >> 1) * 16 + swz / 64; C = (st & 1) * 32 + (swz % 64) / 2; }
__host__ __device__ __forceinline__ int perm32(int rho) { const int n = rho >> 4, i = rho & 15; return 8 * (i >> 2) + 4 * n + (i & 3); }

struct Unit { int pm, pn; const char* a; const char* b; int lrow, nv; };

struct StaticOrder {
    static constexpr bool GATHER = false;
    int nM, nN, nwg, G, c, reps = 1; const char* A; const char* Bt; size_t tstep;
    __device__ void init(const void* A_, const void* Bt_, int M, int N, int K, int G_, int c_) { A = (const char*)A_; Bt = (const char*)Bt_; nM = M / BM; nN = N / BM; nwg = nM * nN; G = G_; c = c_; tstep = (size_t)BM * K * 2; }
    __device__ bool next(int i, Unit& u) const {
        long L = (long)i * G + c; if (L >= (long)nwg * reps) return false; if (L >= nwg) L -= nwg;
        int wgid = (int)L; { const int q = nwg / NXCD, r = nwg % NXCD, xcd = wgid % NXCD, off = wgid / NXCD; wgid = (xcd < r ? xcd * (q + 1) : r * (q + 1) + (xcd - r) * q) + off; }
        const int nig = WGM * nN, gid = wgid / nig, fm = gid * WGM, gsz = (nM - fm) < WGM ? (nM - fm) : WGM;
        u.pm = fm + ((wgid % nig) % gsz); u.pn = (wgid % nig) / gsz; u.a = A + (size_t)u.pm * tstep; u.b = Bt + (size_t)u.pn * tstep; u.lrow = 0; u.nv = BM; return true;
    }
};
struct MoeOrder {
    static constexpr bool GATHER = false;
    int nwg, G, c; const char* A; const char* Bt; const PG8_LAS int* tl; const PG8_LAS int* tnv; size_t a_tstep, b_tstep;
    __device__ void init(const void* A_, const void* Bt_, const PG8_LAS int* tl_, const PG8_LAS int* tnv_, int ntiles, int K, int G_, int c_, int ES = 2) { A = (const char*)A_; Bt = (const char*)Bt_; tl = tl_; tnv = tnv_; nwg = ntiles * 4; G = G_; c = c_; a_tstep = (size_t)BM * K * ES; b_tstep = (size_t)BM * K * ES; }
    __device__ bool next(int i, Unit& u) const {
        const long L = (long)i * G + c; if (L >= nwg) return false;
        int wgid = (int)L; { const int q = nwg / NXCD, r = nwg % NXCD, xcd = wgid % NXCD, off = wgid / NXCD; wgid = (xcd < r ? xcd * (q + 1) : r * (q + 1) + (xcd - r) * q) + off; }
        u.pm = wgid >> 2; u.pn = wgid & 3; u.lrow = __builtin_amdgcn_readfirstlane(tl[u.pm]); u.nv = __builtin_amdgcn_readfirstlane(tnv[u.pm]); const int e = u.lrow >> 15;
        u.a = A + (size_t)u.pm * a_tstep; u.b = Bt + (size_t)(e * 4 + u.pn) * b_tstep; return true;
    }
};

struct MoeGatherOrder {
    static constexpr bool GATHER = true;
    int nwg, G, c, es; const char* A; const char* Bt; const PG8_LAS int* tl; const PG8_LAS int* tnv; const int* list; size_t b_tstep;
    __device__ void init(const void* A_, const void* Bt_, const PG8_LAS int* tl_, const PG8_LAS int* tnv_, const int* list_, int ntiles, int K, int G_, int c_, int ES = 2) { A = (const char*)A_; Bt = (const char*)Bt_; tl = tl_; tnv = tnv_; list = list_; nwg = ntiles * 4; G = G_; c = c_; es = ES; b_tstep = (size_t)BM * K * ES; }
    __device__ bool next(int i, Unit& u) const {
        const long L = (long)i * G + c; if (L >= nwg) return false;
        int wgid = (int)L; { const int q = nwg / NXCD, r = nwg % NXCD, xcd = wgid % NXCD, off = wgid / NXCD; wgid = (xcd < r ? xcd * (q + 1) : r * (q + 1) + (xcd - r) * q) + off; }
        u.pm = wgid >> 2; u.pn = wgid & 3; u.lrow = __builtin_amdgcn_readfirstlane(tl[u.pm]); u.nv = __builtin_amdgcn_readfirstlane(tnv[u.pm]); const int e = u.lrow >> 15;
        u.a = A; u.b = Bt + (size_t)(e * 4 + u.pn) * b_tstep; return true;
    }
    __device__ __forceinline__ void offsets(const Unit& u, int K, const int (&R)[2], const int (&C)[2], unsigned (&o)[2][2]) const {
#pragma unroll
        for (int h = 0; h < 2; ++h)
#pragma unroll
            for (int i = 0; i < 2; ++i) { const int lr = h * HALF + R[i]; const int pr = list[u.lrow + (lr < u.nv ? lr : 0)]; const int tok = (lr < u.nv ? pr : 0) >> 1; o[h][i] = (unsigned)(tok * K) * (unsigned)es + (unsigned)C[i] * 2u; }
    }
};

__device__ __forceinline__ unsigned cvt_pk_bf16(float lo, float hi) { unsigned r; asm volatile("v_cvt_pk_bf16_f32 %0, %1, %2" : "=v"(r) : "v"(lo), "v"(hi)); return r; }

struct EpiStoreBf16 {
    static constexpr bool PERM = true;
    bf16_t* O; int ldc;
    __device__ __forceinline__ void operator()(const f32x4 (&acc)[2][2][4][2], const Unit& u, int wr, int wc, int fr, int fq) const {
        const int row0 = u.pm * BM + wr * 64 + fr; const int col0 = u.pn * BM + wc * 32 + 8 * fq;
#pragma unroll
        for (int ai = 0; ai < 2; ++ai)
#pragma unroll
            for (int m = 0; m < 4; ++m) { bf16_t* rowp = O + (size_t)(row0 + ai * HALF + m * 16) * ldc + col0;
#pragma unroll
                for (int bj = 0; bj < 2; ++bj) { const f32x4 v0 = acc[ai][bj][m][0], v1 = acc[ai][bj][m][1];
                    u32x4 w; w.x = cvt_pk_bf16(v0[0], v0[1]); w.y = cvt_pk_bf16(v0[2], v0[3]); w.z = cvt_pk_bf16(v1[0], v1[1]); w.w = cvt_pk_bf16(v1[2], v1[3]);
                    *(u32x4*)(rowp + bj * HALF) = w; } }
    }
};
struct EpiStorePT {
    static constexpr bool PERM = true;
    bf16_t* O; int nrows; const float* __restrict__ cs;
    __device__ __forceinline__ void operator()(const f32x4 (&acc)[2][2][4][2], const Unit& u, int wr, int wc, int fr, int fq) const {
        const int row0 = u.pm * BM + wr * 64 + fr; const int col0 = wc * 32 + 8 * fq; bf16_t* base = O + (size_t)u.pn * nrows * 256;
        f32x4 c0[2], c1[2];
#pragma unroll
        for (int bj = 0; bj < 2; ++bj) { const float* cp = cs + u.pn * BM + bj * HALF + col0; c0[bj] = *(const f32x4*)cp; c1[bj] = *(const f32x4*)(cp + 4); }
#pragma unroll
        for (int ai = 0; ai < 2; ++ai)
#pragma unroll
            for (int m = 0; m < 4; ++m) { bf16_t* rowp = base + (size_t)(row0 + ai * HALF + m * 16) * 256 + col0;
#pragma unroll
                for (int bj = 0; bj < 2; ++bj) { const f32x4 v0 = acc[ai][bj][m][0] * c0[bj], v1 = acc[ai][bj][m][1] * c1[bj];
                    u32x4 w; w.x = cvt_pk_bf16(v0[0], v0[1]); w.y = cvt_pk_bf16(v0[2], v0[3]); w.z = cvt_pk_bf16(v1[0], v1[1]); w.w = cvt_pk_bf16(v1[2], v1[3]);
                    st16_plain(rowp + bj * HALF, w); } }
    }
};
struct EpiResF32 {
    static constexpr bool PERM = false;
    const float* base; float* out; int ldc;
    __device__ __forceinline__ void operator()(const f32x4 (&acc)[2][2][4][2], const Unit& u, int wr, int wc, int fr, int fq) const {
        const int row0 = u.pm * BM + wr * 64 + fr; const int col0 = u.pn * BM + wc * 32 + 4 * fq;
#pragma unroll
        for (int ai = 0; ai < 2; ++ai)
#pragma unroll
            for (int m = 0; m < 4; ++m) { const size_t off = (size_t)(row0 + ai * HALF + m * 16) * ldc + col0;
#pragma unroll
                for (int bj = 0; bj < 2; ++bj)
#pragma unroll
                    for (int n = 0; n < 2; ++n) { const f32x4 bs = *(const f32x4*)(base + off + bj * HALF + n * 16); *(f32x4*)(out + off + bj * HALF + n * 16) = bs + acc[ai][bj][m][n]; } }
    }
};
struct EpiResBf16 {
    static constexpr bool PERM = true;
    const bf16_t* __restrict__ base; bf16_t* __restrict__ out; int ldc;
    __device__ __forceinline__ void operator()(const f32x4 (&acc)[2][2][4][2], const Unit& u, int wr, int wc, int fr, int fq) const {
        const int row0 = u.pm * BM + wr * 64 + fr; const int col0 = u.pn * BM + wc * 32 + 8 * fq;
        u32x4 r[2][4][2];
#pragma unroll
        for (int ai = 0; ai < 2; ++ai)
#pragma unroll
            for (int m = 0; m < 4; ++m) { const size_t off = (size_t)(row0 + ai * HALF + m * 16) * ldc + col0;
#pragma unroll
                for (int bj = 0; bj < 2; ++bj) r[ai][m][bj] = *(const u32x4*)(base + off + bj * HALF); }
#pragma unroll
        for (int ai = 0; ai < 2; ++ai)
#pragma unroll
            for (int m = 0; m < 4; ++m) { const size_t off = (size_t)(row0 + ai * HALF + m * 16) * ldc + col0;
#pragma unroll
                for (int bj = 0; bj < 2; ++bj) { const u32x4 x = r[ai][m][bj]; const f32x4 a0 = acc[ai][bj][m][0], a1 = acc[ai][bj][m][1];
                    u32x4 w; w.x = cvt_pk_bf16(a0[0] + __builtin_bit_cast(float, x.x << 16), a0[1] + __builtin_bit_cast(float, x.x & 0xffff0000u)); w.y = cvt_pk_bf16(a0[2] + __builtin_bit_cast(float, x.y << 16), a0[3] + __builtin_bit_cast(float, x.y & 0xffff0000u));
                    w.z = cvt_pk_bf16(a1[0] + __builtin_bit_cast(float, x.z << 16), a1[1] + __builtin_bit_cast(float, x.z & 0xffff0000u)); w.w = cvt_pk_bf16(a1[2] + __builtin_bit_cast(float, x.w << 16), a1[3] + __builtin_bit_cast(float, x.w & 0xffff0000u));
                    st16_plain(out + off + bj * HALF, w); } }
    }
};
struct EpiSwiGLU {
    static constexpr bool PERM = true;
    unsigned char* __restrict__ H; const float* __restrict__ rowr;
    __device__ __forceinline__ void operator()(const f32x4 (&acc)[2][2][4][2], const Unit& u, int wr, int wc, int fr, int fq) const {
        const int row0 = u.pm * BM + wr * 64 + fr;
#pragma unroll
        for (int ai = 0; ai < 2; ++ai)
#pragma unroll
            for (int m = 0; m < 4; ++m) { const int lr = wr * 64 + fr + ai * HALF + m * 16; const int row = row0 + ai * HALF + m * 16; const float rr = ((lr < u.nv) ? rowr[u.lrow + lr] : 0.f) * (1.0f / W_SCALE); unsigned char* rowp = H + (size_t)row * 512 + u.pn * 128 + wc * 32 + 8 * fq;
                u32x2 o;
#pragma unroll
                for (int n = 0; n < 2; ++n) { const f32x4 g = acc[ai][0][m][n] * rr, up = acc[ai][1][m][n] * rr; f32x4 h;
#pragma unroll
                    for (int q = 0; q < 4; ++q) h[q] = g[q] * __builtin_amdgcn_rcpf(1.0f + __expf(-g[q])) * up[q];
                    const unsigned pk = pk4_fp8s(h[0], h[1], h[2], h[3], H_SCALE); if (n == 0) o.x = pk; else o.y = pk; }
                *(u32x2*)rowp = o; }
    }
};
constexpr float YP_SCALE = 32.0f;
__device__ __forceinline__ unsigned pk4_fp8(float a, float b, float c, float d) {
    a = __builtin_amdgcn_fmed3f(a * YP_SCALE, -448.f, 448.f); b = __builtin_amdgcn_fmed3f(b * YP_SCALE, -448.f, 448.f); c = __builtin_amdgcn_fmed3f(c * YP_SCALE, -448.f, 448.f); d = __builtin_amdgcn_fmed3f(d * YP_SCALE, -448.f, 448.f);
    int t = __builtin_amdgcn_cvt_pk_fp8_f32(a, b, 0, false); t = __builtin_amdgcn_cvt_pk_fp8_f32(c, d, t, true); return (unsigned)t;
}
struct EpiMoeDown {
    static constexpr bool PERM = true;
    unsigned char* __restrict__ YP; const int* __restrict__ list; const float* __restrict__ roww;
    __device__ __forceinline__ void operator()(const f32x4 (&acc)[2][2][4][2], const Unit& u, int wr, int wc, int fr, int fq) const {
        const int col0 = u.pn * BM + wc * 32 + 8 * fq;
        int prv[2][4]; float wv[2][4];
#pragma unroll
        for (int ai = 0; ai < 2; ++ai)
#pragma unroll
            for (int m = 0; m < 4; ++m) { const int lr = wr * 64 + fr + ai * HALF + m * 16; const int li = u.lrow + (lr < u.nv ? lr : 0); prv[ai][m] = list[li]; wv[ai][m] = roww[li]; }
#pragma unroll
        for (int ai = 0; ai < 2; ++ai)
#pragma unroll
            for (int m = 0; m < 4; ++m) { const int lr = wr * 64 + fr + ai * HALF + m * 16; const bool ok = lr < u.nv; const int pair = ok ? prv[ai][m] : 0; const float w = ok ? wv[ai][m] : 0.f;
                if (ok) { unsigned char* rowp = YP + (size_t)pair * 1024 + col0;
#pragma unroll
                    for (int bj = 0; bj < 2; ++bj) { const f32x4 v0 = acc[ai][bj][m][0] * (w * (1.0f / (W_SCALE * H_SCALE))), v1 = acc[ai][bj][m][1] * (w * (1.0f / (W_SCALE * H_SCALE)));
                        u32x2 o; o.x = pk4_fp8(v0[0], v0[1], v0[2], v0[3]); o.y = pk4_fp8(v1[0], v1[1], v1[2], v1[3]);
                        *(u32x2*)(rowp + bj * HALF) = o; } } }
    }
};

typedef int v8i_t __attribute__((ext_vector_type(8)));
template <class Epi, class Sched, bool ALIGN_EPI = true, bool FP8 = false>
__device__ __forceinline__ void gemm_phase(PG8_LAS unsigned char* lds, const int K, const Sched& S, const Epi& E) {
    const int tid = threadIdx.x, wid = __builtin_amdgcn_readfirstlane(tid >> 6), lane = tid & 63, wr = wid >> 2, wc = wid & 3, fr = lane & 15, fq = lane >> 4;
    constexpr int ES = FP8 ? 1 : 2;
    const int nt = K * ES / (BK * 2);
    unsigned voffA[2], voffB[2]; int sR[2], sC[2];
#pragma unroll
    for (int i = 0; i < 2; ++i) { int R, C; stage_rc(tid * 16 + i * 8192, R, C); const int Rb = Epi::PERM ? ((R & ~31) + perm32(R & 31)) : R; sR[i] = R; sC[i] = C;
        voffA[i] = (unsigned)(R * K) * (unsigned)ES + (unsigned)C * 2u; voffB[i] = (unsigned)(Rb * K) * (unsigned)ES + (unsigned)C * 2u; }
    int sc127 = 0x7f7f7f7f; asm volatile("" : "+v"(sc127));
    constexpr bool GA = Sched::GATHER;
    unsigned oc[2][2], on[2][2];
    const size_t kstep = (size_t)(BK * 2);
    const size_t hstep = (size_t)HALF * K * ES;
    const unsigned ldsw = (unsigned)wid * 1024u;
    const int aoff = lds_byte(wr * 64 + fr, fq * 8), boff = lds_byte(wc * 32 + fr, fq * 8);
#define PG8_SA(b, h) (((b) * 2 + (h)) * HTB)
#define PG8_SB(b, h) ((4 + (b) * 2 + (h)) * HTB)
#define PG8_STAGE(bufoff, gbase, voff) do { _Pragma("unroll") for (int _i = 0; _i < 2; ++_i) \
        __builtin_amdgcn_global_load_lds((const unsigned*)((const char*)(gbase) + (voff)[_i]), (PG8_LAS unsigned*)(lds + (bufoff) + ldsw + _i * 8192), 16, 0, 0); } while (0)
#define PG8_LDA(dst, b, h) do { _Pragma("unroll") for (int m = 0; m < 4; ++m) _Pragma("unroll") for (int k = 0; k < 2; ++k) dst[m][k] = *(const PG8_LAS bf16x8*)(lds + PG8_SA(b, h) + aoff + m * 2048 + k * 1024); } while (0)
#define PG8_LDB(dst, b, h) do { _Pragma("unroll") for (int n = 0; n < 2; ++n) _Pragma("unroll") for (int k = 0; k < 2; ++k) dst[n][k] = *(const PG8_LAS bf16x8*)(lds + PG8_SB(b, h) + boff + n * 2048 + k * 1024); } while (0)
#define PG8_CAT(x0, x1) (v8i_t){ (int)__builtin_bit_cast(u32x4, x0).x, (int)__builtin_bit_cast(u32x4, x0).y, (int)__builtin_bit_cast(u32x4, x0).z, (int)__builtin_bit_cast(u32x4, x0).w, (int)__builtin_bit_cast(u32x4, x1).x, (int)__builtin_bit_cast(u32x4, x1).y, (int)__builtin_bit_cast(u32x4, x1).z, (int)__builtin_bit_cast(u32x4, x1).w }
#define PG8_MMA(ai, bj, At, Bt) do { __builtin_amdgcn_s_setprio(1); _Pragma("unroll") for (int m = 0; m < 4; ++m) _Pragma("unroll") for (int n = 0; n < 2; ++n) { \
        if constexpr (FP8) { const v8i_t b8_ = PG8_CAT(Bt[n][0], Bt[n][1]), a8_ = PG8_CAT(At[m][0], At[m][1]); \
            asm volatile("s_nop 1\n\tv_mfma_scale_f32_16x16x128_f8f6f4 %0, %1, %2, %0, %3, %3 op_sel_hi:[0,0,0]" : "+v"(acc[ai][bj][m][n]) : "v"(b8_), "v"(a8_), "v"(sc127)); } \
        else { _Pragma("unroll") for (int k = 0; k < 2; ++k) acc[ai][bj][m][n] = __builtin_amdgcn_mfma_f32_16x16x32_bf16(Bt[n][k], At[m][k], acc[ai][bj][m][n], 0, 0, 0); } } __builtin_amdgcn_s_setprio(0); } while (0)
#define PG8_WAIT_V(n) asm volatile("s_waitcnt vmcnt(" #n ")" ::: "memory")
#define PG8_WAIT_L(n) asm volatile("s_waitcnt lgkmcnt(" #n ")" ::: "memory")
#define PG8_BAR __builtin_amdgcn_s_barrier()
#define PG8_SCHED __builtin_amdgcn_sched_barrier(0)
    Unit cur, nxt; int ui = 0;
    if (!S.next(0, cur)) return;
    f32x4 acc[2][2][4][2];
#pragma unroll
    for (int a = 0; a < 2; ++a)
#pragma unroll
        for (int b = 0; b < 2; ++b)
#pragma unroll
            for (int m = 0; m < 4; ++m)
#pragma unroll
                for (int n = 0; n < 2; ++n) acc[a][b][m][n] = (f32x4){0.f, 0.f, 0.f, 0.f};
    bf16x8 At[4][2], B0[2][2], B1[2][2];
    const char* cA = cur.a; const char* cB = cur.b;
    const size_t hA = GA ? (size_t)0 : hstep;
    if constexpr (GA) { S.offsets(cur, K, sR, sC, oc); }
#define PG8_OA(h, sel) (GA ? (sel)[h] : voffA)
    PG8_STAGE(PG8_SB(0, 0), cB, voffB); PG8_STAGE(PG8_SB(0, 1), cB + hstep, voffB); PG8_STAGE(PG8_SA(0, 0), cA, PG8_OA(0, oc)); PG8_STAGE(PG8_SA(0, 1), cA + hA, PG8_OA(1, oc));
    if (wr == 1) PG8_BAR;
    PG8_WAIT_V(2); PG8_BAR;
    PG8_STAGE(PG8_SB(1, 0), cB + kstep, voffB); PG8_STAGE(PG8_SA(1, 0), cA + kstep, PG8_OA(0, oc)); PG8_STAGE(PG8_SB(1, 1), cB + hstep + kstep, voffB);
    PG8_WAIT_V(6); PG8_BAR;
    for (;;) {
        const bool has_next = S.next(ui + 1, nxt);
        const char* nA = has_next ? nxt.a : cA; const char* nB = has_next ? nxt.b : cB;
        if constexpr (GA) { if (has_next) S.offsets(nxt, K, sR, sC, on); else {
#pragma unroll
            for (int h = 0; h < 2; ++h)
#pragma unroll
                for (int i = 0; i < 2; ++i) on[h][i] = oc[h][i]; } }
#pragma unroll 1
        for (int t = 0; t < nt; t += 2) {
            const bool last = (t == nt - 2);
            const char* a1 = cA + (size_t)(t + 1) * kstep;
            const char* a2 = last ? nA : cA + (size_t)(t + 2) * kstep; const char* b2 = last ? nB : cB + (size_t)(t + 2) * kstep;
            const char* a3 = a2 + kstep; const char* b3 = b2 + kstep;
            unsigned o2[2][2];
            if constexpr (GA) {
#pragma unroll
                for (int h = 0; h < 2; ++h)
#pragma unroll
                    for (int i = 0; i < 2; ++i) o2[h][i] = last ? on[h][i] : oc[h][i]; }
            PG8_LDB(B0, 0, 0); PG8_LDB(B1, 0, 1); PG8_SCHED; PG8_LDA(At, 0, 0); PG8_STAGE(PG8_SA(1, 1), a1 + hA, PG8_OA(1, oc));
            PG8_WAIT_V(8); PG8_WAIT_L(0); PG8_BAR; PG8_MMA(0, 0, At, B0); PG8_MMA(0, 1, At, B1); PG8_BAR; PG8_SCHED;
            PG8_LDA(At, 0, 1); PG8_STAGE(PG8_SB(0, 0), b2, voffB); PG8_STAGE(PG8_SB(0, 1), b2 + hstep, voffB); PG8_STAGE(PG8_SA(0, 0), a2, PG8_OA(0, o2));
            PG8_WAIT_V(8); PG8_WAIT_L(0); PG8_BAR; PG8_MMA(1, 0, At, B0); PG8_MMA(1, 1, At, B1); PG8_BAR; PG8_SCHED;
            PG8_LDB(B0, 1, 0); PG8_LDB(B1, 1, 1); PG8_SCHED; PG8_LDA(At, 1, 0); PG8_STAGE(PG8_SA(0, 1), a2 + hA, PG8_OA(1, o2));
            PG8_WAIT_V(8); PG8_WAIT_L(0); PG8_BAR; PG8_MMA(0, 0, At, B0); PG8_MMA(0, 1, At, B1); PG8_BAR; PG8_SCHED;
            PG8_LDA(At, 1, 1); PG8_STAGE(PG8_SB(1, 0), b3, voffB); PG8_STAGE(PG8_SB(1, 1), b3 + hstep, voffB); PG8_STAGE(PG8_SA(1, 0), a3, PG8_OA(0, o2));
            PG8_WAIT_V(8); PG8_WAIT_L(0); PG8_BAR; PG8_MMA(1, 0, At, B0); PG8_MMA(1, 1, At, B1); PG8_BAR; PG8_SCHED;
        }
        if constexpr (ALIGN_EPI) { if (wr == 0) PG8_BAR; }
        if constexpr (FP8) asm volatile("s_nop 7\n\ts_nop 7" : "+v"(acc[1][1][0][0]), "+v"(acc[1][1][0][1]), "+v"(acc[1][1][1][0]), "+v"(acc[1][1][1][1]), "+v"(acc[1][1][2][0]), "+v"(acc[1][1][2][1]), "+v"(acc[1][1][3][0]), "+v"(acc[1][1][3][1]) :: "memory");
        E(acc, cur, wr, wc, fr, fq);
        if (!has_next) break;
#pragma unroll
        for (int a = 0; a < 2; ++a)
#pragma unroll
            for (int b = 0; b < 2; ++b)
#pragma unroll
                for (int m = 0; m < 4; ++m)
#pragma unroll
                    for (int n = 0; n < 2; ++n) acc[a][b][m][n] = (f32x4){0.f, 0.f, 0.f, 0.f};
        cur = nxt; cA = nA; cB = nB; ++ui;
        if constexpr (GA) {
#pragma unroll
            for (int h = 0; h < 2; ++h)
#pragma unroll
                for (int i = 0; i < 2; ++i) oc[h][i] = on[h][i]; }
        if constexpr (ALIGN_EPI) { if (wr == 1) PG8_BAR; }
    }
    PG8_WAIT_V(0);
    if constexpr (!ALIGN_EPI) { if (wr == 0) PG8_BAR; }
    PG8_BAR;
#undef PG8_SA
#undef PG8_OA
#undef PG8_CAT
#undef PG8_SB
#undef PG8_STAGE
#undef PG8_LDA
#undef PG8_LDB
#undef PG8_MMA
#undef PG8_WAIT_V
#undef PG8_WAIT_L
#undef PG8_BAR
#undef PG8_SCHED
}
}

#define FDEV __device__ __forceinline__
#define LDSPTR LAS
#define CF_DEFINED
typedef float cf __attribute__((ext_vector_type(2)));
#ifndef FFT_ENGINE_H
#define FFT_ENGINE_H
#ifndef CF_DEFINED
struct cf { float x, y; };
#endif
FDEV cf mkc(float a, float b) { cf r; r.x = a; r.y = b; return r; }
FDEV cf cadd(cf a, cf b) { return mkc(a.x + b.x, a.y + b.y); }
FDEV cf csub(cf a, cf b) { return mkc(a.x - b.x, a.y - b.y); }
FDEV cf cmul(cf a, cf b) { return mkc(a.x * b.x - a.y * b.y, a.x * b.y + a.y * b.x); }
FDEV cf cmulc(cf a, cf b) { return mkc(a.x * b.x + a.y * b.y, a.y * b.x - a.x * b.y); }
FDEV cf mul_mi(cf a) { return mkc(a.y, -a.x); }
FDEV cf mul_pi(cf a) { return mkc(-a.y, a.x); }
constexpr int FFT_N = 4096, FFT_LDS_ELEMS = 16 * 272;
FDEV int fpos(int p) { return 272 * (p >> 8) + 17 * ((p >> 4) & 15) + (p & 15); }

template <bool INV> FDEV void dft16(cf (&v)[16]) {
    const float C1 = 0.92387953251128674f, S1 = 0.38268343236508977f, C2 = 0.70710678118654752f;
#pragma unroll
    for (int n0 = 0; n0 < 4; ++n0) {
        cf x0 = v[n0], x1 = v[4 + n0], x2 = v[8 + n0], x3 = v[12 + n0];
        cf A = cadd(x0, x2), B = csub(x0, x2), C = cadd(x1, x3), D = csub(x1, x3);
        cf Dm = INV ? mul_pi(D) : mul_mi(D);
        v[n0] = cadd(A, C); v[4 + n0] = cadd(B, Dm); v[8 + n0] = csub(A, C); v[12 + n0] = csub(B, Dm);
    }
#define W16(m) (mkc( (m)==0?1.f:(m)==1?C1:(m)==2?C2:(m)==3?S1:(m)==4?0.f:(m)==6?-C2:(m)==9?-C1:0.f, \
                    (INV?1.f:-1.f) * ((m)==0?0.f:(m)==1?S1:(m)==2?C2:(m)==3?C1:(m)==4?1.f:(m)==6?C2:(m)==9?-S1:0.f) ))
    v[4 + 1] = cmul(v[4 + 1], W16(1)); v[4 + 2] = cmul(v[4 + 2], W16(2)); v[4 + 3] = cmul(v[4 + 3], W16(3));
    v[8 + 1] = cmul(v[8 + 1], W16(2)); v[8 + 2] = cmul(v[8 + 2], W16(4)); v[8 + 3] = cmul(v[8 + 3], W16(6));
    v[12 + 1] = cmul(v[12 + 1], W16(3)); v[12 + 2] = cmul(v[12 + 2], W16(6)); v[12 + 3] = cmul(v[12 + 3], W16(9));
#undef W16
    cf o[16];
#pragma unroll
    for (int k1 = 0; k1 < 4; ++k1) {
        cf x0 = v[4 * k1], x1 = v[4 * k1 + 1], x2 = v[4 * k1 + 2], x3 = v[4 * k1 + 3];
        cf A = cadd(x0, x2), B = csub(x0, x2), C = cadd(x1, x3), D = csub(x1, x3);
        cf Dm = INV ? mul_pi(D) : mul_mi(D);
        o[k1] = cadd(A, C); o[k1 + 4] = cadd(B, Dm); o[k1 + 8] = csub(A, C); o[k1 + 12] = csub(B, Dm);
    }
#pragma unroll
    for (int i = 0; i < 16; ++i) v[i] = o[i];
}

template <int GEO> FDEV int geo_idx(int r, int e) {
    if (GEO == 1) return 272 * e + 17 * (r >> 4) + (r & 15);
    if (GEO == 2) return 272 * (r >> 4) + 17 * e + (r & 15);
    return 272 * (r >> 4) + 17 * (r & 15) + e;
}
template <int GEO> FDEV void fft_pass_fwd(LDSPTR cf* buf, const LDSPTR cf* tw, const LDSPTR cf* tw256, int r) {
    cf v[16];
#pragma unroll
    for (int e = 0; e < 16; ++e) v[e] = buf[geo_idx<GEO>(r, e)];
    dft16<false>(v);
    if (GEO == 1) {
#pragma unroll
        for (int s = 1; s < 16; ++s) v[s] = cmul(v[s], tw[(r * s) & 4095]);
    } else if (GEO == 2) {
        const int t = r & 15;
#pragma unroll
        for (int s = 1; s < 16; ++s) v[s] = cmul(v[s], tw256[t * s]);
    }
#pragma unroll
    for (int e = 0; e < 16; ++e) buf[geo_idx<GEO>(r, e)] = v[e];
}
template <int GEO> FDEV void fft_pass_inv(LDSPTR cf* buf, const LDSPTR cf* tw, const LDSPTR cf* tw256, int r) {
    cf v[16];
#pragma unroll
    for (int e = 0; e < 16; ++e) v[e] = buf[geo_idx<GEO>(r, e)];
    if (GEO == 1) {
#pragma unroll
        for (int s = 1; s < 16; ++s) v[s] = cmulc(v[s], tw[(r * s) & 4095]);
    } else if (GEO == 2) {
        const int t = r & 15;
#pragma unroll
        for (int s = 1; s < 16; ++s) v[s] = cmulc(v[s], tw256[t * s]);
    }
    dft16<true>(v);
#pragma unroll
    for (int e = 0; e < 16; ++e) buf[geo_idx<GEO>(r, e)] = v[e];
}
FDEV int freq_pos(int k) { return 256 * (k & 15) + 16 * ((k >> 4) & 15) + (k >> 8); }
#endif

#define XB_TMO      128
#define XB_XCNT(j)  (256  + 64 * (j))
#define XB_XSUB(j)  (1280 + 64 * (j))
#define XB_XGEN(j)  (2304 + 64 * (j))
#define XB_TOP      3328
#define XB_TOPGEN   3392
#define XCD_BAR_WORDS 3456
#define XB_SPIN_CAP (1u << 18)
__device__ __forceinline__ unsigned xb_ld(unsigned* p)              { return __hip_atomic_load(p, __ATOMIC_RELAXED, __HIP_MEMORY_SCOPE_AGENT); }
__device__ __forceinline__ unsigned xb_add(unsigned* p, unsigned v) { return __hip_atomic_fetch_add(p, v, __ATOMIC_RELAXED, __HIP_MEMORY_SCOPE_AGENT); }
__device__ __forceinline__ unsigned xb_xcc_id() { return (unsigned)__builtin_amdgcn_s_getreg((3 << 11) | 20) & 0xFu; }
#define XB_SPIN(cond, bar) do { unsigned _sp = 0; while (cond) { __builtin_amdgcn_s_sleep(1); \
    if ((++_sp & 255u) == 0u) { if (xb_ld(&(bar)[XB_TMO])) break; if (_sp > XB_SPIN_CAP) { atomicAdd(&(bar)[XB_TMO], 1u); break; } } } } while (0)
struct XcdBarrier { unsigned* bar; unsigned x; volatile LAS unsigned* st; };
__device__ __forceinline__ XcdBarrier xcd_barrier_post(unsigned* bar, volatile LAS unsigned* st) {
    XcdBarrier b; b.bar = bar; b.x = xb_xcc_id(); b.st = st;
    if (threadIdx.x == 0) (void)xb_add(&bar[XB_XCNT(b.x)], 1u);
    return b;
}
__device__ __forceinline__ void xcd_barrier_complete(unsigned* bar, unsigned x, unsigned& nloc, unsigned& nx) {
    const unsigned G = gridDim.x * gridDim.y * gridDim.z;
    unsigned sum, cnt, mine, sp = 0u;
    for (;;) {
        sum = 0u; cnt = 0u; mine = 0u;
#pragma unroll
        for (unsigned j = 0; j < 16; ++j) { const unsigned c = xb_ld(&bar[XB_XCNT(j)]); sum += c; cnt += (c > 0u) ? 1u : 0u; mine = (j == x) ? c : mine; }
        if (sum == G) break;
        __builtin_amdgcn_s_sleep(1);
        if ((++sp & 255u) == 0u) { if (xb_ld(&bar[XB_TMO])) break; if (sp > XB_SPIN_CAP) { atomicAdd(&bar[XB_TMO], 1u); break; } }
    }
    nloc = mine > 0u ? mine : 1u; nx = cnt > 0u ? cnt : 1u;
}
__device__ __forceinline__ void xcd_barrier(const XcdBarrier& b) {
    asm volatile("s_waitcnt vmcnt(0)" ::: "memory");
    __syncthreads();
    if (threadIdx.x == 0) {
        unsigned* bar = b.bar;
        __builtin_amdgcn_s_waitcnt(0);
        unsigned nloc = b.st[0], nx = b.st[1];
        if (nloc == 0u) { xcd_barrier_complete(bar, b.x, nloc, nx); b.st[0] = nloc; b.st[1] = nx; }
        const unsigned old = xb_add(&bar[XB_XSUB(b.x)], 1u);
        const unsigned gen = old / nloc;
        if (old + 1u == (gen + 1u) * nloc) {
            __builtin_amdgcn_fence(__ATOMIC_RELEASE, "agent");
            asm volatile("s_waitcnt vmcnt(0)" ::: "memory");
            const unsigned og = xb_add(&bar[XB_TOP], 1u);
            const unsigned tg = og / nx;
            if (og + 1u == (tg + 1u) * nx) xb_add(&bar[XB_TOPGEN], 1u);
            else XB_SPIN(xb_ld(&bar[XB_TOPGEN]) == tg, bar);
            __builtin_amdgcn_fence(__ATOMIC_ACQUIRE, "agent");
            xb_add(&bar[XB_XGEN(b.x)], 1u);
            asm volatile("s_waitcnt vmcnt(0)" ::: "memory");
        } else {
            XB_SPIN(xb_ld(&bar[XB_XGEN(b.x)]) == gen, bar);
            __builtin_amdgcn_fence(__ATOMIC_ACQUIRE, "agent");
            asm volatile("s_waitcnt vmcnt(0)" ::: "memory");
        }
    }
    __syncthreads();
}

struct Frame {
    LAS unsigned char* lds;
    unsigned char* ws;
    int tid, lane, wave, vcu, G, bid;
    const float *x, *norm1_g, *w_in, *conv_w, *conv_b, *f_w_in, *f_b_in, *f_w_mid, *f_b_mid, *f_freq, *f_w_out, *f_bias, *mix_g, *w_out, *norm2_g,
                *w_group, *b_group, *w_router, *b_router, *w_gate, *w_up, *w_down, *final_g;
    float* out;
};
#define WSP(T, off) ((T*)(F.ws + (off)))

__device__ __forceinline__ void transpose_item(const float* W, int ldw, bf16* WT, int ldo, LAS float* scr, int lane, const float* gk = nullptr) {
    asm volatile("" : "+s"(ldw));
    const float* Wl = W + (size_t)(lane >> 5) * ldw + (lane & 31);
    float t[32];
#pragma unroll
    for (int i = 0; i < 32; ++i) t[i] = Wl[(size_t)(2 * i) * ldw];
    if (gk) { const float* gl = gk + (lane >> 5);
#pragma unroll
        for (int i = 0; i < 32; ++i) t[i] *= gl[2 * i]; }
#pragma unroll
    for (int i = 0; i < 32; ++i) { const int kk = 2 * i + (lane >> 5); scr[kk * 33 + (lane & 31)] = t[i]; }
    LDS_WAIT(); asm volatile("" ::: "memory");
    const int c = lane & 7;
#pragma unroll
    for (int j = 0; j < 4; ++j) { const int n = (lane >> 3) + 8 * j; const LAS float* s = scr + (8 * c) * 33 + n;
        u32x4 o; o.x = pk2(s[0 * 33], s[1 * 33]); o.y = pk2(s[2 * 33], s[3 * 33]); o.z = pk2(s[4 * 33], s[5 * 33]); o.w = pk2(s[6 * 33], s[7 * 33]);
        st16_wt(WT + (size_t)n * ldo + 8 * c, o); }
    LDS_WAIT(); asm volatile("" ::: "memory");
}
__device__ __forceinline__ void transpose_item_fp8(const float* W, int ldw, unsigned char* WT, int ldo, LAS float* scr, int lane, const float* gk, float scale) {
    asm volatile("" : "+s"(ldw));
    const float* Wl = W + (size_t)(lane >> 5) * ldw + (lane & 31);
    float t[32];
#pragma unroll
    for (int i = 0; i < 32; ++i) t[i] = Wl[(size_t)(2 * i) * ldw];
    if (gk) { const float* gl = gk + (lane >> 5);
#pragma unroll
        for (int i = 0; i < 32; ++i) t[i] *= gl[2 * i]; }
#pragma unroll
    for (int i = 0; i < 32; ++i) { const int kk = 2 * i + (lane >> 5); scr[kk * 33 + (lane & 31)] = t[i]; }
    LDS_WAIT(); asm volatile("" ::: "memory");
    const int n = lane >> 1, hf = lane & 1; const LAS float* s = scr + (32 * hf) * 33 + n;
    u32x4 o0, o1;
    o0.x = pk4_fp8s(s[0 * 33], s[1 * 33], s[2 * 33], s[3 * 33], scale); o0.y = pk4_fp8s(s[4 * 33], s[5 * 33], s[6 * 33], s[7 * 33], scale);
    o0.z = pk4_fp8s(s[8 * 33], s[9 * 33], s[10 * 33], s[11 * 33], scale); o0.w = pk4_fp8s(s[12 * 33], s[13 * 33], s[14 * 33], s[15 * 33], scale);
    o1.x = pk4_fp8s(s[16 * 33], s[17 * 33], s[18 * 33], s[19 * 33], scale); o1.y = pk4_fp8s(s[20 * 33], s[21 * 33], s[22 * 33], s[23 * 33], scale);
    o1.z = pk4_fp8s(s[24 * 33], s[25 * 33], s[26 * 33], s[27 * 33], scale); o1.w = pk4_fp8s(s[28 * 33], s[29 * 33], s[30 * 33], s[31 * 33], scale);
    unsigned char* d = WT + (size_t)n * ldo + 32 * hf;
    st16_plain(d, o0); st16_plain(d + 16, o1);
    LDS_WAIT(); asm volatile("" ::: "memory");
}
__device__ __forceinline__ void rms_row_to_bf16(const float* xrow, const float* g, bf16* orow, int lane) {
    const GAS f32x4* xr = (const GAS f32x4*)xrow + lane; const GAS f32x4* gr = (const GAS f32x4*)g + lane;
    f32x4 v[4]; float s = 0.f;
#pragma unroll
    for (int j = 0; j < 4; ++j) { v[j] = xr[64 * j]; s += (v[j].x * v[j].x + v[j].y * v[j].y) + (v[j].z * v[j].z + v[j].w * v[j].w); }
    const float rinv = 1.0f / sqrtf(wave_sum(s) * (1.f / 1024.f) + EPS);
    GAS u32x2* o8 = (GAS u32x2*)orow + lane;
#pragma unroll
    for (int j = 0; j < 4; ++j) { const f32x4 gg = gr[64 * j]; u32x2 w; w.x = pk2(v[j].x * rinv * gg.x, v[j].y * rinv * gg.y); w.y = pk2(v[j].z * rinv * gg.z, v[j].w * rinv * gg.w); o8[64 * j] = w; }
}
__device__ __forceinline__ void wave_lds_sync() { asm volatile("s_waitcnt lgkmcnt(0)" ::: "memory"); }
template <int NIN, int astride> __device__ __forceinline__ void mlp_layer(const float* W  , const float* bvec, const float* fvec, const LAS float* ain, LAS float* aout, int lane) {
    float w[64];
    unsigned ul = (unsigned)lane; asm volatile("" : "+v"(ul));
#pragma unroll
    for (int i = 0; i < 64; ++i) w[i] = (i < NIN) ? W[(unsigned)(i * 64) + ul] : 0.f;
    const float b = bvec[lane], fr = fvec[lane];
#pragma unroll 1
    for (int p = 0; p < 16; ++p) {
        const LAS float* ap = ain + p * astride; float s = b;
        if (NIN == 33) {
#pragma unroll
            for (int i = 0; i < 33; ++i) s += ap[i] * w[i];
        } else {
#pragma unroll
            for (int i4 = 0; i4 < 16; ++i4) { const f32x4 hv = *(const LAS f32x4*)(ap + 4 * i4); s += (hv.x * w[4 * i4] + hv.y * w[4 * i4 + 1]) + (hv.z * w[4 * i4 + 2] + hv.w * w[4 * i4 + 3]); }
        }
        aout[p * 64 + lane] = sinf(fr * s);
    }
    asm volatile("s_waitcnt lgkmcnt(0)" ::: "memory");
}
__device__ __forceinline__ void filter_mlp_wave(Frame& F, int pb, int half, unsigned lds_off) {
    const int lane = F.lane;
    asm volatile("" : "+v"(lds_off));
    LAS float* a0 = (LAS float*)(F.lds + lds_off); LAS float* a1 = a0 + 16 * 36; LAS float* a2 = a1 + 1024;
    for (int i = lane; i < 16 * 33; i += 64) { const int p = i / 33, j = i % 33, l = 16 * pb + p; float v;
        if (j == 0) v = (float)l / 4095.0f;
        else { const int q = (j - 1) & 15; const float fq = 1e-4f + (float)q * ((15.0f - 1e-4f) / 15.0f); const float ang = fq * ((2.0f * 3.14159265358979323846f / 4096.0f) * (float)l); v = (j <= 16) ? cosf(ang) : -sinf(ang); }
        a0[p * 36 + j] = v; }
    asm volatile("s_waitcnt lgkmcnt(0)" ::: "memory");
    mlp_layer<33, 36>(F.f_w_in, F.f_b_in, F.f_freq, a0, a1, lane);
    mlp_layer<64, 64>(F.f_w_mid, F.f_b_mid, F.f_freq + 64, a1, a2, lane);
    mlp_layer<64, 64>(F.f_w_mid + 4096, F.f_b_mid + 64, F.f_freq + 128, a2, a1, lane);
    float* KT = WSP(float, WS_KT);
#pragma unroll 1
    for (int m = half; m < 16; m += 4) { const int j = 64 * m + lane;
        float w[64]; unsigned uj = (unsigned)j; asm volatile("" : "+v"(uj));
#pragma unroll
        for (int i = 0; i < 64; ++i) w[i] = F.f_w_out[(unsigned)(i * 1024) + uj];
        const float mind = -3.0701134573253946f, maxd = -15.350567286626973f;
        const float delta = fabsf(mind + (float)(j & 511) * ((maxd - mind) / 511.0f));
        f32x4* o4 = (f32x4*)(KT + (size_t)j * 4096 + 16 * pb);
#pragma unroll 1
        for (int pg = 0; pg < 4; ++pg) {
            float acc[4];
#pragma unroll
            for (int q = 0; q < 4; ++q) { const LAS float* ap = a1 + (4 * pg + q) * 64; float sacc = 0.f;
#pragma unroll
                for (int i4 = 0; i4 < 16; ++i4) { const f32x4 hv = *(const LAS f32x4*)(ap + 4 * i4); sacc += (hv.x * w[4 * i4] + hv.y * w[4 * i4 + 1]) + (hv.z * w[4 * i4 + 2] + hv.w * w[4 * i4 + 3]); }
                acc[q] = sacc * __expf(-((float)(16 * pb + 4 * pg + q) / 4095.0f) * delta); }
            o4[pg] = (f32x4){acc[0], acc[1], acc[2], acc[3]};
        }
    }
}
constexpr int WD_HERE = 0;
__device__ __forceinline__ void phase_prologue(Frame& F) {
    { const int gt = F.bid * NTHREADS + F.tid;
      if (gt < 4096) { f32x2 w; w.x = cospif((float)gt * (1.0f / 2048.0f)); w.y = -sinpif((float)gt * (1.0f / 2048.0f)); WSP(f32x2, WS_TW4096)[gt] = w; }
      else if (gt < 8192) { const int n = gt - 4096; f32x2 w; w.x = cospif((float)n * (1.0f / 4096.0f)); w.y = -sinpif((float)n * (1.0f / 4096.0f)); WSP(f32x2, WS_TW8192)[n] = w; } }
    LAS unsigned* ticket = (LAS unsigned*)(F.lds + 158 * 1024);
    for (int rr_ = 0; rr_ < ((MK_DUP == 15) ? 2 : 1); ++rr_) {
    __syncthreads();
    if (F.tid == 0) ticket[0] = 0u;
    __syncthreads();
    if (F.wave >= 4 && rr_ == 0) { for (int pb = F.bid; pb < 256; pb += F.G) filter_mlp_wave(F, pb, F.wave - 4, (unsigned)((72 + 12 * (F.wave - 4)) * 1024)); }
    {
        LAS float* scr = (LAS float*)(F.lds + F.wave * 8704);
        constexpr int I_IN = 16 * 64, I_OUT = 16 * 32, I_G = 32 * 16 * 16, I_D = 32 * 8 * 32, I_RMS = T_TOK / 4;
        constexpr int NITEMS = I_IN + I_OUT + 2 * I_G + I_RMS + WD_HERE;
        bf16* WIN_T = WSP(bf16, WS_WIN_T); bf16* WOUT_T = WSP(bf16, WS_WOUT_T); unsigned char* WGU8 = WSP(unsigned char, WS_WGU_T); unsigned char* WD8 = WSP(unsigned char, WS_WD_T); bf16* HN = WSP(bf16, WS_HN);
        for (;;) {
            unsigned tk = 0; if (F.lane == 0) tk = __hip_atomic_fetch_add((unsigned*)ticket, 1u, __ATOMIC_RELAXED, __HIP_MEMORY_SCOPE_WORKGROUP);
            tk = __builtin_amdgcn_readfirstlane(tk);
            const long itl = (long)tk * F.G + F.vcu; if (itl >= NITEMS) break;
            int r = (int)itl;
            if (r < I_RMS) {
                const int m0 = 4 * r; f32x4 v[4][4];
#pragma unroll
                for (int q = 0; q < 4; ++q) { const GAS f32x4* xr = (const GAS f32x4*)(F.x + (size_t)(m0 + q) * 1024) + F.lane;
#pragma unroll
                    for (int j = 0; j < 4; ++j) v[q][j] = xr[64 * j]; }
#pragma unroll
                for (int q = 0; q < 4; ++q) { float s = 0.f;
#pragma unroll
                    for (int j = 0; j < 4; ++j) s += (v[q][j].x * v[q][j].x + v[q][j].y * v[q][j].y) + (v[q][j].z * v[q][j].z + v[q][j].w * v[q][j].w);
                    const float rinv = 1.0f / sqrtf(wave_sum(s) * (1.f / 1024.f) + EPS);
                    if (F.lane == 0) WSP(float, WS_RINV1)[m0 + q] = rinv;
                    GAS u32x2* o8 = (GAS u32x2*)(HN + (size_t)(m0 + q) * 1024) + F.lane;
#pragma unroll
                    for (int j = 0; j < 4; ++j) { u32x2 w; w.x = pk2(v[q][j].x, v[q][j].y); w.y = pk2(v[q][j].z, v[q][j].w); o8[64 * j] = w; } }
                continue; } r -= I_RMS;
            if (r < I_IN) { const int kb = r / 64, nb = r % 64; transpose_item(F.w_in + (size_t)(64 * kb) * D_IN_PROJ + 32 * nb, D_IN_PROJ, WIN_T + (size_t)(32 * nb) * 1024 + 64 * kb, 1024, scr, F.lane, F.norm1_g + 64 * kb); continue; } r -= I_IN;
            if (r < I_OUT) { const int kb = r / 32, nb = r % 32; transpose_item(F.w_out + (size_t)(64 * kb) * 1024 + 32 * nb, 1024, WOUT_T + (size_t)(32 * nb) * 1024 + 64 * kb, 1024, scr, F.lane); continue; } r -= I_OUT;
            if (r < 2 * I_G) { const int up = r / I_G; r %= I_G; const int e = r / 256, kb = (r % 256) / 16, nb = r % 16; const int n0 = 32 * nb;
                const float* W = (up ? F.w_up : F.w_gate) + (size_t)e * 1024 * 512 + (size_t)(64 * kb) * 512 + n0;
                const int orow = 256 * (n0 >> 7) + (n0 & 127) + (up ? 128 : 0);
                transpose_item_fp8(W, 512, WGU8 + ((size_t)e * 1024 + orow) * 1024 + 64 * kb, 1024, scr, F.lane, F.norm2_g + 64 * kb, W_SCALE); continue; } r -= 2 * I_G;
            { const int e = r / 256, kb = (r % 256) / 32, nb = r % 32;
              transpose_item_fp8(F.w_down + (size_t)e * 512 * 1024 + (size_t)(64 * kb) * 1024 + 32 * nb, 1024, WD8 + ((size_t)e * 1024 + 32 * nb) * 512 + 64 * kb, 512, scr, F.lane, nullptr, W_SCALE); }
        }
        (void)I_D;
    }
    }
    __syncthreads();
}
__device__ __forceinline__ void wdown_items(Frame& F, int first, int stride) {
    LAS float* scr = (LAS float*)(F.lds + F.wave * 8704); unsigned char* WD8 = WSP(unsigned char, WS_WD_T);
    for (int r = WD_HERE + first; r < 32 * 8 * 32; r += stride) { const int e = r / 256, kb = (r % 256) / 32, nb = r % 32;
        transpose_item_fp8(F.w_down + (size_t)e * 512 * 1024 + (size_t)(64 * kb) * 1024 + 32 * nb, 1024, WD8 + ((size_t)e * 1024 + 32 * nb) * 512 + 64 * kb, 512, scr, F.lane, nullptr, W_SCALE); }
}

__device__ __forceinline__ void load_tw_lds(Frame& F, int tw_off, int tw256_off) {
    __syncthreads();
    LAS f32x2* tw = (LAS f32x2*)(F.lds + tw_off); const f32x2* g = WSP(f32x2, WS_TW4096);
    f32x2 tv[8];
#pragma unroll
    for (int i = 0; i < 8; ++i) tv[i] = g[F.tid + NTHREADS * i];
    const f32x2 t2 = g[16 * (F.tid & 255)];
#pragma unroll
    for (int i = 0; i < 8; ++i) tw[F.tid + NTHREADS * i] = tv[i];
    if (F.tid < 256) ((LAS f32x2*)(F.lds + tw256_off))[F.tid] = t2;
    __syncthreads();
}
__device__ __forceinline__ void fft_fwd3(Frame& F) {
    LAS cf* buf = (LAS cf*)(F.lds + ((F.tid >> 8) ? L_BUFB : L_BUFA)); const LAS cf* tw = (const LAS cf*)(F.lds + L_TW); const LAS cf* t256 = (const LAS cf*)(F.lds + L_TW256); const int r = F.tid & 255;
    fft_pass_fwd<1>(buf, tw, t256, r); __syncthreads(); fft_pass_fwd<2>(buf, tw, t256, r); __syncthreads(); fft_pass_fwd<3>(buf, tw, t256, r); __syncthreads();
}
__device__ __forceinline__ void fft_inv3(Frame& F) {
    LAS cf* buf = (LAS cf*)(F.lds + ((F.tid >> 8) ? L_BUFB : L_BUFA)); const LAS cf* tw = (const LAS cf*)(F.lds + L_TW); const LAS cf* t256 = (const LAS cf*)(F.lds + L_TW256); const int r = F.tid & 255;
    fft_pass_inv<3>(buf, tw, t256, r); __syncthreads(); fft_pass_inv<2>(buf, tw, t256, r); __syncthreads(); fft_pass_inv<1>(buf, tw, t256, r); __syncthreads();
}
__device__ __forceinline__ void filter_items(Frame& F, int first, int stride) {
    LAS cf* bufA = (LAS cf*)(F.lds + L_BUFA); LAS cf* bufB = (LAS cf*)(F.lds + L_BUFB);
    LAS float* kfb = (LAS float*)(F.lds + L_SCR);
    LAS float* red = (LAS float*)(F.lds + L_RED);
    const float* KT = WSP(float, WS_KT); const f32x2* tw2 = WSP(f32x2, WS_TW8192);
    if (first >= 512) return;
    float sfv[8], sbv[8], nfv[8], nbv[8]; f32x2 wv[8];
#pragma unroll
    for (int i = 0; i < 8; ++i) { const int l = F.tid + NTHREADS * i; sfv[i] = KT[(size_t)first * 4096 + l]; sbv[i] = KT[(size_t)(512 + first) * 4096 + l]; wv[i] = tw2[l]; }
#pragma unroll 1
    for (int c = first; c < 512; c += stride) {
        float asum = 0.f;
#pragma unroll
        for (int i = 0; i < 8; ++i) { const int l = F.tid + NTHREADS * i; kfb[l] = sfv[i]; kfb[4096 + l] = sbv[i]; asum += fabsf(sfv[i]) + (l >= 1 ? fabsf(sbv[i]) : 0.f); }
        asum = wave_sum(asum);
        if (F.lane == 0) red[128 + F.wave] = asum;
        { const int cn = (c + stride < 512) ? c + stride : c;
#pragma unroll
          for (int i = 0; i < 8; ++i) { const int l = F.tid + NTHREADS * i; nfv[i] = KT[(size_t)cn * 4096 + l]; nbv[i] = KT[(size_t)(512 + cn) * 4096 + l]; } }
        __syncthreads();
        float tot = 0.f;
#pragma unroll
        for (int i = 0; i < 8; ++i) tot += red[128 + i];
        const float sc = 1.0f / (tot * 8192.0f);
#pragma unroll
        for (int i = 0; i < 8; ++i) { const int n = F.tid + NTHREADS * i;
            const float kf = sfv[i], kbm = (n >= 1) ? kfb[4096 + 4096 - n] : 0.f;
            const float a = (kf + kbm) * sc, d = (kf - kbm) * sc;
            bufA[fpos(n)] = mkc(a, 0.f); bufB[fpos(n)] = mkc(d * wv[i].x, d * wv[i].y); }
        __syncthreads();
        fft_fwd3(F);
        f32x2* KF = WSP(f32x2, WS_KF) + (size_t)c * 8192;
        for (int p = F.tid; p < 4096; p += NTHREADS) { const cf a = bufA[fpos(p)], b = bufB[fpos(p)]; KF[p] = (f32x2){a.x, a.y}; KF[4096 + p] = (f32x2){b.x, b.y}; }
#pragma unroll
        for (int i = 0; i < 8; ++i) { sfv[i] = nfv[i]; sbv[i] = nbv[i]; }
        __syncthreads();
    }
}
__device__ __forceinline__ const bf16* pt_at(const bf16* PT, int row, int tok) { return PT + ((size_t)(tok >> 8) * NPT_ROWS + row) * 256 + (tok & 255); }
struct Row8 { u32x4 w; float lft, rgt; };
__device__ __forceinline__ Row8 row8_load(const bf16* PT, int row, int tb, int l0) {
    Row8 r; r.w = *(const u32x4*)pt_at(PT, row, tb + l0);
    const bf16 a = *pt_at(PT, row, tb + (l0 > 0 ? l0 - 1 : 0)), b = *pt_at(PT, row, tb + (l0 + 8 < 4096 ? l0 + 8 : 4095));
    r.lft = (l0 > 0) ? bf1(a) : 0.f; r.rgt = (l0 + 8 < 4096) ? bf1(b) : 0.f; return r;
}
__device__ __forceinline__ void conv8(const Row8& r, float w0, float w1, float w2, float b, float (&o)[8]) {
    float u[10];
    u[0] = r.lft; u[9] = r.rgt; const u32x4 v = r.w;
    u[1] = bflo(v.x); u[2] = bfhi(v.x); u[3] = bflo(v.y); u[4] = bfhi(v.y); u[5] = bflo(v.z); u[6] = bfhi(v.z); u[7] = bflo(v.w); u[8] = bfhi(v.w);
#pragma unroll
    for (int i = 0; i < 8; ++i) o[i] = b + w0 * u[i] + w1 * u[i + 1] + w2 * u[i + 2];
}
struct HyRaw { Row8 a0, v0, a1, v1; };
__device__ __forceinline__ void hy_load(Frame& F, int it, HyRaw& r) {
    const int c = it >> 2, bp = it & 3, l0 = 8 * F.tid; const bf16* PT = WSP(bf16, WS_PT);
    const int tb = 2 * bp * SEQ;
    r.a0 = row8_load(PT, 512 + c, tb, l0); r.v0 = row8_load(PT, 1024 + c, tb, l0); r.a1 = row8_load(PT, 512 + c, tb + SEQ, l0); r.v1 = row8_load(PT, 1024 + c, tb + SEQ, l0);
}
__device__ __forceinline__ void hyena_items(Frame& F) {
    LAS cf* bufA = (LAS cf*)(F.lds + L_BUFA); LAS cf* bufB = (LAS cf*)(F.lds + L_BUFB); const LAS cf* tw2 = (const LAS cf*)(F.lds + L_SCR);
    const bf16* PT = WSP(bf16, WS_PT); const float* cw = F.conv_w; const float* cb = F.conv_b;
    const int l0 = 8 * F.tid;
    HyRaw nx; int it = F.bid;
    if (it < 2048) hy_load(F, it, nx);
    for (; it < 2048; it += F.G) {
        const int c = it >> 2, bp = it & 3;
        float z0[8], z1[8];
        {
            const float a0 = cw[512 + c], a1 = cw[1536 + 512 + c], a2 = cw[3072 + 512 + c], ab = cb[512 + c];
            const float v0 = cw[1024 + c], v1 = cw[1536 + 1024 + c], v2 = cw[3072 + 1024 + c], vb = cb[1024 + c];
            float t1[8], t2[8];
            conv8(nx.a0, a0, a1, a2, ab, t1); conv8(nx.v0, v0, v1, v2, vb, t2);
#pragma unroll
            for (int i = 0; i < 8; ++i) z0[i] = t1[i] * t2[i];
            conv8(nx.a1, a0, a1, a2, ab, t1); conv8(nx.v1, v0, v1, v2, vb, t2);
#pragma unroll
            for (int i = 0; i < 8; ++i) z1[i] = t1[i] * t2[i];
        }
#pragma unroll
        for (int i = 0; i < 8; ++i) { const int l = l0 + i; const cf z = mkc(z0[i], z1[i]); bufA[fpos(l)] = z; bufB[fpos(l)] = cmul(z, tw2[l]); }
        f32x2 ke[8], ko[8];
        { const f32x2* KF = WSP(f32x2, WS_KF) + (size_t)c * 8192;
#pragma unroll
          for (int i = 0; i < 8; ++i) { ke[i] = KF[F.tid + 512 * i]; ko[i] = KF[4096 + F.tid + 512 * i]; } }
        __syncthreads();
        fft_fwd3(F);
#pragma unroll
        for (int i = 0; i < 8; ++i) { const int q = fpos(F.tid + 512 * i); bufA[q] = cmul(bufA[q], ke[i]); bufB[q] = cmul(bufB[q], ko[i]); }
        Row8 xa, xb;
        { const int tb = 2 * bp * SEQ; xa = row8_load(PT, c, tb, l0); xb = row8_load(PT, c, tb + SEQ, l0); }
        if (it + F.G < 2048) hy_load(F, it + F.G, nx);
        __syncthreads();
        fft_inv3(F);
        {
            const float w0 = cw[c], w1 = cw[1536 + c], w2 = cw[3072 + c], wb = cb[c]; const float bias = F.f_bias[c];
            bf16* YT = WSP(bf16, WS_YT) + (size_t)c * T_TOK + (size_t)(2 * bp) * SEQ;
            float x0a[8], x0b[8], ya[8], yb[8];
            conv8(xa, w0, w1, w2, wb, x0a); conv8(xb, w0, w1, w2, wb, x0b);
#pragma unroll
            for (int i = 0; i < 8; ++i) { const int l = l0 + i; const cf e = bufA[fpos(l)], o = bufB[fpos(l)]; const cf y = cadd(e, cmulc(o, tw2[l]));
                ya[i] = x0a[i] * (y.x + bias * z0[i]); yb[i] = x0b[i] * (y.y + bias * z1[i]); }
            u32x4 oa, ob; oa.x = pk2(ya[0], ya[1]); oa.y = pk2(ya[2], ya[3]); oa.z = pk2(ya[4], ya[5]); oa.w = pk2(ya[6], ya[7]);
            ob.x = pk2(yb[0], yb[1]); ob.y = pk2(yb[2], yb[3]); ob.z = pk2(yb[4], yb[5]); ob.w = pk2(yb[6], yb[7]);
            *(u32x4*)(YT + l0) = oa; *(u32x4*)(YT + SEQ + l0) = ob;
        }
        __syncthreads();
    }
}
struct FoRaw { u32x4 a0, d0, a1, d1; };
__device__ __forceinline__ void fo_load(Frame& F, int q, FoRaw& r) {
    const int f = F.tid >> 8, s = 2 * q + f, b = s >> 9, gc = s & 511, g = gc >> 6, cp = gc & 63, l0 = 16 * (F.tid & 255);
    const bf16* PT = WSP(bf16, WS_PT); const int r1 = 1536 + 128 * g + cp, r2 = r1 + 64, tk = b * SEQ + l0;
    r.a0 = *(const u32x4*)pt_at(PT, r1, tk); r.d0 = *(const u32x4*)pt_at(PT, r2, tk); r.a1 = *(const u32x4*)pt_at(PT, r1, tk + 8); r.d1 = *(const u32x4*)pt_at(PT, r2, tk + 8);
}
__device__ __forceinline__ void fo_put(LAS cf* buf, int l, u32x4 a, u32x4 d) {
    buf[fpos(l + 0)] = mkc(bflo(a.x), bflo(d.x)); buf[fpos(l + 1)] = mkc(bfhi(a.x), bfhi(d.x)); buf[fpos(l + 2)] = mkc(bflo(a.y), bflo(d.y)); buf[fpos(l + 3)] = mkc(bfhi(a.y), bfhi(d.y));
    buf[fpos(l + 4)] = mkc(bflo(a.z), bflo(d.z)); buf[fpos(l + 5)] = mkc(bfhi(a.z), bfhi(d.z)); buf[fpos(l + 6)] = mkc(bflo(a.w), bflo(d.w)); buf[fpos(l + 7)] = mkc(bfhi(a.w), bfhi(d.w));
}
__device__ __forceinline__ void fourier_items(Frame& F) {
    const int f = F.tid >> 8, r = F.tid & 255, l0 = 16 * r;
    LAS cf* buf = (LAS cf*)(F.lds + (f ? L_BUFB : L_BUFA));
    FoRaw nx; int q = F.bid;
    if (q < 2048) fo_load(F, q, nx);
    for (; q < 2048; q += F.G) {
        const int s = 2 * q + f, b = s >> 9, gc = s & 511;
        fo_put(buf, l0, nx.a0, nx.d0); fo_put(buf, l0 + 8, nx.a1, nx.d1);
        if (q + F.G < 2048) fo_load(F, q + F.G, nx);
        __syncthreads();
        fft_fwd3(F);
        bf16* YT = WSP(bf16, WS_YT) + (size_t)(512 + gc) * T_TOK + (size_t)b * SEQ;
        float y[16];
#pragma unroll
        for (int i = 0; i < 16; ++i) y[i] = buf[fpos(freq_pos(l0 + i))].x * (1.0f / 512.0f);
        u32x4 o0, o1; o0.x = pk2(y[0], y[1]); o0.y = pk2(y[2], y[3]); o0.z = pk2(y[4], y[5]); o0.w = pk2(y[6], y[7]);
        o1.x = pk2(y[8], y[9]); o1.y = pk2(y[10], y[11]); o1.z = pk2(y[12], y[13]); o1.w = pk2(y[14], y[15]);
        *(u32x4*)(YT + l0) = o0; *(u32x4*)(YT + l0 + 8) = o1;
        __syncthreads();
    }
}

#define MF_LO 1
constexpr int MF_NS = 288;
constexpr int MF_PS = 24;
constexpr int MF_PLANE = 6144;
typedef short bf16x8v __attribute__((ext_vector_type(8)));
typedef short s16x4v __attribute__((ext_vector_type(4)));
typedef float f32x16 __attribute__((ext_vector_type(16)));
struct DftFrag { bf16x8v hi[2], lo[2]; };
__device__ __forceinline__ void make_dft_frag(DftFrag& f, int lane, bool inv, const LAS cf* tw  ) {
    const int i = lane & 31, h = lane >> 5, ii = i & 15;
#pragma unroll
    for (int st = 0; st < 2; ++st)
#pragma unroll
        for (int j = 0; j < 8; ++j) { const int e = 8 * h + j; const int m = (ii * e) & 15; const cf w = tw[256 * m]; const float c = w.x, s = -w.y;
            const float di = inv ? s : -s;
            const float val = (st == 0) ? ((i < 16) ? c : di) : ((i < 16) ? -di : c);
            const unsigned hb = f2bf(val); const float rem = val - __builtin_bit_cast(float, hb << 16);
            f.hi[st][j] = (short)hb; f.lo[st][j] = (short)f2bf(rem); }
}
__device__ __forceinline__ unsigned cvtpk_v(float lo, float hi) { typedef float f32x2_t __attribute__((ext_vector_type(2))); typedef __bf16 bf16x2_t __attribute__((ext_vector_type(2))); const f32x2_t v = {lo, hi}; const bf16x2_t b = __builtin_convertvector(v, bf16x2_t); return __builtin_bit_cast(unsigned, b); }
__device__ __forceinline__ s16x4v lds_tr16(const LAS bf16* p) { typedef short v4i16_t __attribute__((ext_vector_type(4))); return __builtin_bit_cast(s16x4v, __builtin_amdgcn_ds_read_tr16_b64_v4i16((LAS v4i16_t*)p)); }
template <int PASS, bool INV, int EPI>
__device__ __forceinline__ void mfft_block(const LAS bf16* inR, const LAS bf16* inI, LAS bf16* outR, LAS bf16* outI, const DftFrag& M, const LAS cf* tw, const LAS cf* tw256, int cb, int lane, const cf* kf, float rs) {
    asm volatile("" : "+v"(lane));
    const int n = lane & 31, h = lane >> 5;
    bf16x8v bR, bI;
    if (PASS == 1) {
        const int g = lane >> 4, q = (lane & 15) >> 2, p = lane & 3;
        const int off = (8 * (g >> 1) + q) * MF_NS + 32 * cb + 16 * (g & 1) + 4 * p;
        const LAS bf16* pr = inR + off; const LAS bf16* pi = inI + off;
        const s16x4v r0 = lds_tr16(pr), r1 = lds_tr16(pr + 4 * MF_NS), i0 = lds_tr16(pi), i1 = lds_tr16(pi + 4 * MF_NS);
        asm volatile("" :: "v"(pr), "v"(pi) : "memory");
        bR = (bf16x8v){r0[0], r0[1], r0[2], r0[3], r1[0], r1[1], r1[2], r1[3]}; bI = (bf16x8v){i0[0], i0[1], i0[2], i0[3], i1[0], i1[1], i1[2], i1[3]};
    } else {
        const int off = (32 * cb + n) * MF_PS + 8 * h;
        bR = *(const LAS bf16x8v*)(inR + off); bI = *(const LAS bf16x8v*)(inI + off);
    }
    f32x16 acc = {0.f, 0.f, 0.f, 0.f, 0.f, 0.f, 0.f, 0.f, 0.f, 0.f, 0.f, 0.f, 0.f, 0.f, 0.f, 0.f};
    acc = __builtin_amdgcn_mfma_f32_32x32x16_bf16(M.hi[0], bR, acc, 0, 0, 0);
    acc = __builtin_amdgcn_mfma_f32_32x32x16_bf16(M.hi[1], bI, acc, 0, 0, 0);
#if MF_LO
    acc = __builtin_amdgcn_mfma_f32_32x32x16_bf16(M.lo[0], bR, acc, 0, 0, 0);
    acc = __builtin_amdgcn_mfma_f32_32x32x16_bf16(M.lo[1], bI, acc, 0, 0, 0);
#endif
    const int c = 32 * cb + n;
    int base, qs;
    if (PASS == 1) { base = MF_PS * (c & 15) + (c >> 4) + 64 * MF_PS * h; qs = 16 * MF_PS; }
    else if (PASS == 2) { base = 16 * MF_PS * (c >> 4) + (c & 15) + 4 * MF_PS * h; qs = MF_PS; }
    else { base = (c >> 4) + 16 * (c & 15) + 4 * MF_NS * h; qs = MF_NS; }
    float yr[8], yi[8];
#pragma unroll
    for (int q = 0; q < 8; ++q) { float a = acc[q], b = acc[8 + q];
        if (PASS == 1) { const int s = (q & 3) + 8 * (q >> 2) + 4 * h; const cf w = tw[(c * s) & 4095]; const float wy = INV ? -w.y : w.y; const float t = a * w.x - b * wy; b = a * wy + b * w.x; a = t; }
        else if (PASS == 2) { const int s = (q & 3) + 8 * (q >> 2) + 4 * h; const cf w = tw256[(c & 15) * s]; const float wy = INV ? -w.y : w.y; const float t = a * w.x - b * wy; b = a * wy + b * w.x; a = t; }
        else if (EPI == 1) { const cf w = kf[q]; const float t = a * w.x - b * w.y; b = -(a * w.y + b * w.x); a = t; }
        else if (EPI == 2) { a *= rs; }
        else if (EPI == 3) { a *= rs; b *= rs; }
        yr[q] = a; yi[q] = b; }
#pragma unroll
    for (int q = 0; q < 8; q += 2) { const int o0 = base + qs * ((q & 3) + 8 * (q >> 2)), o1 = o0 + qs;
        const unsigned pr = cvtpk_v(yr[q], yr[q + 1]); outR[o0] = (bf16)(pr & 0xffffu); outR[o1] = (bf16)(pr >> 16);
        if (!(PASS == 3 && EPI == 2)) { const unsigned pi = cvtpk_v(yi[q], yi[q + 1]); outI[o0] = (bf16)(pi & 0xffffu); outI[o1] = (bf16)(pi >> 16); } }
}

__device__ __forceinline__ int mf_nat(int x) { return MF_NS * (x >> 8) + (x & 255); }
__device__ __forceinline__ void fo2_load(Frame& F, int q, FoRaw& r) {
    const int f = F.tid >> 8, pp = 2 * q + f, b = pp >> 8, c = 2 * (pp & 255), l0 = 16 * (F.tid & 255);
    const bf16* PT = WSP(bf16, WS_PT); const int r1 = 1536 + c, r2 = r1 + 1, tk = b * SEQ + l0;
    r.a0 = *(const u32x4*)pt_at(PT, r1, tk); r.d0 = *(const u32x4*)pt_at(PT, r2, tk); r.a1 = *(const u32x4*)pt_at(PT, r1, tk + 8); r.d1 = *(const u32x4*)pt_at(PT, r2, tk + 8);
}
__device__ __forceinline__ void fourier_items_mfma(Frame& F) {
    const int f = F.tid >> 8, r = F.tid & 255, l0 = 16 * r, n0 = mf_nat(l0);
    LAS bf16* S0R = (LAS bf16*)(F.lds + f * 49152); LAS bf16* S0I = S0R + MF_PLANE; LAS bf16* S1R = S0R + 2 * MF_PLANE; LAS bf16* S1I = S0R + 3 * MF_PLANE;
    const LAS cf* tw = (const LAS cf*)(F.lds + M_TW); const LAS cf* t256 = (const LAS cf*)(F.lds + M_TW256);
    DftFrag Mf; make_dft_frag(Mf, F.lane, false, tw);
    const int cb0 = 2 * (F.wave & 3);
    bf16* SP = WSP(bf16, WS_SP);
    FoRaw nx; int q = F.bid;
    if (q < 1024) fo2_load(F, q, nx);
    for (; q < 1024; q += F.G) {
        const int pp = 2 * q + f, b = pp >> 8, c = 2 * (pp & 255);
        *(LAS u32x4*)(S0R + n0) = nx.a0; *(LAS u32x4*)(S0R + n0 + 8) = nx.a1; *(LAS u32x4*)(S0I + n0) = nx.d0; *(LAS u32x4*)(S0I + n0 + 8) = nx.d1;
        if (q + F.G < 1024) fo2_load(F, q + F.G, nx);
        __syncthreads();
        mfft_block<1, false, 0>(S0R, S0I, S1R, S1I, Mf, tw, t256, cb0, F.lane, nullptr, 1.f); mfft_block<1, false, 0>(S0R, S0I, S1R, S1I, Mf, tw, t256, cb0 + 1, F.lane, nullptr, 1.f);
        __syncthreads();
        mfft_block<2, false, 0>(S1R, S1I, S0R, S0I, Mf, tw, t256, cb0, F.lane, nullptr, 1.f); mfft_block<2, false, 0>(S1R, S1I, S0R, S0I, Mf, tw, t256, cb0 + 1, F.lane, nullptr, 1.f);
        __syncthreads();
        mfft_block<3, false, 0>(S0R, S0I, S1R, S1I, Mf, tw, t256, cb0, F.lane, nullptr, 1.f); mfft_block<3, false, 0>(S0R, S0I, S1R, S1I, Mf, tw, t256, cb0 + 1, F.lane, nullptr, 1.f);
        __syncthreads();
        {
            const int k0 = 8 * r, m0 = mf_nat(k0);
            const u32x4 zr = *(const LAS u32x4*)(S1R + m0), zi = *(const LAS u32x4*)(S1I + m0);
            float Zr[8], Zi[8], Mr[8], Mi[8];
            Zr[0] = bflo(zr.x); Zr[1] = bfhi(zr.x); Zr[2] = bflo(zr.y); Zr[3] = bfhi(zr.y); Zr[4] = bflo(zr.z); Zr[5] = bfhi(zr.z); Zr[6] = bflo(zr.w); Zr[7] = bfhi(zr.w);
            Zi[0] = bflo(zi.x); Zi[1] = bfhi(zi.x); Zi[2] = bflo(zi.y); Zi[3] = bfhi(zi.y); Zi[4] = bflo(zi.z); Zi[5] = bfhi(zi.z); Zi[6] = bflo(zi.w); Zi[7] = bfhi(zi.w);
#pragma unroll
            for (int i = 0; i < 8; ++i) { const int km = mf_nat((4096 - k0 - i) & 4095); Mr[i] = bf1(S1R[km]); Mi[i] = bf1(S1I[km]); }
            float Ac[8], Bc[8], Ad[8], Bd[8];
#pragma unroll
            for (int i = 0; i < 8; ++i) { Ac[i] = 0.5f * (Zr[i] + Mr[i]); Bc[i] = 0.5f * (Mi[i] - Zi[i]); Ad[i] = 0.5f * (Zi[i] + Mi[i]); Bd[i] = 0.5f * (Zr[i] - Mr[i]); }
            if (k0 == 0) { const int kn = mf_nat(2048); Bc[0] = bf1(S1R[kn]); Bd[0] = bf1(S1I[kn]); }
            bf16* s0 = SP + ((size_t)(c * 8 + b) * 2) * 2048 + k0; bf16* s1 = SP + ((size_t)((c + 1) * 8 + b) * 2) * 2048 + k0;
            u32x4 o; o.x = pk2(Ac[0], Ac[1]); o.y = pk2(Ac[2], Ac[3]); o.z = pk2(Ac[4], Ac[5]); o.w = pk2(Ac[6], Ac[7]); st16_wt(s0, o);
            o.x = pk2(Bc[0], Bc[1]); o.y = pk2(Bc[2], Bc[3]); o.z = pk2(Bc[4], Bc[5]); o.w = pk2(Bc[6], Bc[7]); st16_wt(s0 + 2048, o);
            o.x = pk2(Ad[0], Ad[1]); o.y = pk2(Ad[2], Ad[3]); o.z = pk2(Ad[4], Ad[5]); o.w = pk2(Ad[6], Ad[7]); st16_wt(s1, o);
            o.x = pk2(Bd[0], Bd[1]); o.y = pk2(Bd[2], Bd[3]); o.z = pk2(Bd[4], Bd[5]); o.w = pk2(Bd[6], Bd[7]); st16_wt(s1 + 2048, o);
        }
        __syncthreads();
    }
    __syncthreads();
}
__device__ __forceinline__ void hyena_items_mfma(Frame& F) {
    const int f = F.tid >> 8;
    LAS bf16* A0R = (LAS bf16*)F.lds; LAS bf16* A0I = A0R + MF_PLANE; LAS bf16* B0R = (LAS bf16*)(F.lds + 49152); LAS bf16* B0I = B0R + MF_PLANE;
    LAS bf16* S0R = (LAS bf16*)(F.lds + f * 49152); LAS bf16* S0I = S0R + MF_PLANE; LAS bf16* S1R = S0R + 2 * MF_PLANE; LAS bf16* S1I = S0R + 3 * MF_PLANE;
    const LAS cf* tw = (const LAS cf*)(F.lds + M_TW); const LAS cf* t256 = (const LAS cf*)(F.lds + M_TW256);
    const cf w81 = mkc(0.99999970586288221916f, -0.00076699031874270453f);
    DftFrag Mf; make_dft_frag(Mf, F.lane, false, tw);
    const bf16* PT = WSP(bf16, WS_PT); const float* cw = F.conv_w; const float* cb = F.conv_b;
    const int l0 = 8 * F.tid, n0 = mf_nat(l0), cb0 = 2 * (F.wave & 3), ln = F.lane & 31, lh = F.lane >> 5;
    HyRaw nx; int it = F.bid;
    if (it < 2048) hy_load(F, it, nx);
    for (; it < 2048; it += F.G) {
        const int c = it >> 2, bp = it & 3;
        float z0[8], z1[8];
        {
            const float a0 = cw[512 + c], a1 = cw[1536 + 512 + c], a2 = cw[3072 + 512 + c], ab = cb[512 + c];
            const float v0 = cw[1024 + c], v1 = cw[1536 + 1024 + c], v2 = cw[3072 + 1024 + c], vb = cb[1024 + c];
            float t1[8], t2[8];
            conv8(nx.a0, a0, a1, a2, ab, t1); conv8(nx.v0, v0, v1, v2, vb, t2);
#pragma unroll
            for (int i = 0; i < 8; ++i) z0[i] = t1[i] * t2[i];
            conv8(nx.a1, a0, a1, a2, ab, t1); conv8(nx.v1, v0, v1, v2, vb, t2);
#pragma unroll
            for (int i = 0; i < 8; ++i) z1[i] = t1[i] * t2[i];
        }
        {
            float br[8], bi[8];
#pragma unroll
            for (int i = 0; i < 8; ++i) { cf w = tw[(l0 >> 1) + (i >> 1)]; if (i & 1) w = cmul(w, w81); br[i] = z0[i] * w.x - z1[i] * w.y; bi[i] = z0[i] * w.y + z1[i] * w.x; }
            u32x4 v; v.x = pk2h(z0[0], z0[1]); v.y = pk2h(z0[2], z0[3]); v.z = pk2h(z0[4], z0[5]); v.w = pk2h(z0[6], z0[7]); *(LAS u32x4*)(A0R + n0) = v;
            v.x = pk2h(z1[0], z1[1]); v.y = pk2h(z1[2], z1[3]); v.z = pk2h(z1[4], z1[5]); v.w = pk2h(z1[6], z1[7]); *(LAS u32x4*)(A0I + n0) = v;
            v.x = pk2h(br[0], br[1]); v.y = pk2h(br[2], br[3]); v.z = pk2h(br[4], br[5]); v.w = pk2h(br[6], br[7]); *(LAS u32x4*)(B0R + n0) = v;
            v.x = pk2h(bi[0], bi[1]); v.y = pk2h(bi[2], bi[3]); v.z = pk2h(bi[4], bi[5]); v.w = pk2h(bi[6], bi[7]); *(LAS u32x4*)(B0I + n0) = v;
        }
        __syncthreads();
        mfft_block<1, false, 0>(S0R, S0I, S1R, S1I, Mf, tw, t256, cb0, F.lane, nullptr, 1.f); mfft_block<1, false, 0>(S0R, S0I, S1R, S1I, Mf, tw, t256, cb0 + 1, F.lane, nullptr, 1.f);
        cf kf[2][8];
        { const f32x4* KF = (const f32x4*)(WSP(f32x2, WS_KF) + (size_t)c * 8192 + (size_t)f * 4096);
#pragma unroll
          for (int j = 0; j < 2; ++j) { const int cc = 32 * (cb0 + j) + ln; const f32x4* kp = KF + (cc * 16 + 4 * lh) / 2;
              const f32x4 k0 = kp[0], k1 = kp[1], k2 = kp[4], k3 = kp[5];
              kf[j][0] = mkc(k0.x, k0.y); kf[j][1] = mkc(k0.z, k0.w); kf[j][2] = mkc(k1.x, k1.y); kf[j][3] = mkc(k1.z, k1.w);
              kf[j][4] = mkc(k2.x, k2.y); kf[j][5] = mkc(k2.z, k2.w); kf[j][6] = mkc(k3.x, k3.y); kf[j][7] = mkc(k3.z, k3.w); } }
        __syncthreads();
        mfft_block<2, false, 0>(S1R, S1I, S0R, S0I, Mf, tw, t256, cb0, F.lane, nullptr, 1.f); mfft_block<2, false, 0>(S1R, S1I, S0R, S0I, Mf, tw, t256, cb0 + 1, F.lane, nullptr, 1.f);
        __syncthreads();
        mfft_block<3, false, 1>(S0R, S0I, S1R, S1I, Mf, tw, t256, cb0, F.lane, kf[0], 1.f); mfft_block<3, false, 1>(S0R, S0I, S1R, S1I, Mf, tw, t256, cb0 + 1, F.lane, kf[1], 1.f);
        __syncthreads();
        mfft_block<1, false, 0>(S1R, S1I, S0R, S0I, Mf, tw, t256, cb0, F.lane, nullptr, 1.f); mfft_block<1, false, 0>(S1R, S1I, S0R, S0I, Mf, tw, t256, cb0 + 1, F.lane, nullptr, 1.f);
        __syncthreads();
        mfft_block<2, false, 0>(S0R, S0I, S1R, S1I, Mf, tw, t256, cb0, F.lane, nullptr, 1.f); mfft_block<2, false, 0>(S0R, S0I, S1R, S1I, Mf, tw, t256, cb0 + 1, F.lane, nullptr, 1.f);
        Row8 xa, xb;
        { const int tb = 2 * bp * SEQ; xa = row8_load(PT, c, tb, l0); xb = row8_load(PT, c, tb + SEQ, l0); }
        if (it + F.G < 2048) hy_load(F, it + F.G, nx);
        __syncthreads();
        mfft_block<3, false, 0>(S1R, S1I, S0R, S0I, Mf, tw, t256, cb0, F.lane, nullptr, 1.f); mfft_block<3, false, 0>(S1R, S1I, S0R, S0I, Mf, tw, t256, cb0 + 1, F.lane, nullptr, 1.f);
        __syncthreads();
        {
            const float w0 = cw[c], w1 = cw[1536 + c], w2 = cw[3072 + c], wb = cb[c]; const float bias = F.f_bias[c];
            bf16* YT = WSP(bf16, WS_YT) + (size_t)c * T_TOK + (size_t)(2 * bp) * SEQ;
            float x0a[8], x0b[8], ya[8], yb[8], er[8], ei[8], orr[8], oi[8];
            conv8(xa, w0, w1, w2, wb, x0a); conv8(xb, w0, w1, w2, wb, x0b);
            { const u32x4 a = *(const LAS u32x4*)(A0R + n0), b = *(const LAS u32x4*)(A0I + n0), d = *(const LAS u32x4*)(B0R + n0), g = *(const LAS u32x4*)(B0I + n0);
              er[0] = bflo(a.x); er[1] = bfhi(a.x); er[2] = bflo(a.y); er[3] = bfhi(a.y); er[4] = bflo(a.z); er[5] = bfhi(a.z); er[6] = bflo(a.w); er[7] = bfhi(a.w);
              ei[0] = bflo(b.x); ei[1] = bfhi(b.x); ei[2] = bflo(b.y); ei[3] = bfhi(b.y); ei[4] = bflo(b.z); ei[5] = bfhi(b.z); ei[6] = bflo(b.w); ei[7] = bfhi(b.w);
              orr[0] = bflo(d.x); orr[1] = bfhi(d.x); orr[2] = bflo(d.y); orr[3] = bfhi(d.y); orr[4] = bflo(d.z); orr[5] = bfhi(d.z); orr[6] = bflo(d.w); orr[7] = bfhi(d.w);
              oi[0] = bflo(g.x); oi[1] = bfhi(g.x); oi[2] = bflo(g.y); oi[3] = bfhi(g.y); oi[4] = bflo(g.z); oi[5] = bfhi(g.z); oi[6] = bflo(g.w); oi[7] = bfhi(g.w); }
#pragma unroll
            for (int i = 0; i < 8; ++i) { cf w = tw[(l0 >> 1) + (i >> 1)]; if (i & 1) w = cmul(w, w81);
                const float eim = -ei[i], oim = -oi[i];
                const float yr = er[i] + (orr[i] * w.x + oim * w.y), yi = eim + (oim * w.x - orr[i] * w.y);
                ya[i] = x0a[i] * (yr + bias * z0[i]); yb[i] = x0b[i] * (yi + bias * z1[i]); }
            u32x4 oa, ob; oa.x = pk2h(ya[0], ya[1]); oa.y = pk2h(ya[2], ya[3]); oa.z = pk2h(ya[4], ya[5]); oa.w = pk2h(ya[6], ya[7]);
            ob.x = pk2h(yb[0], yb[1]); ob.y = pk2h(yb[2], yb[3]); ob.z = pk2h(yb[4], yb[5]); ob.w = pk2h(yb[6], yb[7]);
            st16_wt(YT + l0, oa); st16_wt(YT + SEQ + l0, ob);
        }
        __syncthreads();
    }
}

__device__ __forceinline__ void phase_headnorm(Frame& F) {
    LAS float* tl = (LAS float*)F.lds;
    LAS float* rs = tl + 64 * 257;
    const bf16* YT = WSP(bf16, WS_YT); bf16* YN = WSP(bf16, WS_YN);
    u32x4 nxv[4];
    if (F.bid < 8 * 128) { const int h = F.bid & 7, tok0 = (F.bid >> 3) * 256;
#pragma unroll
        for (int i = 0; i < 4; ++i) { const int idx = F.tid + 512 * i, row = idx >> 5, ch = idx & 31; nxv[i] = *(const u32x4*)(YT + (size_t)(64 * h + row) * T_TOK + tok0 + 8 * ch); } }
    for (int it = F.bid; it < 8 * 128; it += F.G) {
        const int h = it & 7, tt = it >> 3, tok0 = tt * 256;
#pragma unroll
        for (int i = 0; i < 4; ++i) { const int idx = F.tid + 512 * i, row = idx >> 5, ch = idx & 31;
            const u32x4 v = nxv[i]; LAS float* d = tl + row * 257 + 8 * ch;
            d[0] = bflo(v.x); d[1] = bfhi(v.x); d[2] = bflo(v.y); d[3] = bfhi(v.y); d[4] = bflo(v.z); d[5] = bfhi(v.z); d[6] = bflo(v.w); d[7] = bfhi(v.w); }
        if (it + F.G < 8 * 128) { const int it2 = it + F.G, h2 = it2 & 7, tk2 = (it2 >> 3) * 256;
#pragma unroll
            for (int i = 0; i < 4; ++i) { const int idx = F.tid + 512 * i, row = idx >> 5, ch = idx & 31; nxv[i] = *(const u32x4*)(YT + (size_t)(64 * h2 + row) * T_TOK + tk2 + 8 * ch); } }
        __syncthreads();
        if (F.tid < 256) { float s = 0.f;
#pragma unroll 8
            for (int c = 0; c < 64; ++c) { const float v = tl[c * 257 + F.tid]; s += v * v; }
            rs[F.tid] = 1.0f / sqrtf(s * (1.0f / 64.0f) + EPS); }
        __syncthreads();
#pragma unroll
        for (int i = 0; i < 4; ++i) { const int idx = F.tid + 512 * i, tok = idx >> 3, q = idx & 7; const float r = rs[tok]; const float* g = F.mix_g + 64 * h + 8 * q;
            float v[8];
#pragma unroll
            for (int j = 0; j < 8; ++j) v[j] = tl[(8 * q + j) * 257 + tok] * r * g[j];
            u32x4 o; o.x = pk2(v[0], v[1]); o.y = pk2(v[2], v[3]); o.z = pk2(v[4], v[5]); o.w = pk2(v[6], v[7]);
            st16_wt(YN + (size_t)(tok0 + tok) * 1024 + 64 * h + 8 * q, o); }
        __syncthreads();
    }
}

constexpr int MX_NS = 288, MX_XA = 0, MX_XB = 64 * MX_NS * 2, MX_MT = 2 * MX_XB, MX_MTLO = MX_MT + 32768, MX_NYQ = MX_MTLO + 32768, MX_SLOT = 144;
__device__ __forceinline__ void mix_load(Frame& F, int tile, u32x4 (&v)[8]) {
    const int b = tile >> 6, g = (tile >> 3) & 7, kt = tile & 7; const bf16* SP = WSP(bf16, WS_SP);
#pragma unroll
    for (int u = 0; u < 8; ++u) { const int idx = F.tid + NTHREADS * u, row = idx >> 5, ch = idx & 31, ab = row >> 6, c = row & 63;
        v[u] = *(const u32x4*)(SP + ((size_t)((64 * g + c) * 8 + b) * 2 + ab) * 2048 + 256 * kt + 8 * ch); }
}
__device__ __forceinline__ void fourier_mix(Frame& F) {
    LAS bf16* XA = (LAS bf16*)(F.lds + MX_XA); LAS bf16* XB = (LAS bf16*)(F.lds + MX_XB);
    LAS u32x4* MT = (LAS u32x4*)(F.lds + MX_MT); LAS u32x4* MTL = (LAS u32x4*)(F.lds + MX_MTLO); LAS float* nyq = (LAS float*)(F.lds + MX_NYQ);
    LAS unsigned char* STG = F.lds;
    const bf16* SP = WSP(bf16, WS_SP); bf16* YN = WSP(bf16, WS_YN);
    LAS float* cst = nyq + 64;
    __syncthreads();
    if (F.tid < 64) { cst[F.tid] = cospif((float)F.tid * (1.0f / 32.0f)); cst[64 + F.tid] = sinpif((float)F.tid * (1.0f / 32.0f)); }
    __syncthreads();
    for (int idx = F.tid; idx < 32 * 64; idx += NTHREADS) { const int lane = idx & 63, fs = idx >> 6, rb = fs >> 3, s = fs & 7, i = lane & 31, h = lane >> 5;
        unsigned hw[4], lw[4];
#pragma unroll
        for (int jj = 0; jj < 4; ++jj) { unsigned hh[2], ll[2];
#pragma unroll
            for (int u = 0; u < 2; ++u) { const int j = 2 * jj + u, kap = 16 * s + 8 * h + j, c = kap & 63, isB = kap >> 6, cpp = 32 * rb + i, cp = cpp & 63, mir = cpp >> 6;
                const int m = (c * cp) & 63; const float cv = cst[m], sv = cst[64 + m];
                const float val = (isB ? (mir ? sv : -sv) : cv) * (1.0f / 512.0f);
                hh[u] = f2bf(val); ll[u] = f2bf(val - __builtin_bit_cast(float, hh[u] << 16)); }
            hw[jj] = hh[0] | (hh[1] << 16); lw[jj] = ll[0] | (ll[1] << 16); }
        MT[idx] = (u32x4){hw[0], hw[1], hw[2], hw[3]}; MTL[idx] = (u32x4){lw[0], lw[1], lw[2], lw[3]}; }
    u32x4 nxv[8];
    if (F.bid < 512) mix_load(F, F.bid, nxv);
    for (int tile = F.bid; tile < 512; tile += F.G) {
        const int b = tile >> 6, g = (tile >> 3) & 7, kt = tile & 7;
        __syncthreads();
#pragma unroll
        for (int u = 0; u < 8; ++u) { const int idx = F.tid + NTHREADS * u, row = idx >> 5, ch = idx & 31, ab = row >> 6, c = row & 63;
            u32x4 v = nxv[u];
            if (kt == 0 && ab == 1 && ch == 0) { nyq[c] = bflo(v.x); v.x &= 0xffff0000u; }
            *(LAS u32x4*)((ab ? XB : XA) + c * MX_NS + 8 * ch) = v; }
        if (tile + F.G < 512) mix_load(F, tile + F.G, nxv);
        __syncthreads();
        f32x16 acc[4];
#pragma unroll
        for (int rb = 0; rb < 4; ++rb) acc[rb] = (f32x16){0.f, 0.f, 0.f, 0.f, 0.f, 0.f, 0.f, 0.f, 0.f, 0.f, 0.f, 0.f, 0.f, 0.f, 0.f, 0.f};
        { int lane = F.lane; asm volatile("" : "+v"(lane));
          const int gq = lane >> 4, q = (lane & 15) >> 2, p = lane & 3;
#pragma unroll
          for (int s = 0; s < 8; ++s) {
              const LAS bf16* pr = ((s < 4) ? XA : XB) + (16 * (s & 3) + 8 * (gq >> 1) + q) * MX_NS + 32 * F.wave + 16 * (gq & 1) + 4 * p;
              const s16x4v r0 = lds_tr16(pr), r1 = lds_tr16(pr + 4 * MX_NS);
              asm volatile("" :: "v"(pr) : "memory");
              const bf16x8v bfr = (bf16x8v){r0[0], r0[1], r0[2], r0[3], r1[0], r1[1], r1[2], r1[3]};
#pragma unroll
              for (int rb = 0; rb < 4; ++rb) { const bf16x8v mh = __builtin_bit_cast(bf16x8v, MT[(rb * 8 + s) * 64 + lane]), ml = __builtin_bit_cast(bf16x8v, MTL[(rb * 8 + s) * 64 + lane]);
                  acc[rb] = __builtin_amdgcn_mfma_f32_32x32x16_bf16(mh, bfr, acc[rb], 0, 0, 0); acc[rb] = __builtin_amdgcn_mfma_f32_32x32x16_bf16(ml, bfr, acc[rb], 0, 0, 0); } } }
        float sk = 0.f, sm = 0.f;
#pragma unroll
        for (int r = 0; r < 16; ++r) { sk += acc[0][r] * acc[0][r] + acc[1][r] * acc[1][r]; sm += acc[2][r] * acc[2][r] + acc[3][r] * acc[3][r]; }
        sk += __shfl_xor(sk, 32); sm += __shfl_xor(sm, 32);
        const float rk = 1.0f / sqrtf(sk * (1.0f / 64.0f) + EPS), rm = 1.0f / sqrtf(sm * (1.0f / 64.0f) + EPS);
        __syncthreads();
        { const int n = F.lane & 31, hi = F.lane >> 5; const float* mg = F.mix_g + 512 + 64 * g;
#pragma unroll
          for (int rb = 0; rb < 4; ++rb) { const int slot = 32 * F.wave + n + ((rb >> 1) ? 256 : 0); const float rr = (rb >> 1) ? rm : rk;
#pragma unroll
              for (int rg = 0; rg < 4; ++rg) { const int cp = 32 * (rb & 1) + 8 * rg + 4 * hi; const f32x4 gg = *(const f32x4*)(mg + cp);
                  u32x2 w; w.x = pk2(acc[rb][4 * rg] * rr * gg.x, acc[rb][4 * rg + 1] * rr * gg.y); w.y = pk2(acc[rb][4 * rg + 2] * rr * gg.z, acc[rb][4 * rg + 3] * rr * gg.w);
                  *(LAS u32x2*)(STG + slot * MX_SLOT + 2 * cp) = w; } } }
        __syncthreads();
#pragma unroll
        for (int u = 0; u < 8; ++u) { const int idx = F.tid + NTHREADS * u, slot = idx >> 3, ch = idx & 7; const int kk = 256 * kt + (slot & 255);
            const int tok = b * SEQ + ((slot < 256) ? kk : (4096 - kk));
            if (!(slot >= 256 && kk == 0)) st16_wt(YN + (size_t)tok * 1024 + 512 + 64 * g + 8 * ch, *(const LAS u32x4*)(STG + slot * MX_SLOT + 16 * ch)); }
        if (kt == 0 && F.wave == 0) {
            const int cp = F.lane; float y = 0.f;
            for (int c = 0; c < 64; ++c) y += nyq[c] * cst[(c * cp) & 63];
            y *= (1.0f / 512.0f);
            const float r2 = 1.0f / sqrtf(wave_sum(y * y) * (1.0f / 64.0f) + EPS);
            YN[(size_t)(b * SEQ + 2048) * 1024 + 512 + 64 * g + cp] = (bf16)f2bf(y * r2 * F.mix_g[512 + 64 * g + cp]);
        }
    }
    __syncthreads();
}

__device__ __forceinline__ float wave_reduce8(const float (&a)[8], int lane) {
    const bool h5 = (lane & 32) != 0, h4 = (lane & 16) != 0, h3 = (lane & 8) != 0;
    float b[4], c[2], d;
#pragma unroll
    for (int i = 0; i < 4; ++i) { const float snd = h5 ? a[i] : a[4 + i], keep = h5 ? a[4 + i] : a[i]; b[i] = keep + __shfl_xor(snd, 32); }
#pragma unroll
    for (int i = 0; i < 2; ++i) { const float snd = h4 ? b[i] : b[2 + i], keep = h4 ? b[2 + i] : b[i]; c[i] = keep + __shfl_xor(snd, 16); }
    { const float snd = h3 ? c[0] : c[1], keep = h3 ? c[1] : c[0]; d = keep + __shfl_xor(snd, 8); }
    d += __shfl_xor(d, 4); d += __shfl_xor(d, 2); d += __shfl_xor(d, 1);
    return d;
}
__device__ __forceinline__ float rdlane(float v, int l) { return __builtin_bit_cast(float, __builtin_amdgcn_readlane(__builtin_bit_cast(int, v), l)); }
__device__ __forceinline__ void phase_route(Frame& F, const bf16* X1) {
    LAS float* slab = (LAS float*)F.lds;
    LAS float* fin = (LAS float*)(F.lds + 106496);
    LAS int* lcnt = (LAS int*)(F.lds + 147456);
    LAS int* lbase = lcnt + 32;
    LAS int* pe = lcnt + 64;
    LAS float* pw = (LAS float*)(pe + 256);
    LAS float* prr = pw + 256;
    LAS int* prow = (LAS int*)(prr + 256);
    LAS float* lbr = (LAS float*)(prow + 256);
    int* TOT = WSP(int, WS_TOT); int* LIST = WSP(int, WS_LIST); float* ROWW = WSP(float, WS_ROWW); float* ROWR = WSP(float, WS_ROWR);
    unsigned char* X1Q = WSP(unsigned char, WS_X1Q);
    const int n = F.lane & 15, fq = F.lane >> 4, w = F.wave;
    __syncthreads();
    if (F.tid < 32) lbr[F.tid] = F.b_router[F.tid];
    bf16x8v bh[4][3], bl[4][3];
#pragma unroll
    for (int s_ = 0; s_ < 4; ++s_)
#pragma unroll
        for (int c = 0; c < 3; ++c) { const int col = 16 * c + n;
#pragma unroll
            for (int j = 0; j < 8; ++j) { const int k = 128 * w + 32 * s_ + 8 * fq + j; float val = 0.f;
                if (col < 4) val = F.w_group[k * 4 + col]; else if (col < 36) val = F.w_router[((col - 4) >> 3) * 8192 + k * 8 + ((col - 4) & 7)];
                val *= F.norm2_g[k];
                const unsigned hb = f2bf(val); const float rem = val - __builtin_bit_cast(float, hb << 16);
                bh[s_][c][j] = (short)hb; bl[s_][c][j] = (short)f2bf(rem); } }
    const float bg0 = F.b_group[0], bg1 = F.b_group[1], bg2 = F.b_group[2], bg3 = F.b_group[3];
    for (int blk = F.bid; blk < 256; blk += F.G) {
        __syncthreads();
        if (F.tid < 32) lcnt[F.tid] = 0;
        __syncthreads();
        u32x4 a[2][2][4];
#define RT_LOAD(buf, pr) do { _Pragma("unroll") for (int tl_ = 0; tl_ < 2; ++tl_) { const GAS u32x4* xr = (const GAS u32x4*)(X1 + (size_t)(blk * 128 + (pr) * 32 + tl_ * 16 + n) * 1024 + 128 * w + 8 * fq); \
            _Pragma("unroll") for (int s_ = 0; s_ < 4; ++s_) a[buf][tl_][s_] = xr[4 * s_]; } } while (0)
        RT_LOAD(0, 0); RT_LOAD(1, 1);
#pragma unroll
        for (int pr = 0; pr < 4; ++pr) {
#pragma unroll
            for (int tl_ = 0; tl_ < 2; ++tl_) {
                const int tloc = (pr & 1) * 32 + tl_ * 16;
                const int tok = blk * 128 + pr * 32 + tl_ * 16 + n;
                f32x4 acc[3];
#pragma unroll
                for (int c = 0; c < 3; ++c) acc[c] = (f32x4){0.f, 0.f, 0.f, 0.f};
                float ss = 0.f;
#pragma unroll
                for (int s_ = 0; s_ < 4; ++s_) { const u32x4 av = a[pr & 1][tl_][s_]; const bf16x8v ab = __builtin_bit_cast(bf16x8v, av);
#pragma unroll
                    for (int c = 0; c < 3; ++c) { acc[c] = __builtin_amdgcn_mfma_f32_16x16x32_bf16(ab, bh[s_][c], acc[c], 0, 0, 0); acc[c] = __builtin_amdgcn_mfma_f32_16x16x32_bf16(ab, bl[s_][c], acc[c], 0, 0, 0); }
                    const float x0 = bflo(av.x), x1_ = bfhi(av.x), x2 = bflo(av.y), x3 = bfhi(av.y), x4 = bflo(av.z), x5 = bfhi(av.z), x6 = bflo(av.w), x7 = bfhi(av.w);
                    ss += ((x0 * x0 + x1_ * x1_) + (x2 * x2 + x3 * x3)) + ((x4 * x4 + x5 * x5) + (x6 * x6 + x7 * x7));
                    u32x2 o; o.x = pk4_fp8s(x0, x1_, x2, x3, 1.0f); o.y = pk4_fp8s(x4, x5, x6, x7, 1.0f);
                    *(GAS u32x2*)(X1Q + (size_t)tok * 1024 + 128 * w + 32 * s_ + 8 * fq) = o; }
                LAS float* sl = slab + ((w * 64 + tloc + 4 * fq) * 52 + n);
#pragma unroll
                for (int c = 0; c < 3; ++c)
#pragma unroll
                    for (int q = 0; q < 4; ++q) sl[q * 52 + 16 * c] = acc[c][q];
                ss += __shfl_xor(ss, 16); ss += __shfl_xor(ss, 32);
                if (fq == 0) slab[(w * 64 + tloc + n) * 52 + 48] = ss;
            }
            if (pr + 2 < 4) RT_LOAD(pr & 1, pr + 2);
            if (pr & 1) {
                __syncthreads();
                { const int tk = F.tid & 63, p = F.tid >> 6;
#pragma unroll
                  for (int i = 0; i < 5; ++i) { const int ci = p + 8 * i; if (ci < 37) { const int col = ci < 36 ? ci : 48; float sum = 0.f;
#pragma unroll
                          for (int ww = 0; ww < 8; ++ww) sum += slab[(ww * 64 + tk) * 52 + col];
                          fin[tk * 41 + ci] = sum; } } }
                __syncthreads();
                if (F.tid < 64) { const LAS float* f = fin + F.tid * 41;
                    const float rinv = 1.0f / sqrtf(f[36] * (1.f / 1024.f) + EPS);
                    const float gl0 = f[0] * rinv + bg0, gl1 = f[1] * rinv + bg1, gl2 = f[2] * rinv + bg2, gl3 = f[3] * rinv + bg3;
                    int gs = 0; float gm = gl0; if (gl1 > gm) { gm = gl1; gs = 1; } if (gl2 > gm) { gm = gl2; gs = 2; } if (gl3 > gm) { gm = gl3; gs = 3; }
                    const float pg = 1.0f / (expf(gl0 - gm) + expf(gl1 - gm) + expf(gl2 - gm) + expf(gl3 - gm));
                    float er[8];
#pragma unroll
                    for (int e = 0; e < 8; ++e) er[e] = f[4 + 8 * gs + e] * rinv + lbr[gs * 8 + e];
                    int i1 = 0; float m1 = er[0];
#pragma unroll
                    for (int e = 1; e < 8; ++e) if (er[e] > m1) { m1 = er[e]; i1 = e; }
                    int i2 = -1; float m2 = -3.0e38f;
#pragma unroll
                    for (int e = 0; e < 8; ++e) if (e != i1 && er[e] > m2) { m2 = er[e]; i2 = e; }
                    const float e2 = expf(m2 - m1); const float wa1 = pg / (1.0f + e2), wa2 = pg * e2 / (1.0f + e2);
                    const int lp = 2 * ((pr >> 1) * 64 + F.tid); pe[lp] = gs * 8 + i1; pe[lp + 1] = gs * 8 + i2; pw[lp] = wa1; pw[lp + 1] = wa2; prr[lp] = rinv; prr[lp + 1] = rinv;
                    atomicAdd((int*)&lcnt[gs * 8 + i1], 1); atomicAdd((int*)&lcnt[gs * 8 + i2], 1); }
            }
        }
#undef RT_LOAD
        __syncthreads();
        if (F.tid < 32) lbase[F.tid] = atomicAdd(&TOT[F.tid], lcnt[F.tid]);
        __syncthreads();
        if (F.tid < 32) { int nn = lbase[F.tid]; for (int p = 0; p < 256; ++p) if (pe[p] == F.tid) prow[p] = nn++; }
        __syncthreads();
        if (F.tid < 256) { const int row = pe[F.tid] * ECAP + prow[F.tid]; LIST[row] = blk * 256 + F.tid; ROWW[row] = pw[F.tid]; ROWR[row] = prr[F.tid]; }
    }
    __syncthreads();
}

__device__ __forceinline__ int build_tiles(Frame& F) {
    LAS int* tl = (LAS int*)(F.lds + L_TILES); LAS int* tnv = tl + MAX_TILES; LAS int* misc = tnv + MAX_TILES;
    const int* TOT = WSP(int, WS_TOT);
    __syncthreads();
    if (F.tid < 32) misc[33 + F.tid] = TOT[F.tid];
    __syncthreads();
    if (F.tid == 0) { int s = 0; for (int e = 0; e < 32; ++e) { misc[e] = s; s += (misc[33 + e] + 255) >> 8; } misc[32] = s; }
    __syncthreads();
    if (F.tid < 32) { const int e = F.tid, tot = misc[33 + e]; for (int j = 0, t = misc[e]; t < misc[e + 1]; ++j, ++t) { tl[t] = e * ECAP + 256 * j; tnv[t] = (tot - 256 * j) < 256 ? (tot - 256 * j) : 256; } }
    __syncthreads();
    return misc[32];
}

__device__ __forceinline__ void phase_final(Frame& F, const bf16* X1, float* OUT) {
    typedef float f2v __attribute__((ext_vector_type(2)));
    const int gw = F.vcu * NWAVES + F.wave, NGW = F.G * NWAVES; const unsigned char* YP = WSP(unsigned char, WS_YP);
    f32x4 gg[4];
#pragma unroll
    for (int j = 0; j < 4; ++j) gg[j] = ((const GAS f32x4*)F.final_g)[64 * j + F.lane];
    for (int t0 = 4 * gw; t0 < T_TOK; t0 += 4 * NGW) {
        u32x2 xw[4][4]; unsigned ya[4][4], yb[4][4];
#pragma unroll
        for (int r = 0; r < 4; ++r) { const int t = t0 + r;
            const GAS u32x2* xr = (const GAS u32x2*)(X1 + (size_t)t * 1024) + F.lane;
            const GAS unsigned* y0 = (const GAS unsigned*)(YP + (size_t)(2 * t) * 1024) + F.lane; const GAS unsigned* y1 = (const GAS unsigned*)(YP + (size_t)(2 * t + 1) * 1024) + F.lane;
#pragma unroll
            for (int j = 0; j < 4; ++j) { xw[r][j] = xr[64 * j]; ya[r][j] = y0[64 * j]; yb[r][j] = y1[64 * j]; } }
#pragma unroll
        for (int r = 0; r < 4; ++r) { const int t = t0 + r; GAS f32x4* orow = (GAS f32x4*)(OUT + (size_t)t * 1024) + F.lane;
            f32x4 v[4]; float s = 0.f;
#pragma unroll
            for (int j = 0; j < 4; ++j) { const u32x2 x = xw[r][j];
                const f2v a0 = __builtin_amdgcn_cvt_pk_f32_fp8((int)ya[r][j], false), a1 = __builtin_amdgcn_cvt_pk_f32_fp8((int)ya[r][j], true);
                const f2v b0 = __builtin_amdgcn_cvt_pk_f32_fp8((int)yb[r][j], false), b1 = __builtin_amdgcn_cvt_pk_f32_fp8((int)yb[r][j], true);
                const float is = 1.0f / pg8::YP_SCALE;
                v[j].x = bflo(x.x) + (a0[0] + b0[0]) * is; v[j].y = bfhi(x.x) + (a0[1] + b0[1]) * is; v[j].z = bflo(x.y) + (a1[0] + b1[0]) * is; v[j].w = bfhi(x.y) + (a1[1] + b1[1]) * is;
                s += (v[j].x * v[j].x + v[j].y * v[j].y) + (v[j].z * v[j].z + v[j].w * v[j].w); }
            const float rinv = 1.0f / sqrtf(wave_sum(s) * (1.f / 1024.f) + EPS);
#pragma unroll
            for (int j = 0; j < 4; ++j) { f32x4 o; o.x = v[j].x * rinv * gg[j].x; o.y = v[j].y * rinv * gg[j].y; o.z = v[j].z * rinv * gg[j].z; o.w = v[j].w * rinv * gg[j].w; orow[64 * j] = o; } }
    }
}

constexpr int N_PHASES = 10;
#ifndef MK_P4_SLEEP
#define MK_P4_SLEEP 0
#endif
#ifndef MK_STAGGER1
#define MK_STAGGER1 0
#endif
struct Args { const float* in[23]; float* out; unsigned char* ws; int ph_lo, ph_hi; };
static_assert(sizeof(Args) == 23 * 8 + 8 + 8 + 8, "Args has no padding");

__global__ void __launch_bounds__(NTHREADS, 2) mk_fwd(Args args) {
    extern __shared__ __attribute__((aligned(16))) unsigned char lds_raw[];
    Frame F;
    F.lds = (LAS unsigned char*)lds_raw; F.ws = args.ws;
    F.tid = threadIdx.x; F.lane = F.tid & 63; F.wave = __builtin_amdgcn_readfirstlane(F.tid >> 6);
    F.G = gridDim.x; F.bid = blockIdx.x; F.vcu = (F.G % 8 == 0) ? (F.bid % 8) * (F.G / 8) + F.bid / 8 : F.bid;
    F.x = args.in[0]; F.norm1_g = args.in[1]; F.w_in = args.in[2]; F.conv_w = args.in[3]; F.conv_b = args.in[4]; F.f_w_in = args.in[5]; F.f_b_in = args.in[6];
    F.f_w_mid = args.in[7]; F.f_b_mid = args.in[8]; F.f_freq = args.in[9]; F.f_w_out = args.in[10]; F.f_bias = args.in[11]; F.mix_g = args.in[12]; F.w_out = args.in[13];
    F.norm2_g = args.in[14]; F.w_group = args.in[15]; F.b_group = args.in[16]; F.w_router = args.in[17]; F.b_router = args.in[18]; F.w_gate = args.in[19]; F.w_up = args.in[20];
    F.w_down = args.in[21]; F.final_g = args.in[22]; F.out = args.out;
    volatile LAS unsigned* bst = (volatile LAS unsigned*)(F.lds + BARST_OFF);
    if (F.tid < 16) bst[F.tid] = 0u;
    __syncthreads();
    const int lo = args.ph_lo, hi = args.ph_hi;
    const bool need_bar = (hi - lo) > 1;
    XcdBarrier bar; bar.bar = (unsigned*)(F.ws + WS_CTL); bar.x = 0; bar.st = bst;
    if (need_bar) bar = xcd_barrier_post((unsigned*)(F.ws + WS_CTL), bst);
#define IN(k) (lo <= (k) && (k) < hi)
#ifndef MK_DUP
#define MK_DUP -1
#endif
#define REPS(k) (((k) == MK_DUP) ? 2 : 1)
#define SEAM(k) do { if (IN(k) && IN((k) + 1)) xcd_barrier(bar); } while (0)
    bf16* X1 = WSP(bf16, WS_X1);

    if (IN(0)) for (int rep_ = 0; rep_ < REPS(0); ++rep_) { if (rep_) xcd_barrier(bar); phase_prologue(F); } SEAM(0);

    if (IN(1)) {
        pg8::StaticOrder S; S.init(F.ws + WS_WIN_T, F.ws + WS_HN, NPT_ROWS, T_TOK, 1024, F.G, F.bid); S.reps = (MK_DUP == 11) ? 2 : REPS(1);
        pg8::EpiStorePT E{WSP(bf16, WS_PT), NPT_ROWS, WSP(float, WS_RINV1)};
        pg8::gemm_phase<pg8::EpiStorePT, pg8::StaticOrder>(F.lds, 1024, S, E);
        load_tw_lds(F, L_TW, L_TW256);
        filter_items(F, F.bid, F.G);
    } SEAM(1);

    if (IN(2)) for (int rep_ = 0; rep_ < REPS(2); ++rep_) { if (rep_) xcd_barrier(bar);
        load_tw_lds(F, M_TW, M_TW256);
        hyena_items_mfma(F);
        fourier_items_mfma(F);
    } SEAM(2);

    if (IN(3)) for (int rep_ = 0; rep_ < REPS(3); ++rep_) { if (rep_) xcd_barrier(bar); phase_headnorm(F); if (MK_DUP == 13) phase_headnorm(F); for (int rr_ = 0; rr_ < ((MK_DUP == 14) ? 2 : 1); ++rr_) fourier_mix(F); } SEAM(3);

    if (IN(4)) for (int rep_ = 0; rep_ < REPS(4); ++rep_) { if (rep_) xcd_barrier(bar);
        pg8::StaticOrder S; S.init(F.ws + WS_YN, F.ws + WS_WOUT_T, T_TOK, 1024, 1024, F.G, F.bid);
        pg8::EpiResBf16 E{WSP(bf16, WS_HN), X1, 1024};
#if MK_P4_SLEEP
        if ((F.bid >> 3) & 1) { for (int i_ = 0; i_ < MK_P4_SLEEP; ++i_) __builtin_amdgcn_s_sleep(127); }
#endif
        pg8::gemm_phase<pg8::EpiResBf16, pg8::StaticOrder>(F.lds, 1024, S, E);
    } SEAM(4);

    if (IN(5)) { phase_route(F, X1); } if (IN(5) && IN(7)) xcd_barrier(bar);


    if (IN(7)) for (int rep_ = 0; rep_ < REPS(7); ++rep_) { if (rep_) xcd_barrier(bar);
        const int ntiles = __builtin_amdgcn_readfirstlane(build_tiles(F)); const LAS int* tl = (const LAS int*)(F.lds + L_TILES);
        pg8::MoeGatherOrder S; S.init(F.ws + WS_X1Q, F.ws + WS_WGU_T, tl, tl + MAX_TILES, WSP(int, WS_LIST), ntiles, 1024, F.G, F.bid, 1);
        pg8::EpiSwiGLU E{WSP(unsigned char, WS_YT), WSP(float, WS_ROWR)};
        pg8::gemm_phase<pg8::EpiSwiGLU, pg8::MoeGatherOrder, true, true>(F.lds, 1024, S, E);
        if (rep_ == 0) {
            const int nwg = ntiles * 4, R = (nwg + F.G - 1) / F.G, nheavy = nwg - (R - 1) * F.G; const bool all = (nheavy >= F.G) || (nheavy <= 0);
            const int nl = all ? F.G : F.G - nheavy, li = all ? F.bid : F.bid - nheavy;
            if (li >= 0) wdown_items(F, li * NWAVES + F.wave, nl * NWAVES);
        }
    } SEAM(7);

    if (IN(8)) for (int rep_ = 0; rep_ < REPS(8); ++rep_) { if (rep_) xcd_barrier(bar);
        const int ntiles = __builtin_amdgcn_readfirstlane(build_tiles(F)); const LAS int* tl = (const LAS int*)(F.lds + L_TILES);
        pg8::MoeOrder S; S.init(F.ws + WS_YT, F.ws + WS_WD_T, tl, tl + MAX_TILES, ntiles, 512, F.G, F.bid, 1);
        pg8::EpiMoeDown E{WSP(unsigned char, WS_YP), WSP(int, WS_LIST), WSP(float, WS_ROWW)};
        pg8::gemm_phase<pg8::EpiMoeDown, pg8::MoeOrder, true, true>(F.lds, 512, S, E);
    } SEAM(8);

    if (IN(9)) { if (REPS(9) == 2) { phase_final(F, X1, WSP(float, WS_YT)); xcd_barrier(bar); } phase_final(F, X1, F.out); }
#undef IN
#undef SEAM
}


extern "C" void kernel_launch(void* const* d_in, const int* in_sizes, int n_in, void* d_out, int out_size, void* d_ws, size_t ws_size, hipStream_t stream) {
    static int grid = 0;
    if (grid == 0) {
        if (n_in != 23 || in_sizes[0] != T_TOK * D_MODEL || out_size != T_TOK * D_MODEL || ws_size < WS_END) { fprintf(stderr, "kernel_launch: unexpected shapes (n_in %d, in0 %d, out %d, ws %zu)\n", n_in, n_in > 0 ? in_sizes[0] : -1, out_size, ws_size); grid = -1; return; }
        int dev = 0, cus = 0;
        if (hipGetDevice(&dev) != hipSuccess || hipDeviceGetAttribute(&cus, hipDeviceAttributeMultiprocessorCount, dev) != hipSuccess) { grid = -1; return; }
        if (hipFuncSetAttribute((const void*)mk_fwd, hipFuncAttributeMaxDynamicSharedMemorySize, LDS_BYTES) != hipSuccess) { fprintf(stderr, "kernel_launch: hipFuncSetAttribute failed\n"); grid = -1; return; }
        int per_cu = 0;
        if (hipOccupancyMaxActiveBlocksPerMultiprocessor(&per_cu, (const void*)mk_fwd, NTHREADS, LDS_BYTES) != hipSuccess || per_cu < 1) fprintf(stderr, "kernel_launch: occupancy query reports %d\n", per_cu);
        (void)hipGetLastError();
        grid = cus;
    }
    if (grid < 0) return;
    (void)hipMemsetAsync((char*)d_ws + WS_CTL, 0, CTL_ZERO_BYTES, stream);
    Args a{};
    for (int i = 0; i < 23; ++i) a.in[i] = (const float*)d_in[i];
    a.out = (float*)d_out; a.ws = (unsigned char*)d_ws;
#if MK_N_LAUNCHES == 1
    a.ph_lo = 0; a.ph_hi = N_PHASES;
    hipLaunchKernelGGL(mk_fwd, dim3(grid), dim3(NTHREADS), LDS_BYTES, stream, a);
#else
    for (int p = 0; p < N_PHASES; ++p) {
        a.ph_lo = p; a.ph_hi = p + 1;
        hipLaunchKernelGGL(mk_fwd, dim3(grid), dim3(NTHREADS), LDS_BYTES, stream, a);
#ifdef MK_DUPLAUNCH
        if (p == MK_DUPLAUNCH) hipLaunchKernelGGL(mk_fwd, dim3(grid), dim3(NTHREADS), LDS_BYTES, stream, a);
#endif
#if MK_CHECK
        launch_checks(p, a, grid, stream);
#endif
    }
#if MK_CHECK
    launch_encode(a, grid, stream);
#endif
#endif
}
```

```cpp
#include <hip/hip_runtime.h>
#include <cstdio>
#include <cstdint>

#define MK_N_LAUNCHES 1
#define MK_DUP -1
#define MK_CHECK 0

#ifndef MK_DUP
#define MK_DUP -1
#endif
constexpr int D_MODEL = 1024, BATCH = 8, SEQ = 4096, T_TOK = BATCH * SEQ;
constexpr int D_HYENA = 512, D_FOURIER = 512, D_IN_PROJ = 2048, N_EXP = 32, D_EXPERT = 512;
constexpr int NPT_ROWS = 2048;
constexpr float EPS = 1e-6f;
constexpr int MAX_ROWS = 65536 + 32 * 256;
constexpr int MAX_TILES = MAX_ROWS / 256;
constexpr int NWAVES = 8, NTHREADS = 512;

constexpr size_t MiB = 1u << 20;
constexpr size_t WS_CTL = 0, CTL_ZERO_BYTES = 64 * 1024;
constexpr size_t WS_TOT = 48 * 1024;
constexpr size_t WS_RINV1 = 1 * MiB;
constexpr size_t WS_CHK = 192 * 1024;
constexpr size_t WS_TW4096 = 3 * MiB;
constexpr size_t WS_TW8192 = 3 * MiB + 32 * 1024;
constexpr size_t WS_H3 = 4 * MiB;
constexpr size_t WS_WIN_T = 8 * MiB;
constexpr size_t WS_WOUT_T = 13 * MiB;
constexpr size_t WS_WGU_T = 16 * MiB;
constexpr size_t WS_WD_T = 80 * MiB;
constexpr size_t WS_KF = 112 * MiB;
constexpr size_t WS_HN = 144 * MiB;
constexpr size_t WS_PT = 208 * MiB;
constexpr size_t WS_X1Q = 208 * MiB;
constexpr size_t WS_YP = 144 * MiB;
constexpr size_t WS_X1 = 272 * MiB;
constexpr int ECAP = 32768;
constexpr size_t WS_LIST = 336 * MiB;
constexpr size_t WS_ROWW = 340 * MiB;
constexpr size_t WS_ROWR = 344 * MiB;
constexpr size_t WS_YT = 368 * MiB;
constexpr size_t WS_YN = 440 * MiB;
constexpr size_t WS_KT = WS_YN;
constexpr size_t WS_SP = WS_YT + (size_t)512 * T_TOK * 2;
constexpr size_t WS_END = 504 * MiB;

constexpr int LDS_BYTES = 163840;
constexpr int BARST_OFF = LDS_BYTES - 64;
constexpr int FFT_BUF_BYTES = 4352 * 8;
constexpr int L_BUFA = 0, L_BUFB = FFT_BUF_BYTES, L_TW = 2 * FFT_BUF_BYTES, L_SCR = L_TW + 32768, L_RED = L_SCR + 32768, L_TW256 = L_RED + 1024;
static_assert(L_TW256 + 2048 <= BARST_OFF, "LDS map");
constexpr int M_TW = 98304, M_TW256 = M_TW + 32768;
constexpr int L_TILES = 132 * 1024;

#define GAS __attribute__((address_space(1)))
#define LAS __attribute__((address_space(3)))
typedef unsigned short bf16;
typedef float f32x4 __attribute__((ext_vector_type(4)));
typedef float f32x2 __attribute__((ext_vector_type(2)));
typedef unsigned u32x4 __attribute__((ext_vector_type(4)));
typedef unsigned u32x2 __attribute__((ext_vector_type(2)));
#ifndef MK_WT
#define MK_WT 1
#endif
__device__ __forceinline__ void st16_plain(void* p, u32x4 v) { *(u32x4*)p = v; }
__device__ __forceinline__ void st16_wt(void* p, u32x4 v) {
#if MK_WT
    asm volatile("global_store_dwordx4 %0, %1, off sc1\n\ts_nop 1" :: "v"(p), "v"(v) : "memory");
#else
    *(u32x4*)p = v;
#endif
}
constexpr float W_SCALE = 16.0f, H_SCALE = 8.0f;
__device__ __forceinline__ unsigned pk4_fp8s(float a, float b, float c, float d, float sc) {
    a = __builtin_amdgcn_fmed3f(a * sc, -448.f, 448.f); b = __builtin_amdgcn_fmed3f(b * sc, -448.f, 448.f); c = __builtin_amdgcn_fmed3f(c * sc, -448.f, 448.f); d = __builtin_amdgcn_fmed3f(d * sc, -448.f, 448.f);
    int t = __builtin_amdgcn_cvt_pk_fp8_f32(a, b, 0, false); t = __builtin_amdgcn_cvt_pk_fp8_f32(c, d, t, true); return (unsigned)t;
}
#define LDS_WAIT() asm volatile("s_waitcnt lgkmcnt(0)" ::: "memory")
__device__ __forceinline__ unsigned f2bf(float f) { unsigned u = __builtin_bit_cast(unsigned, f); return (u + 0x7fffu + ((u >> 16) & 1u)) >> 16; }
__device__ __forceinline__ unsigned pk2(float lo, float hi) { return f2bf(lo) | (f2bf(hi) << 16); }
__device__ __forceinline__ unsigned pk2h(float lo, float hi) { typedef float f32x2_t __attribute__((ext_vector_type(2))); typedef __bf16 bf16x2_t __attribute__((ext_vector_type(2))); const f32x2_t v = {lo, hi}; const bf16x2_t b = __builtin_convertvector(v, bf16x2_t); return __builtin_bit_cast(unsigned, b); }
__device__ __forceinline__ float bflo(unsigned w) { return __builtin_bit_cast(float, w << 16); }
__device__ __forceinline__ float bfhi(unsigned w) { return __builtin_bit_cast(float, w & 0xffff0000u); }
__device__ __forceinline__ float bf1(bf16 h) { return __builtin_bit_cast(float, (unsigned)h << 16); }
__device__ __forceinline__ float wave_sum(float v) {
#pragma unroll
    for (int o = 1; o < 64; o <<= 1) v += __shfl_xor(v, o);
    return v;
}

namespace pg8 {
#define PG8_LAS __attribute__((address_space(3)))
typedef unsigned short bf16_t;
typedef short bf16x8 __attribute__((ext_vector_type(8)));
typedef float f32x4 __attribute__((ext_vector_type(4)));
typedef unsigned u32x4 __attribute__((ext_vector_type(4)));
typedef unsigned u32x2 __attribute__((ext_vector_type(2)));
constexpr int BM = 256, BK = 64, HALF = 128, HTB = HALF * BK * 2  , STAGE_BYTES = 8 * HTB, NXCD = 8, WGM = 8;

__host__ __device__ __forceinline__ int lds_byte(int r, int c) { const int st = (r >> 4) * 2 + (c >> 5), rr = r & 15, cc = c & 31, ob = rr * 64 + cc * 2; return st * 1024 + (ob ^ (((ob >> 9) & 1) << 5)); }
__host__ __device__ __forceinline__ void stage_rc(int b, int& R, int& C) { const int st = b / 1024, sb = b % 1024, swz = sb ^ (((sb >> 9) & 1) << 5); R = (st >> 1) * 16 + swz / 64; C = (st & 1) * 32 + (swz % 64) / 2; }
__host__ __device__ __forceinline__ int perm32(int rho) { const int n = rho >> 4, i = rho & 15; return 8 * (i >> 2) + 4 * n + (i & 3); }

struct Unit { int pm, pn; const char* a; const char* b; int lrow, nv; };

struct StaticOrder {
    static constexpr bool GATHER = false;
    int nM, nN, nwg, G, c, reps = 1; const char* A; const char* Bt; size_t tstep;
    __device__ void init(const void* A_, const void* Bt_, int M, int N, int K, int G_, int c_) { A = (const char*)A_; Bt = (const char*)Bt_; nM = M / BM; nN = N / BM; nwg = nM * nN; G = G_; c = c_; tstep = (size_t)BM * K * 2; }
    __device__ bool next(int i, Unit& u) const {
        long L = (long)i * G + c; if (L >= (long)nwg * reps) return false; if (L >= nwg) L -= nwg;
        int wgid = (int)L; { const int q = nwg / NXCD, r = nwg % NXCD, xcd = wgid % NXCD, off = wgid / NXCD; wgid = (xcd < r ? xcd * (q + 1) : r * (q + 1) + (xcd - r) * q) + off; }
        const int nig = WGM * nN, gid = wgid / nig, fm = gid * WGM, gsz = (nM - fm) < WGM ? (nM - fm) : WGM;
        u.pm = fm + ((wgid % nig) % gsz); u.pn = (wgid % nig) / gsz; u.a = A + (size_t)u.pm * tstep; u.b = Bt + (size_t)u.pn * tstep; u.lrow = 0; u.nv = BM; return true;
    }
};
struct MoeOrder {
    static constexpr bool GATHER = false;
    int nwg, G, c; const char* A; const char* Bt; const PG8_LAS int* tl; const PG8_LAS int* tnv; size_t a_tstep, b_tstep;
    __device__ void init(const void* A_, const void* Bt_, const PG8_LAS int* tl_, const PG8_LAS int* tnv_, int ntiles, int K, int G_, int c_, int ES = 2) { A = (const char*)A_; Bt = (const char*)Bt_; tl = tl_; tnv = tnv_; nwg = ntiles * 4; G = G_; c = c_; a_tstep = (size_t)BM * K * ES; b_tstep = (size_t)BM * K * ES; }
    __device__ bool next(int i, Unit& u) const {
        const long L = (long)i * G + c; if (L >= nwg) return false;
        int wgid = (int)L; { const int q = nwg / NXCD, r = nwg % NXCD, xcd = wgid % NXCD, off = wgid / NXCD; wgid = (xcd < r ? xcd * (q + 1) : r * (q + 1) + (xcd - r) * q) + off; }
        u.pm = wgid >> 2; u.pn = wgid & 3; u.lrow = __builtin_amdgcn_readfirstlane(tl[u.pm]); u.nv = __builtin_amdgcn_readfirstlane(tnv[u.pm]); const int e = u.lrow >> 15;
        u.a = A + (size_t)u.pm * a_tstep; u.b = Bt + (size_t)(e * 4 + u.pn) * b_tstep; return true;
    }
};

struct MoeGatherOrder {
    static constexpr bool GATHER = true;
    int nwg, G, c, es; const char* A; const char* Bt; const PG8_LAS int* tl; const PG8_LAS int* tnv; const int* list; size_t b_tstep;
    __device__ void init(const void* A_, const void* Bt_, const PG8_LAS int* tl_, const PG8_LAS int* tnv_, const int* list_, int ntiles, int K, int G_, int c_, int ES = 2) { A = (const char*)A_; Bt = (const char*)Bt_; tl = tl_; tnv = tnv_; list = list_; nwg = ntiles * 4; G = G_; c = c_; es = ES; b_tstep = (size_t)BM * K * ES; }
    __device__ bool next(int i, Unit& u) const {
        const long L = (long)i * G + c; if (L >= nwg) return false;
        int wgid = (int)L; { const int q = nwg / NXCD, r = nwg % NXCD, xcd = wgid % NXCD, off = wgid / NXCD; wgid = (xcd < r ? xcd * (q + 1) : r * (q + 1) + (xcd - r) * q) + off; }
        u.pm = wgid >> 2; u.pn = wgid & 3; u.lrow = __builtin_amdgcn_readfirstlane(tl[u.pm]); u.nv = __builtin_amdgcn_readfirstlane(tnv[u.pm]); const int e = u.lrow >> 15;
        u.a = A; u.b = Bt + (size_t)(e * 4 + u.pn) * b_tstep; return true;
    }
    __device__ __forceinline__ void offsets(const Unit& u, int K, const int (&R)[2], const int (&C)[2], unsigned (&o)[2][2]) const {
#pragma unroll
        for (int h = 0; h < 2; ++h)
#pragma unroll
            for (int i = 0; i < 2; ++i) { const int lr = h * HALF + R[i]; const int pr = list[u.lrow + (lr < u.nv ? lr : 0)]; const int tok = (lr < u.nv ? pr : 0) >> 1; o[h][i] = (unsigned)(tok * K) * (unsigned)es + (unsigned)C[i] * 2u; }
    }
};

__device__ __forceinline__ unsigned cvt_pk_bf16(float lo, float hi) { unsigned r; asm volatile("v_cvt_pk_bf16_f32 %0, %1, %2" : "=v"(r) : "v"(lo), "v"(hi)); return r; }

struct EpiStoreBf16 {
    static constexpr bool PERM = true;
    bf16_t* O; int ldc;
    __device__ __forceinline__ void operator()(const f32x4 (&acc)[2][2][4][2], const Unit& u, int wr, int wc, int fr, int fq) const {
        const int row0 = u.pm * BM + wr * 64 + fr; const int col0 = u.pn * BM + wc * 32 + 8 * fq;
#pragma unroll
        for (int ai = 0; ai < 2; ++ai)
#pragma unroll
            for (int m = 0; m < 4; ++m) { bf16_t* rowp = O + (size_t)(row0 + ai * HALF + m * 16) * ldc + col0;
#pragma unroll
                for (int bj = 0; bj < 2; ++bj) { const f32x4 v0 = acc[ai][bj][m][0], v1 = acc[ai][bj][m][1];
                    u32x4 w; w.x = cvt_pk_bf16(v0[0], v0[1]); w.y = cvt_pk_bf16(v0[2], v0[3]); w.z = cvt_pk_bf16(v1[0], v1[1]); w.w = cvt_pk_bf16(v1[2], v1[3]);
                    *(u32x4*)(rowp + bj * HALF) = w; } }
    }
};
struct EpiStorePT {
    static constexpr bool PERM = true;
    bf16_t* O; int nrows; const float* __restrict__ cs;
    __device__ __forceinline__ void operator()(const f32x4 (&acc)[2][2][4][2], const Unit& u, int wr, int wc, int fr, int fq) const {
        const int row0 = u.pm * BM + wr * 64 + fr; const int col0 = wc * 32 + 8 * fq; bf16_t* base = O + (size_t)u.pn * nrows * 256;
        f32x4 c0[2], c1[2];
#pragma unroll
        for (int bj = 0; bj < 2; ++bj) { const float* cp = cs + u.pn * BM + bj * HALF + col0; c0[bj] = *(const f32x4*)cp; c1[bj] = *(const f32x4*)(cp + 4); }
#pragma unroll
        for (int ai = 0; ai < 2; ++ai)
#pragma unroll
            for (int m = 0; m < 4; ++m) { bf16_t* rowp = base + (size_t)(row0 + ai * HALF + m * 16) * 256 + col0;
#pragma unroll
                for (int bj = 0; bj < 2; ++bj) { const f32x4 v0 = acc[ai][bj][m][0] * c0[bj], v1 = acc[ai][bj][m][1] * c1[bj];
                    u32x4 w; w.x = cvt_pk_bf16(v0[0], v0[1]); w.y = cvt_pk_bf16(v0[2], v0[3]); w.z = cvt_pk_bf16(v1[0], v1[1]); w.w = cvt_pk_bf16(v1[2], v1[3]);
                    st16_plain(rowp + bj * HALF, w); } }
    }
};
struct EpiResF32 {
    static constexpr bool PERM = false;
    const float* base; float* out; int ldc;
    __device__ __forceinline__ void operator()(const f32x4 (&acc)[2][2][4][2], const Unit& u, int wr, int wc, int fr, int fq) const {
        const int row0 = u.pm * BM + wr * 64 + fr; const int col0 = u.pn * BM + wc * 32 + 4 * fq;
#pragma unroll
        for (int ai = 0; ai < 2; ++ai)
#pragma unroll
            for (int m = 0; m < 4; ++m) { const size_t off = (size_t)(row0 + ai * HALF + m * 16) * ldc + col0;
#pragma unroll
                for (int bj = 0; bj < 2; ++bj)
#pragma unroll
                    for (int n = 0; n < 2; ++n) { const f32x4 bs = *(const f32x4*)(base + off + bj * HALF + n * 16); *(f32x4*)(out + off + bj * HALF + n * 16) = bs + acc[ai][bj][m][n]; } }
    }
};
struct EpiResBf16 {
    static constexpr bool PERM = true;
    const bf16_t* __restrict__ base; bf16_t* __restrict__ out; int ldc;
    __device__ __forceinline__ void operator()(const f32x4 (&acc)[2][2][4][2], const Unit& u, int wr, int wc, int fr, int fq) const {
        const int row0 = u.pm * BM + wr * 64 + fr; const int col0 = u.pn * BM + wc * 32 + 8 * fq;
        u32x4 r[2][4][2];
#pragma unroll
        for (int ai = 0; ai < 2; ++ai)
#pragma unroll
            for (int m = 0; m < 4; ++m) { const size_t off = (size_t)(row0 + ai * HALF + m * 16) * ldc + col0;
#pragma unroll
                for (int bj = 0; bj < 2; ++bj) r[ai][m][bj] = *(const u32x4*)(base + off + bj * HALF); }
#pragma unroll
        for (int ai = 0; ai < 2; ++ai)
#pragma unroll
            for (int m = 0; m < 4; ++m) { const size_t off = (size_t)(row0 + ai * HALF + m * 16) * ldc + col0;
#pragma unroll
                for (int bj = 0; bj < 2; ++bj) { const u32x4 x = r[ai][m][bj]; const f32x4 a0 = acc[ai][bj][m][0], a1 = acc[ai][bj][m][1];
                    u32x4 w; w.x = cvt_pk_bf16(a0[0] + __builtin_bit_cast(float, x.x << 16), a0[1] + __builtin_bit_cast(float, x.x & 0xffff0000u)); w.y = cvt_pk_bf16(a0[2] + __builtin_bit_cast(float, x.y << 16), a0[3] + __builtin_bit_cast(float, x.y & 0xffff0000u));
                    w.z = cvt_pk_bf16(a1[0] + __builtin_bit_cast(float, x.z << 16), a1[1] + __builtin_bit_cast(float, x.z & 0xffff0000u)); w.w = cvt_pk_bf16(a1[2] + __builtin_bit_cast(float, x.w << 16), a1[3] + __builtin_bit_cast(float, x.w & 0xffff0000u));
                    st16_plain(out + off + bj * HALF, w); } }
    }
};
struct EpiSwiGLU {
    static constexpr bool PERM = true;
    unsigned char* __restrict__ H; const float* __restrict__ rowr;
    __device__ __forceinline__ void operator()(const f32x4 (&acc)[2][2][4][2], const Unit& u, int wr, int wc, int fr, int fq) const {
        const int row0 = u.pm * BM + wr * 64 + fr;
#pragma unroll
        for (int ai = 0; ai < 2; ++ai)
#pragma unroll
            for (int m = 0; m < 4; ++m) { const int lr = wr * 64 + fr + ai * HALF + m * 16; const int row = row0 + ai * HALF + m * 16; const float rr = ((lr < u.nv) ? rowr[u.lrow + lr] : 0.f) * (1.0f / W_SCALE); unsigned char* rowp = H + (size_t)row * 512 + u.pn * 128 + wc * 32 + 8 * fq;
                u32x2 o;
#pragma unroll
                for (int n = 0; n < 2; ++n) { const f32x4 g = acc[ai][0][m][n] * rr, up = acc[ai][1][m][n] * rr; f32x4 h;
#pragma unroll
                    for (int q = 0; q < 4; ++q) h[q] = g[q] * __builtin_amdgcn_rcpf(1.0f + __expf(-g[q])) * up[q];
                    const unsigned pk = pk4_fp8s(h[0], h[1], h[2], h[3], H_SCALE); if (n == 0) o.x = pk; else o.y = pk; }
                *(u32x2*)rowp = o; }
    }
};
constexpr float YP_SCALE = 32.0f;
__device__ __forceinline__ unsigned pk4_fp8(float a, float b, float c, float d) {
    a = __builtin_amdgcn_fmed3f(a * YP_SCALE, -448.f, 448.f); b = __builtin_amdgcn_fmed3f(b * YP_SCALE, -448.f, 448.f); c = __builtin_amdgcn_fmed3f(c * YP_SCALE, -448.f, 448.f); d = __builtin_amdgcn_fmed3f(d * YP_SCALE, -448.f, 448.f);
    int t = __builtin_amdgcn_cvt_pk_fp8_f32(a, b, 0, false); t = __builtin_amdgcn_cvt_pk_fp8_f32(c, d, t, true); return (unsigned)t;
}
struct EpiMoeDown {
    static constexpr bool PERM = true;
    unsigned char* __restrict__ YP; const int* __restrict__ list; const float* __restrict__ roww;
    __device__ __forceinline__ void operator()(const f32x4 (&acc)[2][2][4][2], const Unit& u, int wr, int wc, int fr, int fq) const {
        const int col0 = u.pn * BM + wc * 32 + 8 * fq;
        int prv[2][4]; float wv[2][4];
#pragma unroll
        for (int ai = 0; ai < 2; ++ai)
#pragma unroll
            for (int m = 0; m < 4; ++m) { const int lr = wr * 64 + fr + ai * HALF + m * 16; const int li = u.lrow + (lr < u.nv ? lr : 0); prv[ai][m] = list[li]; wv[ai][m] = roww[li]; }
#pragma unroll
        for (int ai = 0; ai < 2; ++ai)
#pragma unroll
            for (int m = 0; m < 4; ++m) { const int lr = wr * 64 + fr + ai * HALF + m * 16; const bool ok = lr < u.nv; const int pair = ok ? prv[ai][m] : 0; const float w = ok ? wv[ai][m] : 0.f;
                if (ok) { unsigned char* rowp = YP + (size_t)pair * 1024 + col0;
#pragma unroll
                    for (int bj = 0; bj < 2; ++bj) { const f32x4 v0 = acc[ai][bj][m][0] * (w * (1.0f / (W_SCALE * H_SCALE))), v1 = acc[ai][bj][m][1] * (w * (1.0f / (W_SCALE * H_SCALE)));
                        u32x2 o; o.x = pk4_fp8(v0[0], v0[1], v0[2], v0[3]); o.y = pk4_fp8(v1[0], v1[1], v1[2], v1[3]);
                        *(u32x2*)(rowp + bj * HALF) = o; } } }
    }
};

typedef int v8i_t __attribute__((ext_vector_type(8)));
template <class Epi, class Sched, bool ALIGN_EPI = true, bool FP8 = false>
__device__ __forceinline__ void gemm_phase(PG8_LAS unsigned char* lds, const int K, const Sched& S, const Epi& E) {
    const int tid = threadIdx.x, wid = __builtin_amdgcn_readfirstlane(tid >> 6), lane = tid & 63, wr = wid >> 2, wc = wid & 3, fr = lane & 15, fq = lane >> 4;
    constexpr int ES = FP8 ? 1 : 2;
    const int nt = K * ES / (BK * 2);
    unsigned voffA[2], voffB[2]; int sR[2], sC[2];
#pragma unroll
    for (int i = 0; i < 2; ++i) { int R, C; stage_rc(tid * 16 + i * 8192, R, C); const int Rb = Epi::PERM ? ((R & ~31) + perm32(R & 31)) : R; sR[i] = R; sC[i] = C;
        voffA[i] = (unsigned)(R * K) * (unsigned)ES + (unsigned)C * 2u; voffB[i] = (unsigned)(Rb * K) * (unsigned)ES + (unsigned)C * 2u; }
    int sc127 = 0x7f7f7f7f; asm volatile("" : "+v"(sc127));
    constexpr bool GA = Sched::GATHER;
    unsigned oc[2][2], on[2][2];
    const size_t kstep = (size_t)(BK * 2);
    const size_t hstep = (size_t)HALF * K * ES;
    const unsigned ldsw = (unsigned)wid * 1024u;
    const int aoff = lds_byte(wr * 64 + fr, fq * 8), boff = lds_byte(wc * 32 + fr, fq * 8);
#define PG8_SA(b, h) (((b) * 2 + (h)) * HTB)
#define PG8_SB(b, h) ((4 + (b) * 2 + (h)) * HTB)
#define PG8_STAGE(bufoff, gbase, voff) do { _Pragma("unroll") for (int _i = 0; _i < 2; ++_i) \
        __builtin_amdgcn_global_load_lds((const unsigned*)((const char*)(gbase) + (voff)[_i]), (PG8_LAS unsigned*)(lds + (bufoff) + ldsw + _i * 8192), 16, 0, 0); } while (0)
#define PG8_LDA(dst, b, h) do { _Pragma("unroll") for (int m = 0; m < 4; ++m) _Pragma("unroll") for (int k = 0; k < 2; ++k) dst[m][k] = *(const PG8_LAS bf16x8*)(lds + PG8_SA(b, h) + aoff + m * 2048 + k * 1024); } while (0)
#define PG8_LDB(dst, b, h) do { _Pragma("unroll") for (int n = 0; n < 2; ++n) _Pragma("unroll") for (int k = 0; k < 2; ++k) dst[n][k] = *(const PG8_LAS bf16x8*)(lds + PG8_SB(b, h) + boff + n * 2048 + k * 1024); } while (0)
#define PG8_CAT(x0, x1) (v8i_t){ (int)__builtin_bit_cast(u32x4, x0).x, (int)__builtin_bit_cast(u32x4, x0).y, (int)__builtin_bit_cast(u32x4, x0).z, (int)__builtin_bit_cast(u32x4, x0).w, (int)__builtin_bit_cast(u32x4, x1).x, (int)__builtin_bit_cast(u32x4, x1).y, (int)__builtin_bit_cast(u32x4, x1).z, (int)__builtin_bit_cast(u32x4, x1).w }
#define PG8_MMA(ai, bj, At, Bt) do { __builtin_amdgcn_s_setprio(1); _Pragma("unroll") for (int m = 0; m < 4; ++m) _Pragma("unroll") for (int n = 0; n < 2; ++n) { \
        if constexpr (FP8) { const v8i_t b8_ = PG8_CAT(Bt[n][0], Bt[n][1]), a8_ = PG8_CAT(At[m][0], At[m][1]); \
            asm volatile("s_nop 1\n\tv_mfma_scale_f32_16x16x128_f8f6f4 %0, %1, %2, %0, %3, %3 op_sel_hi:[0,0,0]" : "+v"(acc[ai][bj][m][n]) : "v"(b8_), "v"(a8_), "v"(sc127)); } \
        else { _Pragma("unroll") for (int k = 0; k < 2; ++k) acc[ai][bj][m][n] = __builtin_amdgcn_mfma_f32_16x16x32_bf16(Bt[n][k], At[m][k], acc[ai][bj][m][n], 0, 0, 0); } } __builtin_amdgcn_s_setprio(0); } while (0)
#define PG8_WAIT_V(n) asm volatile("s_waitcnt vmcnt(" #n ")" ::: "memory")
#define PG8_WAIT_L(n) asm volatile("s_waitcnt lgkmcnt(" #n ")" ::: "memory")
#define PG8_BAR __builtin_amdgcn_s_barrier()
#define PG8_SCHED __builtin_amdgcn_sched_barrier(0)
    Unit cur, nxt; int ui = 0;
    if (!S.next(0, cur)) return;
    f32x4 acc[2][2][4][2];
#pragma unroll
    for (int a = 0; a < 2; ++a)
#pragma unroll
        for (int b = 0; b < 2; ++b)
#pragma unroll
            for (int m = 0; m < 4; ++m)
#pragma unroll
                for (int n = 0; n < 2; ++n) acc[a][b][m][n] = (f32x4){0.f, 0.f, 0.f, 0.f};
    bf16x8 At[4][2], B0[2][2], B1[2][2];
    const char* cA = cur.a; const char* cB = cur.b;
    const size_t hA = GA ? (size_t)0 : hstep;
    if constexpr (GA) { S.offsets(cur, K, sR, sC, oc); }
#define PG8_OA(h, sel) (GA ? (sel)[h] : voffA)
    PG8_STAGE(PG8_SB(0, 0), cB, voffB); PG8_STAGE(PG8_SB(0, 1), cB + hstep, voffB); PG8_STAGE(PG8_SA(0, 0), cA, PG8_OA(0, oc)); PG8_STAGE(PG8_SA(0, 1), cA + hA, PG8_OA(1, oc));
    if (wr == 1) PG8_BAR;
    PG8_WAIT_V(2); PG8_BAR;
    PG8_STAGE(PG8_SB(1, 0), cB + kstep, voffB); PG8_STAGE(PG8_SA(1, 0), cA + kstep, PG8_OA(0, oc)); PG8_STAGE(PG8_SB(1, 1), cB + hstep + kstep, voffB);
    PG8_WAIT_V(6); PG8_BAR;
    for (;;) {
        const bool has_next = S.next(ui + 1, nxt);
        const char* nA = has_next ? nxt.a : cA; const char* nB = has_next ? nxt.b : cB;
        if constexpr (GA) { if (has_next) S.offsets(nxt, K, sR, sC, on); else {
#pragma unroll
            for (int h = 0; h < 2; ++h)
#pragma unroll
                for (int i = 0; i < 2; ++i) on[h][i] = oc[h][i]; } }
#pragma unroll 1
        for (int t = 0; t < nt; t += 2) {
            const bool last = (t == nt - 2);
            const char* a1 = cA + (size_t)(t + 1) * kstep;
            const char* a2 = last ? nA : cA + (size_t)(t + 2) * kstep; const char* b2 = last ? nB : cB + (size_t)(t + 2) * kstep;
            const char* a3 = a2 + kstep; const char* b3 = b2 + kstep;
            unsigned o2[2][2];
            if constexpr (GA) {
#pragma unroll
                for (int h = 0; h < 2; ++h)
#pragma unroll
                    for (int i = 0; i < 2; ++i) o2[h][i] = last ? on[h][i] : oc[h][i]; }
            PG8_LDB(B0, 0, 0); PG8_LDB(B1, 0, 1); PG8_SCHED; PG8_LDA(At, 0, 0); PG8_STAGE(PG8_SA(1, 1), a1 + hA, PG8_OA(1, oc));
            PG8_WAIT_V(8); PG8_WAIT_L(0); PG8_BAR; PG8_MMA(0, 0, At, B0); PG8_MMA(0, 1, At, B1); PG8_BAR; PG8_SCHED;
            PG8_LDA(At, 0, 1); PG8_STAGE(PG8_SB(0, 0), b2, voffB); PG8_STAGE(PG8_SB(0, 1), b2 + hstep, voffB); PG8_STAGE(PG8_SA(0, 0), a2, PG8_OA(0, o2));
            PG8_WAIT_V(8); PG8_WAIT_L(0); PG8_BAR; PG8_MMA(1, 0, At, B0); PG8_MMA(1, 1, At, B1); PG8_BAR; PG8_SCHED;
            PG8_LDB(B0, 1, 0); PG8_LDB(B1, 1, 1); PG8_SCHED; PG8_LDA(At, 1, 0); PG8_STAGE(PG8_SA(0, 1), a2 + hA, PG8_OA(1, o2));
            PG8_WAIT_V(8); PG8_WAIT_L(0); PG8_BAR; PG8_MMA(0, 0, At, B0); PG8_MMA(0, 1, At, B1); PG8_BAR; PG8_SCHED;
            PG8_LDA(At, 1, 1); PG8_STAGE(PG8_SB(1, 0), b3, voffB); PG8_STAGE(PG8_SB(1, 1), b3 + hstep, voffB); PG8_STAGE(PG8_SA(1, 0), a3, PG8_OA(0, o2));
            PG8_WAIT_V(8); PG8_WAIT_L(0); PG8_BAR; PG8_MMA(1, 0, At, B0); PG8_MMA(1, 1, At, B1); PG8_BAR; PG8_SCHED;
        }
        if constexpr (ALIGN_EPI) { if (wr == 0) PG8_BAR; }
        if constexpr (FP8) asm volatile("s_nop 7\n\ts_nop 7" : "+v"(acc[1][1][0][0]), "+v"(acc[1][1][0][1]), "+v"(acc[1][1][1][0]), "+v"(acc[1][1][1][1]), "+v"(acc[1][1][2][0]), "+v"(acc[1][1][2][1]), "+v"(acc[1][1][3][0]), "+v"(acc[1][1][3][1]) :: "memory");
        E(acc, cur, wr, wc, fr, fq);
        if (!has_next) break;
#pragma unroll
        for (int a = 0; a < 2; ++a)
#pragma unroll
            for (int b = 0; b < 2; ++b)
#pragma unroll
                for (int m = 0; m < 4; ++m)
#pragma unroll
                    for (int n = 0; n < 2; ++n) acc[a][b][m][n] = (f32x4){0.f, 0.f, 0.f, 0.f};
        cur = nxt; cA = nA; cB = nB; ++ui;
        if constexpr (GA) {
#pragma unroll
            for (int h = 0; h < 2; ++h)
#pragma unroll
                for (int i = 0; i < 2; ++i) oc[h][i] = on[h][i]; }
        if constexpr (ALIGN_EPI) { if (wr == 1) PG8_BAR; }
    }
    PG8_WAIT_V(0);
    if constexpr (!ALIGN_EPI) { if (wr == 0) PG8_BAR; }
    PG8_BAR;
#undef PG8_SA
#undef PG8_OA
#undef PG8_CAT
#undef PG8_SB
#undef PG8_STAGE
#undef PG8_LDA
#undef PG8_LDB
#undef PG8_MMA
#undef PG8_WAIT_V
#undef PG8_WAIT_L
#undef PG8_BAR
#undef PG8_SCHED
}
}

#define FDEV __device__ __forceinline__
#define LDSPTR LAS
#define CF_DEFINED
typedef float cf __attribute__((ext_vector_type(2)));
#ifndef FFT_ENGINE_H
#define FFT_ENGINE_H
#ifndef CF_DEFINED
struct cf { float x, y; };
#endif
FDEV cf mkc(float a, float b) { cf r; r.x = a; r.y = b; return r; }
FDEV cf cadd(cf a, cf b) { return mkc(a.x + b.x, a.y + b.y); }
FDEV cf csub(cf a, cf b) { return mkc(a.x - b.x, a.y - b.y); }
FDEV cf cmul(cf a, cf b) { return mkc(a.x * b.x - a.y * b.y, a.x * b.y + a.y * b.x); }
FDEV cf cmulc(cf a, cf b) { return mkc(a.x * b.x + a.y * b.y, a.y * b.x - a.x * b.y); }
FDEV cf mul_mi(cf a) { return mkc(a.y, -a.x); }
FDEV cf mul_pi(cf a) { return mkc(-a.y, a.x); }
constexpr int FFT_N = 4096, FFT_LDS_ELEMS = 16 * 272;
FDEV int fpos(int p) { return 272 * (p >> 8) + 17 * ((p >> 4) & 15) + (p & 15); }

template <bool INV> FDEV void dft16(cf (&v)[16]) {
    const float C1 = 0.92387953251128674f, S1 = 0.38268343236508977f, C2 = 0.70710678118654752f;
#pragma unroll
    for (int n0 = 0; n0 < 4; ++n0) {
        cf x0 = v[n0], x1 = v[4 + n0], x2 = v[8 + n0], x3 = v[12 + n0];
        cf A = cadd(x0, x2), B = csub(x0, x2), C = cadd(x1, x3), D = csub(x1, x3);
        cf Dm = INV ? mul_pi(D) : mul_mi(D);
        v[n0] = cadd(A, C); v[4 + n0] = cadd(B, Dm); v[8 + n0] = csub(A, C); v[12 + n0] = csub(B, Dm);
    }
#define W16(m) (mkc( (m)==0?1.f:(m)==1?C1:(m)==2?C2:(m)==3?S1:(m)==4?0.f:(m)==6?-C2:(m)==9?-C1:0.f, \
                    (INV?1.f:-1.f) * ((m)==0?0.f:(m)==1?S1:(m)==2?C2:(m)==3?C1:(m)==4?1.f:(m)==6?C2:(m)==9?-S1:0.f) ))
    v[4 + 1] = cmul(v[4 + 1], W16(1)); v[4 + 2] = cmul(v[4 + 2], W16(2)); v[4 + 3] = cmul(v[4 + 3], W16(3));
    v[8 + 1] = cmul(v[8 + 1], W16(2)); v[8 + 2] = cmul(v[8 + 2], W16(4)); v[8 + 3] = cmul(v[8 + 3], W16(6));
    v[12 + 1] = cmul(v[12 + 1], W16(3)); v[12 + 2] = cmul(v[12 + 2], W16(6)); v[12 + 3] = cmul(v[12 + 3], W16(9));
#undef W16
    cf o[16];
#pragma unroll
    for (int k1 = 0; k1 < 4; ++k1) {
        cf x0 = v[4 * k1], x1 = v[4 * k1 + 1], x2 = v[4 * k1 + 2], x3 = v[4 * k1 + 3];
        cf A = cadd(x0, x2), B = csub(x0, x2), C = cadd(x1, x3), D = csub(x1, x3);
        cf Dm = INV ? mul_pi(D) : mul_mi(D);
        o[k1] = cadd(A, C); o[k1 + 4] = cadd(B, Dm); o[k1 + 8] = csub(A, C); o[k1 + 12] = csub(B, Dm);
    }
#pragma unroll
    for (int i = 0; i < 16; ++i) v[i] = o[i];
}

template <int GEO> FDEV int geo_idx(int r, int e) {
    if (GEO == 1) return 272 * e + 17 * (r >> 4) + (r & 15);
    if (GEO == 2) return 272 * (r >> 4) + 17 * e + (r & 15);
    return 272 * (r >> 4) + 17 * (r & 15) + e;
}
template <int GEO> FDEV void fft_pass_fwd(LDSPTR cf* buf, const LDSPTR cf* tw, const LDSPTR cf* tw256, int r) {
    cf v[16];
#pragma unroll
    for (int e = 0; e < 16; ++e) v[e] = buf[geo_idx<GEO>(r, e)];
    dft16<false>(v);
    if (GEO == 1) {
#pragma unroll
        for (int s = 1; s < 16; ++s) v[s] = cmul(v[s], tw[(r * s) & 4095]);
    } else if (GEO == 2) {
        const int t = r & 15;
#pragma unroll
        for (int s = 1; s < 16; ++s) v[s] = cmul(v[s], tw256[t * s]);
    }
#pragma unroll
    for (int e = 0; e < 16; ++e) buf[geo_idx<GEO>(r, e)] = v[e];
}
template <int GEO> FDEV void fft_pass_inv(LDSPTR cf* buf, const LDSPTR cf* tw, const LDSPTR cf* tw256, int r) {
    cf v[16];
#pragma unroll
    for (int e = 0; e < 16; ++e) v[e] = buf[geo_idx<GEO>(r, e)];
    if (GEO == 1) {
#pragma unroll
        for (int s = 1; s < 16; ++s) v[s] = cmulc(v[s], tw[(r * s) & 4095]);
    } else if (GEO == 2) {
        const int t = r & 15;
#pragma unroll
        for (int s = 1; s < 16; ++s) v[s] = cmulc(v[s], tw256[t * s]);
    }
    dft16<true>(v);
#pragma unroll
    for (int e = 0; e < 16; ++e) buf[geo_idx<GEO>(r, e)] = v[e];
}
FDEV int freq_pos(int k) { return 256 * (k & 15) + 16 * ((k >> 4) & 15) + (k >> 8); }
#endif

#define XB_TMO      128
#define XB_XCNT(j)  (256  + 64 * (j))
#define XB_XSUB(j)  (1280 + 64 * (j))
#define XB_XGEN(j)  (2304 + 64 * (j))
#define XB_TOP      3328
#define XB_TOPGEN   3392
#define XCD_BAR_WORDS 3456
#define XB_SPIN_CAP (1u << 18)
__device__ __forceinline__ unsigned xb_ld(unsigned* p)              { return __hip_atomic_load(p, __ATOMIC_RELAXED, __HIP_MEMORY_SCOPE_AGENT); }
__device__ __forceinline__ unsigned xb_add(unsigned* p, unsigned v) { return __hip_atomic_fetch_add(p, v, __ATOMIC_RELAXED, __HIP_MEMORY_SCOPE_AGENT); }
__device__ __forceinline__ unsigned xb_xcc_id() { return (unsigned)__builtin_amdgcn_s_getreg((3 << 11) | 20) & 0xFu; }
#define XB_SPIN(cond, bar) do { unsigned _sp = 0; while (cond) { __builtin_amdgcn_s_sleep(1); \
    if ((++_sp & 255u) == 0u) { if (xb_ld(&(bar)[XB_TMO])) break; if (_sp > XB_SPIN_CAP) { atomicAdd(&(bar)[XB_TMO], 1u); break; } } } } while (0)
struct XcdBarrier { unsigned* bar; unsigned x; volatile LAS unsigned* st; };
__device__ __forceinline__ XcdBarrier xcd_barrier_post(unsigned* bar, volatile LAS unsigned* st) {
    XcdBarrier b; b.bar = bar; b.x = xb_xcc_id(); b.st = st;
    if (threadIdx.x == 0) (void)xb_add(&bar[XB_XCNT(b.x)], 1u);
    return b;
}
__device__ __forceinline__ void xcd_barrier_complete(unsigned* bar, unsigned x, unsigned& nloc, unsigned& nx) {
    const unsigned G = gridDim.x * gridDim.y * gridDim.z;
    unsigned sum, cnt, mine, sp = 0u;
    for (;;) {
        sum = 0u; cnt = 0u; mine = 0u;
#pragma unroll
        for (unsigned j = 0; j < 16; ++j) { const unsigned c = xb_ld(&bar[XB_XCNT(j)]); sum += c; cnt += (c > 0u) ? 1u : 0u; mine = (j == x) ? c : mine; }
        if (sum == G) break;
        __builtin_amdgcn_s_sleep(1);
        if ((++sp & 255u) == 0u) { if (xb_ld(&bar[XB_TMO])) break; if (sp > XB_SPIN_CAP) { atomicAdd(&bar[XB_TMO], 1u); break; } }
    }
    nloc = mine > 0u ? mine : 1u; nx = cnt > 0u ? cnt : 1u;
}
__device__ __forceinline__ void xcd_barrier(const XcdBarrier& b) {
    asm volatile("s_waitcnt vmcnt(0)" ::: "memory");
    __syncthreads();
    if (threadIdx.x == 0) {
        unsigned* bar = b.bar;
        __builtin_amdgcn_s_waitcnt(0);
        unsigned nloc = b.st[0], nx = b.st[1];
        if (nloc == 0u) { xcd_barrier_complete(bar, b.x, nloc, nx); b.st[0] = nloc; b.st[1] = nx; }
        const unsigned old = xb_add(&bar[XB_XSUB(b.x)], 1u);
        const unsigned gen = old / nloc;
        if (old + 1u == (gen + 1u) * nloc) {
            __builtin_amdgcn_fence(__ATOMIC_RELEASE, "agent");
            asm volatile("s_waitcnt vmcnt(0)" ::: "memory");
            const unsigned og = xb_add(&bar[XB_TOP], 1u);
            const unsigned tg = og / nx;
            if (og + 1u == (tg + 1u) * nx) xb_add(&bar[XB_TOPGEN], 1u);
            else XB_SPIN(xb_ld(&bar[XB_TOPGEN]) == tg, bar);
            __builtin_amdgcn_fence(__ATOMIC_ACQUIRE, "agent");
            xb_add(&bar[XB_XGEN(b.x)], 1u);
            asm volatile("s_waitcnt vmcnt(0)" ::: "memory");
        } else {
            XB_SPIN(xb_ld(&bar[XB_XGEN(b.x)]) == gen, bar);
            __builtin_amdgcn_fence(__ATOMIC_ACQUIRE, "agent");
            asm volatile("s_waitcnt vmcnt(0)" ::: "memory");
        }
    }
    __syncthreads();
}

struct Frame {
    LAS unsigned char* lds;
    unsigned char* ws;
    int tid, lane, wave, vcu, G, bid;
    const float *x, *norm1_g, *w_in, *conv_w, *conv_b, *f_w_in, *f_b_in, *f_w_mid, *f_b_mid, *f_freq, *f_w_out, *f_bias, *mix_g, *w_out, *norm2_g,
                *w_group, *b_group, *w_router, *b_router, *w_gate, *w_up, *w_down, *final_g;
    float* out;
};
#define WSP(T, off) ((T*)(F.ws + (off)))

__device__ __forceinline__ void transpose_item(const float* W, int ldw, bf16* WT, int ldo, LAS float* scr, int lane, const float* gk = nullptr) {
    asm volatile("" : "+s"(ldw));
    const float* Wl = W + (size_t)(lane >> 5) * ldw + (lane & 31);
    float t[32];
#pragma unroll
    for (int i = 0; i < 32; ++i) t[i] = Wl[(size_t)(2 * i) * ldw];
    if (gk) { const float* gl = gk + (lane >> 5);
#pragma unroll
        for (int i = 0; i < 32; ++i) t[i] *= gl[2 * i]; }
#pragma unroll
    for (int i = 0; i < 32; ++i) { const int kk = 2 * i + (lane >> 5); scr[kk * 33 + (lane & 31)] = t[i]; }
    LDS_WAIT(); asm volatile("" ::: "memory");
    const int c = lane & 7;
#pragma unroll
    for (int j = 0; j < 4; ++j) { const int n = (lane >> 3) + 8 * j; const LAS float* s = scr + (8 * c) * 33 + n;
        u32x4 o; o.x = pk2(s[0 * 33], s[1 * 33]); o.y = pk2(s[2 * 33], s[3 * 33]); o.z = pk2(s[4 * 33], s[5 * 33]); o.w = pk2(s[6 * 33], s[7 * 33]);
        st16_wt(WT + (size_t)n * ldo + 8 * c, o); }
    LDS_WAIT(); asm volatile("" ::: "memory");
}
__device__ __forceinline__ void transpose_item_fp8(const float* W, int ldw, unsigned char* WT, int ldo, LAS float* scr, int lane, const float* gk, float scale) {
    asm volatile("" : "+s"(ldw));
    const float* Wl = W + (size_t)(lane >> 5) * ldw + (lane & 31);
    float t[32];
#pragma unroll
    for (int i = 0; i < 32; ++i) t[i] = Wl[(size_t)(2 * i) * ldw];
    if (gk) { const float* gl = gk + (lane >> 5);
#pragma unroll
        for (int i = 0; i < 32; ++i) t[i] *= gl[2 * i]; }
#pragma unroll
    for (int i = 0; i < 32; ++i) { const int kk = 2 * i + (lane >> 5); scr[kk * 33 + (lane & 31)] = t[i]; }
    LDS_WAIT(); asm volatile("" ::: "memory");
    const int n = lane >> 1, hf = lane & 1; const LAS float* s = scr + (32 * hf) * 33 + n;
    u32x4 o0, o1;
    o0.x = pk4_fp8s(s[0 * 33], s[1 * 33], s[2 * 33], s[3 * 33], scale); o0.y = pk4_fp8s(s[4 * 33], s[5 * 33], s[6 * 33], s[7 * 33], scale);
    o0.z = pk4_fp8s(s[8 * 33], s[9 * 33], s[10 * 33], s[11 * 33], scale); o0.w = pk4_fp8s(s[12 * 33], s[13 * 33], s[14 * 33], s[15 * 33], scale);
    o1.x = pk4_fp8s(s[16 * 33], s[17 * 33], s[18 * 33], s[19 * 33], scale); o1.y = pk4_fp8s(s[20 * 33], s[21 * 33], s[22 * 33], s[23 * 33], scale);
    o1.z = pk4_fp8s(s[24 * 33], s[25 * 33], s[26 * 33], s[27 * 33], scale); o1.w = pk4_fp8s(s[28 * 33], s[29 * 33], s[30 * 33], s[31 * 33], scale);
    unsigned char* d = WT + (size_t)n * ldo + 32 * hf;
    st16_plain(d, o0); st16_plain(d + 16, o1);
    LDS_WAIT(); asm volatile("" ::: "memory");
}
__device__ __forceinline__ void rms_row_to_bf16(const float* xrow, const float* g, bf16* orow, int lane) {
    const GAS f32x4* xr = (const GAS f32x4*)xrow + lane; const GAS f32x4* gr = (const GAS f32x4*)g + lane;
    f32x4 v[4]; float s = 0.f;
#pragma unroll
    for (int j = 0; j < 4; ++j) { v[j] = xr[64 * j]; s += (v[j].x * v[j].x + v[j].y * v[j].y) + (v[j].z * v[j].z + v[j].w * v[j].w); }
    const float rinv = 1.0f / sqrtf(wave_sum(s) * (1.f / 1024.f) + EPS);
    GAS u32x2* o8 = (GAS u32x2*)orow + lane;
#pragma unroll
    for (int j = 0; j < 4; ++j) { const f32x4 gg = gr[64 * j]; u32x2 w; w.x = pk2(v[j].x * rinv * gg.x, v[j].y * rinv * gg.y); w.y = pk2(v[j].z * rinv * gg.z, v[j].w * rinv * gg.w); o8[64 * j] = w; }
}
__device__ __forceinline__ void wave_lds_sync() { asm volatile("s_waitcnt lgkmcnt(0)" ::: "memory"); }
template <int NIN, int astride> __device__ __forceinline__ void mlp_layer(const float* W  , const float* bvec, const float* fvec, const LAS float* ain, LAS float* aout, int lane) {
    float w[64];
    unsigned ul = (unsigned)lane; asm volatile("" : "+v"(ul));
#pragma unroll
    for (int i = 0; i < 64; ++i) w[i] = (i < NIN) ? W[(unsigned)(i * 64) + ul] : 0.f;
    const float b = bvec[lane], fr = fvec[lane];
#pragma unroll 1
    for (int p = 0; p < 16; ++p) {
        const LAS float* ap = ain + p * astride; float s = b;
        if (NIN == 33) {
#pragma unroll
            for (int i = 0; i < 33; ++i) s += ap[i] * w[i];
        } else {
#pragma unroll
            for (int i4 = 0; i4 < 16; ++i4) { const f32x4 hv = *(const LAS f32x4*)(ap + 4 * i4); s += (hv.x * w[4 * i4] + hv.y * w[4 * i4 + 1]) + (hv.z * w[4 * i4 + 2] + hv.w * w[4 * i4 + 3]); }
        }
        aout[p * 64 + lane] = sinf(fr * s);
    }
    asm volatile("s_waitcnt lgkmcnt(0)" ::: "memory");
}
__device__ __forceinline__ void filter_mlp_wave(Frame& F, int pb, int half, unsigned lds_off) {
    const int lane = F.lane;
    asm volatile("" : "+v"(lds_off));
    LAS float* a0 = (LAS float*)(F.lds + lds_off); LAS float* a1 = a0 + 16 * 36; LAS float* a2 = a1 + 1024;
    for (int i = lane; i < 16 * 33; i += 64) { const int p = i / 33, j = i % 33, l = 16 * pb + p; float v;
        if (j == 0) v = (float)l / 4095.0f;
        else { const int q = (j - 1) & 15; const float fq = 1e-4f + (float)q * ((15.0f - 1e-4f) / 15.0f); const float ang = fq * ((2.0f * 3.14159265358979323846f / 4096.0f) * (float)l); v = (j <= 16) ? cosf(ang) : -sinf(ang); }
        a0[p * 36 + j] = v; }
    asm volatile("s_waitcnt lgkmcnt(0)" ::: "memory");
    mlp_layer<33, 36>(F.f_w_in, F.f_b_in, F.f_freq, a0, a1, lane);
    mlp_layer<64, 64>(F.f_w_mid, F.f_b_mid, F.f_freq + 64, a1, a2, lane);
    mlp_layer<64, 64>(F.f_w_mid + 4096, F.f_b_mid + 64, F.f_freq + 128, a2, a1, lane);
    float* KT = WSP(float, WS_KT);
#pragma unroll 1
    for (int m = half; m < 16; m += 4) { const int j = 64 * m + lane;
        float w[64]; unsigned uj = (unsigned)j; asm volatile("" : "+v"(uj));
#pragma unroll
        for (int i = 0; i < 64; ++i) w[i] = F.f_w_out[(unsigned)(i * 1024) + uj];
        const float mind = -3.0701134573253946f, maxd = -15.350567286626973f;
        const float delta = fabsf(mind + (float)(j & 511) * ((maxd - mind) / 511.0f));
        f32x4* o4 = (f32x4*)(KT + (size_t)j * 4096 + 16 * pb);
#pragma unroll 1
        for (int pg = 0; pg < 4; ++pg) {
            float acc[4];
#pragma unroll
            for (int q = 0; q < 4; ++q) { const LAS float* ap = a1 + (4 * pg + q) * 64; float sacc = 0.f;
#pragma unroll
                for (int i4 = 0; i4 < 16; ++i4) { const f32x4 hv = *(const LAS f32x4*)(ap + 4 * i4); sacc += (hv.x * w[4 * i4] + hv.y * w[4 * i4 + 1]) + (hv.z * w[4 * i4 + 2] + hv.w * w[4 * i4 + 3]); }
                acc[q] = sacc * __expf(-((float)(16 * pb + 4 * pg + q) / 4095.0f) * delta); }
            o4[pg] = (f32x4){acc[0], acc[1], acc[2], acc[3]};
        }
    }
}
constexpr int WD_HERE = 0;
__device__ __forceinline__ void phase_prologue(Frame& F) {
    { const int gt = F.bid * NTHREADS + F.tid;
      if (gt < 4096) { f32x2 w; w.x = cospif((float)gt * (1.0f / 2048.0f)); w.y = -sinpif((float)gt * (1.0f / 2048.0f)); WSP(f32x2, WS_TW4096)[gt] = w; }
      else if (gt < 8192) { const int n = gt - 4096; f32x2 w; w.x = cospif((float)n * (1.0f / 4096.0f)); w.y = -sinpif((float)n * (1.0f / 4096.0f)); WSP(f32x2, WS_TW8192)[n] = w; } }
    LAS unsigned* ticket = (LAS unsigned*)(F.lds + 158 * 1024);
    for (int rr_ = 0; rr_ < ((MK_DUP == 15) ? 2 : 1); ++rr_) {
    __syncthreads();
    if (F.tid == 0) ticket[0] = 0u;
    __syncthreads();
    if (F.wave >= 4 && rr_ == 0) { for (int pb = F.bid; pb < 256; pb += F.G) filter_mlp_wave(F, pb, F.wave - 4, (unsigned)((72 + 12 * (F.wave - 4)) * 1024)); }
    {
        LAS float* scr = (LAS float*)(F.lds + F.wave * 8704);
        constexpr int I_IN = 16 * 64, I_OUT = 16 * 32, I_G = 32 * 16 * 16, I_D = 32 * 8 * 32, I_RMS = T_TOK / 4;
        constexpr int NITEMS = I_IN + I_OUT + 2 * I_G + I_RMS + WD_HERE;
        bf16* WIN_T = WSP(bf16, WS_WIN_T); bf16* WOUT_T = WSP(bf16, WS_WOUT_T); unsigned char* WGU8 = WSP(unsigned char, WS_WGU_T); unsigned char* WD8 = WSP(unsigned char, WS_WD_T); bf16* HN = WSP(bf16, WS_HN);
        for (;;) {
            unsigned tk = 0; if (F.lane == 0) tk = __hip_atomic_fetch_add((unsigned*)ticket, 1u, __ATOMIC_RELAXED, __HIP_MEMORY_SCOPE_WORKGROUP);
            tk = __builtin_amdgcn_readfirstlane(tk);
            const long itl = (long)tk * F.G + F.vcu; if (itl >= NITEMS) break;
            int r = (int)itl;
            if (r < I_RMS) {
                const int m0 = 4 * r; f32x4 v[4][4];
#pragma unroll
                for (int q = 0; q < 4; ++q) { const GAS f32x4* xr = (const GAS f32x4*)(F.x + (size_t)(m0 + q) * 1024) + F.lane;
#pragma unroll
                    for (int j = 0; j < 4; ++j) v[q][j] = xr[64 * j]; }
#pragma unroll
                for (int q = 0; q < 4; ++q) { float s = 0.f;
#pragma unroll
                    for (int j = 0; j < 4; ++j) s += (v[q][j].x * v[q][j].x + v[q][j].y * v[q][j].y) + (v[q][j].z * v[q][j].z + v[q][j].w * v[q][j].w);
                    const float rinv = 1.0f / sqrtf(wave_sum(s) * (1.f / 1024.f) + EPS);
                    if (F.lane == 0) WSP(float, WS_RINV1)[m0 + q] = rinv;
                    GAS u32x2* o8 = (GAS u32x2*)(HN + (size_t)(m0 + q) * 1024) + F.lane;
#pragma unroll
                    for (int j = 0; j < 4; ++j) { u32x2 w; w.x = pk2(v[q][j].x, v[q][j].y); w.y = pk2(v[q][j].z, v[q][j].w); o8[64 * j] = w; } }
                continue; } r -= I_RMS;
            if (r < I_IN) { const int kb = r / 64, nb = r % 64; transpose_item(F.w_in + (size_t)(64 * kb) * D_IN_PROJ + 32 * nb, D_IN_PROJ, WIN_T + (size_t)(32 * nb) * 1024 + 64 * kb, 1024, scr, F.lane, F.norm1_g + 64 * kb); continue; } r -= I_IN;
            if (r < I_OUT) { const int kb = r / 32, nb = r % 32; transpose_item(F.w_out + (size_t)(64 * kb) * 1024 + 32 * nb, 1024, WOUT_T + (size_t)(32 * nb) * 1024 + 64 * kb, 1024, scr, F.lane); continue; } r -= I_OUT;
            if (r < 2 * I_G) { const int up = r / I_G; r %= I_G; const int e = r / 256, kb = (r % 256) / 16, nb = r % 16; const int n0 = 32 * nb;
                const float* W = (up ? F.w_up : F.w_gate) + (size_t)e * 1024 * 512 + (size_t)(64 * kb) * 512 + n0;
                const int orow = 256 * (n0 >> 7) + (n0 & 127) + (up ? 128 : 0);
                transpose_item_fp8(W, 512, WGU8 + ((size_t)e * 1024 + orow) * 1024 + 64 * kb, 1024, scr, F.lane, F.norm2_g + 64 * kb, W_SCALE); continue; } r -= 2 * I_G;
            { const int e = r / 256, kb = (r % 256) / 32, nb = r % 32;
              transpose_item_fp8(F.w_down + (size_t)e * 512 * 1024 + (size_t)(64 * kb) * 1024 + 32 * nb, 1024, WD8 + ((size_t)e * 1024 + 32 * nb) * 512 + 64 * kb, 512, scr, F.lane, nullptr, W_SCALE); }
        }
        (void)I_D;
    }
    }
    __syncthreads();
}
__device__ __forceinline__ void wdown_items(Frame& F, int first, int stride) {
    LAS float* scr = (LAS float*)(F.lds + F.wave * 8704); unsigned char* WD8 = WSP(unsigned char, WS_WD_T);
    for (int r = WD_HERE + first; r < 32 * 8 * 32; r += stride) { const int e = r / 256, kb = (r % 256) / 32, nb = r % 32;
        transpose_item_fp8(F.w_down + (size_t)e * 512 * 1024 + (size_t)(64 * kb) * 1024 + 32 * nb, 1024, WD8 + ((size_t)e * 1024 + 32 * nb) * 512 + 64 * kb, 512, scr, F.lane, nullptr, W_SCALE); }
}

__device__ __forceinline__ void load_tw_lds(Frame& F, int tw_off, int tw256_off) {
    __syncthreads();
    LAS f32x2* tw = (LAS f32x2*)(F.lds + tw_off); const f32x2* g = WSP(f32x2, WS_TW4096);
    f32x2 tv[8];
#pragma unroll
    for (int i = 0; i < 8; ++i) tv[i] = g[F.tid + NTHREADS * i];
    const f32x2 t2 = g[16 * (F.tid & 255)];
#pragma unroll
    for (int i = 0; i < 8; ++i) tw[F.tid + NTHREADS * i] = tv[i];
    if (F.tid < 256) ((LAS f32x2*)(F.lds + tw256_off))[F.tid] = t2;
    __syncthreads();
}
__device__ __forceinline__ void fft_fwd3(Frame& F) {
    LAS cf* buf = (LAS cf*)(F.lds + ((F.tid >> 8) ? L_BUFB : L_BUFA)); const LAS cf* tw = (const LAS cf*)(F.lds + L_TW); const LAS cf* t256 = (const LAS cf*)(F.lds + L_TW256); const int r = F.tid & 255;
    fft_pass_fwd<1>(buf, tw, t256, r); __syncthreads(); fft_pass_fwd<2>(buf, tw, t256, r); __syncthreads(); fft_pass_fwd<3>(buf, tw, t256, r); __syncthreads();
}
__device__ __forceinline__ void fft_inv3(Frame& F) {
    LAS cf* buf = (LAS cf*)(F.lds + ((F.tid >> 8) ? L_BUFB : L_BUFA)); const LAS cf* tw = (const LAS cf*)(F.lds + L_TW); const LAS cf* t256 = (const LAS cf*)(F.lds + L_TW256); const int r = F.tid & 255;
    fft_pass_inv<3>(buf, tw, t256, r); __syncthreads(); fft_pass_inv<2>(buf, tw, t256, r); __syncthreads(); fft_pass_inv<1>(buf, tw, t256, r); __syncthreads();
}
__device__ __forceinline__ const bf16* pt_at(const bf16* PT, int row, int tok) { return PT + ((size_t)(tok >> 8) * NPT_ROWS + row) * 256 + (tok & 255); }
struct Row8 { u32x4 w; float lft, rgt; };
__device__ __forceinline__ Row8 row8_load(const bf16* PT, int row, int tb, int l0) {
    Row8 r; r.w = *(const u32x4*)pt_at(PT, row, tb + l0);
    const bf16 a = *pt_at(PT, row, tb + (l0 > 0 ? l0 - 1 : 0)), b = *pt_at(PT, row, tb + (l0 + 8 < 4096 ? l0 + 8 : 4095));
    r.lft = (l0 > 0) ? bf1(a) : 0.f; r.rgt = (l0 + 8 < 4096) ? bf1(b) : 0.f; return r;
}
__device__ __forceinline__ void conv8(const Row8& r, float w0, float w1, float w2, float b, float (&o)[8]) {
    float u[10];
    u[0] = r.lft; u[9] = r.rgt; const u32x4 v = r.w;
    u[1] = bflo(v.x); u[2] = bfhi(v.x); u[3] = bflo(v.y); u[4] = bfhi(v.y); u[5] = bflo(v.z); u[6] = bfhi(v.z); u[7] = bflo(v.w); u[8] = bfhi(v.w);
#pragma unroll
    for (int i = 0; i < 8; ++i) o[i] = b + w0 * u[i] + w1 * u[i + 1] + w2 * u[i + 2];
}
struct HyRaw { Row8 a0, v0, a1, v1; };
__device__ __forceinline__ void hy_load(Frame& F, int it, HyRaw& r) {
    const int c = it >> 2, bp = it & 3, l0 = 8 * F.tid; const bf16* PT = WSP(bf16, WS_PT);
    const int tb = 2 * bp * SEQ;
    r.a0 = row8_load(PT, 512 + c, tb, l0); r.v0 = row8_load(PT, 1024 + c, tb, l0); r.a1 = row8_load(PT, 512 + c, tb + SEQ, l0); r.v1 = row8_load(PT, 1024 + c, tb + SEQ, l0);
}
__device__ __forceinline__ void hyena_items(Frame& F) {
    LAS cf* bufA = (LAS cf*)(F.lds + L_BUFA); LAS cf* bufB = (LAS cf*)(F.lds + L_BUFB); const LAS cf* tw2 = (const LAS cf*)(F.lds + L_SCR);
    const bf16* PT = WSP(bf16, WS_PT); const float* cw = F.conv_w; const float* cb = F.conv_b;
    const int l0 = 8 * F.tid;
    HyRaw nx; int it = F.bid;
    if (it < 2048) hy_load(F, it, nx);
    for (; it < 2048; it += F.G) {
        const int c = it >> 2, bp = it & 3;
        float z0[8], z1[8];
        {
            const float a0 = cw[512 + c], a1 = cw[1536 + 512 + c], a2 = cw[3072 + 512 + c], ab = cb[512 + c];
            const float v0 = cw[1024 + c], v1 = cw[1536 + 1024 + c], v2 = cw[3072 + 1024 + c], vb = cb[1024 + c];
            float t1[8], t2[8];
            conv8(nx.a0, a0, a1, a2, ab, t1); conv8(nx.v0, v0, v1, v2, vb, t2);
#pragma unroll
            for (int i = 0; i < 8; ++i) z0[i] = t1[i] * t2[i];
            conv8(nx.a1, a0, a1, a2, ab, t1); conv8(nx.v1, v0, v1, v2, vb, t2);
#pragma unroll
            for (int i = 0; i < 8; ++i) z1[i] = t1[i] * t2[i];
        }
#pragma unroll
        for (int i = 0; i < 8; ++i) { const int l = l0 + i; const cf z = mkc(z0[i], z1[i]); bufA[fpos(l)] = z; bufB[fpos(l)] = cmul(z, tw2[l]); }
        f32x2 ke[8], ko[8];
        { const f32x2* KF = WSP(f32x2, WS_KF) + (size_t)c * 8192;
#pragma unroll
          for (int i = 0; i < 8; ++i) { ke[i] = KF[F.tid + 512 * i]; ko[i] = KF[4096 + F.tid + 512 * i]; } }
        __syncthreads();
        fft_fwd3(F);
#pragma unroll
        for (int i = 0; i < 8; ++i) { const int q = fpos(F.tid + 512 * i); bufA[q] = cmul(bufA[q], ke[i]); bufB[q] = cmul(bufB[q], ko[i]); }
        Row8 xa, xb;
        { const int tb = 2 * bp * SEQ; xa = row8_load(PT, c, tb, l0); xb = row8_load(PT, c, tb + SEQ, l0); }
        if (it + F.G < 2048) hy_load(F, it + F.G, nx);
        __syncthreads();
        fft_inv3(F);
        {
            const float w0 = cw[c], w1 = cw[1536 + c], w2 = cw[3072 + c], wb = cb[c]; const float bias = F.f_bias[c];
            bf16* YT = WSP(bf16, WS_YT) + (size_t)c * T_TOK + (size_t)(2 * bp) * SEQ;
            float x0a[8], x0b[8], ya[8], yb[8];
            conv8(xa, w0, w1, w2, wb, x0a); conv8(xb, w0, w1, w2, wb, x0b);
#pragma unroll
            for (int i = 0; i < 8; ++i) { const int l = l0 + i; const cf e = bufA[fpos(l)], o = bufB[fpos(l)]; const cf y = cadd(e, cmulc(o, tw2[l]));
                ya[i] = x0a[i] * (y.x + bias * z0[i]); yb[i] = x0b[i] * (y.y + bias * z1[i]); }
            u32x4 oa, ob; oa.x = pk2(ya[0], ya[1]); oa.y = pk2(ya[2], ya[3]); oa.z = pk2(ya[4], ya[5]); oa.w = pk2(ya[6], ya[7]);
            ob.x = pk2(yb[0], yb[1]); ob.y = pk2(yb[2], yb[3]); ob.z = pk2(yb[4], yb[5]); ob.w = pk2(yb[6], yb[7]);
            *(u32x4*)(YT + l0) = oa; *(u32x4*)(YT + SEQ + l0) = ob;
        }
        __syncthreads();
    }
}
struct FoRaw { u32x4 a0, d0, a1, d1; };
__device__ __forceinline__ void fo_load(Frame& F, int q, FoRaw& r) {
    const int f = F.tid >> 8, s = 2 * q + f, b = s >> 9, gc = s & 511, g = gc >> 6, cp = gc & 63, l0 = 16 * (F.tid & 255);
    const bf16* PT = WSP(bf16, WS_PT); const int r1 = 1536 + 128 * g + cp, r2 = r1 + 64, tk = b * SEQ + l0;
    r.a0 = *(const u32x4*)pt_at(PT, r1, tk); r.d0 = *(const u32x4*)pt_at(PT, r2, tk); r.a1 = *(const u32x4*)pt_at(PT, r1, tk + 8); r.d1 = *(const u32x4*)pt_at(PT, r2, tk + 8);
}
__device__ __forceinline__ void fo_put(LAS cf* buf, int l, u32x4 a, u32x4 d) {
    buf[fpos(l + 0)] = mkc(bflo(a.x), bflo(d.x)); buf[fpos(l + 1)] = mkc(bfhi(a.x), bfhi(d.x)); buf[fpos(l + 2)] = mkc(bflo(a.y), bflo(d.y)); buf[fpos(l + 3)] = mkc(bfhi(a.y), bfhi(d.y));
    buf[fpos(l + 4)] = mkc(bflo(a.z), bflo(d.z)); buf[fpos(l + 5)] = mkc(bfhi(a.z), bfhi(d.z)); buf[fpos(l + 6)] = mkc(bflo(a.w), bflo(d.w)); buf[fpos(l + 7)] = mkc(bfhi(a.w), bfhi(d.w));
}
__device__ __forceinline__ void fourier_items(Frame& F) {
    const int f = F.tid >> 8, r = F.tid & 255, l0 = 16 * r;
    LAS cf* buf = (LAS cf*)(F.lds + (f ? L_BUFB : L_BUFA));
    FoRaw nx; int q = F.bid;
    if (q < 2048) fo_load(F, q, nx);
    for (; q < 2048; q += F.G) {
        const int s = 2 * q + f, b = s >> 9, gc = s & 511;
        fo_put(buf, l0, nx.a0, nx.d0); fo_put(buf, l0 + 8, nx.a1, nx.d1);
        if (q + F.G < 2048) fo_load(F, q + F.G, nx);
        __syncthreads();
        fft_fwd3(F);
        bf16* YT = WSP(bf16, WS_YT) + (size_t)(512 + gc) * T_TOK + (size_t)b * SEQ;
        float y[16];
#pragma unroll
        for (int i = 0; i < 16; ++i) y[i] = buf[fpos(freq_pos(l0 + i))].x * (1.0f / 512.0f);
        u32x4 o0, o1; o0.x = pk2(y[0], y[1]); o0.y = pk2(y[2], y[3]); o0.z = pk2(y[4], y[5]); o0.w = pk2(y[6], y[7]);
        o1.x = pk2(y[8], y[9]); o1.y = pk2(y[10], y[11]); o1.z = pk2(y[12], y[13]); o1.w = pk2(y[14], y[15]);
        *(u32x4*)(YT + l0) = o0; *(u32x4*)(YT + l0 + 8) = o1;
        __syncthreads();
    }
}

#define MF_LO 1
constexpr int MF_NS = 288;
constexpr int MF_PS = 24;
constexpr int MF_PLANE = 6144;
typedef short bf16x8v __attribute__((ext_vector_type(8)));
typedef short s16x4v __attribute__((ext_vector_type(4)));
typedef float f32x16 __attribute__((ext_vector_type(16)));
struct DftFrag { bf16x8v hi[2], lo[2]; };
__device__ __forceinline__ void make_dft_frag(DftFrag& f, int lane, bool inv, const LAS cf* tw  ) {
    const int i = lane & 31, h = lane >> 5, ii = i & 15;
#pragma unroll
    for (int st = 0; st < 2; ++st)
#pragma unroll
        for (int j = 0; j < 8; ++j) { const int e = 8 * h + j; const int m = (ii * e) & 15; const cf w = tw[256 * m]; const float c = w.x, s = -w.y;
            const float di = inv ? s : -s;
            const float val = (st == 0) ? ((i < 16) ? c : di) : ((i < 16) ? -di : c);
            const unsigned hb = f2bf(val); const float rem = val - __builtin_bit_cast(float, hb << 16);
            f.hi[st][j] = (short)hb; f.lo[st][j] = (short)f2bf(rem); }
}
__device__ __forceinline__ unsigned cvtpk_v(float lo, float hi) { typedef float f32x2_t __attribute__((ext_vector_type(2))); typedef __bf16 bf16x2_t __attribute__((ext_vector_type(2))); const f32x2_t v = {lo, hi}; const bf16x2_t b = __builtin_convertvector(v, bf16x2_t); return __builtin_bit_cast(unsigned, b); }
__device__ __forceinline__ s16x4v lds_tr16(const LAS bf16* p) { typedef short v4i16_t __attribute__((ext_vector_type(4))); return __builtin_bit_cast(s16x4v, __builtin_amdgcn_ds_read_tr16_b64_v4i16((LAS v4i16_t*)p)); }
template <int PASS, bool INV, int EPI>
__device__ __forceinline__ void mfft_block(const LAS bf16* inR, const LAS bf16* inI, LAS bf16* outR, LAS bf16* outI, const DftFrag& M, const LAS cf* tw, const LAS cf* tw256, int cb, int lane, const cf* kf, float rs) {
    asm volatile("" : "+v"(lane));
    const int n = lane & 31, h = lane >> 5;
    bf16x8v bR, bI;
    if (PASS == 1) {
        const int g = lane >> 4, q = (lane & 15) >> 2, p = lane & 3;
        const int off = (8 * (g >> 1) + q) * MF_NS + 32 * cb + 16 * (g & 1) + 4 * p;
        const LAS bf16* pr = inR + off; const LAS bf16* pi = inI + off;
        const s16x4v r0 = lds_tr16(pr), r1 = lds_tr16(pr + 4 * MF_NS), i0 = lds_tr16(pi), i1 = lds_tr16(pi + 4 * MF_NS);
        asm volatile("" :: "v"(pr), "v"(pi) : "memory");
        bR = (bf16x8v){r0[0], r0[1], r0[2], r0[3], r1[0], r1[1], r1[2], r1[3]}; bI = (bf16x8v){i0[0], i0[1], i0[2], i0[3], i1[0], i1[1], i1[2], i1[3]};
    } else {
        const int off = (32 * cb + n) * MF_PS + 8 * h;
        bR = *(const LAS bf16x8v*)(inR + off); bI = *(const LAS bf16x8v*)(inI + off);
    }
    f32x16 acc = {0.f, 0.f, 0.f, 0.f, 0.f, 0.f, 0.f, 0.f, 0.f, 0.f, 0.f, 0.f, 0.f, 0.f, 0.f, 0.f};
    acc = __builtin_amdgcn_mfma_f32_32x32x16_bf16(M.hi[0], bR, acc, 0, 0, 0);
    acc = __builtin_amdgcn_mfma_f32_32x32x16_bf16(M.hi[1], bI, acc, 0, 0, 0);
#if MF_LO
    acc = __builtin_amdgcn_mfma_f32_32x32x16_bf16(M.lo[0], bR, acc, 0, 0, 0);
    acc = __builtin_amdgcn_mfma_f32_32x32x16_bf16(M.lo[1], bI, acc, 0, 0, 0);
#endif
    const int c = 32 * cb + n;
    int base, qs;
    if (PASS == 1) { base = MF_PS * (c & 15) + (c >> 4) + 64 * MF_PS * h; qs = 16 * MF_PS; }
    else if (PASS == 2) { base = 16 * MF_PS * (c >> 4) + (c & 15) + 4 * MF_PS * h; qs = MF_PS; }
    else { base = (c >> 4) + 16 * (c & 15) + 4 * MF_NS * h; qs = MF_NS; }
    float yr[8], yi[8];
#pragma unroll
    for (int q = 0; q < 8; ++q) { float a = acc[q], b = acc[8 + q];
        if (PASS == 1) { const int s = (q & 3) + 8 * (q >> 2) + 4 * h; const cf w = tw[(c * s) & 4095]; const float wy = INV ? -w.y : w.y; const float t = a * w.x - b * wy; b = a * wy + b * w.x; a = t; }
        else if (PASS == 2) { const int s = (q & 3) + 8 * (q >> 2) + 4 * h; const cf w = tw256[(c & 15) * s]; const float wy = INV ? -w.y : w.y; const float t = a * w.x - b * wy; b = a * wy + b * w.x; a = t; }
        else if (EPI == 1) { const cf w = kf[q]; const float t = a * w.x - b * w.y; b = -(a * w.y + b * w.x); a = t; }
        else if (EPI == 2) { a *= rs; }
        else if (EPI == 3) { a *= rs; b *= rs; }
        yr[q] = a; yi[q] = b; }
    if (PASS == 3 && EPI == 4) {
        f32x2* ko = (f32x2*)const_cast<cf*>(kf) + c * 16 + 4 * h;
#pragma unroll
        for (int g = 0; g < 2; ++g) { *(f32x4*)(ko + 8 * g) = (f32x4){yr[4 * g], yi[4 * g], yr[4 * g + 1], yi[4 * g + 1]}; *(f32x4*)(ko + 8 * g + 2) = (f32x4){yr[4 * g + 2], yi[4 * g + 2], yr[4 * g + 3], yi[4 * g + 3]}; }
        return;
    }
#pragma unroll
    for (int q = 0; q < 8; q += 2) { const int o0 = base + qs * ((q & 3) + 8 * (q >> 2)), o1 = o0 + qs;
        const unsigned pr = cvtpk_v(yr[q], yr[q + 1]); outR[o0] = (bf16)(pr & 0xffffu); outR[o1] = (bf16)(pr >> 16);
        if (!(PASS == 3 && EPI == 2)) { const unsigned pi = cvtpk_v(yi[q], yi[q + 1]); outI[o0] = (bf16)(pi & 0xffffu); outI[o1] = (bf16)(pi >> 16); } }
}

__device__ __forceinline__ int mf_nat(int x) { return MF_NS * (x >> 8) + (x & 255); }
__device__ __forceinline__ void fo2_load(Frame& F, int q, FoRaw& r) {
    const int f = F.tid >> 8, pp = 2 * q + f, b = pp >> 8, c = 2 * (pp & 255), l0 = 16 * (F.tid & 255);
    const bf16* PT = WSP(bf16, WS_PT); const int r1 = 1536 + c, r2 = r1 + 1, tk = b * SEQ + l0;
    r.a0 = *(const u32x4*)pt_at(PT, r1, tk); r.d0 = *(const u32x4*)pt_at(PT, r2, tk); r.a1 = *(const u32x4*)pt_at(PT, r1, tk + 8); r.d1 = *(const u32x4*)pt_at(PT, r2, tk + 8);
}
__device__ __forceinline__ void fourier_items_mfma(Frame& F) {
    const int f = F.tid >> 8, r = F.tid & 255, l0 = 16 * r, n0 = mf_nat(l0);
    LAS bf16* S0R = (LAS bf16*)(F.lds + f * 49152); LAS bf16* S0I = S0R + MF_PLANE; LAS bf16* S1R = S0R + 2 * MF_PLANE; LAS bf16* S1I = S0R + 3 * MF_PLANE;
    const LAS cf* tw = (const LAS cf*)(F.lds + M_TW); const LAS cf* t256 = (const LAS cf*)(F.lds + M_TW256);
    DftFrag Mf; make_dft_frag(Mf, F.lane, false, tw);
    const int cb0 = 2 * (F.wave & 3);
    bf16* SP = WSP(bf16, WS_SP);
    FoRaw nx; int q = F.bid;
    if (q < 1024) fo2_load(F, q, nx);
    for (; q < 1024; q += F.G) {
        const int pp = 2 * q + f, b = pp >> 8, c = 2 * (pp & 255);
        *(LAS u32x4*)(S0R + n0) = nx.a0; *(LAS u32x4*)(S0R + n0 + 8) = nx.a1; *(LAS u32x4*)(S0I + n0) = nx.d0; *(LAS u32x4*)(S0I + n0 + 8) = nx.d1;
        if (q + F.G < 1024) fo2_load(F, q + F.G, nx);
        __syncthreads();
        mfft_block<1, false, 0>(S0R, S0I, S1R, S1I, Mf, tw, t256, cb0, F.lane, nullptr, 1.f); mfft_block<1, false, 0>(S0R, S0I, S1R, S1I, Mf, tw, t256, cb0 + 1, F.lane, nullptr, 1.f);
        __syncthreads();
        mfft_block<2, false, 0>(S1R, S1I, S0R, S0I, Mf, tw, t256, cb0, F.lane, nullptr, 1.f); mfft_block<2, false, 0>(S1R, S1I, S0R, S0I, Mf, tw, t256, cb0 + 1, F.lane, nullptr, 1.f);
        __syncthreads();
        mfft_block<3, false, 0>(S0R, S0I, S1R, S1I, Mf, tw, t256, cb0, F.lane, nullptr, 1.f); mfft_block<3, false, 0>(S0R, S0I, S1R, S1I, Mf, tw, t256, cb0 + 1, F.lane, nullptr, 1.f);
        __syncthreads();
        {
            const int k0 = 8 * r, m0 = mf_nat(k0);
            const u32x4 zr = *(const LAS u32x4*)(S1R + m0), zi = *(const LAS u32x4*)(S1I + m0);
            float Zr[8], Zi[8], Mr[8], Mi[8];
            Zr[0] = bflo(zr.x); Zr[1] = bfhi(zr.x); Zr[2] = bflo(zr.y); Zr[3] = bfhi(zr.y); Zr[4] = bflo(zr.z); Zr[5] = bfhi(zr.z); Zr[6] = bflo(zr.w); Zr[7] = bfhi(zr.w);
            Zi[0] = bflo(zi.x); Zi[1] = bfhi(zi.x); Zi[2] = bflo(zi.y); Zi[3] = bfhi(zi.y); Zi[4] = bflo(zi.z); Zi[5] = bfhi(zi.z); Zi[6] = bflo(zi.w); Zi[7] = bfhi(zi.w);
#pragma unroll
            for (int i = 0; i < 8; ++i) { const int km = mf_nat((4096 - k0 - i) & 4095); Mr[i] = bf1(S1R[km]); Mi[i] = bf1(S1I[km]); }
            float Ac[8], Bc[8], Ad[8], Bd[8];
#pragma unroll
            for (int i = 0; i < 8; ++i) { Ac[i] = 0.5f * (Zr[i] + Mr[i]); Bc[i] = 0.5f * (Mi[i] - Zi[i]); Ad[i] = 0.5f * (Zi[i] + Mi[i]); Bd[i] = 0.5f * (Zr[i] - Mr[i]); }
            if (k0 == 0) { const int kn = mf_nat(2048); Bc[0] = bf1(S1R[kn]); Bd[0] = bf1(S1I[kn]); }
            bf16* s0 = SP + ((size_t)(c * 8 + b) * 2) * 2048 + k0; bf16* s1 = SP + ((size_t)((c + 1) * 8 + b) * 2) * 2048 + k0;
            u32x4 o; o.x = pk2(Ac[0], Ac[1]); o.y = pk2(Ac[2], Ac[3]); o.z = pk2(Ac[4], Ac[5]); o.w = pk2(Ac[6], Ac[7]); st16_wt(s0, o);
            o.x = pk2(Bc[0], Bc[1]); o.y = pk2(Bc[2], Bc[3]); o.z = pk2(Bc[4], Bc[5]); o.w = pk2(Bc[6], Bc[7]); st16_wt(s0 + 2048, o);
            o.x = pk2(Ad[0], Ad[1]); o.y = pk2(Ad[2], Ad[3]); o.z = pk2(Ad[4], Ad[5]); o.w = pk2(Ad[6], Ad[7]); st16_wt(s1, o);
            o.x = pk2(Bd[0], Bd[1]); o.y = pk2(Bd[2], Bd[3]); o.z = pk2(Bd[4], Bd[5]); o.w = pk2(Bd[6], Bd[7]); st16_wt(s1 + 2048, o);
        }
        __syncthreads();
    }
    __syncthreads();
}
__device__ __forceinline__ void filter_items(Frame& F, int first, int stride) {
    const int f = F.tid >> 8;
    LAS bf16* A0R = (LAS bf16*)F.lds; LAS bf16* A0I = A0R + MF_PLANE; LAS bf16* B0R = (LAS bf16*)(F.lds + 49152); LAS bf16* B0I = B0R + MF_PLANE;
    LAS bf16* S0R = (LAS bf16*)(F.lds + f * 49152); LAS bf16* S0I = S0R + MF_PLANE; LAS bf16* S1R = S0R + 2 * MF_PLANE; LAS bf16* S1I = S0R + 3 * MF_PLANE;
    const LAS cf* tw = (const LAS cf*)(F.lds + M_TW); const LAS cf* t256 = (const LAS cf*)(F.lds + M_TW256);
    LAS float* kbl = (LAS float*)(F.lds + 133120);
    LAS float* red = (LAS float*)(F.lds + 149504);
    const cf w81 = mkc(0.99999970586288221916f, -0.00076699031874270453f);
    if (first >= 512) return;
    DftFrag Mf; make_dft_frag(Mf, F.lane, false, tw);
    const float* KT = WSP(float, WS_KT);
    const int l0 = 8 * F.tid, n0 = mf_nat(l0), cb0 = 2 * (F.wave & 3);
    f32x4 sf0, sf1, sb0, sb1, nf0, nf1, nb0, nb1;
    { const f32x4* pf = (const f32x4*)(KT + (size_t)first * 4096 + l0); const f32x4* pb = (const f32x4*)(KT + (size_t)(512 + first) * 4096 + l0); sf0 = pf[0]; sf1 = pf[1]; sb0 = pb[0]; sb1 = pb[1]; }
#pragma unroll 1
    for (int c = first; c < 512; c += stride) {
        *(LAS f32x4*)(kbl + l0) = sb0; *(LAS f32x4*)(kbl + l0 + 4) = sb1;
        float asum = (fabsf(sf0.x) + fabsf(sf0.y)) + (fabsf(sf0.z) + fabsf(sf0.w)) + (fabsf(sf1.x) + fabsf(sf1.y)) + (fabsf(sf1.z) + fabsf(sf1.w))
                   + ((l0 >= 1 ? fabsf(sb0.x) : 0.f) + fabsf(sb0.y)) + (fabsf(sb0.z) + fabsf(sb0.w)) + (fabsf(sb1.x) + fabsf(sb1.y)) + (fabsf(sb1.z) + fabsf(sb1.w));
        asum = wave_sum(asum);
        if (F.lane == 0) red[F.wave] = asum;
        { const int cn = (c + stride < 512) ? c + stride : c;
          const f32x4* pf = (const f32x4*)(KT + (size_t)cn * 4096 + l0); const f32x4* pb = (const f32x4*)(KT + (size_t)(512 + cn) * 4096 + l0); nf0 = pf[0]; nf1 = pf[1]; nb0 = pb[0]; nb1 = pb[1]; }
        __syncthreads();
        float tot = 0.f;
#pragma unroll
        for (int i = 0; i < 8; ++i) tot += red[i];
        const float sc = 1.0f / (tot * 8192.0f);
        {
            const float kfv[8] = {sf0.x, sf0.y, sf0.z, sf0.w, sf1.x, sf1.y, sf1.z, sf1.w};
            float ar[8], br[8], bi[8];
#pragma unroll
            for (int i = 0; i < 8; ++i) { const int n = l0 + i; const float kbm = (n >= 1) ? kbl[4096 - n] : 0.f;
                const float a = (kfv[i] + kbm) * sc, d = (kfv[i] - kbm) * sc;
                cf w = tw[(l0 >> 1) + (i >> 1)]; if (i & 1) w = cmul(w, w81);
                ar[i] = a; br[i] = d * w.x; bi[i] = d * w.y; }
            u32x4 v; v.x = pk2h(ar[0], ar[1]); v.y = pk2h(ar[2], ar[3]); v.z = pk2h(ar[4], ar[5]); v.w = pk2h(ar[6], ar[7]); *(LAS u32x4*)(A0R + n0) = v;
            *(LAS u32x4*)(A0I + n0) = (u32x4){0u, 0u, 0u, 0u};
            v.x = pk2h(br[0], br[1]); v.y = pk2h(br[2], br[3]); v.z = pk2h(br[4], br[5]); v.w = pk2h(br[6], br[7]); *(LAS u32x4*)(B0R + n0) = v;
            v.x = pk2h(bi[0], bi[1]); v.y = pk2h(bi[2], bi[3]); v.z = pk2h(bi[4], bi[5]); v.w = pk2h(bi[6], bi[7]); *(LAS u32x4*)(B0I + n0) = v;
        }
        __syncthreads();
        mfft_block<1, false, 0>(S0R, S0I, S1R, S1I, Mf, tw, t256, cb0, F.lane, nullptr, 1.f); mfft_block<1, false, 0>(S0R, S0I, S1R, S1I, Mf, tw, t256, cb0 + 1, F.lane, nullptr, 1.f);
        __syncthreads();
        mfft_block<2, false, 0>(S1R, S1I, S0R, S0I, Mf, tw, t256, cb0, F.lane, nullptr, 1.f); mfft_block<2, false, 0>(S1R, S1I, S0R, S0I, Mf, tw, t256, cb0 + 1, F.lane, nullptr, 1.f);
        __syncthreads();
        { const cf* KFo = (const cf*)(WSP(f32x2, WS_KF) + (size_t)c * 8192 + (size_t)f * 4096);
          mfft_block<3, false, 4>(S0R, S0I, S1R, S1I, Mf, tw, t256, cb0, F.lane, KFo, 1.f); mfft_block<3, false, 4>(S0R, S0I, S1R, S1I, Mf, tw, t256, cb0 + 1, F.lane, KFo, 1.f); }
        sf0 = nf0; sf1 = nf1; sb0 = nb0; sb1 = nb1;
        __syncthreads();
    }
}
__device__ __forceinline__ void hyena_items_mfma(Frame& F) {
    const int f = F.tid >> 8;
    LAS bf16* A0R = (LAS bf16*)F.lds; LAS bf16* A0I = A0R + MF_PLANE; LAS bf16* B0R = (LAS bf16*)(F.lds + 49152); LAS bf16* B0I = B0R + MF_PLANE;
    LAS bf16* S0R = (LAS bf16*)(F.lds + f * 49152); LAS bf16* S0I = S0R + MF_PLANE; LAS bf16* S1R = S0R + 2 * MF_PLANE; LAS bf16* S1I = S0R + 3 * MF_PLANE;
    const LAS cf* tw = (const LAS cf*)(F.lds + M_TW); const LAS cf* t256 = (const LAS cf*)(F.lds + M_TW256);
    const cf w81 = mkc(0.99999970586288221916f, -0.00076699031874270453f);
    DftFrag Mf; make_dft_frag(Mf, F.lane, false, tw);
    const bf16* PT = WSP(bf16, WS_PT); const float* cw = F.conv_w; const float* cb = F.conv_b;
    const int l0 = 8 * F.tid, n0 = mf_nat(l0), cb0 = 2 * (F.wave & 3), ln = F.lane & 31, lh = F.lane >> 5;
    HyRaw nx; int it = F.bid;
    if (it < 2048) hy_load(F, it, nx);
    for (; it < 2048; it += F.G) {
        const int c = it >> 2, bp = it & 3;
        float z0[8], z1[8];
        {
            const float a0 = cw[512 + c], a1 = cw[1536 + 512 + c], a2 = cw[3072 + 512 + c], ab = cb[512 + c];
            const float v0 = cw[1024 + c], v1 = cw[1536 + 1024 + c], v2 = cw[3072 + 1024 + c], vb = cb[1024 + c];
            float t1[8], t2[8];
            conv8(nx.a0, a0, a1, a2, ab, t1); conv8(nx.v0, v0, v1, v2, vb, t2);
#pragma unroll
            for (int i = 0; i < 8; ++i) z0[i] = t1[i] * t2[i];
            conv8(nx.a1, a0, a1, a2, ab, t1); conv8(nx.v1, v0, v1, v2, vb, t2);
#pragma unroll
            for (int i = 0; i < 8; ++i) z1[i] = t1[i] * t2[i];
        }
        {
            float br[8], bi[8];
#pragma unroll
            for (int i = 0; i < 8; ++i) { cf w = tw[(l0 >> 1) + (i >> 1)]; if (i & 1) w = cmul(w, w81); br[i] = z0[i] * w.x - z1[i] * w.y; bi[i] = z0[i] * w.y + z1[i] * w.x; }
            u32x4 v; v.x = pk2h(z0[0], z0[1]); v.y = pk2h(z0[2], z0[3]); v.z = pk2h(z0[4], z0[5]); v.w = pk2h(z0[6], z0[7]); *(LAS u32x4*)(A0R + n0) = v;
            v.x = pk2h(z1[0], z1[1]); v.y = pk2h(z1[2], z1[3]); v.z = pk2h(z1[4], z1[5]); v.w = pk2h(z1[6], z1[7]); *(LAS u32x4*)(A0I + n0) = v;
            v.x = pk2h(br[0], br[1]); v.y = pk2h(br[2], br[3]); v.z = pk2h(br[4], br[5]); v.w = pk2h(br[6], br[7]); *(LAS u32x4*)(B0R + n0) = v;
            v.x = pk2h(bi[0], bi[1]); v.y = pk2h(bi[2], bi[3]); v.z = pk2h(bi[4], bi[5]); v.w = pk2h(bi[6], bi[7]); *(LAS u32x4*)(B0I + n0) = v;
        }
        __syncthreads();
        mfft_block<1, false, 0>(S0R, S0I, S1R, S1I, Mf, tw, t256, cb0, F.lane, nullptr, 1.f); mfft_block<1, false, 0>(S0R, S0I, S1R, S1I, Mf, tw, t256, cb0 + 1, F.lane, nullptr, 1.f);
        cf kf[2][8];
        { const f32x4* KF = (const f32x4*)(WSP(f32x2, WS_KF) + (size_t)c * 8192 + (size_t)f * 4096);
#pragma unroll
          for (int j = 0; j < 2; ++j) { const int cc = 32 * (cb0 + j) + ln; const f32x4* kp = KF + (cc * 16 + 4 * lh) / 2;
              const f32x4 k0 = kp[0], k1 = kp[1], k2 = kp[4], k3 = kp[5];
              kf[j][0] = mkc(k0.x, k0.y); kf[j][1] = mkc(k0.z, k0.w); kf[j][2] = mkc(k1.x, k1.y); kf[j][3] = mkc(k1.z, k1.w);
              kf[j][4] = mkc(k2.x, k2.y); kf[j][5] = mkc(k2.z, k2.w); kf[j][6] = mkc(k3.x, k3.y); kf[j][7] = mkc(k3.z, k3.w); } }
        __syncthreads();
        mfft_block<2, false, 0>(S1R, S1I, S0R, S0I, Mf, tw, t256, cb0, F.lane, nullptr, 1.f); mfft_block<2, false, 0>(S1R, S1I, S0R, S0I, Mf, tw, t256, cb0 + 1, F.lane, nullptr, 1.f);
        __syncthreads();
        mfft_block<3, false, 1>(S0R, S0I, S1R, S1I, Mf, tw, t256, cb0, F.lane, kf[0], 1.f); mfft_block<3, false, 1>(S0R, S0I, S1R, S1I, Mf, tw, t256, cb0 + 1, F.lane, kf[1], 1.f);
        __syncthreads();
        mfft_block<1, false, 0>(S1R, S1I, S0R, S0I, Mf, tw, t256, cb0, F.lane, nullptr, 1.f); mfft_block<1, false, 0>(S1R, S1I, S0R, S0I, Mf, tw, t256, cb0 + 1, F.lane, nullptr, 1.f);
        __syncthreads();
        mfft_block<2, false, 0>(S0R, S0I, S1R, S1I, Mf, tw, t256, cb0, F.lane, nullptr, 1.f); mfft_block<2, false, 0>(S0R, S0I, S1R, S1I, Mf, tw, t256, cb0 + 1, F.lane, nullptr, 1.f);
        Row8 xa, xb;
        { const int tb = 2 * bp * SEQ; xa = row8_load(PT, c, tb, l0); xb = row8_load(PT, c, tb + SEQ, l0); }
        if (it + F.G < 2048) hy_load(F, it + F.G, nx);
        __syncthreads();
        mfft_block<3, false, 0>(S1R, S1I, S0R, S0I, Mf, tw, t256, cb0, F.lane, nullptr, 1.f); mfft_block<3, false, 0>(S1R, S1I, S0R, S0I, Mf, tw, t256, cb0 + 1, F.lane, nullptr, 1.f);
        __syncthreads();
        {
            const float w0 = cw[c], w1 = cw[1536 + c], w2 = cw[3072 + c], wb = cb[c]; const float bias = F.f_bias[c];
            bf16* YT = WSP(bf16, WS_YT) + (size_t)c * T_TOK + (size_t)(2 * bp) * SEQ;
            float x0a[8], x0b[8], ya[8], yb[8], er[8], ei[8], orr[8], oi[8];
            conv8(xa, w0, w1, w2, wb, x0a); conv8(xb, w0, w1, w2, wb, x0b);
            { const u32x4 a = *(const LAS u32x4*)(A0R + n0), b = *(const LAS u32x4*)(A0I + n0), d = *(const LAS u32x4*)(B0R + n0), g = *(const LAS u32x4*)(B0I + n0);
              er[0] = bflo(a.x); er[1] = bfhi(a.x); er[2] = bflo(a.y); er[3] = bfhi(a.y); er[4] = bflo(a.z); er[5] = bfhi(a.z); er[6] = bflo(a.w); er[7] = bfhi(a.w);
              ei[0] = bflo(b.x); ei[1] = bfhi(b.x); ei[2] = bflo(b.y); ei[3] = bfhi(b.y); ei[4] = bflo(b.z); ei[5] = bfhi(b.z); ei[6] = bflo(b.w); ei[7] = bfhi(b.w);
              orr[0] = bflo(d.x); orr[1] = bfhi(d.x); orr[2] = bflo(d.y); orr[3] = bfhi(d.y); orr[4] = bflo(d.z); orr[5] = bfhi(d.z); orr[6] = bflo(d.w); orr[7] = bfhi(d.w);
              oi[0] = bflo(g.x); oi[1] = bfhi(g.x); oi[2] = bflo(g.y); oi[3] = bfhi(g.y); oi[4] = bflo(g.z); oi[5] = bfhi(g.z); oi[6] = bflo(g.w); oi[7] = bfhi(g.w); }
#pragma unroll
            for (int i = 0; i < 8; ++i) { cf w = tw[(l0 >> 1) + (i >> 1)]; if (i & 1) w = cmul(w, w81);
                const float eim = -ei[i], oim = -oi[i];
                const float yr = er[i] + (orr[i] * w.x + oim * w.y), yi = eim + (oim * w.x - orr[i] * w.y);
                ya[i] = x0a[i] * (yr + bias * z0[i]); yb[i] = x0b[i] * (yi + bias * z1[i]); }
            u32x4 oa, ob; oa.x = pk2h(ya[0], ya[1]); oa.y = pk2h(ya[2], ya[3]); oa.z = pk2h(ya[4], ya[5]); oa.w = pk2h(ya[6], ya[7]);
            ob.x = pk2h(yb[0], yb[1]); ob.y = pk2h(yb[2], yb[3]); ob.z = pk2h(yb[4], yb[5]); ob.w = pk2h(yb[6], yb[7]);
            st16_wt(YT + l0, oa); st16_wt(YT + SEQ + l0, ob);
        }
        __syncthreads();
    }
}

__device__ __forceinline__ void phase_headnorm(Frame& F) {
    LAS float* tl = (LAS float*)F.lds;
    LAS float* rs = tl + 64 * 257;
    const bf16* YT = WSP(bf16, WS_YT); bf16* YN = WSP(bf16, WS_YN);
    u32x4 nxv[4];
    if (F.bid < 8 * 128) { const int h = F.bid & 7, tok0 = (F.bid >> 3) * 256;
#pragma unroll
        for (int i = 0; i < 4; ++i) { const int idx = F.tid + 512 * i, row = idx >> 5, ch = idx & 31; nxv[i] = *(const u32x4*)(YT + (size_t)(64 * h + row) * T_TOK + tok0 + 8 * ch); } }
    for (int it = F.bid; it < 8 * 128; it += F.G) {
        const int h = it & 7, tt = it >> 3, tok0 = tt * 256;
#pragma unroll
        for (int i = 0; i < 4; ++i) { const int idx = F.tid + 512 * i, row = idx >> 5, ch = idx & 31;
            const u32x4 v = nxv[i]; LAS float* d = tl + row * 257 + 8 * ch;
            d[0] = bflo(v.x); d[1] = bfhi(v.x); d[2] = bflo(v.y); d[3] = bfhi(v.y); d[4] = bflo(v.z); d[5] = bfhi(v.z); d[6] = bflo(v.w); d[7] = bfhi(v.w); }
        if (it + F.G < 8 * 128) { const int it2 = it + F.G, h2 = it2 & 7, tk2 = (it2 >> 3) * 256;
#pragma unroll
            for (int i = 0; i < 4; ++i) { const int idx = F.tid + 512 * i, row = idx >> 5, ch = idx & 31; nxv[i] = *(const u32x4*)(YT + (size_t)(64 * h2 + row) * T_TOK + tk2 + 8 * ch); } }
        __syncthreads();
        if (F.tid < 256) { float s = 0.f;
#pragma unroll 8
            for (int c = 0; c < 64; ++c) { const float v = tl[c * 257 + F.tid]; s += v * v; }
            rs[F.tid] = 1.0f / sqrtf(s * (1.0f / 64.0f) + EPS); }
        __syncthreads();
#pragma unroll
        for (int i = 0; i < 4; ++i) { const int idx = F.tid + 512 * i, tok = idx >> 3, q = idx & 7; const float r = rs[tok]; const float* g = F.mix_g + 64 * h + 8 * q;
            float v[8];
#pragma unroll
            for (int j = 0; j < 8; ++j) v[j] = tl[(8 * q + j) * 257 + tok] * r * g[j];
            u32x4 o; o.x = pk2(v[0], v[1]); o.y = pk2(v[2], v[3]); o.z = pk2(v[4], v[5]); o.w = pk2(v[6], v[7]);
            st16_wt(YN + (size_t)(tok0 + tok) * 1024 + 64 * h + 8 * q, o); }
        __syncthreads();
    }
}

constexpr int MX_NS = 288, MX_XA = 0, MX_XB = 64 * MX_NS * 2, MX_MT = 2 * MX_XB, MX_MTLO = MX_MT + 32768, MX_NYQ = MX_MTLO + 32768, MX_SLOT = 144;
__device__ __forceinline__ void mix_load(Frame& F, int tile, u32x4 (&v)[8]) {
    const int b = tile >> 6, g = (tile >> 3) & 7, kt = tile & 7; const bf16* SP = WSP(bf16, WS_SP);
#pragma unroll
    for (int u = 0; u < 8; ++u) { const int idx = F.tid + NTHREADS * u, row = idx >> 5, ch = idx & 31, ab = row >> 6, c = row & 63;
        v[u] = *(const u32x4*)(SP + ((size_t)((64 * g + c) * 8 + b) * 2 + ab) * 2048 + 256 * kt + 8 * ch); }
}
__device__ __forceinline__ void fourier_mix(Frame& F) {
    LAS bf16* XA = (LAS bf16*)(F.lds + MX_XA); LAS bf16* XB = (LAS bf16*)(F.lds + MX_XB);
    LAS u32x4* MT = (LAS u32x4*)(F.lds + MX_MT); LAS u32x4* MTL = (LAS u32x4*)(F.lds + MX_MTLO); LAS float* nyq = (LAS float*)(F.lds + MX_NYQ);
    LAS unsigned char* STG = F.lds;
    const bf16* SP = WSP(bf16, WS_SP); bf16* YN = WSP(bf16, WS_YN);
    LAS float* cst = nyq + 64;
    __syncthreads();
    if (F.tid < 64) { cst[F.tid] = cospif((float)F.tid * (1.0f / 32.0f)); cst[64 + F.tid] = sinpif((float)F.tid * (1.0f / 32.0f)); }
    __syncthreads();
    for (int idx = F.tid; idx < 32 * 64; idx += NTHREADS) { const int lane = idx & 63, fs = idx >> 6, rb = fs >> 3, s = fs & 7, i = lane & 31, h = lane >> 5;
        unsigned hw[4], lw[4];
#pragma unroll
        for (int jj = 0; jj < 4; ++jj) { unsigned hh[2], ll[2];
#pragma unroll
            for (int u = 0; u < 2; ++u) { const int j = 2 * jj + u, kap = 16 * s + 8 * h + j, c = kap & 63, isB = kap >> 6, cpp = 32 * rb + i, cp = cpp & 63, mir = cpp >> 6;
                const int m = (c * cp) & 63; const float cv = cst[m], sv = cst[64 + m];
                const float val = (isB ? (mir ? sv : -sv) : cv) * (1.0f / 512.0f);
                hh[u] = f2bf(val); ll[u] = f2bf(val - __builtin_bit_cast(float, hh[u] << 16)); }
            hw[jj] = hh[0] | (hh[1] << 16); lw[jj] = ll[0] | (ll[1] << 16); }
        MT[idx] = (u32x4){hw[0], hw[1], hw[2], hw[3]}; MTL[idx] = (u32x4){lw[0], lw[1], lw[2], lw[3]}; }
    u32x4 nxv[8];
    if (F.bid < 512) mix_load(F, F.bid, nxv);
    for (int tile = F.bid; tile < 512; tile += F.G) {
        const int b = tile >> 6, g = (tile >> 3) & 7, kt = tile & 7;
        __syncthreads();
#pragma unroll
        for (int u = 0; u < 8; ++u) { const int idx = F.tid + NTHREADS * u, row = idx >> 5, ch = idx & 31, ab = row >> 6, c = row & 63;
            u32x4 v = nxv[u];
            if (kt == 0 && ab == 1 && ch == 0) { nyq[c] = bflo(v.x); v.x &= 0xffff0000u; }
            *(LAS u32x4*)((ab ? XB : XA) + c * MX_NS + 8 * ch) = v; }
        if (tile + F.G < 512) mix_load(F, tile + F.G, nxv);
        __syncthreads();
        f32x16 acc[4];
#pragma unroll
        for (int rb = 0; rb < 4; ++rb) acc[rb] = (f32x16){0.f, 0.f, 0.f, 0.f, 0.f, 0.f, 0.f, 0.f, 0.f, 0.f, 0.f, 0.f, 0.f, 0.f, 0.f, 0.f};
        { int lane = F.lane; asm volatile("" : "+v"(lane));
          const int gq = lane >> 4, q = (lane & 15) >> 2, p = lane & 3;
#pragma unroll
          for (int s = 0; s < 8; ++s) {
              const LAS bf16* pr = ((s < 4) ? XA : XB) + (16 * (s & 3) + 8 * (gq >> 1) + q) * MX_NS + 32 * F.wave + 16 * (gq & 1) + 4 * p;
              const s16x4v r0 = lds_tr16(pr), r1 = lds_tr16(pr + 4 * MX_NS);
              asm volatile("" :: "v"(pr) : "memory");
              const bf16x8v bfr = (bf16x8v){r0[0], r0[1], r0[2], r0[3], r1[0], r1[1], r1[2], r1[3]};
#pragma unroll
              for (int rb = 0; rb < 4; ++rb) { const bf16x8v mh = __builtin_bit_cast(bf16x8v, MT[(rb * 8 + s) * 64 + lane]), ml = __builtin_bit_cast(bf16x8v, MTL[(rb * 8 + s) * 64 + lane]);
                  acc[rb] = __builtin_amdgcn_mfma_f32_32x32x16_bf16(mh, bfr, acc[rb], 0, 0, 0); acc[rb] = __builtin_amdgcn_mfma_f32_32x32x16_bf16(ml, bfr, acc[rb], 0, 0, 0); } } }
        float sk = 0.f, sm = 0.f;
#pragma unroll
        for (int r = 0; r < 16; ++r) { sk += acc[0][r] * acc[0][r] + acc[1][r] * acc[1][r]; sm += acc[2][r] * acc[2][r] + acc[3][r] * acc[3][r]; }
        sk += __shfl_xor(sk, 32); sm += __shfl_xor(sm, 32);
        const float rk = 1.0f / sqrtf(sk * (1.0f / 64.0f) + EPS), rm = 1.0f / sqrtf(sm * (1.0f / 64.0f) + EPS);
        __syncthreads();
        { const int n = F.lane & 31, hi = F.lane >> 5; const float* mg = F.mix_g + 512 + 64 * g;
#pragma unroll
          for (int rb = 0; rb < 4; ++rb) { const int slot = 32 * F.wave + n + ((rb >> 1) ? 256 : 0); const float rr = (rb >> 1) ? rm : rk;
#pragma unroll
              for (int rg = 0; rg < 4; ++rg) { const int cp = 32 * (rb & 1) + 8 * rg + 4 * hi; const f32x4 gg = *(const f32x4*)(mg + cp);
                  u32x2 w; w.x = pk2(acc[rb][4 * rg] * rr * gg.x, acc[rb][4 * rg + 1] * rr * gg.y); w.y = pk2(acc[rb][4 * rg + 2] * rr * gg.z, acc[rb][4 * rg + 3] * rr * gg.w);
                  *(LAS u32x2*)(STG + slot * MX_SLOT + 2 * cp) = w; } } }
        __syncthreads();
#pragma unroll
        for (int u = 0; u < 8; ++u) { const int idx = F.tid + NTHREADS * u, slot = idx >> 3, ch = idx & 7; const int kk = 256 * kt + (slot & 255);
            const int tok = b * SEQ + ((slot < 256) ? kk : (4096 - kk));
            if (!(slot >= 256 && kk == 0)) st16_wt(YN + (size_t)tok * 1024 + 512 + 64 * g + 8 * ch, *(const LAS u32x4*)(STG + slot * MX_SLOT + 16 * ch)); }
        if (kt == 0 && F.wave == 0) {
            const int cp = F.lane; float y = 0.f;
            for (int c = 0; c < 64; ++c) y += nyq[c] * cst[(c * cp) & 63];
            y *= (1.0f / 512.0f);
            const float r2 = 1.0f / sqrtf(wave_sum(y * y) * (1.0f / 64.0f) + EPS);
            YN[(size_t)(b * SEQ + 2048) * 1024 + 512 + 64 * g + cp] = (bf16)f2bf(y * r2 * F.mix_g[512 + 64 * g + cp]);
        }
    }
    __syncthreads();
}

__device__ __forceinline__ float wave_reduce8(const float (&a)[8], int lane) {
    const bool h5 = (lane & 32) != 0, h4 = (lane & 16) != 0, h3 = (lane & 8) != 0;
    float b[4], c[2], d;
#pragma unroll
    for (int i = 0; i < 4; ++i) { const float snd = h5 ? a[i] : a[4 + i], keep = h5 ? a[4 + i] : a[i]; b[i] = keep + __shfl_xor(snd, 32); }
#pragma unroll
    for (int i = 0; i < 2; ++i) { const float snd = h4 ? b[i] : b[2 + i], keep = h4 ? b[2 + i] : b[i]; c[i] = keep + __shfl_xor(snd, 16); }
    { const float snd = h3 ? c[0] : c[1], keep = h3 ? c[1] : c[0]; d = keep + __shfl_xor(snd, 8); }
    d += __shfl_xor(d, 4); d += __shfl_xor(d, 2); d += __shfl_xor(d, 1);
    return d;
}
__device__ __forceinline__ float rdlane(float v, int l) { return __builtin_bit_cast(float, __builtin_amdgcn_readlane(__builtin_bit_cast(int, v), l)); }
__device__ __forceinline__ void phase_route(Frame& F, const bf16* X1) {
    LAS float* slab = (LAS float*)F.lds;
    LAS float* fin = (LAS float*)(F.lds + 106496);
    LAS int* lcnt = (LAS int*)(F.lds + 147456);
    LAS int* lbase = lcnt + 32;
    LAS int* pe = lcnt + 64;
    LAS float* pw = (LAS float*)(pe + 256);
    LAS float* prr = pw + 256;
    LAS int* prow = (LAS int*)(prr + 256);
    LAS float* lbr = (LAS float*)(prow + 256);
    int* TOT = WSP(int, WS_TOT); int* LIST = WSP(int, WS_LIST); float* ROWW = WSP(float, WS_ROWW); float* ROWR = WSP(float, WS_ROWR);
    unsigned char* X1Q = WSP(unsigned char, WS_X1Q);
    const int n = F.lane & 15, fq = F.lane >> 4, w = F.wave;
    __syncthreads();
    if (F.tid < 32) lbr[F.tid] = F.b_router[F.tid];
    bf16x8v bh[4][3], bl[4][3];
#pragma unroll
    for (int s_ = 0; s_ < 4; ++s_)
#pragma unroll
        for (int c = 0; c < 3; ++c) { const int col = 16 * c + n;
#pragma unroll
            for (int j = 0; j < 8; ++j) { const int k = 128 * w + 32 * s_ + 8 * fq + j; float val = 0.f;
                if (col < 4) val = F.w_group[k * 4 + col]; else if (col < 36) val = F.w_router[((col - 4) >> 3) * 8192 + k * 8 + ((col - 4) & 7)];
                val *= F.norm2_g[k];
                const unsigned hb = f2bf(val); const float rem = val - __builtin_bit_cast(float, hb << 16);
                bh[s_][c][j] = (short)hb; bl[s_][c][j] = (short)f2bf(rem); } }
    const float bg0 = F.b_group[0], bg1 = F.b_group[1], bg2 = F.b_group[2], bg3 = F.b_group[3];
    for (int blk = F.bid; blk < 256; blk += F.G) {
        __syncthreads();
        if (F.tid < 32) lcnt[F.tid] = 0;
        __syncthreads();
        u32x4 a[2][2][4];
#define RT_LOAD(buf, pr) do { _Pragma("unroll") for (int tl_ = 0; tl_ < 2; ++tl_) { const GAS u32x4* xr = (const GAS u32x4*)(X1 + (size_t)(blk * 128 + (pr) * 32 + tl_ * 16 + n) * 1024 + 128 * w + 8 * fq); \
            _Pragma("unroll") for (int s_ = 0; s_ < 4; ++s_) a[buf][tl_][s_] = xr[4 * s_]; } } while (0)
        RT_LOAD(0, 0); RT_LOAD(1, 1);
#pragma unroll
        for (int pr = 0; pr < 4; ++pr) {
#pragma unroll
            for (int tl_ = 0; tl_ < 2; ++tl_) {
                const int tloc = (pr & 1) * 32 + tl_ * 16;
                const int tok = blk * 128 + pr * 32 + tl_ * 16 + n;
                f32x4 acc[3];
#pragma unroll
                for (int c = 0; c < 3; ++c) acc[c] = (f32x4){0.f, 0.f, 0.f, 0.f};
                float ss = 0.f;
#pragma unroll
                for (int s_ = 0; s_ < 4; ++s_) { const u32x4 av = a[pr & 1][tl_][s_]; const bf16x8v ab = __builtin_bit_cast(bf16x8v, av);
#pragma unroll
                    for (int c = 0; c < 3; ++c) { acc[c] = __builtin_amdgcn_mfma_f32_16x16x32_bf16(ab, bh[s_][c], acc[c], 0, 0, 0); acc[c] = __builtin_amdgcn_mfma_f32_16x16x32_bf16(ab, bl[s_][c], acc[c], 0, 0, 0); }
                    const float x0 = bflo(av.x), x1_ = bfhi(av.x), x2 = bflo(av.y), x3 = bfhi(av.y), x4 = bflo(av.z), x5 = bfhi(av.z), x6 = bflo(av.w), x7 = bfhi(av.w);
                    ss += ((x0 * x0 + x1_ * x1_) + (x2 * x2 + x3 * x3)) + ((x4 * x4 + x5 * x5) + (x6 * x6 + x7 * x7));
                    u32x2 o; o.x = pk4_fp8s(x0, x1_, x2, x3, 1.0f); o.y = pk4_fp8s(x4, x5, x6, x7, 1.0f);
                    *(GAS u32x2*)(X1Q + (size_t)tok * 1024 + 128 * w + 32 * s_ + 8 * fq) = o; }
                LAS float* sl = slab + ((w * 64 + tloc + 4 * fq) * 52 + n);
#pragma unroll
                for (int c = 0; c < 3; ++c)
#pragma unroll
                    for (int q = 0; q < 4; ++q) sl[q * 52 + 16 * c] = acc[c][q];
                ss += __shfl_xor(ss, 16); ss += __shfl_xor(ss, 32);
                if (fq == 0) slab[(w * 64 + tloc + n) * 52 + 48] = ss;
            }
            if (pr + 2 < 4) RT_LOAD(pr & 1, pr + 2);
            if (pr & 1) {
                __syncthreads();
                { const int tk = F.tid & 63, p = F.tid >> 6;
#pragma unroll
                  for (int i = 0; i < 5; ++i) { const int ci = p + 8 * i; if (ci < 37) { const int col = ci < 36 ? ci : 48; float sum = 0.f;
#pragma unroll
                          for (int ww = 0; ww < 8; ++ww) sum += slab[(ww * 64 + tk) * 52 + col];
                          fin[tk * 41 + ci] = sum; } } }
                __syncthreads();
                if (F.tid < 64) { const LAS float* f = fin + F.tid * 41;
                    const float rinv = 1.0f / sqrtf(f[36] * (1.f / 1024.f) + EPS);
                    const float gl0 = f[0] * rinv + bg0, gl1 = f[1] * rinv + bg1, gl2 = f[2] * rinv + bg2, gl3 = f[3] * rinv + bg3;
                    int gs = 0; float gm = gl0; if (gl1 > gm) { gm = gl1; gs = 1; } if (gl2 > gm) { gm = gl2; gs = 2; } if (gl3 > gm) { gm = gl3; gs = 3; }
                    const float pg = 1.0f / (expf(gl0 - gm) + expf(gl1 - gm) + expf(gl2 - gm) + expf(gl3 - gm));
                    float er[8];
#pragma unroll
                    for (int e = 0; e < 8; ++e) er[e] = f[4 + 8 * gs + e] * rinv + lbr[gs * 8 + e];
                    int i1 = 0; float m1 = er[0];
#pragma unroll
                    for (int e = 1; e < 8; ++e) if (er[e] > m1) { m1 = er[e]; i1 = e; }
                    int i2 = -1; float m2 = -3.0e38f;
#pragma unroll
                    for (int e = 0; e < 8; ++e) if (e != i1 && er[e] > m2) { m2 = er[e]; i2 = e; }
                    const float e2 = expf(m2 - m1); const float wa1 = pg / (1.0f + e2), wa2 = pg * e2 / (1.0f + e2);
                    const int lp = 2 * ((pr >> 1) * 64 + F.tid); pe[lp] = gs * 8 + i1; pe[lp + 1] = gs * 8 + i2; pw[lp] = wa1; pw[lp + 1] = wa2; prr[lp] = rinv; prr[lp + 1] = rinv;
                    atomicAdd((int*)&lcnt[gs * 8 + i1], 1); atomicAdd((int*)&lcnt[gs * 8 + i2], 1); }
            }
        }
#undef RT_LOAD
        __syncthreads();
        if (F.tid < 32) lbase[F.tid] = atomicAdd(&TOT[F.tid], lcnt[F.tid]);
        __syncthreads();
        if (F.tid < 32) { int nn = lbase[F.tid]; for (int p = 0; p < 256; ++p) if (pe[p] == F.tid) prow[p] = nn++; }
        __syncthreads();
        if (F.tid < 256) { const int row = pe[F.tid] * ECAP + prow[F.tid]; LIST[row] = blk * 256 + F.tid; ROWW[row] = pw[F.tid]; ROWR[row] = prr[F.tid]; }
    }
    __syncthreads();
}

__device__ __forceinline__ int build_tiles(Frame& F) {
    LAS int* tl = (LAS int*)(F.lds + L_TILES); LAS int* tnv = tl + MAX_TILES; LAS int* misc = tnv + MAX_TILES;
    const int* TOT = WSP(int, WS_TOT);
    __syncthreads();
    if (F.tid < 32) misc[33 + F.tid] = TOT[F.tid];
    __syncthreads();
    if (F.tid == 0) { int s = 0; for (int e = 0; e < 32; ++e) { misc[e] = s; s += (misc[33 + e] + 255) >> 8; } misc[32] = s; }
    __syncthreads();
    if (F.tid < 32) { const int e = F.tid, tot = misc[33 + e]; for (int j = 0, t = misc[e]; t < misc[e + 1]; ++j, ++t) { tl[t] = e * ECAP + 256 * j; tnv[t] = (tot - 256 * j) < 256 ? (tot - 256 * j) : 256; } }
    __syncthreads();
    return misc[32];
}

__device__ __forceinline__ void phase_final(Frame& F, const bf16* X1, float* OUT) {
    typedef float f2v __attribute__((ext_vector_type(2)));
    const int gw = F.vcu * NWAVES + F.wave, NGW = F.G * NWAVES; const unsigned char* YP = WSP(unsigned char, WS_YP);
    f32x4 gg[4];
#pragma unroll
    for (int j = 0; j < 4; ++j) gg[j] = ((const GAS f32x4*)F.final_g)[64 * j + F.lane];
    for (int t0 = 4 * gw; t0 < T_TOK; t0 += 4 * NGW) {
        u32x2 xw[4][4]; unsigned ya[4][4], yb[4][4];
#pragma unroll
        for (int r = 0; r < 4; ++r) { const int t = t0 + r;
            const GAS u32x2* xr = (const GAS u32x2*)(X1 + (size_t)t * 1024) + F.lane;
            const GAS unsigned* y0 = (const GAS unsigned*)(YP + (size_t)(2 * t) * 1024) + F.lane; const GAS unsigned* y1 = (const GAS unsigned*)(YP + (size_t)(2 * t + 1) * 1024) + F.lane;
#pragma unroll
            for (int j = 0; j < 4; ++j) { xw[r][j] = xr[64 * j]; ya[r][j] = y0[64 * j]; yb[r][j] = y1[64 * j]; } }
#pragma unroll
        for (int r = 0; r < 4; ++r) { const int t = t0 + r; GAS f32x4* orow = (GAS f32x4*)(OUT + (size_t)t * 1024) + F.lane;
            f32x4 v[4]; float s = 0.f;
#pragma unroll
            for (int j = 0; j < 4; ++j) { const u32x2 x = xw[r][j];
                const f2v a0 = __builtin_amdgcn_cvt_pk_f32_fp8((int)ya[r][j], false), a1 = __builtin_amdgcn_cvt_pk_f32_fp8((int)ya[r][j], true);
                const f2v b0 = __builtin_amdgcn_cvt_pk_f32_fp8((int)yb[r][j], false), b1 = __builtin_amdgcn_cvt_pk_f32_fp8((int)yb[r][j], true);
                const float is = 1.0f / pg8::YP_SCALE;
                v[j].x = bflo(x.x) + (a0[0] + b0[0]) * is; v[j].y = bfhi(x.x) + (a0[1] + b0[1]) * is; v[j].z = bflo(x.y) + (a1[0] + b1[0]) * is; v[j].w = bfhi(x.y) + (a1[1] + b1[1]) * is;
                s += (v[j].x * v[j].x + v[j].y * v[j].y) + (v[j].z * v[j].z + v[j].w * v[j].w); }
            const float rinv = 1.0f / sqrtf(wave_sum(s) * (1.f / 1024.f) + EPS);
#pragma unroll
            for (int j = 0; j < 4; ++j) { f32x4 o; o.x = v[j].x * rinv * gg[j].x; o.y = v[j].y * rinv * gg[j].y; o.z = v[j].z * rinv * gg[j].z; o.w = v[j].w * rinv * gg[j].w; orow[64 * j] = o; } }
    }
}

constexpr int N_PHASES = 10;
#ifndef MK_P4_SLEEP
#define MK_P4_SLEEP 0
#endif
#ifndef MK_STAGGER1
#define MK_STAGGER1 0
#endif
struct Args { const float* in[23]; float* out; unsigned char* ws; int ph_lo, ph_hi; };
static_assert(sizeof(Args) == 23 * 8 + 8 + 8 + 8, "Args has no padding");

__global__ void __launch_bounds__(NTHREADS, 2) mk_fwd(Args args) {
    extern __shared__ __attribute__((aligned(16))) unsigned char lds_raw[];
    Frame F;
    F.lds = (LAS unsigned char*)lds_raw; F.ws = args.ws;
    F.tid = threadIdx.x; F.lane = F.tid & 63; F.wave = __builtin_amdgcn_readfirstlane(F.tid >> 6);
    F.G = gridDim.x; F.bid = blockIdx.x; F.vcu = (F.G % 8 == 0) ? (F.bid % 8) * (F.G / 8) + F.bid / 8 : F.bid;
    F.x = args.in[0]; F.norm1_g = args.in[1]; F.w_in = args.in[2]; F.conv_w = args.in[3]; F.conv_b = args.in[4]; F.f_w_in = args.in[5]; F.f_b_in = args.in[6];
    F.f_w_mid = args.in[7]; F.f_b_mid = args.in[8]; F.f_freq = args.in[9]; F.f_w_out = args.in[10]; F.f_bias = args.in[11]; F.mix_g = args.in[12]; F.w_out = args.in[13];
    F.norm2_g = args.in[14]; F.w_group = args.in[15]; F.b_group = args.in[16]; F.w_router = args.in[17]; F.b_router = args.in[18]; F.w_gate = args.in[19]; F.w_up = args.in[20];
    F.w_down = args.in[21]; F.final_g = args.in[22]; F.out = args.out;
    volatile LAS unsigned* bst = (volatile LAS unsigned*)(F.lds + BARST_OFF);
    if (F.tid < 16) bst[F.tid] = 0u;
    __syncthreads();
    const int lo = args.ph_lo, hi = args.ph_hi;
    const bool need_bar = (hi - lo) > 1;
    XcdBarrier bar; bar.bar = (unsigned*)(F.ws + WS_CTL); bar.x = 0; bar.st = bst;
    if (need_bar) bar = xcd_barrier_post((unsigned*)(F.ws + WS_CTL), bst);
#define IN(k) (lo <= (k) && (k) < hi)
#ifndef MK_DUP
#define MK_DUP -1
#endif
#define REPS(k) (((k) == MK_DUP) ? 2 : 1)
#define SEAM(k) do { if (IN(k) && IN((k) + 1)) xcd_barrier(bar); } while (0)
    bf16* X1 = WSP(bf16, WS_X1);

    if (IN(0)) for (int rep_ = 0; rep_ < REPS(0); ++rep_) { if (rep_) xcd_barrier(bar); phase_prologue(F); } SEAM(0);

    if (IN(1)) {
        pg8::StaticOrder S; S.init(F.ws + WS_WIN_T, F.ws + WS_HN, NPT_ROWS, T_TOK, 1024, F.G, F.bid); S.reps = (MK_DUP == 11) ? 2 : REPS(1);
        pg8::EpiStorePT E{WSP(bf16, WS_PT), NPT_ROWS, WSP(float, WS_RINV1)};
        pg8::gemm_phase<pg8::EpiStorePT, pg8::StaticOrder>(F.lds, 1024, S, E);
        load_tw_lds(F, M_TW, M_TW256);
        filter_items(F, F.bid, F.G);
    } SEAM(1);

    if (IN(2)) for (int rep_ = 0; rep_ < REPS(2); ++rep_) { if (rep_) xcd_barrier(bar);
        load_tw_lds(F, M_TW, M_TW256);
        hyena_items_mfma(F);
        fourier_items_mfma(F);
    } SEAM(2);

    if (IN(3)) for (int rep_ = 0; rep_ < REPS(3); ++rep_) { if (rep_) xcd_barrier(bar); phase_headnorm(F); if (MK_DUP == 13) phase_headnorm(F); for (int rr_ = 0; rr_ < ((MK_DUP == 14) ? 2 : 1); ++rr_) fourier_mix(F); } SEAM(3);

    if (IN(4)) for (int rep_ = 0; rep_ < REPS(4); ++rep_) { if (rep_) xcd_barrier(bar);
        pg8::StaticOrder S; S.init(F.ws + WS_YN, F.ws + WS_WOUT_T, T_TOK, 1024, 1024, F.G, F.bid);
        pg8::EpiResBf16 E{WSP(bf16, WS_HN), X1, 1024};
#if MK_P4_SLEEP
        if ((F.bid >> 3) & 1) { for (int i_ = 0; i_ < MK_P4_SLEEP; ++i_) __builtin_amdgcn_s_sleep(127); }
#endif
        pg8::gemm_phase<pg8::EpiResBf16, pg8::StaticOrder>(F.lds, 1024, S, E);
    } SEAM(4);

    if (IN(5)) { phase_route(F, X1); } if (IN(5) && IN(7)) xcd_barrier(bar);


    if (IN(7)) for (int rep_ = 0; rep_ < REPS(7); ++rep_) { if (rep_) xcd_barrier(bar);
        const int ntiles = __builtin_amdgcn_readfirstlane(build_tiles(F)); const LAS int* tl = (const LAS int*)(F.lds + L_TILES);
        pg8::MoeGatherOrder S; S.init(F.ws + WS_X1Q, F.ws + WS_WGU_T, tl, tl + MAX_TILES, WSP(int, WS_LIST), ntiles, 1024, F.G, F.bid, 1);
        pg8::EpiSwiGLU E{WSP(unsigned char, WS_YT), WSP(float, WS_ROWR)};
        pg8::gemm_phase<pg8::EpiSwiGLU, pg8::MoeGatherOrder, true, true>(F.lds, 1024, S, E);
        if (rep_ == 0) {
            const int nwg = ntiles * 4, R = (nwg + F.G - 1) / F.G, nheavy = nwg - (R - 1) * F.G; const bool all = (nheavy >= F.G) || (nheavy <= 0);
            const int nl = all ? F.G : F.G - nheavy, li = all ? F.bid : F.bid - nheavy;
            if (li >= 0) wdown_items(F, li * NWAVES + F.wave, nl * NWAVES);
        }
    } SEAM(7);

    if (IN(8)) for (int rep_ = 0; rep_ < REPS(8); ++rep_) { if (rep_) xcd_barrier(bar);
        const int ntiles = __builtin_amdgcn_readfirstlane(build_tiles(F)); const LAS int* tl = (const LAS int*)(F.lds + L_TILES);
        pg8::MoeOrder S; S.init(F.ws + WS_YT, F.ws + WS_WD_T, tl, tl + MAX_TILES, ntiles, 512, F.G, F.bid, 1);
        pg8::EpiMoeDown E{WSP(unsigned char, WS_YP), WSP(int, WS_LIST), WSP(float, WS_ROWW)};
        pg8::gemm_phase<pg8::EpiMoeDown, pg8::MoeOrder, true, true>(F.lds, 512, S, E);
    } SEAM(8);

    if (IN(9)) { if (REPS(9) == 2) { phase_final(F, X1, WSP(float, WS_YT)); xcd_barrier(bar); } phase_final(F, X1, F.out); }
#undef IN
#undef SEAM
}


extern "C" void kernel_launch(void* const* d_in, const int* in_sizes, int n_in, void* d_out, int out_size, void* d_ws, size_t ws_size, hipStream_t stream) {
    static int grid = 0;
    if (grid == 0) {
        if (n_in != 23 || in_sizes[0] != T_TOK * D_MODEL || out_size != T_TOK * D_MODEL || ws_size < WS_END) { fprintf(stderr, "kernel_launch: unexpected shapes (n_in %d, in0 %d, out %d, ws %zu)\n", n_in, n_in > 0 ? in_sizes[0] : -1, out_size, ws_size); grid = -1; return; }
        int dev = 0, cus = 0;
        if (hipGetDevice(&dev) != hipSuccess || hipDeviceGetAttribute(&cus, hipDeviceAttributeMultiprocessorCount, dev) != hipSuccess) { grid = -1; return; }
        if (hipFuncSetAttribute((const void*)mk_fwd, hipFuncAttributeMaxDynamicSharedMemorySize, LDS_BYTES) != hipSuccess) { fprintf(stderr, "kernel_launch: hipFuncSetAttribute failed\n"); grid = -1; return; }
        int per_cu = 0;
        if (hipOccupancyMaxActiveBlocksPerMultiprocessor(&per_cu, (const void*)mk_fwd, NTHREADS, LDS_BYTES) != hipSuccess || per_cu < 1) fprintf(stderr, "kernel_launch: occupancy query reports %d\n", per_cu);
        (void)hipGetLastError();
        grid = cus;
    }
    if (grid < 0) return;
    (void)hipMemsetAsync((char*)d_ws + WS_CTL, 0, CTL_ZERO_BYTES, stream);
    Args a{};
    for (int i = 0; i < 23; ++i) a.in[i] = (const float*)d_in[i];
    a.out = (float*)d_out; a.ws = (unsigned char*)d_ws;
#if MK_N_LAUNCHES == 1
    a.ph_lo = 0; a.ph_hi = N_PHASES;
    hipLaunchKernelGGL(mk_fwd, dim3(grid), dim3(NTHREADS), LDS_BYTES, stream, a);
#else
    for (int p = 0; p < N_PHASES; ++p) {
        a.ph_lo = p; a.ph_hi = p + 1;
        hipLaunchKernelGGL(mk_fwd, dim3(grid), dim3(NTHREADS), LDS_BYTES, stream, a);
#ifdef MK_DUPLAUNCH
        if (p == MK_DUPLAUNCH) hipLaunchKernelGGL(mk_fwd, dim3(grid), dim3(NTHREADS), LDS_BYTES, stream, a);
#endif
#if MK_CHECK
        launch_checks(p, a, grid, stream);
#endif
    }
#if MK_CHECK
    launch_encode(a, grid, stream);
#endif
#endif
}
```
